# Optimizing an MI355X kernel written in HIP

```python
import math, functools
import jax, jax.numpy as jnp
from jax import lax
import numpy as np

D_MODEL = 2048
BATCH = 4
SEQ = 2048
DEPTH = 2

CTX_LEN = 256
GRID_W = 64
EPS = 1e-6
SHORT_CONV = 3

A_DK = 128
A_DV = 128
A_HEADS = D_MODEL // 128
A_QK = A_HEADS * A_DK
A_WIDTH = A_HEADS * A_DV
DN_CHUNK = 64
B_WIDTH = D_MODEL
C_WIDTH = D_MODEL
C_GROUPS = D_MODEL // 128
C_CHUNK = 128
D_WIDTH = D_MODEL
D_GROUPS = 4
D_GW = D_WIDTH // D_GROUPS
POOL_RADII = (1, 2, 4, 8)

N_EVEN = (DEPTH + 1) // 2
N_ODD = DEPTH // 2

QKV_W = 2 * A_QK + A_WIDTH
EVEN_SPLITS = (QKV_W, QKV_W + A_WIDTH, QKV_W + A_WIDTH + 4 * A_HEADS,
               QKV_W + A_WIDTH + 4 * A_HEADS + B_WIDTH,
               QKV_W + A_WIDTH + 4 * A_HEADS + 2 * B_WIDTH,
               QKV_W + A_WIDTH + 4 * A_HEADS + 3 * B_WIDTH)
EVEN_COLS = QKV_W + A_WIDTH + 4 * A_HEADS + 4 * B_WIDTH
ODD_SPLITS = (2 * C_WIDTH, 3 * C_WIDTH, 3 * C_WIDTH + D_WIDTH)
ODD_COLS = 3 * C_WIDTH + 2 * D_WIDTH

kernel_name = 'hybrid_deltanet_shortconv_chunkmlp_pool_prefix_dit'


def _rmsnorm(x, w):
    xf = x.astype(jnp.float32)
    y = xf * lax.rsqrt(jnp.mean(xf * xf, axis=-1, keepdims=True) + EPS)
    return (y * w).astype(x.dtype)


def _layernorm(x, w, b):
    xf = x.astype(jnp.float32)
    mu = jnp.mean(xf, axis=-1, keepdims=True)
    xc = xf - mu
    var = jnp.mean(xc * xc, axis=-1, keepdims=True)
    return (xc * lax.rsqrt(var + EPS) * w + b).astype(x.dtype)


def _l2norm(x):
    return x * lax.rsqrt(jnp.sum(x * x, axis=-1, keepdims=True) + EPS)


def _dwconv(t, w):
    K = w.shape[0]
    r = K // 2
    L = t.shape[-2]
    tp = jnp.pad(t, [(0, 0)] * (t.ndim - 2) + [(r, r), (0, 0)])
    out = tp[..., 0:L, :] * w[0]
    for i in range(1, K):
        out = out + tp[..., i:i + L, :] * w[i]
    return out


def _centred_mean(t, r):
    L = t.shape[-2]
    cs = jnp.cumsum(t.astype(jnp.float32), axis=-2)
    cs = jnp.concatenate([jnp.zeros_like(cs[..., :1, :]), cs], axis=-2)
    idx = jnp.arange(L)
    hi = jnp.minimum(idx + r + 1, L)
    lo = jnp.maximum(idx - r, 0)
    s = cs[..., hi, :] - cs[..., lo, :]
    cnt = (hi - lo).astype(jnp.float32)[:, None]
    return (s / cnt).astype(t.dtype)


def _on_rows(fn, t, arg):
    Bn, L, C = t.shape
    rows = L // GRID_W
    return fn(t.reshape(Bn, rows, GRID_W, C), arg).reshape(Bn, L, C)


_conv_latent = functools.partial(_on_rows, _dwconv)
_mean_latent = functools.partial(_on_rows, _centred_mean)


def _gdn_chunk_scan(q, k, v, g, beta, s0):
    Bn, H, L, dk = q.shape
    dv = v.shape[-1]
    C = DN_CHUNK
    n = L // C
    q = q * (dk ** -0.5)
    kb = k * beta[..., None]
    vb = v * beta[..., None]
    rs = lambda t: t.reshape((Bn, H, n, C) + t.shape[3:])
    q, k, kb, vb, g = rs(q), rs(k), rs(kb), rs(vb), rs(g)
    gc = jnp.cumsum(g, axis=-1)
    tril = jnp.tril(jnp.ones((C, C), dtype=bool))
    strict = jnp.tril(jnp.ones((C, C), dtype=bool), -1)
    decay = jnp.exp(jnp.where(tril, gc[..., :, None] - gc[..., None, :], -jnp.inf))
    m = jnp.where(strict, jnp.einsum('bhnid,bhnjd->bhnij', kb, k) * decay, 0.0)
    eye = jnp.eye(C, dtype=jnp.float32)
    t_inv = lax.linalg.triangular_solve(eye + m, jnp.broadcast_to(eye, m.shape),
                                        left_side=True, lower=True, unit_diagonal=True)
    w = jnp.einsum('bhnij,bhnjd->bhnid', t_inv, kb * jnp.exp(gc)[..., None])
    u = jnp.einsum('bhnij,bhnjd->bhnid', t_inv, vb)
    a_intra = jnp.where(tril, jnp.einsum('bhnid,bhnjd->bhnij', q, k) * decay, 0.0)
    qg = q * jnp.exp(gc)[..., None]
    kg = k * jnp.exp(gc[..., -1:] - gc)[..., None]
    g_last = jnp.exp(gc[..., -1])

    def step(S, xs):
        w_i, u_i, a_i, qg_i, kg_i, gl_i = xs
        v_new = u_i - w_i @ S
        o = qg_i @ S + a_i @ v_new
        S = S * gl_i[..., None, None] + jnp.swapaxes(kg_i, -1, -2) @ v_new
        return S, o

    mv = lambda t: jnp.moveaxis(t, 2, 0)
    S, o = lax.scan(step, s0, (mv(w), mv(u), mv(a_intra), mv(qg), mv(kg), mv(g_last)))
    o = jnp.moveaxis(o, 0, 2).reshape(Bn, H, L, dv)
    return o, S


def _even_stream(p, conv, w_conv_qkv, a_log, dt_bias, w_conv_b):
    qkv, z_a, ab, b_g, c_g, h_b, z_b = jnp.split(p, EVEN_SPLITS, axis=-1)
    Bn, L, _ = p.shape
    qkv = jax.nn.silu(conv(qkv, w_conv_qkv))
    q, k, v = jnp.split(qkv, (A_QK, 2 * A_QK), axis=-1)
    heads = lambda t, d: jnp.swapaxes(t.reshape(Bn, L, A_HEADS, d), 1, 2).astype(jnp.float32)
    q = _l2norm(heads(q, A_DK))
    k = _l2norm(heads(k, A_DK))
    v = heads(v, A_DV)
    ab = jnp.transpose(ab.astype(jnp.float32).reshape(Bn, L, 4, A_HEADS), (2, 0, 3, 1))
    a_raw, b_raw = ab[:2], ab[2:]
    g = -jnp.exp(a_log.astype(jnp.float32))[:, None, :, None] * jax.nn.softplus(
        a_raw + dt_bias.astype(jnp.float32)[:, None, :, None])
    beta = jax.nn.sigmoid(b_raw)
    y_b = b_g * conv(c_g * h_b, w_conv_b) * jax.nn.silu(z_b)
    return (q, k, v, g, beta), z_a, y_b


def _even_mixer(h_x, h_c, w_in, w_conv_qkv, a_log, dt_bias, head_norm, w_conv_b, w_out):
    (qx, kx, vx, gx, bx), zx, ybx = _even_stream(h_x @ w_in, _conv_latent, w_conv_qkv, a_log, dt_bias, w_conv_b)
    (qc, kc, vc, gcx, bc), zc, ybc = _even_stream(h_c @ w_in, _dwconv, w_conv_qkv, a_log, dt_bias, w_conv_b)
    Bn = h_x.shape[0]
    o_x = 0.0
    o_c = 0.0
    for d in range(2):
        f = (lambda t: jnp.flip(t, axis=2)) if d == 1 else (lambda t: t)
        s0 = jnp.zeros((Bn, A_HEADS, A_DK, A_DV), jnp.float32)
        oc_d, s_ctx = _gdn_chunk_scan(f(qc), f(kc), f(vc), f(gcx[d]), f(bc[d]), s0)
        ox_d, _ = _gdn_chunk_scan(f(qx), f(kx), f(vx), f(gx[d]), f(bx[d]), s_ctx)
        o_c = o_c + f(oc_d)
        o_x = o_x + f(ox_d)

    def finish(o, z, y_b):
        Bq, H, L, dv = o.shape
        o = _rmsnorm(o, head_norm)
        o = jnp.swapaxes(o, 1, 2).reshape(Bq, L, A_WIDTH).astype(z.dtype) * jax.nn.silu(z)
        return jnp.concatenate([o, y_b], axis=-1) @ w_out

    return finish(o_x, zx, ybx), finish(o_c, zc, ybc)


def _chunk_token_mix(u, v, w_s, b_s):
    Bn, L, _ = v.shape
    n = L // C_CHUNK
    vr = v.reshape(Bn, n, C_CHUNK, C_GROUPS, C_WIDTH // C_GROUPS)
    s = jnp.einsum('gpq,bnqgc->bnpgc', w_s, vr) + b_s.T[:, :, None]
    return u * s.reshape(Bn, L, C_WIDTH)


def _multi_scale_pool(p, mean_fn, pool_w, pool_scale):
    groups = jnp.split(p, D_GROUPS, axis=-1)
    diffs = jnp.stack([mean_fn(gp, r) - gp for gp, r in zip(groups, POOL_RADII)], axis=-2)
    y = jnp.einsum('blgc,gcd->blgd', diffs, pool_w).reshape(p.shape)
    return y * pool_scale


def _odd_stream(p, mean_fn, ln_w, ln_b, w_s, b_s, pool_w, pool_scale, w_out):
    uv, z_c, p_d, z_d = jnp.split(p, ODD_SPLITS, axis=-1)
    u, v = jnp.split(jax.nn.gelu(uv), 2, axis=-1)
    y_c = _chunk_token_mix(u, _layernorm(v, ln_w, ln_b), w_s, b_s) * jax.nn.silu(z_c)
    y_d = _multi_scale_pool(p_d, mean_fn, pool_w, pool_scale) * jax.nn.silu(z_d)
    return jnp.concatenate([y_c, y_d], axis=-1) @ w_out


def setup_inputs(seed: int = 0) -> dict:
    key = jax.random.key(seed)
    ks = jax.random.split(key, 24)
    nrm = lambda k, shape, s: jax.random.normal(k, shape, jnp.float32) * s
    D = D_MODEL
    x = nrm(ks[0], (BATCH, SEQ, D), 1.0)
    c = nrm(ks[1], (BATCH, D), 1.0)
    ctx = nrm(ks[2], (BATCH, CTX_LEN, D), 1.0)
    c_ctx = nrm(ks[3], (D,), 1.0)
    ada_w = nrm(ks[4], (DEPTH, D, 3 * D), 0.5 * D ** -0.5)
    ada_b = nrm(ks[5], (DEPTH, 3 * D), 0.02)
    norm_w = 1.0 + nrm(ks[6], (DEPTH, D), 0.02)
    e_w_in = nrm(ks[7], (N_EVEN, D, EVEN_COLS), D ** -0.5)
    e_conv_qkv = nrm(ks[8], (N_EVEN, SHORT_CONV, QKV_W), SHORT_CONV ** -0.5)
    e_a_log = jnp.log(jax.random.uniform(ks[9], (N_EVEN, 2, A_HEADS), jnp.float32, 1.0, 16.0))
    dt = jnp.exp(jax.random.uniform(ks[10], (N_EVEN, 2, A_HEADS), jnp.float32, math.log(1e-3), math.log(0.1)))
    e_dt_bias = dt + jnp.log(-jnp.expm1(-dt))
    e_head_norm = 1.0 + nrm(ks[11], (N_EVEN, A_DV), 0.02)
    e_conv_b = nrm(ks[12], (N_EVEN, SHORT_CONV, B_WIDTH), SHORT_CONV ** -0.5)
    e_w_out = nrm(ks[13], (N_EVEN, A_WIDTH + B_WIDTH, D), (A_WIDTH + B_WIDTH) ** -0.5)
    o_w_in = nrm(ks[14], (N_ODD, D, ODD_COLS), D ** -0.5)
    o_ln_w = 1.0 + nrm(ks[15], (N_ODD, C_WIDTH), 0.02)
    o_ln_b = nrm(ks[16], (N_ODD, C_WIDTH), 0.02)
    o_w_s = nrm(ks[17], (N_ODD, C_GROUPS, C_CHUNK, C_CHUNK), C_CHUNK ** -0.5)
    o_b_s = nrm(ks[18], (N_ODD, C_GROUPS, C_CHUNK), 0.02)
    o_pool_w = nrm(ks[19], (N_ODD, D_GROUPS, D_GW, D_GW), D_GW ** -0.5)
    o_pool_scale = 1.0 + nrm(ks[20], (N_ODD, D_WIDTH), 0.1)
    o_w_out = nrm(ks[21], (N_ODD, C_WIDTH + D_WIDTH, D), (C_WIDTH + D_WIDTH) ** -0.5)
    final_norm_w = 1.0 + nrm(ks[22], (D,), 0.02)
    return {'x': x, 'c': c, 'ctx': ctx, 'c_ctx': c_ctx, 'ada_w': ada_w, 'ada_b': ada_b, 'norm_w': norm_w,
            'e_w_in': e_w_in, 'e_conv_qkv': e_conv_qkv, 'e_a_log': e_a_log, 'e_dt_bias': e_dt_bias,
            'e_head_norm': e_head_norm, 'e_conv_b': e_conv_b, 'e_w_out': e_w_out,
            'o_w_in': o_w_in, 'o_ln_w': o_ln_w, 'o_ln_b': o_ln_b, 'o_w_s': o_w_s, 'o_b_s': o_b_s,
            'o_pool_w': o_pool_w, 'o_pool_scale': o_pool_scale, 'o_w_out': o_w_out,
            'final_norm_w': final_norm_w}


def reference(x, c, ctx, c_ctx, ada_w, ada_b, norm_w, e_w_in, e_conv_qkv, e_a_log, e_dt_bias, e_head_norm,
              e_conv_b, e_w_out, o_w_in, o_ln_w, o_ln_b, o_w_s, o_b_s, o_pool_w, o_pool_scale, o_w_out,
              final_norm_w):
    for layer in range(DEPTH):
        last = layer == DEPTH - 1
        even = layer % 2 == 0
        i = layer // 2
        need_ctx = even or not last
        mod_x = jax.nn.silu(c) @ ada_w[layer] + ada_b[layer]
        sh_x, sc_x, gt_x = jnp.split(mod_x[:, None, :], 3, axis=-1)
        h_x = _rmsnorm(x, norm_w[layer]) * (1.0 + sc_x) + sh_x
        if need_ctx:
            mod_c = jax.nn.silu(c_ctx) @ ada_w[layer] + ada_b[layer]
            sh_c, sc_c, gt_c = jnp.split(mod_c, 3, axis=-1)
            h_c = _rmsnorm(ctx, norm_w[layer]) * (1.0 + sc_c) + sh_c
        if even:
            y_x, y_c = _even_mixer(h_x, h_c, e_w_in[i], e_conv_qkv[i], e_a_log[i], e_dt_bias[i],
                                   e_head_norm[i], e_conv_b[i], e_w_out[i])
        else:
            odd_args = (o_ln_w[i], o_ln_b[i], o_w_s[i], o_b_s[i], o_pool_w[i], o_pool_scale[i], o_w_out[i])
            y_x = _odd_stream(h_x @ o_w_in[i], _mean_latent, *odd_args)
            if need_ctx:
                y_c = _odd_stream(h_c @ o_w_in[i], _centred_mean, *odd_args)
        x = x + gt_x * y_x
        if not last:
            ctx = ctx + gt_c * y_c
    return _rmsnorm(x, final_norm_w)
```

```cpp
#include <hip/hip_runtime.h>
#include <hip/hip_cooperative_groups.h>
#include <cstdio>
#include <cstdint>
namespace cg = cooperative_groups;

#ifndef MK_N_LAUNCHES
#define MK_N_LAUNCHES 14
#endif
#ifndef DBG_SEL
#define DBG_SEL 200
#endif
#ifndef ABLATE
#define ABLATE 0
#endif
#ifndef STOP_AFTER
#define STOP_AFTER 13
#endif

#define LAS __attribute__((address_space(3)))
typedef unsigned short bf16_t;
typedef short bf16x8 __attribute__((ext_vector_type(8)));
typedef float f32x2 __attribute__((ext_vector_type(2)));
typedef float f32x4 __attribute__((ext_vector_type(4)));
typedef float f32x16 __attribute__((ext_vector_type(16)));
typedef unsigned u32x2 __attribute__((ext_vector_type(2)));
typedef unsigned u32x4 __attribute__((ext_vector_type(4)));

constexpr int DM = 2048, NB = 4, SEQ = 2048, CTXL = 256, MX = NB * SEQ, MC = NB * CTXL, MT = MX + MC;
constexpr int NTOK = CTXL + SEQ;
constexpr int NHD = 16, HD = 128, NBH = NB * NHD;
constexpr int N1SRC = 16448, N1P = 16640, N3 = 10240;
constexpr int NCH = NTOK / 64;
constexpr float EPS = 1e-6f;
constexpr int NPHASE = 14;

constexpr size_t MiB = 1u << 20;
constexpr size_t WS_CTL = 0, CTL_BYTES = 1 * MiB;
constexpr size_t WS_MOD = 1 * MiB;
constexpr size_t WS_GG = 2 * MiB, WS_BETA = 4 * MiB, WS_GC = 6 * MiB;
constexpr size_t WS_STATS = 7 * MiB + 512 * 1024;
constexpr size_t WS_WT2 = 8 * MiB;
constexpr size_t WS_WT1 = 24 * MiB;
constexpr size_t WS_WT3 = 24 * MiB, WS_WT4 = 64 * MiB, WS_WTP = 80 * MiB;
constexpr size_t WS_H = 89 * MiB;
constexpr size_t WS_OB = 89 * MiB;
constexpr size_t WS_PQKV = 125 * MiB;
constexpr size_t WS_TU = 125 * MiB, WS_AI = 161 * MiB, WS_OF = 197 * MiB;
constexpr size_t WS_ZA = 233 * MiB;
constexpr size_t WS_AB = 265 * MiB;
constexpr size_t WS_Y = 268 * MiB;
constexpr size_t WS_QN = 332 * MiB, WS_KN = 368 * MiB, WS_KT = 404 * MiB, WS_VT = 440 * MiB;
constexpr size_t WS_P1 = 125 * MiB;
constexpr size_t WS_DIFF = 285 * MiB;
constexpr size_t WS_Y2 = 396 * MiB;
constexpr size_t WS_END = 476 * MiB;
constexpr int CW_BAR = 4096;

constexpr int LDS_BYTES = 147456;
constexpr int MISC_OFF = LDS_BYTES - 256;

__device__ __forceinline__ float bf_lo(unsigned w) { return __uint_as_float(w << 16); }
__device__ __forceinline__ float bf_hi(unsigned w) { return __uint_as_float(w & 0xffff0000u); }
__device__ __forceinline__ float bf2f(bf16_t b) { return __uint_as_float(((unsigned)b) << 16); }
typedef __bf16 bf16v2 __attribute__((ext_vector_type(2)));
__device__ __forceinline__ unsigned cvt_pk_bf16(float lo, float hi) { const f32x2 v = {lo, hi}; const bf16v2 r = __builtin_convertvector(v, bf16v2); return __builtin_bit_cast(unsigned, r); }
__device__ __forceinline__ bf16_t f2bf(float f) { return (bf16_t)(cvt_pk_bf16(f, 0.f) & 0xffffu); }
__device__ __forceinline__ float sigmoid_f(float x) { return __builtin_amdgcn_rcpf(1.0f + __expf(-x)); }
__device__ __forceinline__ float silu_f(float x) { return x * sigmoid_f(x); }
__device__ __forceinline__ float gelu_f(float x) { const float u = 0.7978845608028654f * (x + 0.044715f * x * x * x); return x * sigmoid_f(2.0f * u); }
__device__ __forceinline__ float softplus_f(float x) { return fmaxf(x, 0.f) + log1pf(__expf(-fabsf(x))); }
__device__ __forceinline__ float wave_sum(float v) {
#pragma unroll
    for (int o = 1; o < 64; o <<= 1) v += __shfl_xor(v, o);
    return v;
}
__device__ __forceinline__ float dpp_shr1(float x, float old) { return __builtin_bit_cast(float, __builtin_amdgcn_update_dpp(__builtin_bit_cast(int, old), __builtin_bit_cast(int, x), 0x111, 0xf, 0xf, false)); }
__device__ __forceinline__ float dpp_shl1(float x, float old) { return __builtin_bit_cast(float, __builtin_amdgcn_update_dpp(__builtin_bit_cast(int, old), __builtin_bit_cast(int, x), 0x101, 0xf, 0xf, false)); }
#ifndef MK_DEBUG
#define MK_DEBUG 0
#endif
#define LDS_WAIT() asm volatile("s_waitcnt lgkmcnt(0)" ::: "memory")

#define XB_TMO      128
#define XB_XCNT(j)  (256  + 64 * (j))
#define XB_XSUB(j)  (1280 + 64 * (j))
#define XB_XGEN(j)  (2304 + 64 * (j))
#define XB_TOP      3328
#define XB_TOPGEN   3392
#define XCD_BAR_WORDS 3456
#define XB_SPIN_CAP (1u << 20)
__device__ __forceinline__ unsigned xb_ld(unsigned* p)              { return __hip_atomic_load(p, __ATOMIC_RELAXED, __HIP_MEMORY_SCOPE_AGENT); }
__device__ __forceinline__ unsigned xb_add(unsigned* p, unsigned v) { return __hip_atomic_fetch_add(p, v, __ATOMIC_RELAXED, __HIP_MEMORY_SCOPE_AGENT); }
__device__ __forceinline__ unsigned xb_xcc_id() { return (unsigned)__builtin_amdgcn_s_getreg((3 << 11) | 20) & 0xFu; }
#define XB_SPIN(cond, bar) do { unsigned _sp = 0; while (cond) { __builtin_amdgcn_s_sleep(1); \
    if ((++_sp & 255u) == 0u) { if (xb_ld(&(bar)[XB_TMO])) break; if (_sp > XB_SPIN_CAP) { atomicAdd(&(bar)[XB_TMO], 1u); break; } } } } while (0)
struct XcdBarrier { unsigned* bar; unsigned x; volatile LAS unsigned* st; };
__device__ __forceinline__ XcdBarrier xcd_barrier_post(unsigned* bar, volatile LAS unsigned* st) {
    XcdBarrier b; b.bar = bar; b.x = xb_xcc_id(); b.st = st;
    if (threadIdx.x == 0) (void)xb_add(&bar[XB_XCNT(b.x)], 1u);
    return b;
}
__device__ __forceinline__ void xcd_barrier_complete(unsigned* bar, unsigned x, unsigned& nloc, unsigned& nx) {
    const unsigned G = gridDim.x * gridDim.y * gridDim.z;
    unsigned sum, cnt, mine, sp = 0u;
    for (;;) {
        sum = 0u; cnt = 0u; mine = 0u;
#pragma unroll
        for (unsigned j = 0; j < 16; ++j) { const unsigned c = xb_ld(&bar[XB_XCNT(j)]); sum += c; cnt += (c > 0u) ? 1u : 0u; mine = (j == x) ? c : mine; }
        if (sum == G) break;
        __builtin_amdgcn_s_sleep(1);
        if ((++sp & 255u) == 0u) { if (xb_ld(&bar[XB_TMO])) break; if (sp > XB_SPIN_CAP) { atomicAdd(&bar[XB_TMO], 1u); break; } }
    }
    nloc = mine > 0u ? mine : 1u; nx = cnt > 0u ? cnt : 1u;
}
__device__ __forceinline__ void xcd_barrier(const XcdBarrier& b) {
    asm volatile("s_waitcnt vmcnt(0)" ::: "memory");
    __syncthreads();
    if (threadIdx.x == 0) {
        unsigned* bar = b.bar;
        __builtin_amdgcn_s_waitcnt(0);
        unsigned nloc = b.st[0], nx = b.st[1];
        if (nloc == 0u) { xcd_barrier_complete(bar, b.x, nloc, nx); b.st[0] = nloc; b.st[1] = nx; }
        const unsigned old = xb_add(&bar[XB_XSUB(b.x)], 1u);
        const unsigned gen = old / nloc;
        if (old + 1u == (gen + 1u) * nloc) {
            __builtin_amdgcn_fence(__ATOMIC_RELEASE, "agent");
            asm volatile("s_waitcnt vmcnt(0)" ::: "memory");
            const unsigned og = xb_add(&bar[XB_TOP], 1u);
            const unsigned tg = og / nx;
            if (og + 1u == (tg + 1u) * nx) xb_add(&bar[XB_TOPGEN], 1u);
            else XB_SPIN(xb_ld(&bar[XB_TOPGEN]) == tg, bar);
            __builtin_amdgcn_fence(__ATOMIC_ACQUIRE, "agent");
            xb_add(&bar[XB_XGEN(b.x)], 1u);
            asm volatile("s_waitcnt vmcnt(0)" ::: "memory");
        } else {
            XB_SPIN(xb_ld(&bar[XB_XGEN(b.x)]) == gen, bar);
            __builtin_amdgcn_fence(__ATOMIC_ACQUIRE, "agent");
            asm volatile("s_waitcnt vmcnt(0)" ::: "memory");
        }
    }
    __syncthreads();
}

namespace pg8 {
constexpr int BM = 256, BK = 64, HALF = 128, HTB = HALF * BK * 2, STAGE_BYTES = 8 * HTB, NXCD = 8, WGM = 8;
__host__ __device__ __forceinline__ int lds_byte(int r, int c) { const int st = (r >> 4) * 2 + (c >> 5), rr = r & 15, cc = c & 31, ob = rr * 64 + cc * 2; return st * 1024 + (ob ^ (((ob >> 9) & 1) << 5)); }
__host__ __device__ __forceinline__ void stage_rc(int b, int& R, int& C) { const int st = b / 1024, sb = b % 1024, swz = sb ^ (((sb >> 9) & 1) << 5); R = (st >> 1) * 16 + swz / 64; C = (st & 1) * 32 + (swz % 64) / 2; }
__host__ __device__ __forceinline__ int perm32(int rho) { const int n = rho >> 4, i = rho & 15; return 8 * (i >> 2) + 4 * n + (i & 3); }
struct Unit { int pm, pn, aux; const char* a; const char* b; };
__device__ __forceinline__ void tile_order(int L, int nM, int nN, int& pm, int& pn) {
    const int nwg = nM * nN; int wgid = L;
    { const int q = nwg / NXCD, r = nwg % NXCD, xcd = wgid % NXCD, off = wgid / NXCD; wgid = (xcd < r ? xcd * (q + 1) : r * (q + 1) + (xcd - r) * q) + off; }
    const int nig = WGM * nN, gid = wgid / nig, fm = gid * WGM, gsz = (nM - fm) < WGM ? (nM - fm) : WGM;
    pm = fm + ((wgid % nig) % gsz); pn = (wgid % nig) / gsz;
}
struct StaticOrder {
    int nM, nN, G, c; const char* A; const char* B; size_t ta, tb;
    __device__ __forceinline__ bool next(int i, Unit& u) const {
        const long L = (long)i * G + c; if (L >= (long)nM * nN) return false;
        tile_order((int)L, nM, nN, u.pm, u.pn); u.aux = 0; u.a = A + (size_t)u.pm * ta; u.b = B + (size_t)u.pn * tb; return true;
    }
};
#define PG8_LAS __attribute__((address_space(3)))
template <class Epi, class Sched>
__device__ __forceinline__ void gemm_phase(PG8_LAS unsigned char* lds, const int K, const int lda, const int ldb, const Sched& S, const Epi& E) {
    const int tid = threadIdx.x, wid = __builtin_amdgcn_readfirstlane(tid >> 6), lane = tid & 63, wr = wid >> 2, wc = wid & 3, fr = lane & 15, fq = lane >> 4;
    const int nt = K / BK;
    unsigned voffA[2], voffB[2];
#pragma unroll
    for (int i = 0; i < 2; ++i) { int R, C; stage_rc(tid * 16 + i * 8192, R, C); const int Rb = Epi::PERM ? ((R & ~31) + perm32(R & 31)) : R;
        voffA[i] = (unsigned)(R * lda + C) * 2u; voffB[i] = (unsigned)(Rb * ldb + C) * 2u; }
    const size_t kstep = (size_t)(BK * 2);
    const size_t hstepA = (size_t)HALF * lda * 2, hstepB = (size_t)HALF * ldb * 2;
    const unsigned ldsw = (unsigned)wid * 1024u;
    const int aoff = lds_byte(wr * 64 + fr, fq * 8), boff = lds_byte(wc * 32 + fr, fq * 8);
#define PG8_SA(b, h) (((b) * 2 + (h)) * HTB)
#define PG8_SB(b, h) ((4 + (b) * 2 + (h)) * HTB)
#define PG8_STAGE(bufoff, gbase, voff) do { _Pragma("unroll") for (int _i = 0; _i < 2; ++_i) \
        __builtin_amdgcn_global_load_lds((const unsigned*)((const char*)(gbase) + (voff)[_i]), (PG8_LAS unsigned*)(lds + (bufoff) + ldsw + _i * 8192), 16, 0, 0); } while (0)
#define PG8_LDA(dst, b, h) do { _Pragma("unroll") for (int m = 0; m < 4; ++m) _Pragma("unroll") for (int k = 0; k < 2; ++k) dst[m][k] = *(const PG8_LAS bf16x8*)(lds + PG8_SA(b, h) + aoff + m * 2048 + k * 1024); } while (0)
#define PG8_LDB(dst, b, h) do { _Pragma("unroll") for (int n = 0; n < 2; ++n) _Pragma("unroll") for (int k = 0; k < 2; ++k) dst[n][k] = *(const PG8_LAS bf16x8*)(lds + PG8_SB(b, h) + boff + n * 2048 + k * 1024); } while (0)
#define PG8_MMA(ai, bj, At, Bt) do { __builtin_amdgcn_s_setprio(1); _Pragma("unroll") for (int m = 0; m < 4; ++m) _Pragma("unroll") for (int n = 0; n < 2; ++n) _Pragma("unroll") for (int k = 0; k < 2; ++k) \
        acc[ai][bj][m][n] = __builtin_amdgcn_mfma_f32_16x16x32_bf16(Bt[n][k], At[m][k], acc[ai][bj][m][n], 0, 0, 0); __builtin_amdgcn_s_setprio(0); } while (0)
#define PG8_WAIT_V(n) asm volatile("s_waitcnt vmcnt(" #n ")" ::: "memory")
#define PG8_WAIT_L(n) asm volatile("s_waitcnt lgkmcnt(" #n ")" ::: "memory")
#define PG8_BAR __builtin_amdgcn_s_barrier()
#define PG8_SCHED __builtin_amdgcn_sched_barrier(0)
    Unit cur, nxt; int ui = 0;
    if (!S.next(0, cur)) return;
    f32x4 acc[2][2][4][2];
#pragma unroll
    for (int a = 0; a < 2; ++a)
#pragma unroll
        for (int b = 0; b < 2; ++b)
#pragma unroll
            for (int m = 0; m < 4; ++m)
#pragma unroll
                for (int n = 0; n < 2; ++n) acc[a][b][m][n] = (f32x4){0.f, 0.f, 0.f, 0.f};
    bf16x8 At[4][2], B0[2][2], B1[2][2];
    const char* cA = cur.a; const char* cB = cur.b;
    PG8_STAGE(PG8_SB(0, 0), cB, voffB); PG8_STAGE(PG8_SB(0, 1), cB + hstepB, voffB); PG8_STAGE(PG8_SA(0, 0), cA, voffA); PG8_STAGE(PG8_SA(0, 1), cA + hstepA, voffA);
    if (wr == 1) PG8_BAR;
    PG8_WAIT_V(2); PG8_BAR;
    PG8_STAGE(PG8_SB(1, 0), cB + kstep, voffB); PG8_STAGE(PG8_SA(1, 0), cA + kstep, voffA); PG8_STAGE(PG8_SB(1, 1), cB + hstepB + kstep, voffB);
    PG8_WAIT_V(6); PG8_BAR;
    for (;;) {
        const bool has_next = S.next(ui + 1, nxt);
        const char* nA = has_next ? nxt.a : cA; const char* nB = has_next ? nxt.b : cB;
        for (int t = 0; t < nt; t += 2) {
            const bool last = (t == nt - 2);
            const char* a1 = cA + (size_t)(t + 1) * kstep;
            const char* a2 = last ? nA : cA + (size_t)(t + 2) * kstep; const char* b2 = last ? nB : cB + (size_t)(t + 2) * kstep;
            const char* a3 = a2 + kstep; const char* b3 = b2 + kstep;
            PG8_LDB(B0, 0, 0); PG8_LDB(B1, 0, 1); PG8_SCHED; PG8_LDA(At, 0, 0); PG8_STAGE(PG8_SA(1, 1), a1 + hstepA, voffA);
            PG8_WAIT_V(8); PG8_WAIT_L(0); PG8_BAR; PG8_MMA(0, 0, At, B0); PG8_MMA(0, 1, At, B1); PG8_BAR; PG8_SCHED;
            PG8_LDA(At, 0, 1); PG8_STAGE(PG8_SB(0, 0), b2, voffB); PG8_STAGE(PG8_SB(0, 1), b2 + hstepB, voffB); PG8_STAGE(PG8_SA(0, 0), a2, voffA);
            PG8_WAIT_V(8); PG8_WAIT_L(0); PG8_BAR; PG8_MMA(1, 0, At, B0); PG8_MMA(1, 1, At, B1); PG8_BAR; PG8_SCHED;
            PG8_LDB(B0, 1, 0); PG8_LDB(B1, 1, 1); PG8_SCHED; PG8_LDA(At, 1, 0); PG8_STAGE(PG8_SA(0, 1), a2 + hstepA, voffA);
            PG8_WAIT_V(8); PG8_WAIT_L(0); PG8_BAR; PG8_MMA(0, 0, At, B0); PG8_MMA(0, 1, At, B1); PG8_BAR; PG8_SCHED;
            PG8_LDA(At, 1, 1); PG8_STAGE(PG8_SB(1, 0), b3, voffB); PG8_STAGE(PG8_SB(1, 1), b3 + hstepB, voffB); PG8_STAGE(PG8_SA(1, 0), a3, voffA);
            PG8_WAIT_V(8); PG8_WAIT_L(0); PG8_BAR; PG8_MMA(1, 0, At, B0); PG8_MMA(1, 1, At, B1); PG8_BAR; PG8_SCHED;
        }
        if (wr == 0) PG8_BAR;
        E(acc, cur, wr, wc, fr, fq);
        if (!has_next) break;
#pragma unroll
        for (int a = 0; a < 2; ++a)
#pragma unroll
            for (int b = 0; b < 2; ++b)
#pragma unroll
                for (int m = 0; m < 4; ++m)
#pragma unroll
                    for (int n = 0; n < 2; ++n) acc[a][b][m][n] = (f32x4){0.f, 0.f, 0.f, 0.f};
        cur = nxt; cA = nA; cB = nB; ++ui;
        if (wr == 1) PG8_BAR;
    }
    PG8_WAIT_V(0);
    PG8_BAR;
#undef PG8_SA
#undef PG8_SB
#undef PG8_STAGE
#undef PG8_LDA
#undef PG8_LDB
#undef PG8_MMA
#undef PG8_WAIT_V
#undef PG8_WAIT_L
#undef PG8_BAR
#undef PG8_SCHED
}
}

#if MK_DEBUG
__device__ __forceinline__ bool badf(float v) { return !(fabsf(v) < 1e30f); }
__device__ __forceinline__ void dbg_bf16(const bf16_t* p, int rows, int cols, size_t ld, unsigned* flag, int gt, int ngt) {
    const int cpr = cols / 8; bool bad = false;
    for (size_t i = gt; i < (size_t)rows * cpr; i += ngt) { const size_t r = i / cpr, c = (i % cpr) * 8; const u32x4 a = *(const u32x4*)(p + r * ld + c);
        bad |= badf(bf_lo(a.x)) | badf(bf_hi(a.x)) | badf(bf_lo(a.y)) | badf(bf_hi(a.y)) | badf(bf_lo(a.z)) | badf(bf_hi(a.z)) | badf(bf_lo(a.w)) | badf(bf_hi(a.w)); }
    if (bad) *flag = 1u;
}
__device__ __forceinline__ void dbg_max_bf16(const bf16_t* p, size_t n, unsigned* slot, int gt, int ngt) {
    float m = 0.f;
    for (size_t i = (size_t)gt * 8; i < n; i += (size_t)ngt * 8) { const u32x4 a = *(const u32x4*)(p + i);
        m = fmaxf(m, fmaxf(fmaxf(fmaxf(fabsf(bf_lo(a.x)), fabsf(bf_hi(a.x))), fmaxf(fabsf(bf_lo(a.y)), fabsf(bf_hi(a.y)))), fmaxf(fmaxf(fabsf(bf_lo(a.z)), fabsf(bf_hi(a.z))), fmaxf(fabsf(bf_lo(a.w)), fabsf(bf_hi(a.w)))))); }
    atomicMax(slot, __float_as_uint(m));
}
__device__ __forceinline__ void dbg_f32(const float* p, int rows, int cols, size_t ld, unsigned* flag, int gt, int ngt) {
    const int cpr = cols / 4; bool bad = false;
    for (size_t i = gt; i < (size_t)rows * cpr; i += ngt) { const size_t r = i / cpr, c = (i % cpr) * 4; const f32x4 a = *(const f32x4*)(p + r * ld + c);
        bad |= badf(a.x) | badf(a.y) | badf(a.z) | badf(a.w); }
    if (bad) *flag = 1u;
}
#endif
struct Args { const float* in[23]; float* out; unsigned char* ws; int ph_lo, ph_hi, never, pad; };
enum { I_X = 0, I_C, I_CTX, I_CCTX, I_ADAW, I_ADAB, I_NORMW, I_EWIN, I_ECONVQKV, I_EALOG, I_EDTB, I_EHN, I_ECONVB, I_EWOUT, I_OWIN, I_OLNW, I_OLNB, I_OWS, I_OBS, I_OPW, I_OPS, I_OWOUT, I_FNW };

template <class SrcFn>
__device__ __forceinline__ void conv_item(const float* W, int ldw, int K, bf16_t* WT, int c0, int k0, LAS float* scr, int lane, const SrcFn& src) {
    const int sc = src(c0 + (lane & 31));
#pragma unroll 8
    for (int i = 0; i < 32; ++i) { const int kk = 2 * i + (lane >> 5); scr[kk * 33 + (lane & 31)] = sc >= 0 ? W[(size_t)(k0 + kk) * ldw + sc] : 0.f; }
    LDS_WAIT(); asm volatile("" ::: "memory");
    const int c = lane & 7;
#pragma unroll
    for (int j = 0; j < 4; ++j) { const int n = (lane >> 3) + 8 * j; const LAS float* s = scr + (8 * c) * 33 + n;
        u32x4 o; o.x = cvt_pk_bf16(s[0 * 33], s[1 * 33]); o.y = cvt_pk_bf16(s[2 * 33], s[3 * 33]); o.z = cvt_pk_bf16(s[4 * 33], s[5 * 33]); o.w = cvt_pk_bf16(s[6 * 33], s[7 * 33]);
        *(u32x4*)(WT + (size_t)(c0 + n) * K + k0 + 8 * c) = o; }
    LDS_WAIT(); asm volatile("" ::: "memory");
}
struct SrcId { __device__ __forceinline__ int operator()(int c) const { return c; } };
struct SrcW1 { __device__ __forceinline__ int operator()(int c) const {
    if (c < 8192) return c;
    if (c < 16384) { const int cc = c - 8192, T = cc >> 8, cp = cc & 255, bj = cp >> 7, wc = (cp >> 5) & 3, fq = (cp >> 3) & 3, n = (cp >> 2) & 1, j = cp & 3;
        return 8256 + 2048 * (2 * bj + n) + 64 * T + 16 * wc + 4 * fq + j; }
    const int cp = c - 16384; return cp < 64 ? 8192 + cp : -1; } };

__device__ __forceinline__ void mod_task(const float* adaw, const float* adab, float* modl, int n0, const LAS float* tab, LAS float* red, int wave, int lane) {
    const int col = n0 + (lane & 31), kp = lane >> 5;
    float acc[5] = {0.f, 0.f, 0.f, 0.f, 0.f};
    const float* wp = adaw + (size_t)(256 * wave + kp) * 6144 + col;
#pragma unroll 8
    for (int kk = 0; kk < 128; ++kk) { const float wv = wp[(size_t)kk * 2 * 6144]; const int k = 256 * wave + 2 * kk + kp;
#pragma unroll
        for (int r = 0; r < 5; ++r) acc[r] += tab[r * 2048 + k] * wv; }
#pragma unroll
    for (int r = 0; r < 5; ++r) { acc[r] += __shfl_xor(acc[r], 32); if (lane < 32) red[(wave * 5 + r) * 32 + lane] = acc[r]; }
    __syncthreads();
    if (threadIdx.x < 160) { const int r = threadIdx.x >> 5, c = threadIdx.x & 31; float s = adab[n0 + c];
#pragma unroll
        for (int w = 0; w < 8; ++w) s += red[(w * 5 + r) * 32 + c];
        modl[r * 6144 + n0 + c] = s; }
    __syncthreads();
}
__device__ __forceinline__ void silu_table(const float* c, const float* cctx, LAS float* tab) {
    for (int i = threadIdx.x; i < 5 * 2048; i += 512) { const float v = i < 8192 ? c[i] : cctx[i - 8192]; tab[i] = silu_f(v); }
    __syncthreads();
}

__device__ __forceinline__ void hrow(const float* xrow, const float* nw, const float* modr, bf16_t* orow, int lane) {
    const f32x4* xr = (const f32x4*)xrow + lane;
    f32x4 v[8]; float s = 0.f;
#pragma unroll
    for (int j = 0; j < 8; ++j) { v[j] = xr[64 * j]; s += (v[j].x * v[j].x + v[j].y * v[j].y) + (v[j].z * v[j].z + v[j].w * v[j].w); }
    const float rstd = rsqrtf(wave_sum(s) * (1.f / DM) + EPS);
    u32x2* o8 = (u32x2*)orow + lane;
#pragma unroll
    for (int j = 0; j < 8; ++j) { const f32x4 w = ((const f32x4*)nw)[lane + 64 * j], sh = ((const f32x4*)modr)[lane + 64 * j], sc = ((const f32x4*)(modr + 2048))[lane + 64 * j];
        const f32x4 y = v[j] * rstd * w * (sc + 1.0f) + sh; u32x2 p; p.x = cvt_pk_bf16(y.x, y.y); p.y = cvt_pk_bf16(y.z, y.w); o8[64 * j] = p; }
}

typedef f32x4 AccT[2][2][4][2];
struct Sched1 { int G, c; const char* A; const char* B;
    __device__ __forceinline__ bool next(int i, pg8::Unit& u) const {
        const int L = i * G + c; if (L >= 2180) return false;
        if (L < 2080) pg8::tile_order(L, 32, 65, u.pm, u.pn);
        else { const int l = L - 2080; u.pm = 32 + (l & 3); const int t = l >> 2; u.pn = t < 24 ? t : 64; }
        u.aux = 0; u.a = A + (size_t)u.pm * (256 * 2048 * 2); u.b = B + (size_t)u.pn * (256 * 2048 * 2); return true; } };
struct Epi1 { static constexpr bool PERM = true;
    bf16_t* PQKV; bf16_t* ZA; float* AB; bf16_t* Y; const float* convb;
    __device__ __forceinline__ void operator()(const AccT& acc, const pg8::Unit& u, int wr, int wc, int fr, int fq) const {
        const int row0 = u.pm * 256 + wr * 64 + fr;
        if (u.pn < 32) {
            const bool act = u.pn >= 24;
            bf16_t* base = act ? ZA : PQKV; const int ldc = act ? 2048 : 6144; const int col0 = (act ? (u.pn - 24) : u.pn) * 256 + wc * 32 + 8 * fq;
#pragma unroll
            for (int ai = 0; ai < 2; ++ai)
#pragma unroll
                for (int m = 0; m < 4; ++m) { bf16_t* rowp = base + (size_t)(row0 + ai * 128 + m * 16) * ldc + col0;
#pragma unroll
                    for (int bj = 0; bj < 2; ++bj) { f32x4 v0 = acc[ai][bj][m][0], v1 = acc[ai][bj][m][1];
                        if (act) {
#pragma unroll
                            for (int j = 0; j < 4; ++j) { v0[j] = silu_f(v0[j]); v1[j] = silu_f(v1[j]); } }
                        u32x4 w; w.x = cvt_pk_bf16(v0[0], v0[1]); w.y = cvt_pk_bf16(v0[2], v0[3]); w.z = cvt_pk_bf16(v1[0], v1[1]); w.w = cvt_pk_bf16(v1[2], v1[3]);
                        *(u32x4*)(rowp + bj * 128) = w; } }
        } else if (u.pn < 64) {
            const int lane = threadIdx.x & 63;
            const int ch0 = 64 * (u.pn - 32) + 16 * wc + 4 * fq;
            const f32x4 cw0 = *(const f32x4*)(convb + ch0), cw1 = *(const f32x4*)(convb + 2048 + ch0), cw2 = *(const f32x4*)(convb + 4096 + ch0);
#pragma unroll
            for (int ai = 0; ai < 2; ++ai) {
                f32x4 pr[4];
#pragma unroll
                for (int m = 0; m < 4; ++m) pr[m] = acc[ai][0][m][1] * acc[ai][1][m][0];
#pragma unroll
                for (int m = 0; m < 4; ++m) { f32x4 y;
#pragma unroll
                    for (int j = 0; j < 4; ++j) {
                        const float bp = m > 0 ? __shfl(pr[m > 0 ? m - 1 : 0][j], lane | 15) : 0.f;
                        const float bn = m < 3 ? __shfl(pr[m < 3 ? m + 1 : 3][j], lane & ~15) : 0.f;
                        const float up = dpp_shr1(pr[m][j], bp), dn = dpp_shl1(pr[m][j], bn);
                        const float cv = cw0[j] * up + cw1[j] * pr[m][j] + cw2[j] * dn;
                        y[j] = acc[ai][0][m][0][j] * cv * silu_f(acc[ai][1][m][1][j]); if (ABLATE & 2) y[j] = 0.f; }
                    u32x2 w; w.x = cvt_pk_bf16(y[0], y[1]); w.y = cvt_pk_bf16(y[2], y[3]);
                    *(u32x2*)(Y + (size_t)(row0 + ai * 128 + m * 16) * 4096 + 2048 + ch0) = w; } }
        } else {
            if (wc < 2) {
#pragma unroll
                for (int ai = 0; ai < 2; ++ai)
#pragma unroll
                    for (int m = 0; m < 4; ++m)
#pragma unroll
                        for (int n = 0; n < 2; ++n) *(f32x4*)(AB + (size_t)(row0 + ai * 128 + m * 16) * 64 + 32 * wc + 8 * fq + 4 * n) = acc[ai][0][m][n]; }
        }
    } };
struct EpiResid { static constexpr bool PERM = false;
    const float* resid; float* out; const float* gate;
    __device__ __forceinline__ void operator()(const AccT& acc, const pg8::Unit& u, int wr, int wc, int fr, int fq) const {
        const int row0 = u.pm * 256 + wr * 64 + fr, col0 = u.pn * 256 + wc * 32 + 4 * fq; const float* g = gate + (size_t)(u.pm >> 3) * 6144;
        f32x4 gv[2][2];
#pragma unroll
        for (int bj = 0; bj < 2; ++bj)
#pragma unroll
            for (int n = 0; n < 2; ++n) gv[bj][n] = *(const f32x4*)(g + col0 + bj * 128 + n * 16);
#pragma unroll
        for (int ai = 0; ai < 2; ++ai)
#pragma unroll
            for (int m = 0; m < 4; ++m) { const size_t off = (size_t)(row0 + ai * 128 + m * 16) * DM + col0;
#pragma unroll
                for (int bj = 0; bj < 2; ++bj)
#pragma unroll
                    for (int n = 0; n < 2; ++n) { const f32x4 r = *(const f32x4*)(resid + off + bj * 128 + n * 16); *(f32x4*)(out + off + bj * 128 + n * 16) = r + gv[bj][n] * acc[ai][bj][m][n]; }
                asm volatile("" ::: "memory"); }
    } };
struct Epi3 { static constexpr bool PERM = true;
    bf16_t* P1;
    __device__ __forceinline__ void operator()(const AccT& acc, const pg8::Unit& u, int wr, int wc, int fr, int fq) const {
        const int row0 = u.pm * 256 + wr * 64 + fr, col0 = u.pn * 256 + wc * 32 + 8 * fq;
        const int act = u.pn < 16 ? 1 : ((u.pn >= 24 && u.pn < 32) ? 0 : 2);
#pragma unroll
        for (int ai = 0; ai < 2; ++ai)
#pragma unroll
            for (int m = 0; m < 4; ++m) { bf16_t* rowp = P1 + (size_t)(row0 + ai * 128 + m * 16) * N3 + col0;
#pragma unroll
                for (int bj = 0; bj < 2; ++bj) { f32x4 v0 = acc[ai][bj][m][0], v1 = acc[ai][bj][m][1];
                    if (act == 1) {
#pragma unroll
                        for (int j = 0; j < 4; ++j) { v0[j] = gelu_f(v0[j]); v1[j] = gelu_f(v1[j]); } }
                    else if (act == 2) {
#pragma unroll
                        for (int j = 0; j < 4; ++j) { v0[j] = silu_f(v0[j]); v1[j] = silu_f(v1[j]); } }
                    u32x4 w; w.x = cvt_pk_bf16(v0[0], v0[1]); w.y = cvt_pk_bf16(v0[2], v0[3]); w.z = cvt_pk_bf16(v1[0], v1[1]); w.w = cvt_pk_bf16(v1[2], v1[3]);
                    *(u32x4*)(rowp + bj * 128) = w; } }
    } };
struct SchedPool { int G, c; const char* A; const char* B;
    __device__ __forceinline__ bool next(int i, pg8::Unit& u) const {
        const int L = i * G + c; if (L >= 256) return false;
        u.aux = L >> 6; u.pn = (L >> 5) & 1; u.pm = L & 31;
        u.a = A + ((size_t)u.pm * 256 * 2048 + 512 * u.aux) * 2; u.b = B + ((size_t)u.aux * 512 * 512 + (size_t)u.pn * 256 * 512) * 2; return true; } };
struct EpiPool { static constexpr bool PERM = true;
    const bf16_t* P1; bf16_t* Y2; const float* pscale;
    __device__ __forceinline__ void operator()(const AccT& acc, const pg8::Unit& u, int wr, int wc, int fr, int fq) const {
        const int row0 = u.pm * 256 + wr * 64 + fr, colg = 512 * u.aux + 256 * u.pn + wc * 32 + 8 * fq;
        f32x4 ps[2][2];
#pragma unroll
        for (int bj = 0; bj < 2; ++bj)
#pragma unroll
            for (int n = 0; n < 2; ++n) ps[bj][n] = *(const f32x4*)(pscale + colg + bj * 128 + 4 * n);
#pragma unroll
        for (int ai = 0; ai < 2; ++ai)
#pragma unroll
            for (int m = 0; m < 4; ++m) { const size_t row = (size_t)(row0 + ai * 128 + m * 16);
#pragma unroll
                for (int bj = 0; bj < 2; ++bj) { const u32x4 z = *(const u32x4*)(P1 + row * N3 + 8192 + colg + bj * 128);
                    f32x4 v0 = acc[ai][bj][m][0] * ps[bj][0], v1 = acc[ai][bj][m][1] * ps[bj][1]; if (ABLATE & 8) { v0 = v0 * 0.f; v1 = v1 * 0.f; }
                    u32x4 w; w.x = cvt_pk_bf16(v0[0] * bf_lo(z.x), v0[1] * bf_hi(z.x)); w.y = cvt_pk_bf16(v0[2] * bf_lo(z.y), v0[3] * bf_hi(z.y));
                    w.z = cvt_pk_bf16(v1[0] * bf_lo(z.z), v1[1] * bf_hi(z.z)); w.w = cvt_pk_bf16(v1[2] * bf_lo(z.w), v1[3] * bf_hi(z.w));
                    *(u32x4*)(Y2 + row * 4096 + 2048 + colg + bj * 128) = w; } }
    } };

__device__ __forceinline__ void qkv_task(int task, const bf16_t* PQKV, const float* convw, bf16_t* QN, bf16_t* KN, bf16_t* KT, bf16_t* VT, int lane) {
    const int head = task & 15, tens = (task >> 4) % 3, blk = task / 48;
    int b, t0, prow0, tokb; bool isx;
    if (blk < 128) { isx = true; b = blk >> 5; t0 = (blk & 31) * 64; prow0 = b * SEQ + t0; tokb = CTXL + t0; }
    else { isx = false; const int cb = blk - 128; b = cb >> 2; t0 = (cb & 3) * 64; prow0 = MX + b * CTXL + t0; tokb = t0; }
    const int col = tens * 2048 + head * 128 + 2 * lane;
    const f32x2 w0 = *(const f32x2*)(convw + col), w1 = *(const f32x2*)(convw + 6144 + col), w2 = *(const f32x2*)(convw + 12288 + col);
    const bf16_t* p = PQKV + (size_t)prow0 * 6144 + col;
    const int bh = b * NHD + head;
    unsigned pv = 0u, cu, nx;
    if (!isx && t0 > 0) pv = *(const unsigned*)(p - 6144);
    cu = *(const unsigned*)p;
    unsigned tr0[4], tr1[4];
    float hold0 = 0.f, hold1 = 0.f;
#pragma unroll 8
    for (int i = 0; i < 64; ++i) {
        nx = 0u;
        if (i < 63 || (!isx && t0 < 192)) nx = *(const unsigned*)(p + (size_t)(i + 1) * 6144);
        float o0 = w0.x * bf_lo(pv) + w1.x * bf_lo(cu) + w2.x * bf_lo(nx);
        float o1 = w0.y * bf_hi(pv) + w1.y * bf_hi(cu) + w2.y * bf_hi(nx);
        o0 = silu_f(o0); o1 = silu_f(o1);
        if (tens < 2) { const float ss = wave_sum(o0 * o0 + o1 * o1); const float sc = rsqrtf(ss + EPS); o0 *= sc; o1 *= sc; }
        const int tok = tokb + i;
        if (tens == 0) *(unsigned*)(QN + ((size_t)bh * NTOK + tok) * HD + 2 * lane) = cvt_pk_bf16(o0, o1);
        if (tens == 1) *(unsigned*)(KN + ((size_t)bh * NTOK + tok) * HD + 2 * lane) = cvt_pk_bf16(o0, o1);
        if (tens >= 1) {
            if (i & 1) { tr0[(i >> 1) & 3] = cvt_pk_bf16(hold0, o0); tr1[(i >> 1) & 3] = cvt_pk_bf16(hold1, o1); } else { hold0 = o0; hold1 = o1; }
            if ((i & 7) == 7) { bf16_t* T = (tens == 1 ? KT : VT) + ((size_t)bh * HD + 2 * lane) * NTOK + tok - 7;
                *(u32x4*)T = (u32x4){tr0[0], tr0[1], tr0[2], tr0[3]}; *(u32x4*)(T + NTOK) = (u32x4){tr1[0], tr1[1], tr1[2], tr1[3]}; } }
        pv = cu; cu = nx;
    }
}
__device__ __forceinline__ void ab_task(int blk, const float* AB, const float* alog, const float* dtb, float* GG, float* BETA, int lane) {
    int b, prow0, tokb;
    if (blk < 128) { b = blk >> 5; const int t0 = (blk & 31) * 64; prow0 = b * SEQ + t0; tokb = CTXL + t0; }
    else { const int cb = blk - 128; b = cb >> 2; const int t0 = (cb & 3) * 64; prow0 = MX + b * CTXL + t0; tokb = t0; }
    const int kind = lane >> 4, h = lane & 15, d = kind & 1;
    const float A = __expf(alog[d * 16 + h]), db = dtb[d * 16 + h];
    float* dst = (kind < 2 ? GG : BETA) + ((size_t)d * NBH + b * NHD + h) * NTOK + tokb;
#pragma unroll 4
    for (int i = 0; i < 64; ++i) { const float v = AB[(size_t)(prow0 + i) * 64 + lane];
        dst[i] = kind < 2 ? -A * softplus_f(v + db) : sigmoid_f(v); }
}

template <int I> struct FS {
    static __device__ __forceinline__ void run(const LAS float* Ml, float (&Tc)[64], int lane) {
        float a = (lane == I) ? 1.f : 0.f;
#pragma unroll
        for (int jq = 0; jq < (I + 3) / 4; ++jq) { const f32x4 mv = *(const LAS f32x4*)(Ml + I * 68 + 4 * jq);
#pragma unroll
            for (int e = 0; e < 4; ++e) if (4 * jq + e < I) a = fmaf(-mv[e], Tc[4 * jq + e], a); }
        Tc[I] = a;
        __builtin_amdgcn_sched_barrier(0);
        if constexpr (I + 1 < 64) FS<I + 1>::run(Ml, Tc, lane);
    } };
__device__ __forceinline__ void chunk_task(int task, const bf16_t* QN, const bf16_t* KN, const float* GG, const float* BETA, float* GC, bf16_t* TU, bf16_t* AI, LAS float* tab, int lane) {
    const int tc = task % NCH, bh = (task / NCH) & 63, dir = task / (NCH * 64);
    const int tok0 = 64 * tc;
    LAS float* Ml = tab + 128;
    const int mytok = tok0 + (dir ? 63 - lane : lane);
    const size_t gidx = ((size_t)dir * NBH + bh) * NTOK + mytok;
    const float gl = GG[gidx], bl = BETA[gidx];
    float gc = gl;
#pragma unroll
    for (int o = 1; o < 64; o <<= 1) { const float t = __shfl_up(gc, o); if (lane >= o) gc += t; }
    GC[gidx] = gc;
    tab[lane] = gc; tab[64 + lane] = bl;
    LDS_WAIT(); asm volatile("" ::: "memory");
    const int r = lane & 31, hh = lane >> 5;
    bf16x8 ka[2][8];
#pragma unroll
    for (int ib = 0; ib < 2; ++ib) { const int tk = tok0 + (dir ? 63 - (32 * ib + r) : 32 * ib + r); const bf16x8* kp = (const bf16x8*)(KN + ((size_t)bh * NTOK + tk) * HD + 8 * hh);
#pragma unroll
        for (int s = 0; s < 8; ++s) ka[ib][s] = kp[2 * s]; }
    const bool isx = tc >= 4;
    bf16_t* aib = AI + (((size_t)dir * NBH + bh) * NCH + tc) * 4096;
    if (isx) {
#pragma unroll
        for (int ib = 0; ib < 2; ++ib) {
            bf16x8 qa[8]; { const int tk = tok0 + (dir ? 63 - (32 * ib + r) : 32 * ib + r); const bf16x8* qp = (const bf16x8*)(QN + ((size_t)bh * NTOK + tk) * HD + 8 * hh);
#pragma unroll
                for (int s = 0; s < 8; ++s) qa[s] = qp[2 * s]; }
#pragma unroll
            for (int jb = 0; jb < 2; ++jb) {
                f32x16 a = {};
                if (jb <= ib) {
#pragma unroll
                    for (int s = 0; s < 8; ++s) a = __builtin_amdgcn_mfma_f32_32x32x16_bf16(qa[s], ka[jb][s], a, 0, 0, 0); }
                const int jp = 32 * jb + r; const float gcj = tab[jp];
                bf16_t vv[16];
#pragma unroll
                for (int g = 0; g < 4; ++g) { const f32x4 gci = *(const LAS f32x4*)(tab + 32 * ib + 8 * g + 4 * hh);
#pragma unroll
                    for (int e = 0; e < 4; ++e) { const int ip = 32 * ib + 8 * g + 4 * hh + e;
                        vv[4 * g + e] = f2bf((jp <= ip) ? 0.08838834764831845f * a[4 * g + e] * __expf(gci[e] - gcj) : 0.f); } }
                if (dir == 0) { bf16_t* bp = aib + (32 * ib + 4 * hh) * 64 + jp;
#pragma unroll
                    for (int e = 0; e < 16; ++e) bp[((e & 3) + 8 * (e >> 2)) * 64] = vv[e]; }
                else { bf16_t* bp = aib + (63 - 32 * ib - 4 * hh) * 64 + (63 - jp);
#pragma unroll
                    for (int e = 0; e < 16; ++e) bp[-((e & 3) + 8 * (e >> 2)) * 64] = vv[e]; } } }
    }
    f32x16 Mt[3];
#pragma unroll
    for (int t = 0; t < 3; ++t) { const int ib = t > 0, jb = t > 1; f32x16 a = {};
#pragma unroll
        for (int s = 0; s < 8; ++s) a = __builtin_amdgcn_mfma_f32_32x32x16_bf16(ka[ib][s], ka[jb][s], a, 0, 0, 0);
        Mt[t] = a; }
    LAS float* Mlb = Ml + 4 * hh * 68 + r;
#pragma unroll
    for (int t = 0; t < 3; ++t) { const int ib = t > 0, jb = t > 1; const int jp = 32 * jb + r; const float gcj = tab[jp];
#pragma unroll
        for (int g = 0; g < 4; ++g) { const f32x4 gci = *(const LAS f32x4*)(tab + 32 * ib + 8 * g + 4 * hh), bi = *(const LAS f32x4*)(tab + 64 + 32 * ib + 8 * g + 4 * hh);
#pragma unroll
            for (int e = 0; e < 4; ++e) { const int ip = 32 * ib + 8 * g + 4 * hh + e;
                Mt[t][4 * g + e] = (jp < ip) ? bi[e] * Mt[t][4 * g + e] * __expf(gci[e] - gcj) : 0.f;
                Mlb[(32 * ib + 8 * g + e) * 68 + 32 * jb] = Mt[t][4 * g + e]; } } }
    LDS_WAIT(); asm volatile("" ::: "memory");
    float Tc[64];
    FS<0>::run(Ml, Tc, lane);
    bf16_t* tub = TU + (((size_t)dir * NBH + bh) * NCH + tc) * 4096;
    if (dir == 0) { bf16_t* bp = tub + lane;
#pragma unroll
        for (int i = 0; i < 64; ++i) bp[i * 64] = f2bf(Tc[i] * bl); }
    else { bf16_t* bp = tub + 63 * 64 + (63 - lane);
#pragma unroll
        for (int i = 0; i < 64; ++i) bp[-i * 64] = f2bf(Tc[i] * bl); }
    LDS_WAIT(); asm volatile("" ::: "memory");
}

constexpr int F_Q = 0, F_KT = 17408, F_VT = 35840, F_TU = 45056, F_A = 54272, F_W = 63488, F_ST = 80896, F_VN = 98304, F_VNG = 107520, F_TAB = 116736;
__device__ __forceinline__ f32x16 mma_tile(f32x16 acc, const LAS bf16_t* A, int lda, const LAS bf16_t* B, int ldb, int ksteps, int lane) {
    const LAS bf16_t* ap = A + (lane & 31) * lda + 8 * (lane >> 5); const LAS bf16_t* bp = B + (lane & 31) * ldb + 8 * (lane >> 5);
    for (int s = 0; s < ksteps; ++s) acc = __builtin_amdgcn_mfma_f32_32x32x16_bf16(*(const LAS bf16x8*)(ap + 16 * s), *(const LAS bf16x8*)(bp + 16 * s), acc, 0, 0, 0);
    return acc;
}
__device__ __forceinline__ void scan_chain(int chain, LAS unsigned char* lds, const bf16_t* KNdbg, const bf16_t* QN, const bf16_t* KT, const bf16_t* VT, const bf16_t* TU, const bf16_t* AI, const float* GC, bf16_t* OF, bf16_t* OB) {
    const int tid = threadIdx.x, wave = __builtin_amdgcn_readfirstlane(tid >> 6), lane = tid & 63;
    const int half = chain & 1, bh = (chain >> 1) & 63, dir = chain >> 7, b = bh >> 4, h = bh & 15;
    LAS bf16_t* Qs = (LAS bf16_t*)(lds + F_Q); LAS bf16_t* KTs = (LAS bf16_t*)(lds + F_KT); LAS bf16_t* VTs = (LAS bf16_t*)(lds + F_VT);
    LAS bf16_t* TUs = (LAS bf16_t*)(lds + F_TU); LAS bf16_t* As = (LAS bf16_t*)(lds + F_A); LAS bf16_t* Ws = (LAS bf16_t*)(lds + F_W);
    LAS bf16_t* STs = (LAS bf16_t*)(lds + F_ST); LAS bf16_t* VNs = (LAS bf16_t*)(lds + F_VN); LAS bf16_t* VNGs = (LAS bf16_t*)(lds + F_VNG);
    LAS float* tab = (LAS float*)(lds + F_TAB);
    for (int i = tid; i < 17408 / 4; i += 512) ((LAS unsigned*)STs)[i] = 0u;
    f32x16 Sacc = {};
    bf16_t* Od = ((ABLATE & 64) ? !dir : dir) ? OB : OF;
    const int c = lane & 31, hh = lane >> 5;
    __syncthreads();
    for (int step = 0; step < NCH; ++step) {
        const int tc = dir == 0 ? step : (step < 4 ? 3 - step : 39 - step);
        const int tok0 = 64 * tc; const bool isx = tc >= 4;
        if (isx) { for (int i = tid; i < 1024; i += 512) { const int t = i >> 4, ch = i & 15; *(LAS u32x4*)(Qs + t * 136 + ch * 8) = *(const u32x4*)(QN + ((size_t)bh * NTOK + tok0 + t) * HD + ch * 8); } }
        if (ABLATE & 256) { for (int i = tid; i < 8192; i += 512) { const int t = i >> 7, k = i & 127; KTs[k * 72 + t] = KNdbg[((size_t)bh * NTOK + tok0 + t) * HD + k]; } }
        else
        for (int i = tid; i < 1024; i += 512) { const int k = i >> 3, ch = i & 7; *(LAS u32x4*)(KTs + k * 72 + ch * 8) = *(const u32x4*)(KT + ((size_t)bh * HD + k) * NTOK + tok0 + ch * 8); }
        { const int d = tid >> 3, ch = tid & 7; *(LAS u32x4*)(VTs + d * 72 + ch * 8) = *(const u32x4*)(VT + ((size_t)bh * HD + 64 * half + d) * NTOK + tok0 + ch * 8);
          const size_t cb = (((size_t)dir * NBH + bh) * NCH + tc) * 4096;
          *(LAS u32x4*)(TUs + d * 72 + ch * 8) = *(const u32x4*)(TU + cb + d * 64 + ch * 8);
          if (isx) *(LAS u32x4*)(As + d * 72 + ch * 8) = *(const u32x4*)(AI + cb + d * 64 + ch * 8); }
        if (tid < 64) { const float* gp = GC + ((size_t)dir * NBH + bh) * NTOK + tok0; const float g = gp[tid], gl = gp[dir ? 0 : 63];
            tab[tid] = __expf(g); tab[64 + tid] = __expf(gl - g); if (tid == 0) tab[128] = __expf(gl); }
        __syncthreads();
        {
            const int kb = wave & 3, tb = wave >> 2;
            f32x16 a = {};
            const LAS bf16_t* ap = KTs + (32 * kb + c) * 72 + 8 * hh; const LAS bf16_t* bp = TUs + (32 * tb + c) * 72 + 8 * hh;
#pragma unroll
            for (int s = 0; s < 4; ++s) {
                const bf16x8 av = *(const LAS bf16x8*)(ap + 16 * s); const u32x4 bu = *(const LAS u32x4*)(bp + 16 * s);
                const f32x4 e0 = *(const LAS f32x4*)(tab + 16 * s + 8 * hh), e1 = *(const LAS f32x4*)(tab + 16 * s + 8 * hh + 4);
                u32x4 bs; bs.x = cvt_pk_bf16(bf_lo(bu.x) * e0[0], bf_hi(bu.x) * e0[1]); bs.y = cvt_pk_bf16(bf_lo(bu.y) * e0[2], bf_hi(bu.y) * e0[3]);
                bs.z = cvt_pk_bf16(bf_lo(bu.z) * e1[0], bf_hi(bu.z) * e1[1]); bs.w = cvt_pk_bf16(bf_lo(bu.w) * e1[2], bf_hi(bu.w) * e1[3]);
                a = __builtin_amdgcn_mfma_f32_32x32x16_bf16(av, __builtin_bit_cast(bf16x8, bs), a, 0, 0, 0); }
#pragma unroll
            for (int g = 0; g < 4; ++g) { u32x2 w; w.x = cvt_pk_bf16(-a[4 * g], -a[4 * g + 1]); w.y = cvt_pk_bf16(-a[4 * g + 2], -a[4 * g + 3]);
                *(LAS u32x2*)(Ws + (32 * tb + c) * 136 + 32 * kb + 8 * g + 4 * hh) = w; }
        }
        __syncthreads();
        f32x16 oacc = {};
        const int tb2 = (wave >> 1) & 1, db2 = wave & 1;
        if (wave < 4) {
            f32x16 a = {};
            a = mma_tile(a, TUs + 32 * tb2 * 72, 72, VTs + 32 * db2 * 72, 72, 4, lane);
            a = mma_tile(a, Ws + 32 * tb2 * 136, 136, STs + 32 * db2 * 136, 136, 8, lane);
#pragma unroll
            for (int g = 0; g < 4; ++g) { const f32x4 sc = *(const LAS f32x4*)(tab + 64 + 32 * tb2 + 8 * g + 4 * hh);
                u32x2 w, wg; w.x = cvt_pk_bf16(a[4 * g], a[4 * g + 1]); w.y = cvt_pk_bf16(a[4 * g + 2], a[4 * g + 3]);
                wg.x = cvt_pk_bf16(a[4 * g] * sc[0], a[4 * g + 1] * sc[1]); wg.y = cvt_pk_bf16(a[4 * g + 2] * sc[2], a[4 * g + 3] * sc[3]);
                *(LAS u32x2*)(VNs + (32 * db2 + c) * 72 + 32 * tb2 + 8 * g + 4 * hh) = w; *(LAS u32x2*)(VNGs + (32 * db2 + c) * 72 + 32 * tb2 + 8 * g + 4 * hh) = wg; }
        } else if (isx) {
            oacc = mma_tile(oacc, Qs + 32 * tb2 * 136, 136, STs + 32 * db2 * 136, 136, 8, lane);
#pragma unroll
            for (int g = 0; g < 4; ++g) { const f32x4 sc = *(const LAS f32x4*)(tab + 32 * tb2 + 8 * g + 4 * hh);
#pragma unroll
                for (int e = 0; e < 4; ++e) oacc[4 * g + e] *= 0.08838834764831845f * sc[e]; }
        }
        __syncthreads();
        {
            const int kb = wave & 3, db = wave >> 2; const float egl = tab[128];
#pragma unroll
            for (int e = 0; e < 16; ++e) Sacc[e] *= egl;
            Sacc = mma_tile(Sacc, KTs + 32 * kb * 72, 72, VNGs + 32 * db * 72, 72, 4, lane);
            if (wave >= 4 && isx) {
                oacc = mma_tile(oacc, As + 32 * tb2 * 72, 72, VNs + 32 * db2 * 72, 72, 4, lane);
                bf16_t* op = Od + ((size_t)b * SEQ + (tok0 - CTXL) + 32 * tb2) * DM + h * HD + 64 * half + 32 * db2 + c;
#pragma unroll
                for (int e = 0; e < 16; ++e) { const int t = (e & 3) + 8 * (e >> 2) + 4 * hh; op[(size_t)t * DM] = f2bf(oacc[e]); }
            }
            __syncthreads();
#pragma unroll
            for (int g = 0; g < 4; ++g) { u32x2 w; w.x = cvt_pk_bf16(Sacc[4 * g], Sacc[4 * g + 1]); w.y = cvt_pk_bf16(Sacc[4 * g + 2], Sacc[4 * g + 3]);
                *(LAS u32x2*)(STs + (32 * db + c) * 136 + 32 * kb + 8 * g + 4 * hh) = w; }
        }
        __syncthreads();
    }
}

#ifndef DBG_THR
#define DBG_THR 1000.f
#endif
__device__ __forceinline__ void finish_row(int row, const bf16_t* OF, const bf16_t* OB, const bf16_t* ZA, const float* hn, bf16_t* Y, int lane, unsigned* dbgh) {
    const f32x4 h0 = *(const f32x4*)(hn + 8 * (lane & 15)), h1 = *(const f32x4*)(hn + 8 * (lane & 15) + 4);
#pragma unroll
    for (int it = 0; it < 4; ++it) {
        const size_t off = (size_t)row * DM + it * 512 + lane * 8;
        const u32x4 a_ = *(const u32x4*)(OF + off), bq_ = *(const u32x4*)(OB + off), z = *(const u32x4*)(ZA + off);
        u32x4 a = a_, bq = bq_; if (ABLATE & 16) bq = (u32x4){0u, 0u, 0u, 0u}; if (ABLATE & 32) a = (u32x4){0u, 0u, 0u, 0u};
        float o[8] = {bf_lo(a.x) + bf_lo(bq.x), bf_hi(a.x) + bf_hi(bq.x), bf_lo(a.y) + bf_lo(bq.y), bf_hi(a.y) + bf_hi(bq.y), bf_lo(a.z) + bf_lo(bq.z), bf_hi(a.z) + bf_hi(bq.z), bf_lo(a.w) + bf_lo(bq.w), bf_hi(a.w) + bf_hi(bq.w)};
#if MK_DEBUG
        { float mb = 0.f, mf = 0.f; const float ofx[8] = {bf_lo(a.x), bf_hi(a.x), bf_lo(a.y), bf_hi(a.y), bf_lo(a.z), bf_hi(a.z), bf_lo(a.w), bf_hi(a.w)};
          const float obx[8] = {bf_lo(bq.x), bf_hi(bq.x), bf_lo(bq.y), bf_hi(bq.y), bf_lo(bq.z), bf_hi(bq.z), bf_lo(bq.w), bf_hi(bq.w)};
#pragma unroll
          for (int e = 0; e < 8; ++e) { mb = fmaxf(mb, fabsf(obx[e])); mf = fmaxf(mf, fabsf(ofx[e])); }
          const int bhq = (row / SEQ) * 16 + it * 4 + (lane >> 4);
          if (mb > DBG_THR) dbgh[bhq] = 1u; if (mf > DBG_THR) dbgh[64 + bhq] = 1u; }
#endif
        if (ABLATE & 128) { const float of_[8] = {bf_lo(a.x), bf_hi(a.x), bf_lo(a.y), bf_hi(a.y), bf_lo(a.z), bf_hi(a.z), bf_lo(a.w), bf_hi(a.w)};
            const float ob_[8] = {bf_lo(bq.x), bf_hi(bq.x), bf_lo(bq.y), bf_hi(bq.y), bf_lo(bq.z), bf_hi(bq.z), bf_lo(bq.w), bf_hi(bq.w)};
#pragma unroll
            for (int e = 0; e < 8; ++e) o[e] = of_[e] + ob_[e] * (1.f / 4096.f); }
        float ss = 0.f;
#pragma unroll
        for (int e = 0; e < 8; ++e) ss += o[e] * o[e];
        ss += __shfl_xor(ss, 1); ss += __shfl_xor(ss, 2); ss += __shfl_xor(ss, 4); ss += __shfl_xor(ss, 8);
        const float rs = rsqrtf(ss * (1.f / HD) + EPS);
        const float zf[8] = {bf_lo(z.x), bf_hi(z.x), bf_lo(z.y), bf_hi(z.y), bf_lo(z.z), bf_hi(z.z), bf_lo(z.w), bf_hi(z.w)};
        const float hv[8] = {h0[0], h0[1], h0[2], h0[3], h1[0], h1[1], h1[2], h1[3]};
        float y[8];
#pragma unroll
        for (int e = 0; e < 8; ++e) { y[e] = o[e] * rs * hv[e] * zf[e]; if (ABLATE & 1) y[e] = 0.f; }
        u32x4 w; w.x = cvt_pk_bf16(y[0], y[1]); w.y = cvt_pk_bf16(y[2], y[3]); w.z = cvt_pk_bf16(y[4], y[5]); w.w = cvt_pk_bf16(y[6], y[7]);
        *(u32x4*)(Y + (size_t)row * 4096 + it * 512 + lane * 8) = w;
    }
}

__device__ __forceinline__ void stats_row(int row, const bf16_t* P1, float* STATS, int lane) {
    const bf16_t* p = P1 + (size_t)row * N3 + 2048;
    float v[32]; float s = 0.f;
#pragma unroll
    for (int j = 0; j < 4; ++j) { const u32x4 a = *(const u32x4*)(p + j * 512 + lane * 8);
        v[8 * j] = bf_lo(a.x); v[8 * j + 1] = bf_hi(a.x); v[8 * j + 2] = bf_lo(a.y); v[8 * j + 3] = bf_hi(a.y); v[8 * j + 4] = bf_lo(a.z); v[8 * j + 5] = bf_hi(a.z); v[8 * j + 6] = bf_lo(a.w); v[8 * j + 7] = bf_hi(a.w); }
#pragma unroll
    for (int e = 0; e < 32; ++e) s += v[e];
    const float mu = wave_sum(s) * (1.f / DM); float q = 0.f;
#pragma unroll
    for (int e = 0; e < 32; ++e) { const float d = v[e] - mu; q += d * d; }
    const float rstd = rsqrtf(wave_sum(q) * (1.f / DM) + EPS);
    if (lane == 0) { STATS[2 * row] = mu; STATS[2 * row + 1] = rstd; }
}
template <int R> __device__ __forceinline__ void diff_task(const bf16_t* p, bf16_t* o) {
    unsigned v[64];
#pragma unroll
    for (int i = 0; i < 64; ++i) v[i] = *(const unsigned*)(p + (size_t)i * N3);
    float s0 = 0.f, s1 = 0.f;
#pragma unroll
    for (int i = 0; i < R; ++i) { s0 += bf_lo(v[i]); s1 += bf_hi(v[i]); }
#pragma unroll
    for (int i = 0; i < 64; ++i) {
        if (i + R < 64) { s0 += bf_lo(v[i + R]); s1 += bf_hi(v[i + R]); }
        if (i - R - 1 >= 0) { s0 -= bf_lo(v[i - R - 1 >= 0 ? i - R - 1 : 0]); s1 -= bf_hi(v[i - R - 1 >= 0 ? i - R - 1 : 0]); }
        const int hi = (i + R + 1 < 64) ? i + R + 1 : 64, lo = (i - R > 0) ? i - R : 0; const float inv = 1.0f / (float)(hi - lo);
        *(unsigned*)(o + (size_t)i * DM) = cvt_pk_bf16(s0 * inv - bf_lo(v[i]), s1 * inv - bf_hi(v[i]));
    }
}

constexpr int K_W = 0, K_V = 34816;
__device__ __forceinline__ void tmix_task(int task, LAS unsigned char* lds, const float* ws, const float* bs, const float* lnw, const float* lnb, const float* STATS, const bf16_t* P1, bf16_t* Y2) {
    const int tid = threadIdx.x, wave = __builtin_amdgcn_readfirstlane(tid >> 6), lane = tid & 63;
    const int g = task & 15, n = (task >> 4) & 15, b = task >> 8;
    const int row0 = b * SEQ + 128 * n;
    LAS bf16_t* Wsb = (LAS bf16_t*)(lds + K_W); LAS bf16_t* VnT = (LAS bf16_t*)(lds + K_V);
    for (int i = tid; i < 4096; i += 512) { const int p = i >> 5, q4 = (i & 31) * 4; const f32x4 w = *(const f32x4*)(ws + ((size_t)g * 128 + p) * 128 + q4);
        u32x2 o; o.x = cvt_pk_bf16(w.x, w.y); o.y = cvt_pk_bf16(w.z, w.w); *(LAS u32x2*)(Wsb + p * 136 + q4) = o; }
    for (int i = tid; i < 2048; i += 512) { const int q = i >> 4, c8 = (i & 15) * 8;
        const u32x4 a = *(const u32x4*)(P1 + (size_t)(row0 + q) * N3 + 2048 + 128 * g + c8);
        const float mu = STATS[2 * (row0 + q)], rstd = STATS[2 * (row0 + q) + 1];
        const f32x4 w0 = *(const f32x4*)(lnw + 128 * g + c8), w1 = *(const f32x4*)(lnw + 128 * g + c8 + 4), b0 = *(const f32x4*)(lnb + 128 * g + c8), b1 = *(const f32x4*)(lnb + 128 * g + c8 + 4);
        const float x[8] = {bf_lo(a.x), bf_hi(a.x), bf_lo(a.y), bf_hi(a.y), bf_lo(a.z), bf_hi(a.z), bf_lo(a.w), bf_hi(a.w)};
        const float wv[8] = {w0[0], w0[1], w0[2], w0[3], w1[0], w1[1], w1[2], w1[3]}, bv[8] = {b0[0], b0[1], b0[2], b0[3], b1[0], b1[1], b1[2], b1[3]};
#pragma unroll
        for (int e = 0; e < 8; ++e) VnT[(c8 + e) * 136 + q] = f2bf((x[e] - mu) * rstd * wv[e] + bv[e]); }
    __syncthreads();
    const int pb = wave >> 1, c = lane & 31, hh = lane >> 5;
#pragma unroll
    for (int t = 0; t < 2; ++t) { const int cb = 2 * (wave & 1) + t;
        f32x16 a = {};
        a = mma_tile(a, Wsb + 32 * pb * 136, 136, VnT + 32 * cb * 136, 136, 8, lane);
        const int ch = 128 * g + 32 * cb + c;
#pragma unroll
        for (int e = 0; e < 16; ++e) { const int p = 32 * pb + (e & 3) + 8 * (e >> 2) + 4 * hh; const size_t row = (size_t)(row0 + p);
            const float s = a[e] + bs[g * 128 + p];
            const float y = bf2f(P1[row * N3 + ch]) * s * bf2f(P1[row * N3 + 4096 + ch]);
            Y2[row * 4096 + ch] = f2bf((ABLATE & 4) ? 0.f : y); } }
    __syncthreads();
}

__device__ __forceinline__ void final_row(float* xrow, const float* fw, int lane) {
    f32x4* xr = (f32x4*)xrow + lane;
    f32x4 v[8]; float s = 0.f;
#pragma unroll
    for (int j = 0; j < 8; ++j) { v[j] = xr[64 * j]; s += (v[j].x * v[j].x + v[j].y * v[j].y) + (v[j].z * v[j].z + v[j].w * v[j].w); }
    const float rstd = rsqrtf(wave_sum(s) * (1.f / DM) + EPS);
#pragma unroll
    for (int j = 0; j < 8; ++j) xr[64 * j] = v[j] * rstd * ((const f32x4*)fw)[lane + 64 * j];
}

__global__ void __launch_bounds__(512, 2) fwd_kernel(Args args) {
    extern __shared__ __attribute__((aligned(16))) unsigned char lds_raw[];
    LAS unsigned char* lds = (LAS unsigned char*)lds_raw;
    const int tid = threadIdx.x, lane = tid & 63, wave = __builtin_amdgcn_readfirstlane(tid >> 6);
    const int G = gridDim.x, bid = blockIdx.x;
    const int gw = bid * 8 + wave, NGW = G * 8;
    unsigned char* ws = args.ws;
    volatile LAS unsigned* MISC = (volatile LAS unsigned*)(lds + MISC_OFF);
    if (tid < 16) MISC[tid] = 0u;
    __syncthreads();
    if (args.never) cg::this_grid().sync();
    XcdBarrier bar; bar.bar = (unsigned*)(ws + WS_CTL) + CW_BAR; bar.x = 0; bar.st = MISC;
    const int lo = args.ph_lo, hi = args.ph_hi;
    if (hi - lo > 1) bar = xcd_barrier_post((unsigned*)(ws + WS_CTL) + CW_BAR, MISC);
#ifndef PH_MASK
#define PH_MASK 0x3fff
#endif
#define IN(k) ((((PH_MASK) >> (k)) & 1) && lo <= (k) && (k) < hi)
#define SEAM(k) do { if (IN(k) && IN((k) + 1)) xcd_barrier(bar); } while (0)
    float* MOD = (float*)(ws + WS_MOD);
#if MK_DEBUG
    unsigned* DBG = (unsigned*)(ws + WS_CTL) + 2048; const int gt = bid * 512 + tid, ngt = G * 512;
#endif
    bf16_t* WT1 = (bf16_t*)(ws + WS_WT1); bf16_t* WT2 = (bf16_t*)(ws + WS_WT2); bf16_t* WT3 = (bf16_t*)(ws + WS_WT3); bf16_t* WT4 = (bf16_t*)(ws + WS_WT4); bf16_t* WTP = (bf16_t*)(ws + WS_WTP);
    bf16_t* H = (bf16_t*)(ws + WS_H);

    if (IN(0)) {
        if (bid < 192) { LAS float* tab = (LAS float*)lds; silu_table(args.in[I_C], args.in[I_CCTX], tab);
            for (int t = bid; t < 192; t += G) mod_task(args.in[I_ADAW], args.in[I_ADAB], MOD, 32 * t, tab, (LAS float*)(lds + 40960), wave, lane);
            __syncthreads(); }
        LAS float* scr = (LAS float*)(lds + wave * 8448);
        const SrcW1 s1; const SrcId sid;
        for (int it = gw; it < 16640 + 4096; it += NGW) {
            if (it < 16640) { const int cb = it >> 5, kb = it & 31; conv_item(args.in[I_EWIN], N1SRC, 2048, WT1, 32 * cb, 64 * kb, scr, lane, s1); }
            else { const int r = it - 16640, cb = r >> 6, kb = r & 63; conv_item(args.in[I_EWOUT], 2048, 4096, WT2, 32 * cb, 64 * kb, scr, lane, sid); }
        }
    }
    SEAM(0);
    if (IN(1)) {
#if MK_DEBUG
        dbg_f32(MOD, 5, 6144, 6144, DBG + 0, gt, ngt); dbg_bf16(WT1, 16640, 2048, 2048, DBG + 0, gt, ngt); dbg_bf16(WT2, 2048, 4096, 4096, DBG + 0, gt, ngt);
#endif
        for (int m = gw; m < MT; m += NGW) {
            const float* src = m < MX ? args.in[I_X] + (size_t)m * DM : args.in[I_CTX] + (size_t)(m - MX) * DM;
            const int r = m < MX ? m / SEQ : 4;
            hrow(src, args.in[I_NORMW], MOD + r * 6144, H + (size_t)m * DM, lane);
        }
    }
    SEAM(1);
    if (IN(2)) {
#if MK_DEBUG
        dbg_bf16(H, MT, 2048, 2048, DBG + 1, gt, ngt);
#endif
        Sched1 S{G, bid, (const char*)H, (const char*)WT1};
        Epi1 E{(bf16_t*)(ws + WS_PQKV), (bf16_t*)(ws + WS_ZA), (float*)(ws + WS_AB), (bf16_t*)(ws + WS_Y), args.in[I_ECONVB]};
        pg8::gemm_phase<Epi1, Sched1>(lds, 2048, 2048, 2048, S, E);
    }
    SEAM(2);
    if (IN(3)) {
#if MK_DEBUG
        dbg_bf16((const bf16_t*)(ws + WS_PQKV), MT, 6144, 6144, DBG + 2, gt, ngt); dbg_bf16((const bf16_t*)(ws + WS_ZA), MX, 2048, 2048, DBG + 2, gt, ngt);
        dbg_f32((const float*)(ws + WS_AB), MT, 64, 64, DBG + 2, gt, ngt); dbg_bf16((const bf16_t*)(ws + WS_Y) + 2048, MX, 2048, 4096, DBG + 2, gt, ngt);
#endif
        for (int t = gw; t < 6912 + 144; t += NGW) {
            if (t < 6912) qkv_task(t, (const bf16_t*)(ws + WS_PQKV), args.in[I_ECONVQKV], (bf16_t*)(ws + WS_QN), (bf16_t*)(ws + WS_KN), (bf16_t*)(ws + WS_KT), (bf16_t*)(ws + WS_VT), lane);
            else ab_task(t - 6912, (const float*)(ws + WS_AB), args.in[I_EALOG], args.in[I_EDTB], (float*)(ws + WS_GG), (float*)(ws + WS_BETA), lane);
        }
    }
    SEAM(3);
    if (IN(4)) {
#if MK_DEBUG
        dbg_bf16((const bf16_t*)(ws + WS_QN), 64 * NTOK, 128, 128, DBG + 3, gt, ngt); dbg_bf16((const bf16_t*)(ws + WS_KN), 64 * NTOK, 128, 128, DBG + 3, gt, ngt);
        dbg_bf16((const bf16_t*)(ws + WS_KT), 64 * 128, NTOK, NTOK, DBG + 3, gt, ngt); dbg_bf16((const bf16_t*)(ws + WS_VT), 64 * 128, NTOK, NTOK, DBG + 3, gt, ngt);
        dbg_f32((const float*)(ws + WS_GG), 128, NTOK, NTOK, DBG + 3, gt, ngt); dbg_f32((const float*)(ws + WS_BETA), 128, NTOK, NTOK, DBG + 3, gt, ngt);
#endif
        LAS float* tab = (LAS float*)(lds + wave * 17920);
        for (int t = gw; t < 2 * 64 * NCH; t += NGW)
            chunk_task(t, (const bf16_t*)(ws + WS_QN), (const bf16_t*)(ws + WS_KN), (const float*)(ws + WS_GG), (const float*)(ws + WS_BETA), (float*)(ws + WS_GC), (bf16_t*)(ws + WS_TU), (bf16_t*)(ws + WS_AI), tab, lane);
        __syncthreads();
        if (bid < 192) { LAS float* stab = (LAS float*)lds; silu_table(args.in[I_C], args.in[I_CCTX], stab);
            for (int t = bid; t < 192; t += G) mod_task(args.in[I_ADAW] + (size_t)2048 * 6144, args.in[I_ADAB] + 6144, MOD + 5 * 6144, 32 * t, stab, (LAS float*)(lds + 40960), wave, lane);
            __syncthreads(); }
        LAS float* scr = (LAS float*)(lds + wave * 8448);
        const SrcId sid;
        for (int it = gw; it < 10240 + 4096 + 512; it += NGW) {
            if (it < 10240) { const int cb = it >> 5, kb = it & 31; conv_item(args.in[I_OWIN], N3, 2048, WT3, 32 * cb, 64 * kb, scr, lane, sid); }
            else if (it < 14336) { const int r = it - 10240, cb = r >> 6, kb = r & 63; conv_item(args.in[I_OWOUT], 2048, 4096, WT4, 32 * cb, 64 * kb, scr, lane, sid); }
            else { const int r = it - 14336, gq = r >> 7, cb = (r >> 3) & 15, kb = r & 7; conv_item(args.in[I_OPW] + (size_t)gq * 512 * 512, 512, 512, WTP + (size_t)gq * 512 * 512, 32 * cb, 64 * kb, scr, lane, sid); }
        }
    }
    SEAM(4);
    if (IN(5)) {
#if MK_DEBUG
        dbg_bf16((const bf16_t*)(ws + WS_TU), 2 * 64 * NCH, 4096, 4096, DBG + 4, gt, ngt);
        if (gt == 100) {
            const int dirq = 1, bhq = 0, tcq = 20, tok0q = 64 * tcq; const bf16_t* KNq = (const bf16_t*)(ws + WS_KN) + ((size_t)bhq * NTOK + tok0q) * HD;
            const float* gq = (const float*)(ws + WS_GG) + ((size_t)dirq * NBH + bhq) * NTOK + tok0q; const float* bq = (const float*)(ws + WS_BETA) + ((size_t)dirq * NBH + bhq) * NTOK + tok0q;
            const bf16_t* tq = (const bf16_t*)(ws + WS_TU) + (((size_t)dirq * NBH + bhq) * NCH + tcq) * 4096;
            float worst = 0.f;
            for (int a = 0; a < 64; a += 7) for (int b2 = 0; b2 < 64; b2 += 5) {
                float r = 0.f;
                for (int m = 0; m < 64; ++m) {
                    float im = (a == m) ? 1.f : 0.f;
                    if (m > a) { float kk = 0.f; for (int e = 0; e < HD; ++e) kk += bf2f(KNq[a * HD + e]) * bf2f(KNq[m * HD + e]); float gd = 0.f; for (int t = a; t < m; ++t) gd += gq[t]; im = bq[a] * kk * __expf(gd); }
                    const float T = bf2f(tq[m * 64 + b2]) / bq[b2];
                    r += im * T; }
                worst = fmaxf(worst, fabsf(r - ((a == b2) ? 1.f : 0.f))); }
            DBG[980] = __float_as_uint(worst); }
        if (gt < 64) { const int bhq = gt & 63; const bf16_t* tq = (const bf16_t*)(ws + WS_TU) + (((size_t)1 * NBH + bhq) * NCH + 20) * 4096; float so = 0.f;
            for (int i = 0; i < 64; ++i) for (int j = 0; j < 64; ++j) { const float v = fabsf(bf2f(tq[i * 64 + j])); if (i != j) so += v; }
            DBG[910 + bhq] = __float_as_uint(so); }
        dbg_max_bf16((const bf16_t*)(ws + WS_TU), (size_t)128 * NCH * 4096, DBG + 900, gt, ngt);
        dbg_max_bf16((const bf16_t*)(ws + WS_KN), (size_t)64 * NTOK * 128, DBG + 901, gt, ngt);
        dbg_max_bf16((const bf16_t*)(ws + WS_KT), (size_t)64 * NTOK * 128, DBG + 902, gt, ngt);
        dbg_max_bf16((const bf16_t*)(ws + WS_VT), (size_t)64 * NTOK * 128, DBG + 903, gt, ngt);
        dbg_max_bf16((const bf16_t*)(ws + WS_QN), (size_t)64 * NTOK * 128, DBG + 904, gt, ngt);
        for (int q = 0; q < 128; ++q) dbg_bf16((const bf16_t*)(ws + WS_AI) + ((size_t)q * NCH + 4) * 4096, 32, 4096, 4096, DBG + 4, gt, ngt);
        dbg_f32((const float*)(ws + WS_GC), 128, NTOK, NTOK, DBG + 4, gt, ngt); dbg_f32(MOD + 5 * 6144, 4, 6144, 6144, DBG + 4, gt, ngt);
        dbg_bf16(WT3, 10240, 2048, 2048, DBG + 4, gt, ngt); dbg_bf16(WT4, 2048, 4096, 4096, DBG + 4, gt, ngt); dbg_bf16(WTP, 2048, 512, 512, DBG + 4, gt, ngt);
#endif
        for (int ch = bid; ch < 256; ch += G) { scan_chain(ch, lds, (const bf16_t*)(ws + WS_KN), (const bf16_t*)(ws + WS_QN), (const bf16_t*)(ws + WS_KT), (const bf16_t*)(ws + WS_VT), (const bf16_t*)(ws + WS_TU), (const bf16_t*)(ws + WS_AI), (const float*)(ws + WS_GC), (bf16_t*)(ws + WS_OF), (bf16_t*)(ws + WS_OB)); __syncthreads(); }
    }
    SEAM(5);
    if (IN(6)) {
#if MK_DEBUG
        dbg_bf16((const bf16_t*)(ws + WS_OF), MX, 2048, 2048, DBG + 5, gt, ngt); dbg_bf16((const bf16_t*)(ws + WS_OB), MX, 2048, 2048, DBG + 5, gt, ngt);
        dbg_max_bf16((const bf16_t*)(ws + WS_OF), (size_t)MX * 2048, DBG + 905, gt, ngt); dbg_max_bf16((const bf16_t*)(ws + WS_OB), (size_t)MX * 2048, DBG + 906, gt, ngt);
#endif
        for (int m = gw; m < MX; m += NGW) finish_row(m, (const bf16_t*)(ws + WS_OF), (const bf16_t*)(ws + WS_OB), (const bf16_t*)(ws + WS_ZA), args.in[I_EHN], (bf16_t*)(ws + WS_Y), lane, (unsigned*)(ws + WS_CTL) + 3072);
    }
    SEAM(6);
    if (IN(7)) {
#if MK_DEBUG
        dbg_bf16((const bf16_t*)(ws + WS_Y), MX, 2048, 4096, DBG + 6, gt, ngt);
#endif
        pg8::StaticOrder S{32, 8, G, bid, (const char*)(ws + WS_Y), (const char*)WT2, (size_t)256 * 4096 * 2, (size_t)256 * 4096 * 2};
        EpiResid E{args.in[I_X], args.out, MOD + 4096};
        pg8::gemm_phase<EpiResid, pg8::StaticOrder>(lds, 4096, 4096, 4096, S, E);
    }
    SEAM(7);
    if (IN(8)) {
#if MK_DEBUG
        dbg_f32(args.out, MX, 2048, 2048, DBG + 7, gt, ngt);
#endif
        for (int m = gw; m < MX; m += NGW) hrow(args.out + (size_t)m * DM, args.in[I_NORMW] + DM, MOD + 5 * 6144 + (m / SEQ) * 6144, H + (size_t)m * DM, lane);
    }
    SEAM(8);
    if (IN(9)) {
#if MK_DEBUG
        dbg_bf16(H, MX, 2048, 2048, DBG + 8, gt, ngt);
#endif
        pg8::StaticOrder S{32, 40, G, bid, (const char*)H, (const char*)WT3, (size_t)256 * 2048 * 2, (size_t)256 * 2048 * 2};
        Epi3 E{(bf16_t*)(ws + WS_P1)};
        pg8::gemm_phase<Epi3, pg8::StaticOrder>(lds, 2048, 2048, 2048, S, E);
    }
    SEAM(9);
    if (IN(10)) {
#if MK_DEBUG
        dbg_bf16((const bf16_t*)(ws + WS_P1), MX, N3, N3, DBG + 9, gt, ngt);
#endif
        for (int m = gw; m < MX; m += NGW) stats_row(m, (const bf16_t*)(ws + WS_P1), (float*)(ws + WS_STATS), lane);
        for (int t = gw; t < 128 * 16; t += NGW) { const int blk = t >> 4, cc = t & 15, grp = cc >> 2;
            const bf16_t* p = (const bf16_t*)(ws + WS_P1) + (size_t)(64 * blk) * N3 + 6144 + 128 * cc + 2 * lane; bf16_t* o = (bf16_t*)(ws + WS_DIFF) + (size_t)(64 * blk) * DM + 128 * cc + 2 * lane;
            if (grp == 0) diff_task<1>(p, o); else if (grp == 1) diff_task<2>(p, o); else if (grp == 2) diff_task<4>(p, o); else diff_task<8>(p, o); }
    }
    SEAM(10);
    if (IN(11)) {
#if MK_DEBUG
        dbg_f32((const float*)(ws + WS_STATS), 1, 2 * MX, 2 * MX, DBG + 10, gt, ngt); dbg_bf16((const bf16_t*)(ws + WS_DIFF), MX, 2048, 2048, DBG + 10, gt, ngt);
#endif
        SchedPool S{G, bid, (const char*)(ws + WS_DIFF), (const char*)WTP};
        EpiPool E{(const bf16_t*)(ws + WS_P1), (bf16_t*)(ws + WS_Y2), args.in[I_OPS]};
        pg8::gemm_phase<EpiPool, SchedPool>(lds, 512, 2048, 512, S, E);
        __syncthreads();
        for (int t = bid; t < 1024; t += G) tmix_task(t, lds, args.in[I_OWS], args.in[I_OBS], args.in[I_OLNW], args.in[I_OLNB], (const float*)(ws + WS_STATS), (const bf16_t*)(ws + WS_P1), (bf16_t*)(ws + WS_Y2));
    }
    SEAM(11);
    if (IN(12)) {
#if MK_DEBUG
        dbg_bf16((const bf16_t*)(ws + WS_Y2), MX, 4096, 4096, DBG + 11, gt, ngt);
#endif
        pg8::StaticOrder S{32, 8, G, bid, (const char*)(ws + WS_Y2), (const char*)WT4, (size_t)256 * 4096 * 2, (size_t)256 * 4096 * 2};
        EpiResid E{args.out, args.out, MOD + 5 * 6144 + 4096};
        pg8::gemm_phase<EpiResid, pg8::StaticOrder>(lds, 4096, 4096, 4096, S, E);
    }
    SEAM(12);
    if (IN(13)) {
#if MK_DEBUG
        dbg_f32(args.out, MX, 2048, 2048, DBG + 12, gt, ngt);
        for (size_t i = gt; i < (size_t)MX * DM; i += ngt) { const float v = args.out[i]; if (badf(v)) args.out[i] = 0.f; }
        asm volatile("s_waitcnt vmcnt(0)" ::: "memory"); __syncthreads();
#endif
        for (int m = gw; m < MX; m += NGW) final_row(args.out + (size_t)m * DM, args.in[I_FNW], lane);
#if MK_DEBUG
        asm volatile("s_waitcnt vmcnt(0)" ::: "memory"); __syncthreads();
        if (bid == 0 && tid == 0) { int first = -1; unsigned mask = 0; for (int k = 12; k >= 0; --k) if (__hip_atomic_load(DBG + k, __ATOMIC_RELAXED, __HIP_MEMORY_SCOPE_AGENT)) { first = k; mask |= 1u << k; }
            if (first >= 0) args.out[0] = 1000.f * (float)(first + 1);
            { int cb = 0, cf = 0; for (int q = 0; q < 64; ++q) { cb += (int)__hip_atomic_load(DBG + 1024 + q, __ATOMIC_RELAXED, __HIP_MEMORY_SCOPE_AGENT); cf += (int)__hip_atomic_load(DBG + 1024 + 64 + q, __ATOMIC_RELAXED, __HIP_MEMORY_SCOPE_AGENT); }
              args.out[0] = 1000.f * (float)(DBG_SEL ? cf : cb) + 500.f;
              if (DBG_SEL == 30 || DBG_SEL == 31) { const int dsel = DBG_SEL - 30; int fb = -1; for (int q = 0; q < 64; ++q) if (__hip_atomic_load(DBG + 1024 + (dsel ? 0 : 64) + q, __ATOMIC_RELAXED, __HIP_MEMORY_SCOPE_AGENT)) { fb = q; break; }
                  float mg = 0.f; if (fb >= 0) { const float* gq = (const float*)(ws + WS_GG) + ((size_t)dsel * NBH + fb) * NTOK; for (int i = 256; i < NTOK; ++i) mg += gq[i]; mg = -mg / 2048.f; }
                  args.out[0] = 1.0e4f * mg + 1000.f * 1000.f * (float)(fb & 15); }
              else if (DBG_SEL == 200) { args.out[0] = 1.0e5f * __uint_as_float(__hip_atomic_load(DBG + 980, __ATOMIC_RELAXED, __HIP_MEMORY_SCOPE_AGENT)) + 1000.f; }
              else if (DBG_SEL >= 60 && DBG_SEL < 124) { args.out[0] = 1.0e3f * __uint_as_float(__hip_atomic_load(DBG + 910 + (DBG_SEL - 60), __ATOMIC_RELAXED, __HIP_MEMORY_SCOPE_AGENT)); }
              else if (DBG_SEL >= 40 && DBG_SEL < 60) { const int bhq = DBG_SEL - 40; const bf16_t* tq = (const bf16_t*)(ws + WS_TU) + (((size_t)1 * NBH + bhq) * NCH + 20) * 4096; float so = 0.f, sd = 0.f;
                  for (int i = 0; i < 64; ++i) for (int j = 0; j < 64; ++j) { const float v = fabsf(bf2f(tq[i * 64 + j])); if (i == j) sd += v; else so += v; }
                  args.out[0] = 1.0e4f * so + 1.0e8f; }
              else if (DBG_SEL >= 10) args.out[0] = 1.0e2f * __uint_as_float(__hip_atomic_load(DBG + 900 + (DBG_SEL - 10), __ATOMIC_RELAXED, __HIP_MEMORY_SCOPE_AGENT)); } }
#endif
    }
#if STOP_AFTER < 13
    if (lo == 14) {
        const size_t NO = (size_t)MX * DM; const size_t gtid = (size_t)bid * 512 + tid, ngtid = (size_t)G * 512;
        for (size_t i = gtid; i < NO; i += ngtid) {
            float acc = 0.f;
#define DG_BF(off, n) do { const bf16_t* q_ = (const bf16_t*)(ws + (off)); for (size_t j = i; j < (size_t)(n); j += NO) acc += bf2f(q_[j]); } while (0)
#define DG_F32(off, n) do { const float* q_ = (const float*)(ws + (off)); for (size_t j = i; j < (size_t)(n); j += NO) acc += q_[j]; } while (0)
#if STOP_AFTER == 0
            DG_BF(WS_WT1, (size_t)16640 * 2048); DG_BF(WS_WT2, (size_t)2048 * 4096); DG_F32(WS_MOD, 5 * 6144);
#elif STOP_AFTER == 1
            DG_BF(WS_H, (size_t)MT * 2048);
#elif STOP_AFTER == 2
            DG_BF(WS_PQKV, (size_t)MT * 6144); DG_BF(WS_ZA, (size_t)MX * 2048); DG_F32(WS_AB, (size_t)MT * 64);
            { const bf16_t* q_ = (const bf16_t*)(ws + WS_Y); const size_t r = i / 2048, c = i % 2048; acc += bf2f(q_[r * 4096 + 2048 + c]); }
#elif STOP_AFTER == 3
            DG_BF(WS_QN, (size_t)64 * NTOK * 128); DG_BF(WS_KN, (size_t)64 * NTOK * 128); DG_BF(WS_KT, (size_t)64 * NTOK * 128); DG_BF(WS_VT, (size_t)64 * NTOK * 128);
            DG_F32(WS_GG, (size_t)128 * NTOK); DG_F32(WS_BETA, (size_t)128 * NTOK);
#elif STOP_AFTER == 4
            DG_BF(WS_TU, (size_t)128 * NCH * 4096); DG_F32(WS_GC, (size_t)128 * NTOK); DG_F32(WS_MOD, 10 * 6144);
            DG_BF(WS_WT3, (size_t)10240 * 2048); DG_BF(WS_WT4, (size_t)2048 * 4096); DG_BF(WS_WTP, (size_t)2048 * 512);
            { const bf16_t* q_ = (const bf16_t*)(ws + WS_AI); for (size_t j = i; j < (size_t)128 * NCH * 4096; j += NO) { const size_t tcq = (j / 4096) % NCH; if (tcq >= 4) acc += bf2f(q_[j]); } }
#elif STOP_AFTER == 5
            DG_BF(WS_OF, (size_t)MX * 2048); DG_BF(WS_OB, (size_t)MX * 2048);
#elif STOP_AFTER == 6
            DG_BF(WS_Y, (size_t)MX * 4096);
#elif STOP_AFTER == 7
            acc = args.out[i];
#elif STOP_AFTER == 8
            DG_BF(WS_H, (size_t)MX * 2048);
#elif STOP_AFTER == 9
            DG_BF(WS_P1, (size_t)MX * N3);
#elif STOP_AFTER == 10
            DG_BF(WS_DIFF, (size_t)MX * 2048); DG_F32(WS_STATS, (size_t)MX * 2);
#elif STOP_AFTER == 11
            DG_BF(WS_Y2, (size_t)MX * 4096);
#else
            acc = args.out[i];
#endif
            if (badf(acc)) acc = 12345.f;
            args.out[i] = acc;
        }
    }
#endif
#undef IN
#undef SEAM
}

extern "C" void kernel_launch(void* const* d_in, const int* in_sizes, int n_in, void* d_out, int out_size, void* d_ws, size_t ws_size, hipStream_t stream) {
    static int grid = 0;
    if (grid == 0) {
        if (n_in != 23 || out_size != MX * DM || ws_size < WS_END) { fprintf(stderr, "kernel_launch: unexpected shapes (n_in %d, out %d, ws %zu < %zu)\n", n_in, out_size, ws_size, (size_t)WS_END); grid = -1; return; }
        int dev = 0, cus = 0, per_cu = 0;
        if (hipGetDevice(&dev) != hipSuccess || hipDeviceGetAttribute(&cus, hipDeviceAttributeMultiprocessorCount, dev) != hipSuccess) { grid = -1; return; }
        if (hipFuncSetAttribute((const void*)fwd_kernel, hipFuncAttributeMaxDynamicSharedMemorySize, LDS_BYTES) != hipSuccess) { fprintf(stderr, "kernel_launch: hipFuncSetAttribute failed\n"); grid = -1; return; }
        if (hipOccupancyMaxActiveBlocksPerMultiprocessor(&per_cu, (const void*)fwd_kernel, 512, LDS_BYTES) != hipSuccess || per_cu < 1) { fprintf(stderr, "kernel_launch: occupancy query says %d\n", per_cu); }
        (void)hipGetLastError();
        grid = cus;
    }
    if (grid < 0) return;
    if (hipMemsetAsync((char*)d_ws + WS_CTL, 0, CTL_BYTES, stream) != hipSuccess) { fprintf(stderr, "kernel_launch: memset failed\n"); return; }
    Args a{};
    for (int i = 0; i < 23; ++i) a.in[i] = (const float*)d_in[i];
    a.out = (float*)d_out; a.ws = (unsigned char*)d_ws; a.never = 0; a.pad = 0;
    const int nl = (STOP_AFTER < 13) ? STOP_AFTER + 2 : MK_N_LAUNCHES;
    for (int li = 0; li < nl; ++li) {
        a.ph_lo = (nl == 1) ? 0 : li; a.ph_hi = (nl == 1) ? NPHASE : li + 1;
        if (STOP_AFTER < 13 && li == nl - 1) { a.ph_lo = 14; a.ph_hi = 15; }
        void* kargs[] = {&a};
        hipError_t e = hipLaunchCooperativeKernel((const void*)fwd_kernel, dim3(grid), dim3(512), kargs, LDS_BYTES, stream);
        if (e != hipSuccess) { fprintf(stderr, "kernel_launch: launch %d failed: %s\n", li, hipGetErrorString(e)); break; }
    }
}
```

```cpp
#include <hip/hip_runtime.h>
#include <hip/hip_cooperative_groups.h>
#include <cstdio>
#include <cstdint>
namespace cg = cooperative_groups;

#ifndef MK_N_LAUNCHES
#define MK_N_LAUNCHES 1
#endif
#ifndef DBG_SEL
#define DBG_SEL 200
#endif
#ifndef ABLATE
#define ABLATE 0
#endif
#ifndef STOP_AFTER
#define STOP_AFTER 13
#endif

#define LAS __attribute__((address_space(3)))
typedef unsigned short bf16_t;
typedef short bf16x8 __attribute__((ext_vector_type(8)));
typedef float f32x2 __attribute__((ext_vector_type(2)));
typedef float f32x4 __attribute__((ext_vector_type(4)));
typedef float f32x16 __attribute__((ext_vector_type(16)));
typedef unsigned u32x2 __attribute__((ext_vector_type(2)));
typedef unsigned u32x4 __attribute__((ext_vector_type(4)));

constexpr int DM = 2048, NB = 4, SEQ = 2048, CTXL = 256, MX = NB * SEQ, MC = NB * CTXL, MT = MX + MC;
constexpr int NTOK = CTXL + SEQ;
constexpr int NHD = 16, HD = 128, NBH = NB * NHD;
constexpr int N1SRC = 16448, N1P = 16640, N3 = 10240;
constexpr int NCH = NTOK / 64;
constexpr float EPS = 1e-6f;
constexpr int NPHASE = 14;

constexpr size_t MiB = 1u << 20;
constexpr size_t WS_CTL = 0, CTL_BYTES = 1 * MiB;
constexpr size_t WS_MOD = 1 * MiB;
constexpr size_t WS_GG = 2 * MiB, WS_BETA = 4 * MiB, WS_GC = 6 * MiB;
constexpr size_t WS_STATS = 7 * MiB + 512 * 1024;
constexpr size_t WS_WT2 = 8 * MiB;
constexpr size_t WS_WT1 = 24 * MiB;
constexpr size_t WS_WT3 = 24 * MiB, WS_WT4 = 64 * MiB, WS_WTP = 80 * MiB;
constexpr size_t WS_H = 89 * MiB;
constexpr size_t WS_OB = 89 * MiB;
constexpr size_t WS_PQKV = 125 * MiB;
constexpr size_t WS_TU = 125 * MiB, WS_AI = 161 * MiB, WS_OF = 197 * MiB;
constexpr size_t WS_ZA = 233 * MiB;
constexpr size_t WS_AB = 265 * MiB;
constexpr size_t WS_Y = 268 * MiB;
constexpr size_t WS_QN = 332 * MiB, WS_KN = 368 * MiB, WS_KT = 404 * MiB, WS_VT = 440 * MiB;
constexpr size_t WS_P1 = 125 * MiB;
constexpr size_t WS_DIFF = 285 * MiB;
constexpr size_t WS_Y2 = 396 * MiB;
constexpr size_t WS_END = 476 * MiB;
constexpr int CW_BAR = 4096;

constexpr int LDS_BYTES = 147456;
constexpr int MISC_OFF = LDS_BYTES - 256;

__device__ __forceinline__ float bf_lo(unsigned w) { return __uint_as_float(w << 16); }
__device__ __forceinline__ float bf_hi(unsigned w) { return __uint_as_float(w & 0xffff0000u); }
__device__ __forceinline__ float bf2f(bf16_t b) { return __uint_as_float(((unsigned)b) << 16); }
typedef __bf16 bf16v2 __attribute__((ext_vector_type(2)));
__device__ __forceinline__ unsigned cvt_pk_bf16(float lo, float hi) { const f32x2 v = {lo, hi}; const bf16v2 r = __builtin_convertvector(v, bf16v2); return __builtin_bit_cast(unsigned, r); }
__device__ __forceinline__ bf16_t f2bf(float f) { return (bf16_t)(cvt_pk_bf16(f, 0.f) & 0xffffu); }
__device__ __forceinline__ float sigmoid_f(float x) { return __builtin_amdgcn_rcpf(1.0f + __expf(-x)); }
__device__ __forceinline__ float silu_f(float x) { return x * sigmoid_f(x); }
__device__ __forceinline__ float gelu_f(float x) { const float u = 0.7978845608028654f * (x + 0.044715f * x * x * x); return x * sigmoid_f(2.0f * u); }
__device__ __forceinline__ float softplus_f(float x) { return fmaxf(x, 0.f) + log1pf(__expf(-fabsf(x))); }
__device__ __forceinline__ float wave_sum(float v) {
#pragma unroll
    for (int o = 1; o < 64; o <<= 1) v += __shfl_xor(v, o);
    return v;
}
__device__ __forceinline__ float dpp_shr1(float x, float old) { return __builtin_bit_cast(float, __builtin_amdgcn_update_dpp(__builtin_bit_cast(int, old), __builtin_bit_cast(int, x), 0x111, 0xf, 0xf, false)); }
__device__ __forceinline__ float dpp_shl1(float x, float old) { return __builtin_bit_cast(float, __builtin_amdgcn_update_dpp(__builtin_bit_cast(int, old), __builtin_bit_cast(int, x), 0x101, 0xf, 0xf, false)); }
#ifndef MK_DEBUG
#define MK_DEBUG 0
#endif
#define LDS_WAIT() asm volatile("s_waitcnt lgkmcnt(0)" ::: "memory")

#define XB_TMO      128
#define XB_XCNT(j)  (256  + 64 * (j))
#define XB_XSUB(j)  (1280 + 64 * (j))
#define XB_XGEN(j)  (2304 + 64 * (j))
#define XB_TOP      3328
#define XB_TOPGEN   3392
#define XCD_BAR_WORDS 3456
#define XB_SPIN_CAP (1u << 20)
__device__ __forceinline__ unsigned xb_ld(unsigned* p)              { return __hip_atomic_load(p, __ATOMIC_RELAXED, __HIP_MEMORY_SCOPE_AGENT); }
__device__ __forceinline__ unsigned xb_add(unsigned* p, unsigned v) { return __hip_atomic_fetch_add(p, v, __ATOMIC_RELAXED, __HIP_MEMORY_SCOPE_AGENT); }
__device__ __forceinline__ unsigned xb_xcc_id() { return (unsigned)__builtin_amdgcn_s_getreg((3 << 11) | 20) & 0xFu; }
#define XB_SPIN(cond, bar) do { unsigned _sp = 0; while (cond) { __builtin_amdgcn_s_sleep(1); \
    if ((++_sp & 255u) == 0u) { if (xb_ld(&(bar)[XB_TMO])) break; if (_sp > XB_SPIN_CAP) { atomicAdd(&(bar)[XB_TMO], 1u); break; } } } } while (0)
struct XcdBarrier { unsigned* bar; unsigned x; volatile LAS unsigned* st; };
__device__ __forceinline__ XcdBarrier xcd_barrier_post(unsigned* bar, volatile LAS unsigned* st) {
    XcdBarrier b; b.bar = bar; b.x = xb_xcc_id(); b.st = st;
    if (threadIdx.x == 0) (void)xb_add(&bar[XB_XCNT(b.x)], 1u);
    return b;
}
__device__ __forceinline__ void xcd_barrier_complete(unsigned* bar, unsigned x, unsigned& nloc, unsigned& nx) {
    const unsigned G = gridDim.x * gridDim.y * gridDim.z;
    unsigned sum, cnt, mine, sp = 0u;
    for (;;) {
        sum = 0u; cnt = 0u; mine = 0u;
#pragma unroll
        for (unsigned j = 0; j < 16; ++j) { const unsigned c = xb_ld(&bar[XB_XCNT(j)]); sum += c; cnt += (c > 0u) ? 1u : 0u; mine = (j == x) ? c : mine; }
        if (sum == G) break;
        __builtin_amdgcn_s_sleep(1);
        if ((++sp & 255u) == 0u) { if (xb_ld(&bar[XB_TMO])) break; if (sp > XB_SPIN_CAP) { atomicAdd(&bar[XB_TMO], 1u); break; } }
    }
    nloc = mine > 0u ? mine : 1u; nx = cnt > 0u ? cnt : 1u;
}
__device__ __forceinline__ void xcd_barrier(const XcdBarrier& b) {
    asm volatile("s_waitcnt vmcnt(0)" ::: "memory");
    __syncthreads();
    if (threadIdx.x == 0) {
        unsigned* bar = b.bar;
        __builtin_amdgcn_s_waitcnt(0);
        unsigned nloc = b.st[0], nx = b.st[1];
        if (nloc == 0u) { xcd_barrier_complete(bar, b.x, nloc, nx); b.st[0] = nloc; b.st[1] = nx; }
        const unsigned old = xb_add(&bar[XB_XSUB(b.x)], 1u);
        const unsigned gen = old / nloc;
        if (old + 1u == (gen + 1u) * nloc) {
            __builtin_amdgcn_fence(__ATOMIC_RELEASE, "agent");
            asm volatile("s_waitcnt vmcnt(0)" ::: "memory");
            const unsigned og = xb_add(&bar[XB_TOP], 1u);
            const unsigned tg = og / nx;
            if (og + 1u == (tg + 1u) * nx) xb_add(&bar[XB_TOPGEN], 1u);
            else XB_SPIN(xb_ld(&bar[XB_TOPGEN]) == tg, bar);
            __builtin_amdgcn_fence(__ATOMIC_ACQUIRE, "agent");
            xb_add(&bar[XB_XGEN(b.x)], 1u);
            asm volatile("s_waitcnt vmcnt(0)" ::: "memory");
        } else {
            XB_SPIN(xb_ld(&bar[XB_XGEN(b.x)]) == gen, bar);
            __builtin_amdgcn_fence(__ATOMIC_ACQUIRE, "agent");
            asm volatile("s_waitcnt vmcnt(0)" ::: "memory");
        }
    }
    __syncthreads();
}

namespace pg8 {
constexpr int BM = 256, BK = 64, HALF = 128, HTB = HALF * BK * 2, STAGE_BYTES = 8 * HTB, NXCD = 8, WGM = 8;
__host__ __device__ __forceinline__ int lds_byte(int r, int c) { const int st = (r >> 4) * 2 + (c >> 5), rr = r & 15, cc = c & 31, ob = rr * 64 + cc * 2; return st * 1024 + (ob ^ (((ob >> 9) & 1) << 5)); }
__host__ __device__ __forceinline__ void stage_rc(int b, int& R, int& C) { const int st = b / 1024, sb = b % 1024, swz = sb ^ (((sb >> 9) & 1) << 5); R = (st >> 1) * 16 + swz / 64; C = (st & 1) * 32 + (swz % 64) / 2; }
__host__ __device__ __forceinline__ int perm32(int rho) { const int n = rho >> 4, i = rho & 15; return 8 * (i >> 2) + 4 * n + (i & 3); }
struct Unit { int pm, pn, aux; const char* a; const char* b; };
__device__ __forceinline__ void tile_order(int L, int nM, int nN, int& pm, int& pn) {
    const int nwg = nM * nN; int wgid = L;
    { const int q = nwg / NXCD, r = nwg % NXCD, xcd = wgid % NXCD, off = wgid / NXCD; wgid = (xcd < r ? xcd * (q + 1) : r * (q + 1) + (xcd - r) * q) + off; }
    const int nig = WGM * nN, gid = wgid / nig, fm = gid * WGM, gsz = (nM - fm) < WGM ? (nM - fm) : WGM;
    pm = fm + ((wgid % nig) % gsz); pn = (wgid % nig) / gsz;
}
struct StaticOrder {
    int nM, nN, G, c; const char* A; const char* B; size_t ta, tb;
    __device__ __forceinline__ bool next(int i, Unit& u) const {
        const long L = (long)i * G + c; if (L >= (long)nM * nN) return false;
        tile_order((int)L, nM, nN, u.pm, u.pn); u.aux = 0; u.a = A + (size_t)u.pm * ta; u.b = B + (size_t)u.pn * tb; return true;
    }
};
#define PG8_LAS __attribute__((address_space(3)))
template <class Epi, class Sched>
__device__ __forceinline__ void gemm_phase(PG8_LAS unsigned char* lds, const int K, const int lda, const int ldb, const Sched& S, const Epi& E) {
    const int tid = threadIdx.x, wid = __builtin_amdgcn_readfirstlane(tid >> 6), lane = tid & 63, wr = wid >> 2, wc = wid & 3, fr = lane & 15, fq = lane >> 4;
    const int nt = K / BK;
    unsigned voffA[2], voffB[2];
#pragma unroll
    for (int i = 0; i < 2; ++i) { int R, C; stage_rc(tid * 16 + i * 8192, R, C); const int Rb = Epi::PERM ? ((R & ~31) + perm32(R & 31)) : R;
        voffA[i] = (unsigned)(R * lda + C) * 2u; voffB[i] = (unsigned)(Rb * ldb + C) * 2u; }
    const size_t kstep = (size_t)(BK * 2);
    const size_t hstepA = (size_t)HALF * lda * 2, hstepB = (size_t)HALF * ldb * 2;
    const unsigned ldsw = (unsigned)wid * 1024u;
    const int aoff = lds_byte(wr * 64 + fr, fq * 8), boff = lds_byte(wc * 32 + fr, fq * 8);
#define PG8_SA(b, h) (((b) * 2 + (h)) * HTB)
#define PG8_SB(b, h) ((4 + (b) * 2 + (h)) * HTB)
#define PG8_STAGE(bufoff, gbase, voff) do { _Pragma("unroll") for (int _i = 0; _i < 2; ++_i) \
        __builtin_amdgcn_global_load_lds((const unsigned*)((const char*)(gbase) + (voff)[_i]), (PG8_LAS unsigned*)(lds + (bufoff) + ldsw + _i * 8192), 16, 0, 0); } while (0)
#define PG8_LDA(dst, b, h) do { _Pragma("unroll") for (int m = 0; m < 4; ++m) _Pragma("unroll") for (int k = 0; k < 2; ++k) dst[m][k] = *(const PG8_LAS bf16x8*)(lds + PG8_SA(b, h) + aoff + m * 2048 + k * 1024); } while (0)
#define PG8_LDB(dst, b, h) do { _Pragma("unroll") for (int n = 0; n < 2; ++n) _Pragma("unroll") for (int k = 0; k < 2; ++k) dst[n][k] = *(const PG8_LAS bf16x8*)(lds + PG8_SB(b, h) + boff + n * 2048 + k * 1024); } while (0)
#define PG8_MMA(ai, bj, At, Bt) do { __builtin_amdgcn_s_setprio(1); _Pragma("unroll") for (int m = 0; m < 4; ++m) _Pragma("unroll") for (int n = 0; n < 2; ++n) _Pragma("unroll") for (int k = 0; k < 2; ++k) \
        acc[ai][bj][m][n] = __builtin_amdgcn_mfma_f32_16x16x32_bf16(Bt[n][k], At[m][k], acc[ai][bj][m][n], 0, 0, 0); __builtin_amdgcn_s_setprio(0); } while (0)
#define PG8_WAIT_V(n) asm volatile("s_waitcnt vmcnt(" #n ")" ::: "memory")
#define PG8_WAIT_L(n) asm volatile("s_waitcnt lgkmcnt(" #n ")" ::: "memory")
#define PG8_BAR __builtin_amdgcn_s_barrier()
#define PG8_SCHED __builtin_amdgcn_sched_barrier(0)
    Unit cur, nxt; int ui = 0;
    if (!S.next(0, cur)) return;
    f32x4 acc[2][2][4][2];
#pragma unroll
    for (int a = 0; a < 2; ++a)
#pragma unroll
        for (int b = 0; b < 2; ++b)
#pragma unroll
            for (int m = 0; m < 4; ++m)
#pragma unroll
                for (int n = 0; n < 2; ++n) acc[a][b][m][n] = (f32x4){0.f, 0.f, 0.f, 0.f};
    bf16x8 At[4][2], B0[2][2], B1[2][2];
    const char* cA = cur.a; const char* cB = cur.b;
    PG8_STAGE(PG8_SB(0, 0), cB, voffB); PG8_STAGE(PG8_SB(0, 1), cB + hstepB, voffB); PG8_STAGE(PG8_SA(0, 0), cA, voffA); PG8_STAGE(PG8_SA(0, 1), cA + hstepA, voffA);
    if (wr == 1) PG8_BAR;
    PG8_WAIT_V(2); PG8_BAR;
    PG8_STAGE(PG8_SB(1, 0), cB + kstep, voffB); PG8_STAGE(PG8_SA(1, 0), cA + kstep, voffA); PG8_STAGE(PG8_SB(1, 1), cB + hstepB + kstep, voffB);
    PG8_WAIT_V(6); PG8_BAR;
    for (;;) {
        const bool has_next = S.next(ui + 1, nxt);
        const char* nA = has_next ? nxt.a : cA; const char* nB = has_next ? nxt.b : cB;
        for (int t = 0; t < nt; t += 2) {
            const bool last = (t == nt - 2);
            const char* a1 = cA + (size_t)(t + 1) * kstep;
            const char* a2 = last ? nA : cA + (size_t)(t + 2) * kstep; const char* b2 = last ? nB : cB + (size_t)(t + 2) * kstep;
            const char* a3 = a2 + kstep; const char* b3 = b2 + kstep;
            PG8_LDB(B0, 0, 0); PG8_LDB(B1, 0, 1); PG8_SCHED; PG8_LDA(At, 0, 0); PG8_STAGE(PG8_SA(1, 1), a1 + hstepA, voffA);
            PG8_WAIT_V(8); PG8_WAIT_L(0); PG8_BAR; PG8_MMA(0, 0, At, B0); PG8_MMA(0, 1, At, B1); PG8_BAR; PG8_SCHED;
            PG8_LDA(At, 0, 1); PG8_STAGE(PG8_SB(0, 0), b2, voffB); PG8_STAGE(PG8_SB(0, 1), b2 + hstepB, voffB); PG8_STAGE(PG8_SA(0, 0), a2, voffA);
            PG8_WAIT_V(8); PG8_WAIT_L(0); PG8_BAR; PG8_MMA(1, 0, At, B0); PG8_MMA(1, 1, At, B1); PG8_BAR; PG8_SCHED;
            PG8_LDB(B0, 1, 0); PG8_LDB(B1, 1, 1); PG8_SCHED; PG8_LDA(At, 1, 0); PG8_STAGE(PG8_SA(0, 1), a2 + hstepA, voffA);
            PG8_WAIT_V(8); PG8_WAIT_L(0); PG8_BAR; PG8_MMA(0, 0, At, B0); PG8_MMA(0, 1, At, B1); PG8_BAR; PG8_SCHED;
            PG8_LDA(At, 1, 1); PG8_STAGE(PG8_SB(1, 0), b3, voffB); PG8_STAGE(PG8_SB(1, 1), b3 + hstepB, voffB); PG8_STAGE(PG8_SA(1, 0), a3, voffA);
            PG8_WAIT_V(8); PG8_WAIT_L(0); PG8_BAR; PG8_MMA(1, 0, At, B0); PG8_MMA(1, 1, At, B1); PG8_BAR; PG8_SCHED;
        }
        if (wr == 0) PG8_BAR;
        E(acc, cur, wr, wc, fr, fq);
        if (!has_next) break;
#pragma unroll
        for (int a = 0; a < 2; ++a)
#pragma unroll
            for (int b = 0; b < 2; ++b)
#pragma unroll
                for (int m = 0; m < 4; ++m)
#pragma unroll
                    for (int n = 0; n < 2; ++n) acc[a][b][m][n] = (f32x4){0.f, 0.f, 0.f, 0.f};
        cur = nxt; cA = nA; cB = nB; ++ui;
        if (wr == 1) PG8_BAR;
    }
    PG8_WAIT_V(0);
    PG8_BAR;
#undef PG8_SA
#undef PG8_SB
#undef PG8_STAGE
#undef PG8_LDA
#undef PG8_LDB
#undef PG8_MMA
#undef PG8_WAIT_V
#undef PG8_WAIT_L
#undef PG8_BAR
#undef PG8_SCHED
}
}

#if MK_DEBUG
__device__ __forceinline__ bool badf(float v) { return !(fabsf(v) < 1e30f); }
__device__ __forceinline__ void dbg_bf16(const bf16_t* p, int rows, int cols, size_t ld, unsigned* flag, int gt, int ngt) {
    const int cpr = cols / 8; bool bad = false;
    for (size_t i = gt; i < (size_t)rows * cpr; i += ngt) { const size_t r = i / cpr, c = (i % cpr) * 8; const u32x4 a = *(const u32x4*)(p + r * ld + c);
        bad |= badf(bf_lo(a.x)) | badf(bf_hi(a.x)) | badf(bf_lo(a.y)) | badf(bf_hi(a.y)) | badf(bf_lo(a.z)) | badf(bf_hi(a.z)) | badf(bf_lo(a.w)) | badf(bf_hi(a.w)); }
    if (bad) *flag = 1u;
}
__device__ __forceinline__ void dbg_max_bf16(const bf16_t* p, size_t n, unsigned* slot, int gt, int ngt) {
    float m = 0.f;
    for (size_t i = (size_t)gt * 8; i < n; i += (size_t)ngt * 8) { const u32x4 a = *(const u32x4*)(p + i);
        m = fmaxf(m, fmaxf(fmaxf(fmaxf(fabsf(bf_lo(a.x)), fabsf(bf_hi(a.x))), fmaxf(fabsf(bf_lo(a.y)), fabsf(bf_hi(a.y)))), fmaxf(fmaxf(fabsf(bf_lo(a.z)), fabsf(bf_hi(a.z))), fmaxf(fabsf(bf_lo(a.w)), fabsf(bf_hi(a.w)))))); }
    atomicMax(slot, __float_as_uint(m));
}
__device__ __forceinline__ void dbg_f32(const float* p, int rows, int cols, size_t ld, unsigned* flag, int gt, int ngt) {
    const int cpr = cols / 4; bool bad = false;
    for (size_t i = gt; i < (size_t)rows * cpr; i += ngt) { const size_t r = i / cpr, c = (i % cpr) * 4; const f32x4 a = *(const f32x4*)(p + r * ld + c);
        bad |= badf(a.x) | badf(a.y) | badf(a.z) | badf(a.w); }
    if (bad) *flag = 1u;
}
#endif
struct Args { const float* in[23]; float* out; unsigned char* ws; int ph_lo, ph_hi, never, pad; };
enum { I_X = 0, I_C, I_CTX, I_CCTX, I_ADAW, I_ADAB, I_NORMW, I_EWIN, I_ECONVQKV, I_EALOG, I_EDTB, I_EHN, I_ECONVB, I_EWOUT, I_OWIN, I_OLNW, I_OLNB, I_OWS, I_OBS, I_OPW, I_OPS, I_OWOUT, I_FNW };

template <class SrcFn>
__device__ __forceinline__ void conv_item(const float* W, int ldw, int K, bf16_t* WT, int c0, int k0, LAS float* scr, int lane, const SrcFn& src) {
    const int sc = src(c0 + (lane & 31));
#pragma unroll 8
    for (int i = 0; i < 32; ++i) { const int kk = 2 * i + (lane >> 5); scr[kk * 33 + (lane & 31)] = sc >= 0 ? W[(size_t)(k0 + kk) * ldw + sc] : 0.f; }
    LDS_WAIT(); asm volatile("" ::: "memory");
    const int c = lane & 7;
#pragma unroll
    for (int j = 0; j < 4; ++j) { const int n = (lane >> 3) + 8 * j; const LAS float* s = scr + (8 * c) * 33 + n;
        u32x4 o; o.x = cvt_pk_bf16(s[0 * 33], s[1 * 33]); o.y = cvt_pk_bf16(s[2 * 33], s[3 * 33]); o.z = cvt_pk_bf16(s[4 * 33], s[5 * 33]); o.w = cvt_pk_bf16(s[6 * 33], s[7 * 33]);
        *(u32x4*)(WT + (size_t)(c0 + n) * K + k0 + 8 * c) = o; }
    LDS_WAIT(); asm volatile("" ::: "memory");
}
struct SrcId { __device__ __forceinline__ int operator()(int c) const { return c; } };
struct SrcW1 { __device__ __forceinline__ int operator()(int c) const {
    if (c < 8192) return c;
    if (c < 16384) { const int cc = c - 8192, T = cc >> 8, cp = cc & 255, bj = cp >> 7, wc = (cp >> 5) & 3, fq = (cp >> 3) & 3, n = (cp >> 2) & 1, j = cp & 3;
        return 8256 + 2048 * (2 * bj + n) + 64 * T + 16 * wc + 4 * fq + j; }
    const int cp = c - 16384; return cp < 64 ? 8192 + cp : -1; } };

__device__ __forceinline__ void mod_task(const float* adaw, const float* adab, float* modl, int n0, const LAS float* tab, LAS float* red, int wave, int lane) {
    const int col = n0 + (lane & 31), kp = lane >> 5;
    float acc[5] = {0.f, 0.f, 0.f, 0.f, 0.f};
    const float* wp = adaw + (size_t)(256 * wave + kp) * 6144 + col;
#pragma unroll 8
    for (int kk = 0; kk < 128; ++kk) { const float wv = wp[(size_t)kk * 2 * 6144]; const int k = 256 * wave + 2 * kk + kp;
#pragma unroll
        for (int r = 0; r < 5; ++r) acc[r] += tab[r * 2048 + k] * wv; }
#pragma unroll
    for (int r = 0; r < 5; ++r) { acc[r] += __shfl_xor(acc[r], 32); if (lane < 32) red[(wave * 5 + r) * 32 + lane] = acc[r]; }
    __syncthreads();
    if (threadIdx.x < 160) { const int r = threadIdx.x >> 5, c = threadIdx.x & 31; float s = adab[n0 + c];
#pragma unroll
        for (int w = 0; w < 8; ++w) s += red[(w * 5 + r) * 32 + c];
        modl[r * 6144 + n0 + c] = s; }
    __syncthreads();
}
__device__ __forceinline__ void silu_table(const float* c, const float* cctx, LAS float* tab) {
    for (int i = threadIdx.x; i < 5 * 2048; i += 512) { const float v = i < 8192 ? c[i] : cctx[i - 8192]; tab[i] = silu_f(v); }
    __syncthreads();
}

__device__ __forceinline__ void hrow(const float* xrow, const float* nw, const float* modr, bf16_t* orow, int lane) {
    const f32x4* xr = (const f32x4*)xrow + lane;
    f32x4 v[8]; float s = 0.f;
#pragma unroll
    for (int j = 0; j < 8; ++j) { v[j] = xr[64 * j]; s += (v[j].x * v[j].x + v[j].y * v[j].y) + (v[j].z * v[j].z + v[j].w * v[j].w); }
    const float rstd = rsqrtf(wave_sum(s) * (1.f / DM) + EPS);
    u32x2* o8 = (u32x2*)orow + lane;
#pragma unroll
    for (int j = 0; j < 8; ++j) { const f32x4 w = ((const f32x4*)nw)[lane + 64 * j], sh = ((const f32x4*)modr)[lane + 64 * j], sc = ((const f32x4*)(modr + 2048))[lane + 64 * j];
        const f32x4 y = v[j] * rstd * w * (sc + 1.0f) + sh; u32x2 p; p.x = cvt_pk_bf16(y.x, y.y); p.y = cvt_pk_bf16(y.z, y.w); o8[64 * j] = p; }
}

typedef f32x4 AccT[2][2][4][2];
struct Sched1 { int G, c; const char* A; const char* B;
    __device__ __forceinline__ bool next(int i, pg8::Unit& u) const {
        const int L = i * G + c; if (L >= 2180) return false;
        if (L < 2080) pg8::tile_order(L, 32, 65, u.pm, u.pn);
        else { const int l = L - 2080; u.pm = 32 + (l & 3); const int t = l >> 2; u.pn = t < 24 ? t : 64; }
        u.aux = 0; u.a = A + (size_t)u.pm * (256 * 2048 * 2); u.b = B + (size_t)u.pn * (256 * 2048 * 2); return true; } };
struct Epi1 { static constexpr bool PERM = true;
    bf16_t* PQKV; bf16_t* ZA; float* AB; bf16_t* Y; const float* convb;
    __device__ __forceinline__ void operator()(const AccT& acc, const pg8::Unit& u, int wr, int wc, int fr, int fq) const {
        const int row0 = u.pm * 256 + wr * 64 + fr;
        if (u.pn < 32) {
            const bool act = u.pn >= 24;
            bf16_t* base = act ? ZA : PQKV; const int ldc = act ? 2048 : 6144; const int col0 = (act ? (u.pn - 24) : u.pn) * 256 + wc * 32 + 8 * fq;
#pragma unroll
            for (int ai = 0; ai < 2; ++ai)
#pragma unroll
                for (int m = 0; m < 4; ++m) { bf16_t* rowp = base + (size_t)(row0 + ai * 128 + m * 16) * ldc + col0;
#pragma unroll
                    for (int bj = 0; bj < 2; ++bj) { f32x4 v0 = acc[ai][bj][m][0], v1 = acc[ai][bj][m][1];
                        if (act) {
#pragma unroll
                            for (int j = 0; j < 4; ++j) { v0[j] = silu_f(v0[j]); v1[j] = silu_f(v1[j]); } }
                        u32x4 w; w.x = cvt_pk_bf16(v0[0], v0[1]); w.y = cvt_pk_bf16(v0[2], v0[3]); w.z = cvt_pk_bf16(v1[0], v1[1]); w.w = cvt_pk_bf16(v1[2], v1[3]);
                        *(u32x4*)(rowp + bj * 128) = w; } }
        } else if (u.pn < 64) {
            const int lane = threadIdx.x & 63;
            const int ch0 = 64 * (u.pn - 32) + 16 * wc + 4 * fq;
            const f32x4 cw0 = *(const f32x4*)(convb + ch0), cw1 = *(const f32x4*)(convb + 2048 + ch0), cw2 = *(const f32x4*)(convb + 4096 + ch0);
#pragma unroll
            for (int ai = 0; ai < 2; ++ai) {
                f32x4 pr[4];
#pragma unroll
                for (int m = 0; m < 4; ++m) pr[m] = acc[ai][0][m][1] * acc[ai][1][m][0];
#pragma unroll
                for (int m = 0; m < 4; ++m) { f32x4 y;
#pragma unroll
                    for (int j = 0; j < 4; ++j) {
                        const float bp = m > 0 ? __shfl(pr[m > 0 ? m - 1 : 0][j], lane | 15) : 0.f;
                        const float bn = m < 3 ? __shfl(pr[m < 3 ? m + 1 : 3][j], lane & ~15) : 0.f;
                        const float up = dpp_shr1(pr[m][j], bp), dn = dpp_shl1(pr[m][j], bn);
                        const float cv = cw0[j] * up + cw1[j] * pr[m][j] + cw2[j] * dn;
                        y[j] = acc[ai][0][m][0][j] * cv * silu_f(acc[ai][1][m][1][j]); if (ABLATE & 2) y[j] = 0.f; }
                    u32x2 w; w.x = cvt_pk_bf16(y[0], y[1]); w.y = cvt_pk_bf16(y[2], y[3]);
                    *(u32x2*)(Y + (size_t)(row0 + ai * 128 + m * 16) * 4096 + 2048 + ch0) = w; } }
        } else {
            if (wc < 2) {
#pragma unroll
                for (int ai = 0; ai < 2; ++ai)
#pragma unroll
                    for (int m = 0; m < 4; ++m)
#pragma unroll
                        for (int n = 0; n < 2; ++n) *(f32x4*)(AB + (size_t)(row0 + ai * 128 + m * 16) * 64 + 32 * wc + 8 * fq + 4 * n) = acc[ai][0][m][n]; }
        }
    } };
struct EpiResid { static constexpr bool PERM = false;
    const float* resid; float* out; const float* gate;
    __device__ __forceinline__ void operator()(const AccT& acc, const pg8::Unit& u, int wr, int wc, int fr, int fq) const {
        const int row0 = u.pm * 256 + wr * 64 + fr, col0 = u.pn * 256 + wc * 32 + 4 * fq; const float* g = gate + (size_t)(u.pm >> 3) * 6144;
        f32x4 gv[2][2];
#pragma unroll
        for (int bj = 0; bj < 2; ++bj)
#pragma unroll
            for (int n = 0; n < 2; ++n) gv[bj][n] = *(const f32x4*)(g + col0 + bj * 128 + n * 16);
#pragma unroll
        for (int ai = 0; ai < 2; ++ai)
#pragma unroll
            for (int m = 0; m < 4; ++m) { const size_t off = (size_t)(row0 + ai * 128 + m * 16) * DM + col0;
#pragma unroll
                for (int bj = 0; bj < 2; ++bj)
#pragma unroll
                    for (int n = 0; n < 2; ++n) { const f32x4 r = *(const f32x4*)(resid + off + bj * 128 + n * 16); *(f32x4*)(out + off + bj * 128 + n * 16) = r + gv[bj][n] * acc[ai][bj][m][n]; }
                asm volatile("" ::: "memory"); }
    } };
struct Epi3 { static constexpr bool PERM = true;
    bf16_t* P1;
    __device__ __forceinline__ void operator()(const AccT& acc, const pg8::Unit& u, int wr, int wc, int fr, int fq) const {
        const int row0 = u.pm * 256 + wr * 64 + fr, col0 = u.pn * 256 + wc * 32 + 8 * fq;
        const int act = u.pn < 16 ? 1 : ((u.pn >= 24 && u.pn < 32) ? 0 : 2);
#pragma unroll
        for (int ai = 0; ai < 2; ++ai)
#pragma unroll
            for (int m = 0; m < 4; ++m) { bf16_t* rowp = P1 + (size_t)(row0 + ai * 128 + m * 16) * N3 + col0;
#pragma unroll
                for (int bj = 0; bj < 2; ++bj) { f32x4 v0 = acc[ai][bj][m][0], v1 = acc[ai][bj][m][1];
                    if (act == 1) {
#pragma unroll
                        for (int j = 0; j < 4; ++j) { v0[j] = gelu_f(v0[j]); v1[j] = gelu_f(v1[j]); } }
                    else if (act == 2) {
#pragma unroll
                        for (int j = 0; j < 4; ++j) { v0[j] = silu_f(v0[j]); v1[j] = silu_f(v1[j]); } }
                    u32x4 w; w.x = cvt_pk_bf16(v0[0], v0[1]); w.y = cvt_pk_bf16(v0[2], v0[3]); w.z = cvt_pk_bf16(v1[0], v1[1]); w.w = cvt_pk_bf16(v1[2], v1[3]);
                    *(u32x4*)(rowp + bj * 128) = w; } }
    } };
struct SchedPool { int G, c; const char* A; const char* B;
    __device__ __forceinline__ bool next(int i, pg8::Unit& u) const {
        const int L = i * G + c; if (L >= 256) return false;
        u.aux = L >> 6; u.pn = (L >> 5) & 1; u.pm = L & 31;
        u.a = A + ((size_t)u.pm * 256 * 2048 + 512 * u.aux) * 2; u.b = B + ((size_t)u.aux * 512 * 512 + (size_t)u.pn * 256 * 512) * 2; return true; } };
struct EpiPool { static constexpr bool PERM = true;
    const bf16_t* P1; bf16_t* Y2; const float* pscale;
    __device__ __forceinline__ void operator()(const AccT& acc, const pg8::Unit& u, int wr, int wc, int fr, int fq) const {
        const int row0 = u.pm * 256 + wr * 64 + fr, colg = 512 * u.aux + 256 * u.pn + wc * 32 + 8 * fq;
        f32x4 ps[2][2];
#pragma unroll
        for (int bj = 0; bj < 2; ++bj)
#pragma unroll
            for (int n = 0; n < 2; ++n) ps[bj][n] = *(const f32x4*)(pscale + colg + bj * 128 + 4 * n);
#pragma unroll
        for (int ai = 0; ai < 2; ++ai)
#pragma unroll
            for (int m = 0; m < 4; ++m) { const size_t row = (size_t)(row0 + ai * 128 + m * 16);
#pragma unroll
                for (int bj = 0; bj < 2; ++bj) { const u32x4 z = *(const u32x4*)(P1 + row * N3 + 8192 + colg + bj * 128);
                    f32x4 v0 = acc[ai][bj][m][0] * ps[bj][0], v1 = acc[ai][bj][m][1] * ps[bj][1]; if (ABLATE & 8) { v0 = v0 * 0.f; v1 = v1 * 0.f; }
                    u32x4 w; w.x = cvt_pk_bf16(v0[0] * bf_lo(z.x), v0[1] * bf_hi(z.x)); w.y = cvt_pk_bf16(v0[2] * bf_lo(z.y), v0[3] * bf_hi(z.y));
                    w.z = cvt_pk_bf16(v1[0] * bf_lo(z.z), v1[1] * bf_hi(z.z)); w.w = cvt_pk_bf16(v1[2] * bf_lo(z.w), v1[3] * bf_hi(z.w));
                    *(u32x4*)(Y2 + row * 4096 + 2048 + colg + bj * 128) = w; } }
    } };

__device__ __forceinline__ void qkv_task(int task, const bf16_t* PQKV, const float* convw, bf16_t* QN, bf16_t* KN, bf16_t* KT, bf16_t* VT, int lane) {
    const int head = task & 15, tens = (task >> 4) % 3, blk = task / 48;
    int b, t0, prow0, tokb; bool isx;
    if (blk < 128) { isx = true; b = blk >> 5; t0 = (blk & 31) * 64; prow0 = b * SEQ + t0; tokb = CTXL + t0; }
    else { isx = false; const int cb = blk - 128; b = cb >> 2; t0 = (cb & 3) * 64; prow0 = MX + b * CTXL + t0; tokb = t0; }
    const int col = tens * 2048 + head * 128 + 2 * lane;
    const f32x2 w0 = *(const f32x2*)(convw + col), w1 = *(const f32x2*)(convw + 6144 + col), w2 = *(const f32x2*)(convw + 12288 + col);
    const bf16_t* p = PQKV + (size_t)prow0 * 6144 + col;
    const int bh = b * NHD + head;
    unsigned pv = 0u, cu, nx;
    if (!isx && t0 > 0) pv = *(const unsigned*)(p - 6144);
    cu = *(const unsigned*)p;
    unsigned tr0[4], tr1[4];
    float hold0 = 0.f, hold1 = 0.f;
#pragma unroll 8
    for (int i = 0; i < 64; ++i) {
        nx = 0u;
        if (i < 63 || (!isx && t0 < 192)) nx = *(const unsigned*)(p + (size_t)(i + 1) * 6144);
        float o0 = w0.x * bf_lo(pv) + w1.x * bf_lo(cu) + w2.x * bf_lo(nx);
        float o1 = w0.y * bf_hi(pv) + w1.y * bf_hi(cu) + w2.y * bf_hi(nx);
        o0 = silu_f(o0); o1 = silu_f(o1);
        if (tens < 2) { const float ss = wave_sum(o0 * o0 + o1 * o1); const float sc = rsqrtf(ss + EPS); o0 *= sc; o1 *= sc; }
        const int tok = tokb + i;
        if (tens == 0) *(unsigned*)(QN + ((size_t)bh * NTOK + tok) * HD + 2 * lane) = cvt_pk_bf16(o0, o1);
        if (tens == 1) *(unsigned*)(KN + ((size_t)bh * NTOK + tok) * HD + 2 * lane) = cvt_pk_bf16(o0, o1);
        if (tens >= 1) {
            if (i & 1) { tr0[(i >> 1) & 3] = cvt_pk_bf16(hold0, o0); tr1[(i >> 1) & 3] = cvt_pk_bf16(hold1, o1); } else { hold0 = o0; hold1 = o1; }
            if ((i & 7) == 7) { bf16_t* T = (tens == 1 ? KT : VT) + ((size_t)bh * HD + 2 * lane) * NTOK + tok - 7;
                *(u32x4*)T = (u32x4){tr0[0], tr0[1], tr0[2], tr0[3]}; *(u32x4*)(T + NTOK) = (u32x4){tr1[0], tr1[1], tr1[2], tr1[3]}; } }
        pv = cu; cu = nx;
    }
}
__device__ __forceinline__ void ab_task(int blk, const float* AB, const float* alog, const float* dtb, float* GG, float* BETA, int lane) {
    int b, prow0, tokb;
    if (blk < 128) { b = blk >> 5; const int t0 = (blk & 31) * 64; prow0 = b * SEQ + t0; tokb = CTXL + t0; }
    else { const int cb = blk - 128; b = cb >> 2; const int t0 = (cb & 3) * 64; prow0 = MX + b * CTXL + t0; tokb = t0; }
    const int kind = lane >> 4, h = lane & 15, d = kind & 1;
    const float A = __expf(alog[d * 16 + h]), db = dtb[d * 16 + h];
    float* dst = (kind < 2 ? GG : BETA) + ((size_t)d * NBH + b * NHD + h) * NTOK + tokb;
#pragma unroll 4
    for (int i = 0; i < 64; ++i) { const float v = AB[(size_t)(prow0 + i) * 64 + lane];
        dst[i] = kind < 2 ? -A * softplus_f(v + db) : sigmoid_f(v); }
}

template <int I> struct FS {
    static __device__ __forceinline__ void run(const LAS float* Ml, float (&Tc)[64], int lane) {
        float a = (lane == I) ? 1.f : 0.f;
#pragma unroll
        for (int jq = 0; jq < (I + 3) / 4; ++jq) { const f32x4 mv = *(const LAS f32x4*)(Ml + I * 68 + 4 * jq);
#pragma unroll
            for (int e = 0; e < 4; ++e) if (4 * jq + e < I) a = fmaf(-mv[e], Tc[4 * jq + e], a); }
        Tc[I] = a;
        __builtin_amdgcn_sched_barrier(0);
        if constexpr (I + 1 < 64) FS<I + 1>::run(Ml, Tc, lane);
    } };
__device__ __forceinline__ void chunk_task(int task, const bf16_t* QN, const bf16_t* KN, const float* GG, const float* BETA, float* GC, bf16_t* TU, bf16_t* AI, LAS float* tab, int lane) {
    const int tc = task % NCH, bh = (task / NCH) & 63, dir = task / (NCH * 64);
    const int tok0 = 64 * tc;
    LAS float* Ml = tab + 128;
    const int mytok = tok0 + (dir ? 63 - lane : lane);
    const size_t gidx = ((size_t)dir * NBH + bh) * NTOK + mytok;
    const float gl = GG[gidx], bl = BETA[gidx];
    float gc = gl;
#pragma unroll
    for (int o = 1; o < 64; o <<= 1) { const float t = __shfl_up(gc, o); if (lane >= o) gc += t; }
    GC[gidx] = gc;
    tab[lane] = gc; tab[64 + lane] = bl;
    LDS_WAIT(); asm volatile("" ::: "memory");
    const int r = lane & 31, hh = lane >> 5;
    bf16x8 ka[2][8];
#pragma unroll
    for (int ib = 0; ib < 2; ++ib) { const int tk = tok0 + (dir ? 63 - (32 * ib + r) : 32 * ib + r); const bf16x8* kp = (const bf16x8*)(KN + ((size_t)bh * NTOK + tk) * HD + 8 * hh);
#pragma unroll
        for (int s = 0; s < 8; ++s) ka[ib][s] = kp[2 * s]; }
    const bool isx = tc >= 4;
    bf16_t* aib = AI + (((size_t)dir * NBH + bh) * NCH + tc) * 4096;
    if (isx) {
#pragma unroll
        for (int ib = 0; ib < 2; ++ib) {
            bf16x8 qa[8]; { const int tk = tok0 + (dir ? 63 - (32 * ib + r) : 32 * ib + r); const bf16x8* qp = (const bf16x8*)(QN + ((size_t)bh * NTOK + tk) * HD + 8 * hh);
#pragma unroll
                for (int s = 0; s < 8; ++s) qa[s] = qp[2 * s]; }
#pragma unroll
            for (int jb = 0; jb < 2; ++jb) {
                f32x16 a = {};
                if (jb <= ib) {
#pragma unroll
                    for (int s = 0; s < 8; ++s) a = __builtin_amdgcn_mfma_f32_32x32x16_bf16(qa[s], ka[jb][s], a, 0, 0, 0); }
                const int jp = 32 * jb + r; const float gcj = tab[jp];
                bf16_t vv[16];
#pragma unroll
                for (int g = 0; g < 4; ++g) { const f32x4 gci = *(const LAS f32x4*)(tab + 32 * ib + 8 * g + 4 * hh);
#pragma unroll
                    for (int e = 0; e < 4; ++e) { const int ip = 32 * ib + 8 * g + 4 * hh + e;
                        vv[4 * g + e] = f2bf((jp <= ip) ? 0.08838834764831845f * a[4 * g + e] * __expf(gci[e] - gcj) : 0.f); } }
                if (dir == 0) { bf16_t* bp = aib + (32 * ib + 4 * hh) * 64 + jp;
#pragma unroll
                    for (int e = 0; e < 16; ++e) bp[((e & 3) + 8 * (e >> 2)) * 64] = vv[e]; }
                else { bf16_t* bp = aib + (63 - 32 * ib - 4 * hh) * 64 + (63 - jp);
#pragma unroll
                    for (int e = 0; e < 16; ++e) bp[-((e & 3) + 8 * (e >> 2)) * 64] = vv[e]; } } }
    }
    f32x16 Mt[3];
#pragma unroll
    for (int t = 0; t < 3; ++t) { const int ib = t > 0, jb = t > 1; f32x16 a = {};
#pragma unroll
        for (int s = 0; s < 8; ++s) a = __builtin_amdgcn_mfma_f32_32x32x16_bf16(ka[ib][s], ka[jb][s], a, 0, 0, 0);
        Mt[t] = a; }
    LAS float* Mlb = Ml + 4 * hh * 68 + r;
#pragma unroll
    for (int t = 0; t < 3; ++t) { const int ib = t > 0, jb = t > 1; const int jp = 32 * jb + r; const float gcj = tab[jp];
#pragma unroll
        for (int g = 0; g < 4; ++g) { const f32x4 gci = *(const LAS f32x4*)(tab + 32 * ib + 8 * g + 4 * hh), bi = *(const LAS f32x4*)(tab + 64 + 32 * ib + 8 * g + 4 * hh);
#pragma unroll
            for (int e = 0; e < 4; ++e) { const int ip = 32 * ib + 8 * g + 4 * hh + e;
                Mt[t][4 * g + e] = (jp < ip) ? bi[e] * Mt[t][4 * g + e] * __expf(gci[e] - gcj) : 0.f;
                Mlb[(32 * ib + 8 * g + e) * 68 + 32 * jb] = Mt[t][4 * g + e]; } } }
    LDS_WAIT(); asm volatile("" ::: "memory");
    float Tc[64];
    FS<0>::run(Ml, Tc, lane);
    bf16_t* tub = TU + (((size_t)dir * NBH + bh) * NCH + tc) * 4096;
    if (dir == 0) { bf16_t* bp = tub + lane;
#pragma unroll
        for (int i = 0; i < 64; ++i) bp[i * 64] = f2bf(Tc[i] * bl); }
    else { bf16_t* bp = tub + 63 * 64 + (63 - lane);
#pragma unroll
        for (int i = 0; i < 64; ++i) bp[-i * 64] = f2bf(Tc[i] * bl); }
    LDS_WAIT(); asm volatile("" ::: "memory");
}

constexpr int F_Q = 0, F_KT = 17408, F_VT = 35840, F_TU = 45056, F_A = 54272, F_W = 63488, F_ST = 80896, F_VN = 98304, F_VNG = 107520, F_TAB = 116736;
__device__ __forceinline__ f32x16 mma_tile(f32x16 acc, const LAS bf16_t* A, int lda, const LAS bf16_t* B, int ldb, int ksteps, int lane) {
    const LAS bf16_t* ap = A + (lane & 31) * lda + 8 * (lane >> 5); const LAS bf16_t* bp = B + (lane & 31) * ldb + 8 * (lane >> 5);
    for (int s = 0; s < ksteps; ++s) acc = __builtin_amdgcn_mfma_f32_32x32x16_bf16(*(const LAS bf16x8*)(ap + 16 * s), *(const LAS bf16x8*)(bp + 16 * s), acc, 0, 0, 0);
    return acc;
}
__device__ __forceinline__ void scan_chain(int chain, LAS unsigned char* lds, const bf16_t* KNdbg, const bf16_t* QN, const bf16_t* KT, const bf16_t* VT, const bf16_t* TU, const bf16_t* AI, const float* GC, bf16_t* OF, bf16_t* OB) {
    const int tid = threadIdx.x, wave = __builtin_amdgcn_readfirstlane(tid >> 6), lane = tid & 63;
    const int half = chain & 1, bh = (chain >> 1) & 63, dir = chain >> 7, b = bh >> 4, h = bh & 15;
    LAS bf16_t* Qs = (LAS bf16_t*)(lds + F_Q); LAS bf16_t* KTs = (LAS bf16_t*)(lds + F_KT); LAS bf16_t* VTs = (LAS bf16_t*)(lds + F_VT);
    LAS bf16_t* TUs = (LAS bf16_t*)(lds + F_TU); LAS bf16_t* As = (LAS bf16_t*)(lds + F_A); LAS bf16_t* Ws = (LAS bf16_t*)(lds + F_W);
    LAS bf16_t* STs = (LAS bf16_t*)(lds + F_ST); LAS bf16_t* VNs = (LAS bf16_t*)(lds + F_VN); LAS bf16_t* VNGs = (LAS bf16_t*)(lds + F_VNG);
    LAS float* tab = (LAS float*)(lds + F_TAB);
    for (int i = tid; i < 17408 / 4; i += 512) ((LAS unsigned*)STs)[i] = 0u;
    f32x16 Sacc = {};
    bf16_t* Od = ((ABLATE & 64) ? !dir : dir) ? OB : OF;
    const int c = lane & 31, hh = lane >> 5;
    __syncthreads();
    for (int step = 0; step < NCH; ++step) {
        const int tc = dir == 0 ? step : (step < 4 ? 3 - step : 39 - step);
        const int tok0 = 64 * tc; const bool isx = tc >= 4;
        if (isx) { for (int i = tid; i < 1024; i += 512) { const int t = i >> 4, ch = i & 15; *(LAS u32x4*)(Qs + t * 136 + ch * 8) = *(const u32x4*)(QN + ((size_t)bh * NTOK + tok0 + t) * HD + ch * 8); } }
        if (ABLATE & 256) { for (int i = tid; i < 8192; i += 512) { const int t = i >> 7, k = i & 127; KTs[k * 72 + t] = KNdbg[((size_t)bh * NTOK + tok0 + t) * HD + k]; } }
        else
        for (int i = tid; i < 1024; i += 512) { const int k = i >> 3, ch = i & 7; *(LAS u32x4*)(KTs + k * 72 + ch * 8) = *(const u32x4*)(KT + ((size_t)bh * HD + k) * NTOK + tok0 + ch * 8); }
        { const int d = tid >> 3, ch = tid & 7; *(LAS u32x4*)(VTs + d * 72 + ch * 8) = *(const u32x4*)(VT + ((size_t)bh * HD + 64 * half + d) * NTOK + tok0 + ch * 8);
          const size_t cb = (((size_t)dir * NBH + bh) * NCH + tc) * 4096;
          *(LAS u32x4*)(TUs + d * 72 + ch * 8) = *(const u32x4*)(TU + cb + d * 64 + ch * 8);
          if (isx) *(LAS u32x4*)(As + d * 72 + ch * 8) = *(const u32x4*)(AI + cb + d * 64 + ch * 8); }
        if (tid < 64) { const float* gp = GC + ((size_t)dir * NBH + bh) * NTOK + tok0; const float g = gp[tid], gl = gp[dir ? 0 : 63];
            tab[tid] = __expf(g); tab[64 + tid] = __expf(gl - g); if (tid == 0) tab[128] = __expf(gl); }
        __syncthreads();
        {
            const int kb = wave & 3, tb = wave >> 2;
            f32x16 a = {};
            const LAS bf16_t* ap = KTs + (32 * kb + c) * 72 + 8 * hh; const LAS bf16_t* bp = TUs + (32 * tb + c) * 72 + 8 * hh;
#pragma unroll
            for (int s = 0; s < 4; ++s) {
                const bf16x8 av = *(const LAS bf16x8*)(ap + 16 * s); const u32x4 bu = *(const LAS u32x4*)(bp + 16 * s);
                const f32x4 e0 = *(const LAS f32x4*)(tab + 16 * s + 8 * hh), e1 = *(const LAS f32x4*)(tab + 16 * s + 8 * hh + 4);
                u32x4 bs; bs.x = cvt_pk_bf16(bf_lo(bu.x) * e0[0], bf_hi(bu.x) * e0[1]); bs.y = cvt_pk_bf16(bf_lo(bu.y) * e0[2], bf_hi(bu.y) * e0[3]);
                bs.z = cvt_pk_bf16(bf_lo(bu.z) * e1[0], bf_hi(bu.z) * e1[1]); bs.w = cvt_pk_bf16(bf_lo(bu.w) * e1[2], bf_hi(bu.w) * e1[3]);
                a = __builtin_amdgcn_mfma_f32_32x32x16_bf16(av, __builtin_bit_cast(bf16x8, bs), a, 0, 0, 0); }
#pragma unroll
            for (int g = 0; g < 4; ++g) { u32x2 w; w.x = cvt_pk_bf16(-a[4 * g], -a[4 * g + 1]); w.y = cvt_pk_bf16(-a[4 * g + 2], -a[4 * g + 3]);
                *(LAS u32x2*)(Ws + (32 * tb + c) * 136 + 32 * kb + 8 * g + 4 * hh) = w; }
        }
        __syncthreads();
        f32x16 oacc = {};
        const int tb2 = (wave >> 1) & 1, db2 = wave & 1;
        if (wave < 4) {
            f32x16 a = {};
            a = mma_tile(a, TUs + 32 * tb2 * 72, 72, VTs + 32 * db2 * 72, 72, 4, lane);
            a = mma_tile(a, Ws + 32 * tb2 * 136, 136, STs + 32 * db2 * 136, 136, 8, lane);
#pragma unroll
            for (int g = 0; g < 4; ++g) { const f32x4 sc = *(const LAS f32x4*)(tab + 64 + 32 * tb2 + 8 * g + 4 * hh);
                u32x2 w, wg; w.x = cvt_pk_bf16(a[4 * g], a[4 * g + 1]); w.y = cvt_pk_bf16(a[4 * g + 2], a[4 * g + 3]);
                wg.x = cvt_pk_bf16(a[4 * g] * sc[0], a[4 * g + 1] * sc[1]); wg.y = cvt_pk_bf16(a[4 * g + 2] * sc[2], a[4 * g + 3] * sc[3]);
                *(LAS u32x2*)(VNs + (32 * db2 + c) * 72 + 32 * tb2 + 8 * g + 4 * hh) = w; *(LAS u32x2*)(VNGs + (32 * db2 + c) * 72 + 32 * tb2 + 8 * g + 4 * hh) = wg; }
        } else if (isx) {
            oacc = mma_tile(oacc, Qs + 32 * tb2 * 136, 136, STs + 32 * db2 * 136, 136, 8, lane);
#pragma unroll
            for (int g = 0; g < 4; ++g) { const f32x4 sc = *(const LAS f32x4*)(tab + 32 * tb2 + 8 * g + 4 * hh);
#pragma unroll
                for (int e = 0; e < 4; ++e) oacc[4 * g + e] *= 0.08838834764831845f * sc[e]; }
        }
        __syncthreads();
        {
            const int kb = wave & 3, db = wave >> 2; const float egl = tab[128];
#pragma unroll
            for (int e = 0; e < 16; ++e) Sacc[e] *= egl;
            Sacc = mma_tile(Sacc, KTs + 32 * kb * 72, 72, VNGs + 32 * db * 72, 72, 4, lane);
            if (wave >= 4 && isx) {
                oacc = mma_tile(oacc, As + 32 * tb2 * 72, 72, VNs + 32 * db2 * 72, 72, 4, lane);
                bf16_t* op = Od + ((size_t)b * SEQ + (tok0 - CTXL) + 32 * tb2) * DM + h * HD + 64 * half + 32 * db2 + c;
#pragma unroll
                for (int e = 0; e < 16; ++e) { const int t = (e & 3) + 8 * (e >> 2) + 4 * hh; op[(size_t)t * DM] = f2bf(oacc[e]); }
            }
            __syncthreads();
#pragma unroll
            for (int g = 0; g < 4; ++g) { u32x2 w; w.x = cvt_pk_bf16(Sacc[4 * g], Sacc[4 * g + 1]); w.y = cvt_pk_bf16(Sacc[4 * g + 2], Sacc[4 * g + 3]);
                *(LAS u32x2*)(STs + (32 * db + c) * 136 + 32 * kb + 8 * g + 4 * hh) = w; }
        }
        __syncthreads();
    }
}

#ifndef DBG_THR
#define DBG_THR 1000.f
#endif
__device__ __forceinline__ void finish_row(int row, const bf16_t* OF, const bf16_t* OB, const bf16_t* ZA, const float* hn, bf16_t* Y, int lane, unsigned* dbgh) {
    const f32x4 h0 = *(const f32x4*)(hn + 8 * (lane & 15)), h1 = *(const f32x4*)(hn + 8 * (lane & 15) + 4);
#pragma unroll
    for (int it = 0; it < 4; ++it) {
        const size_t off = (size_t)row * DM + it * 512 + lane * 8;
        const u32x4 a_ = *(const u32x4*)(OF + off), bq_ = *(const u32x4*)(OB + off), z = *(const u32x4*)(ZA + off);
        u32x4 a = a_, bq = bq_; if (ABLATE & 16) bq = (u32x4){0u, 0u, 0u, 0u}; if (ABLATE & 32) a = (u32x4){0u, 0u, 0u, 0u};
        float o[8] = {bf_lo(a.x) + bf_lo(bq.x), bf_hi(a.x) + bf_hi(bq.x), bf_lo(a.y) + bf_lo(bq.y), bf_hi(a.y) + bf_hi(bq.y), bf_lo(a.z) + bf_lo(bq.z), bf_hi(a.z) + bf_hi(bq.z), bf_lo(a.w) + bf_lo(bq.w), bf_hi(a.w) + bf_hi(bq.w)};
#if MK_DEBUG
        { float mb = 0.f, mf = 0.f; const float ofx[8] = {bf_lo(a.x), bf_hi(a.x), bf_lo(a.y), bf_hi(a.y), bf_lo(a.z), bf_hi(a.z), bf_lo(a.w), bf_hi(a.w)};
          const float obx[8] = {bf_lo(bq.x), bf_hi(bq.x), bf_lo(bq.y), bf_hi(bq.y), bf_lo(bq.z), bf_hi(bq.z), bf_lo(bq.w), bf_hi(bq.w)};
#pragma unroll
          for (int e = 0; e < 8; ++e) { mb = fmaxf(mb, fabsf(obx[e])); mf = fmaxf(mf, fabsf(ofx[e])); }
          const int bhq = (row / SEQ) * 16 + it * 4 + (lane >> 4);
          if (mb > DBG_THR) dbgh[bhq] = 1u; if (mf > DBG_THR) dbgh[64 + bhq] = 1u; }
#endif
        if (ABLATE & 128) { const float of_[8] = {bf_lo(a.x), bf_hi(a.x), bf_lo(a.y), bf_hi(a.y), bf_lo(a.z), bf_hi(a.z), bf_lo(a.w), bf_hi(a.w)};
            const float ob_[8] = {bf_lo(bq.x), bf_hi(bq.x), bf_lo(bq.y), bf_hi(bq.y), bf_lo(bq.z), bf_hi(bq.z), bf_lo(bq.w), bf_hi(bq.w)};
#pragma unroll
            for (int e = 0; e < 8; ++e) o[e] = of_[e] + ob_[e] * (1.f / 4096.f); }
        float ss = 0.f;
#pragma unroll
        for (int e = 0; e < 8; ++e) ss += o[e] * o[e];
        ss += __shfl_xor(ss, 1); ss += __shfl_xor(ss, 2); ss += __shfl_xor(ss, 4); ss += __shfl_xor(ss, 8);
        const float rs = rsqrtf(ss * (1.f / HD) + EPS);
        const float zf[8] = {bf_lo(z.x), bf_hi(z.x), bf_lo(z.y), bf_hi(z.y), bf_lo(z.z), bf_hi(z.z), bf_lo(z.w), bf_hi(z.w)};
        const float hv[8] = {h0[0], h0[1], h0[2], h0[3], h1[0], h1[1], h1[2], h1[3]};
        float y[8];
#pragma unroll
        for (int e = 0; e < 8; ++e) { y[e] = o[e] * rs * hv[e] * zf[e]; if (ABLATE & 1) y[e] = 0.f; }
        u32x4 w; w.x = cvt_pk_bf16(y[0], y[1]); w.y = cvt_pk_bf16(y[2], y[3]); w.z = cvt_pk_bf16(y[4], y[5]); w.w = cvt_pk_bf16(y[6], y[7]);
        *(u32x4*)(Y + (size_t)row * 4096 + it * 512 + lane * 8) = w;
    }
}

__device__ __forceinline__ void stats_row(int row, const bf16_t* P1, float* STATS, int lane) {
    const bf16_t* p = P1 + (size_t)row * N3 + 2048;
    float v[32]; float s = 0.f;
#pragma unroll
    for (int j = 0; j < 4; ++j) { const u32x4 a = *(const u32x4*)(p + j * 512 + lane * 8);
        v[8 * j] = bf_lo(a.x); v[8 * j + 1] = bf_hi(a.x); v[8 * j + 2] = bf_lo(a.y); v[8 * j + 3] = bf_hi(a.y); v[8 * j + 4] = bf_lo(a.z); v[8 * j + 5] = bf_hi(a.z); v[8 * j + 6] = bf_lo(a.w); v[8 * j + 7] = bf_hi(a.w); }
#pragma unroll
    for (int e = 0; e < 32; ++e) s += v[e];
    const float mu = wave_sum(s) * (1.f / DM); float q = 0.f;
#pragma unroll
    for (int e = 0; e < 32; ++e) { const float d = v[e] - mu; q += d * d; }
    const float rstd = rsqrtf(wave_sum(q) * (1.f / DM) + EPS);
    if (lane == 0) { STATS[2 * row] = mu; STATS[2 * row + 1] = rstd; }
}
template <int R> __device__ __forceinline__ void diff_task(const bf16_t* p, bf16_t* o) {
    unsigned v[64];
#pragma unroll
    for (int i = 0; i < 64; ++i) v[i] = *(const unsigned*)(p + (size_t)i * N3);
    float s0 = 0.f, s1 = 0.f;
#pragma unroll
    for (int i = 0; i < R; ++i) { s0 += bf_lo(v[i]); s1 += bf_hi(v[i]); }
#pragma unroll
    for (int i = 0; i < 64; ++i) {
        if (i + R < 64) { s0 += bf_lo(v[i + R]); s1 += bf_hi(v[i + R]); }
        if (i - R - 1 >= 0) { s0 -= bf_lo(v[i - R - 1 >= 0 ? i - R - 1 : 0]); s1 -= bf_hi(v[i - R - 1 >= 0 ? i - R - 1 : 0]); }
        const int hi = (i + R + 1 < 64) ? i + R + 1 : 64, lo = (i - R > 0) ? i - R : 0; const float inv = 1.0f / (float)(hi - lo);
        *(unsigned*)(o + (size_t)i * DM) = cvt_pk_bf16(s0 * inv - bf_lo(v[i]), s1 * inv - bf_hi(v[i]));
    }
}

constexpr int K_W = 0, K_V = 34816;
__device__ __forceinline__ void tmix_task(int task, LAS unsigned char* lds, const float* ws, const float* bs, const float* lnw, const float* lnb, const float* STATS, const bf16_t* P1, bf16_t* Y2) {
    const int tid = threadIdx.x, wave = __builtin_amdgcn_readfirstlane(tid >> 6), lane = tid & 63;
    const int g = task & 15, n = (task >> 4) & 15, b = task >> 8;
    const int row0 = b * SEQ + 128 * n;
    LAS bf16_t* Wsb = (LAS bf16_t*)(lds + K_W); LAS bf16_t* VnT = (LAS bf16_t*)(lds + K_V);
    for (int i = tid; i < 4096; i += 512) { const int p = i >> 5, q4 = (i & 31) * 4; const f32x4 w = *(const f32x4*)(ws + ((size_t)g * 128 + p) * 128 + q4);
        u32x2 o; o.x = cvt_pk_bf16(w.x, w.y); o.y = cvt_pk_bf16(w.z, w.w); *(LAS u32x2*)(Wsb + p * 136 + q4) = o; }
    for (int i = tid; i < 2048; i += 512) { const int q = i >> 4, c8 = (i & 15) * 8;
        const u32x4 a = *(const u32x4*)(P1 + (size_t)(row0 + q) * N3 + 2048 + 128 * g + c8);
        const float mu = STATS[2 * (row0 + q)], rstd = STATS[2 * (row0 + q) + 1];
        const f32x4 w0 = *(const f32x4*)(lnw + 128 * g + c8), w1 = *(const f32x4*)(lnw + 128 * g + c8 + 4), b0 = *(const f32x4*)(lnb + 128 * g + c8), b1 = *(const f32x4*)(lnb + 128 * g + c8 + 4);
        const float x[8] = {bf_lo(a.x), bf_hi(a.x), bf_lo(a.y), bf_hi(a.y), bf_lo(a.z), bf_hi(a.z), bf_lo(a.w), bf_hi(a.w)};
        const float wv[8] = {w0[0], w0[1], w0[2], w0[3], w1[0], w1[1], w1[2], w1[3]}, bv[8] = {b0[0], b0[1], b0[2], b0[3], b1[0], b1[1], b1[2], b1[3]};
#pragma unroll
        for (int e = 0; e < 8; ++e) VnT[(c8 + e) * 136 + q] = f2bf((x[e] - mu) * rstd * wv[e] + bv[e]); }
    __syncthreads();
    const int pb = wave >> 1, c = lane & 31, hh = lane >> 5;
#pragma unroll
    for (int t = 0; t < 2; ++t) { const int cb = 2 * (wave & 1) + t;
        f32x16 a = {};
        a = mma_tile(a, Wsb + 32 * pb * 136, 136, VnT + 32 * cb * 136, 136, 8, lane);
        const int ch = 128 * g + 32 * cb + c;
#pragma unroll
        for (int e = 0; e < 16; ++e) { const int p = 32 * pb + (e & 3) + 8 * (e >> 2) + 4 * hh; const size_t row = (size_t)(row0 + p);
            const float s = a[e] + bs[g * 128 + p];
            const float y = bf2f(P1[row * N3 + ch]) * s * bf2f(P1[row * N3 + 4096 + ch]);
            Y2[row * 4096 + ch] = f2bf((ABLATE & 4) ? 0.f : y); } }
    __syncthreads();
}

__device__ __forceinline__ void final_row(float* xrow, const float* fw, int lane) {
    f32x4* xr = (f32x4*)xrow + lane;
    f32x4 v[8]; float s = 0.f;
#pragma unroll
    for (int j = 0; j < 8; ++j) { v[j] = xr[64 * j]; s += (v[j].x * v[j].x + v[j].y * v[j].y) + (v[j].z * v[j].z + v[j].w * v[j].w); }
    const float rstd = rsqrtf(wave_sum(s) * (1.f / DM) + EPS);
#pragma unroll
    for (int j = 0; j < 8; ++j) xr[64 * j] = v[j] * rstd * ((const f32x4*)fw)[lane + 64 * j];
}

__global__ void __launch_bounds__(512, 2) fwd_kernel(Args args) {
    extern __shared__ __attribute__((aligned(16))) unsigned char lds_raw[];
    LAS unsigned char* lds = (LAS unsigned char*)lds_raw;
    const int tid = threadIdx.x, lane = tid & 63, wave = __builtin_amdgcn_readfirstlane(tid >> 6);
    const int G = gridDim.x, bid = blockIdx.x;
    const int gw = bid * 8 + wave, NGW = G * 8;
    unsigned char* ws = args.ws;
    volatile LAS unsigned* MISC = (volatile LAS unsigned*)(lds + MISC_OFF);
    if (tid < 16) MISC[tid] = 0u;
    __syncthreads();
    if (args.never) cg::this_grid().sync();
    XcdBarrier bar; bar.bar = (unsigned*)(ws + WS_CTL) + CW_BAR; bar.x = 0; bar.st = MISC;
    const int lo = args.ph_lo, hi = args.ph_hi;
    if (hi - lo > 1) bar = xcd_barrier_post((unsigned*)(ws + WS_CTL) + CW_BAR, MISC);
#ifndef PH_MASK
#define PH_MASK 0x3fff
#endif
#define IN(k) ((((PH_MASK) >> (k)) & 1) && lo <= (k) && (k) < hi)
#define SEAM(k) do { if (IN(k) && IN((k) + 1)) xcd_barrier(bar); } while (0)
    float* MOD = (float*)(ws + WS_MOD);
#if MK_DEBUG
    unsigned* DBG = (unsigned*)(ws + WS_CTL) + 2048; const int gt = bid * 512 + tid, ngt = G * 512;
#endif
    bf16_t* WT1 = (bf16_t*)(ws + WS_WT1); bf16_t* WT2 = (bf16_t*)(ws + WS_WT2); bf16_t* WT3 = (bf16_t*)(ws + WS_WT3); bf16_t* WT4 = (bf16_t*)(ws + WS_WT4); bf16_t* WTP = (bf16_t*)(ws + WS_WTP);
    bf16_t* H = (bf16_t*)(ws + WS_H);

    if (IN(0)) {
        if (bid < 192) { LAS float* tab = (LAS float*)lds; silu_table(args.in[I_C], args.in[I_CCTX], tab);
            for (int t = bid; t < 192; t += G) mod_task(args.in[I_ADAW], args.in[I_ADAB], MOD, 32 * t, tab, (LAS float*)(lds + 40960), wave, lane);
            __syncthreads(); }
        LAS float* scr = (LAS float*)(lds + wave * 8448);
        const SrcW1 s1; const SrcId sid;
        for (int it = gw; it < 16640 + 4096; it += NGW) {
            if (it < 16640) { const int cb = it >> 5, kb = it & 31; conv_item(args.in[I_EWIN], N1SRC, 2048, WT1, 32 * cb, 64 * kb, scr, lane, s1); }
            else { const int r = it - 16640, cb = r >> 6, kb = r & 63; conv_item(args.in[I_EWOUT], 2048, 4096, WT2, 32 * cb, 64 * kb, scr, lane, sid); }
        }
    }
    SEAM(0);
    if (IN(1)) {
#if MK_DEBUG
        dbg_f32(MOD, 5, 6144, 6144, DBG + 0, gt, ngt); dbg_bf16(WT1, 16640, 2048, 2048, DBG + 0, gt, ngt); dbg_bf16(WT2, 2048, 4096, 4096, DBG + 0, gt, ngt);
#endif
        for (int m = gw; m < MT; m += NGW) {
            const float* src = m < MX ? args.in[I_X] + (size_t)m * DM : args.in[I_CTX] + (size_t)(m - MX) * DM;
            const int r = m < MX ? m / SEQ : 4;
            hrow(src, args.in[I_NORMW], MOD + r * 6144, H + (size_t)m * DM, lane);
        }
    }
    SEAM(1);
    if (IN(2)) {
#if MK_DEBUG
        dbg_bf16(H, MT, 2048, 2048, DBG + 1, gt, ngt);
#endif
        Sched1 S{G, bid, (const char*)H, (const char*)WT1};
        Epi1 E{(bf16_t*)(ws + WS_PQKV), (bf16_t*)(ws + WS_ZA), (float*)(ws + WS_AB), (bf16_t*)(ws + WS_Y), args.in[I_ECONVB]};
        pg8::gemm_phase<Epi1, Sched1>(lds, 2048, 2048, 2048, S, E);
    }
    SEAM(2);
    if (IN(3)) {
#if MK_DEBUG
        dbg_bf16((const bf16_t*)(ws + WS_PQKV), MT, 6144, 6144, DBG + 2, gt, ngt); dbg_bf16((const bf16_t*)(ws + WS_ZA), MX, 2048, 2048, DBG + 2, gt, ngt);
        dbg_f32((const float*)(ws + WS_AB), MT, 64, 64, DBG + 2, gt, ngt); dbg_bf16((const bf16_t*)(ws + WS_Y) + 2048, MX, 2048, 4096, DBG + 2, gt, ngt);
#endif
        for (int t = gw; t < 6912 + 144; t += NGW) {
            if (t < 6912) qkv_task(t, (const bf16_t*)(ws + WS_PQKV), args.in[I_ECONVQKV], (bf16_t*)(ws + WS_QN), (bf16_t*)(ws + WS_KN), (bf16_t*)(ws + WS_KT), (bf16_t*)(ws + WS_VT), lane);
            else ab_task(t - 6912, (const float*)(ws + WS_AB), args.in[I_EALOG], args.in[I_EDTB], (float*)(ws + WS_GG), (float*)(ws + WS_BETA), lane);
        }
    }
    SEAM(3);
    if (IN(4)) {
#if MK_DEBUG
        dbg_bf16((const bf16_t*)(ws + WS_QN), 64 * NTOK, 128, 128, DBG + 3, gt, ngt); dbg_bf16((const bf16_t*)(ws + WS_KN), 64 * NTOK, 128, 128, DBG + 3, gt, ngt);
        dbg_bf16((const bf16_t*)(ws + WS_KT), 64 * 128, NTOK, NTOK, DBG + 3, gt, ngt); dbg_bf16((const bf16_t*)(ws + WS_VT), 64 * 128, NTOK, NTOK, DBG + 3, gt, ngt);
        dbg_f32((const float*)(ws + WS_GG), 128, NTOK, NTOK, DBG + 3, gt, ngt); dbg_f32((const float*)(ws + WS_BETA), 128, NTOK, NTOK, DBG + 3, gt, ngt);
#endif
        LAS float* tab = (LAS float*)(lds + wave * 17920);
        for (int t = gw; t < 2 * 64 * NCH; t += NGW)
            chunk_task(t, (const bf16_t*)(ws + WS_QN), (const bf16_t*)(ws + WS_KN), (const float*)(ws + WS_GG), (const float*)(ws + WS_BETA), (float*)(ws + WS_GC), (bf16_t*)(ws + WS_TU), (bf16_t*)(ws + WS_AI), tab, lane);
        __syncthreads();
        if (bid < 192) { LAS float* stab = (LAS float*)lds; silu_table(args.in[I_C], args.in[I_CCTX], stab);
            for (int t = bid; t < 192; t += G) mod_task(args.in[I_ADAW] + (size_t)2048 * 6144, args.in[I_ADAB] + 6144, MOD + 5 * 6144, 32 * t, stab, (LAS float*)(lds + 40960), wave, lane);
            __syncthreads(); }
        LAS float* scr = (LAS float*)(lds + wave * 8448);
        const SrcId sid;
        for (int it = gw; it < 10240 + 4096 + 512; it += NGW) {
            if (it < 10240) { const int cb = it >> 5, kb = it & 31; conv_item(args.in[I_OWIN], N3, 2048, WT3, 32 * cb, 64 * kb, scr, lane, sid); }
            else if (it < 14336) { const int r = it - 10240, cb = r >> 6, kb = r & 63; conv_item(args.in[I_OWOUT], 2048, 4096, WT4, 32 * cb, 64 * kb, scr, lane, sid); }
            else { const int r = it - 14336, gq = r >> 7, cb = (r >> 3) & 15, kb = r & 7; conv_item(args.in[I_OPW] + (size_t)gq * 512 * 512, 512, 512, WTP + (size_t)gq * 512 * 512, 32 * cb, 64 * kb, scr, lane, sid); }
        }
    }
    SEAM(4);
    if (IN(5)) {
#if MK_DEBUG
        dbg_bf16((const bf16_t*)(ws + WS_TU), 2 * 64 * NCH, 4096, 4096, DBG + 4, gt, ngt);
        if (gt == 100) {
            const int dirq = 1, bhq = 0, tcq = 20, tok0q = 64 * tcq; const bf16_t* KNq = (const bf16_t*)(ws + WS_KN) + ((size_t)bhq * NTOK + tok0q) * HD;
            const float* gq = (const float*)(ws + WS_GG) + ((size_t)dirq * NBH + bhq) * NTOK + tok0q; const float* bq = (const float*)(ws + WS_BETA) + ((size_t)dirq * NBH + bhq) * NTOK + tok0q;
            const bf16_t* tq = (const bf16_t*)(ws + WS_TU) + (((size_t)dirq * NBH + bhq) * NCH + tcq) * 4096;
            float worst = 0.f;
            for (int a = 0; a < 64; a += 7) for (int b2 = 0; b2 < 64; b2 += 5) {
                float r = 0.f;
                for (int m = 0; m < 64; ++m) {
                    float im = (a == m) ? 1.f : 0.f;
                    if (m > a) { float kk = 0.f; for (int e = 0; e < HD; ++e) kk += bf2f(KNq[a * HD + e]) * bf2f(KNq[m * HD + e]); float gd = 0.f; for (int t = a; t < m; ++t) gd += gq[t]; im = bq[a] * kk * __expf(gd); }
                    const float T = bf2f(tq[m * 64 + b2]) / bq[b2];
                    r += im * T; }
                worst = fmaxf(worst, fabsf(r - ((a == b2) ? 1.f : 0.f))); }
            DBG[980] = __float_as_uint(worst); }
        if (gt < 64) { const int bhq = gt & 63; const bf16_t* tq = (const bf16_t*)(ws + WS_TU) + (((size_t)1 * NBH + bhq) * NCH + 20) * 4096; float so = 0.f;
            for (int i = 0; i < 64; ++i) for (int j = 0; j < 64; ++j) { const float v = fabsf(bf2f(tq[i * 64 + j])); if (i != j) so += v; }
            DBG[910 + bhq] = __float_as_uint(so); }
        dbg_max_bf16((const bf16_t*)(ws + WS_TU), (size_t)128 * NCH * 4096, DBG + 900, gt, ngt);
        dbg_max_bf16((const bf16_t*)(ws + WS_KN), (size_t)64 * NTOK * 128, DBG + 901, gt, ngt);
        dbg_max_bf16((const bf16_t*)(ws + WS_KT), (size_t)64 * NTOK * 128, DBG + 902, gt, ngt);
        dbg_max_bf16((const bf16_t*)(ws + WS_VT), (size_t)64 * NTOK * 128, DBG + 903, gt, ngt);
        dbg_max_bf16((const bf16_t*)(ws + WS_QN), (size_t)64 * NTOK * 128, DBG + 904, gt, ngt);
        for (int q = 0; q < 128; ++q) dbg_bf16((const bf16_t*)(ws + WS_AI) + ((size_t)q * NCH + 4) * 4096, 32, 4096, 4096, DBG + 4, gt, ngt);
        dbg_f32((const float*)(ws + WS_GC), 128, NTOK, NTOK, DBG + 4, gt, ngt); dbg_f32(MOD + 5 * 6144, 4, 6144, 6144, DBG + 4, gt, ngt);
        dbg_bf16(WT3, 10240, 2048, 2048, DBG + 4, gt, ngt); dbg_bf16(WT4, 2048, 4096, 4096, DBG + 4, gt, ngt); dbg_bf16(WTP, 2048, 512, 512, DBG + 4, gt, ngt);
#endif
        for (int ch = bid; ch < 256; ch += G) { scan_chain(ch, lds, (const bf16_t*)(ws + WS_KN), (const bf16_t*)(ws + WS_QN), (const bf16_t*)(ws + WS_KT), (const bf16_t*)(ws + WS_VT), (const bf16_t*)(ws + WS_TU), (const bf16_t*)(ws + WS_AI), (const float*)(ws + WS_GC), (bf16_t*)(ws + WS_OF), (bf16_t*)(ws + WS_OB)); __syncthreads(); }
    }
    SEAM(5);
    if (IN(6)) {
#if MK_DEBUG
        dbg_bf16((const bf16_t*)(ws + WS_OF), MX, 2048, 2048, DBG + 5, gt, ngt); dbg_bf16((const bf16_t*)(ws + WS_OB), MX, 2048, 2048, DBG + 5, gt, ngt);
        dbg_max_bf16((const bf16_t*)(ws + WS_OF), (size_t)MX * 2048, DBG + 905, gt, ngt); dbg_max_bf16((const bf16_t*)(ws + WS_OB), (size_t)MX * 2048, DBG + 906, gt, ngt);
#endif
        for (int m = gw; m < MX; m += NGW) finish_row(m, (const bf16_t*)(ws + WS_OF), (const bf16_t*)(ws + WS_OB), (const bf16_t*)(ws + WS_ZA), args.in[I_EHN], (bf16_t*)(ws + WS_Y), lane, (unsigned*)(ws + WS_CTL) + 3072);
    }
    SEAM(6);
    if (IN(7)) {
#if MK_DEBUG
        dbg_bf16((const bf16_t*)(ws + WS_Y), MX, 2048, 4096, DBG + 6, gt, ngt);
#endif
        pg8::StaticOrder S{32, 8, G, bid, (const char*)(ws + WS_Y), (const char*)WT2, (size_t)256 * 4096 * 2, (size_t)256 * 4096 * 2};
        EpiResid E{args.in[I_X], args.out, MOD + 4096};
        pg8::gemm_phase<EpiResid, pg8::StaticOrder>(lds, 4096, 4096, 4096, S, E);
    }
    SEAM(7);
    if (IN(8)) {
#if MK_DEBUG
        dbg_f32(args.out, MX, 2048, 2048, DBG + 7, gt, ngt);
#endif
        for (int m = gw; m < MX; m += NGW) hrow(args.out + (size_t)m * DM, args.in[I_NORMW] + DM, MOD + 5 * 6144 + (m / SEQ) * 6144, H + (size_t)m * DM, lane);
    }
    SEAM(8);
    if (IN(9)) {
#if MK_DEBUG
        dbg_bf16(H, MX, 2048, 2048, DBG + 8, gt, ngt);
#endif
        pg8::StaticOrder S{32, 40, G, bid, (const char*)H, (const char*)WT3, (size_t)256 * 2048 * 2, (size_t)256 * 2048 * 2};
        Epi3 E{(bf16_t*)(ws + WS_P1)};
        pg8::gemm_phase<Epi3, pg8::StaticOrder>(lds, 2048, 2048, 2048, S, E);
    }
    SEAM(9);
    if (IN(10)) {
#if MK_DEBUG
        dbg_bf16((const bf16_t*)(ws + WS_P1), MX, N3, N3, DBG + 9, gt, ngt);
#endif
        for (int m = gw; m < MX; m += NGW) stats_row(m, (const bf16_t*)(ws + WS_P1), (float*)(ws + WS_STATS), lane);
        for (int t = gw; t < 128 * 16; t += NGW) { const int blk = t >> 4, cc = t & 15, grp = cc >> 2;
            const bf16_t* p = (const bf16_t*)(ws + WS_P1) + (size_t)(64 * blk) * N3 + 6144 + 128 * cc + 2 * lane; bf16_t* o = (bf16_t*)(ws + WS_DIFF) + (size_t)(64 * blk) * DM + 128 * cc + 2 * lane;
            if (grp == 0) diff_task<1>(p, o); else if (grp == 1) diff_task<2>(p, o); else if (grp == 2) diff_task<4>(p, o); else diff_task<8>(p, o); }
    }
    SEAM(10);
    if (IN(11)) {
#if MK_DEBUG
        dbg_f32((const float*)(ws + WS_STATS), 1, 2 * MX, 2 * MX, DBG + 10, gt, ngt); dbg_bf16((const bf16_t*)(ws + WS_DIFF), MX, 2048, 2048, DBG + 10, gt, ngt);
#endif
        SchedPool S{G, bid, (const char*)(ws + WS_DIFF), (const char*)WTP};
        EpiPool E{(const bf16_t*)(ws + WS_P1), (bf16_t*)(ws + WS_Y2), args.in[I_OPS]};
        pg8::gemm_phase<EpiPool, SchedPool>(lds, 512, 2048, 512, S, E);
        __syncthreads();
        for (int t = bid; t < 1024; t += G) tmix_task(t, lds, args.in[I_OWS], args.in[I_OBS], args.in[I_OLNW], args.in[I_OLNB], (const float*)(ws + WS_STATS), (const bf16_t*)(ws + WS_P1), (bf16_t*)(ws + WS_Y2));
    }
    SEAM(11);
    if (IN(12)) {
#if MK_DEBUG
        dbg_bf16((const bf16_t*)(ws + WS_Y2), MX, 4096, 4096, DBG + 11, gt, ngt);
#endif
        pg8::StaticOrder S{32, 8, G, bid, (const char*)(ws + WS_Y2), (const char*)WT4, (size_t)256 * 4096 * 2, (size_t)256 * 4096 * 2};
        EpiResid E{args.out, args.out, MOD + 5 * 6144 + 4096};
        pg8::gemm_phase<EpiResid, pg8::StaticOrder>(lds, 4096, 4096, 4096, S, E);
    }
    SEAM(12);
    if (IN(13)) {
#if MK_DEBUG
        dbg_f32(args.out, MX, 2048, 2048, DBG + 12, gt, ngt);
        for (size_t i = gt; i < (size_t)MX * DM; i += ngt) { const float v = args.out[i]; if (badf(v)) args.out[i] = 0.f; }
        asm volatile("s_waitcnt vmcnt(0)" ::: "memory"); __syncthreads();
#endif
        for (int m = gw; m < MX; m += NGW) final_row(args.out + (size_t)m * DM, args.in[I_FNW], lane);
#if MK_DEBUG
        asm volatile("s_waitcnt vmcnt(0)" ::: "memory"); __syncthreads();
        if (bid == 0 && tid == 0) { int first = -1; unsigned mask = 0; for (int k = 12; k >= 0; --k) if (__hip_atomic_load(DBG + k, __ATOMIC_RELAXED, __HIP_MEMORY_SCOPE_AGENT)) { first = k; mask |= 1u << k; }
            if (first >= 0) args.out[0] = 1000.f * (float)(first + 1);
            { int cb = 0, cf = 0; for (int q = 0; q < 64; ++q) { cb += (int)__hip_atomic_load(DBG + 1024 + q, __ATOMIC_RELAXED, __HIP_MEMORY_SCOPE_AGENT); cf += (int)__hip_atomic_load(DBG + 1024 + 64 + q, __ATOMIC_RELAXED, __HIP_MEMORY_SCOPE_AGENT); }
              args.out[0] = 1000.f * (float)(DBG_SEL ? cf : cb) + 500.f;
              if (DBG_SEL == 30 || DBG_SEL == 31) { const int dsel = DBG_SEL - 30; int fb = -1; for (int q = 0; q < 64; ++q) if (__hip_atomic_load(DBG + 1024 + (dsel ? 0 : 64) + q, __ATOMIC_RELAXED, __HIP_MEMORY_SCOPE_AGENT)) { fb = q; break; }
                  float mg = 0.f; if (fb >= 0) { const float* gq = (const float*)(ws + WS_GG) + ((size_t)dsel * NBH + fb) * NTOK; for (int i = 256; i < NTOK; ++i) mg += gq[i]; mg = -mg / 2048.f; }
                  args.out[0] = 1.0e4f * mg + 1000.f * 1000.f * (float)(fb & 15); }
              else if (DBG_SEL == 200) { args.out[0] = 1.0e5f * __uint_as_float(__hip_atomic_load(DBG + 980, __ATOMIC_RELAXED, __HIP_MEMORY_SCOPE_AGENT)) + 1000.f; }
              else if (DBG_SEL >= 60 && DBG_SEL < 124) { args.out[0] = 1.0e3f * __uint_as_float(__hip_atomic_load(DBG + 910 + (DBG_SEL - 60), __ATOMIC_RELAXED, __HIP_MEMORY_SCOPE_AGENT)); }
              else if (DBG_SEL >= 40 && DBG_SEL < 60) { const int bhq = DBG_SEL - 40; const bf16_t* tq = (const bf16_t*)(ws + WS_TU) + (((size_t)1 * NBH + bhq) * NCH + 20) * 4096; float so = 0.f, sd = 0.f;
                  for (int i = 0; i < 64; ++i) for (int j = 0; j < 64; ++j) { const float v = fabsf(bf2f(tq[i * 64 + j])); if (i == j) sd += v; else so += v; }
                  args.out[0] = 1.0e4f * so + 1.0e8f; }
              else if (DBG_SEL >= 10) args.out[0] = 1.0e2f * __uint_as_float(__hip_atomic_load(DBG + 900 + (DBG_SEL - 10), __ATOMIC_RELAXED, __HIP_MEMORY_SCOPE_AGENT)); } }
#endif
    }
#if STOP_AFTER < 13
    if (lo == 14) {
        const size_t NO = (size_t)MX * DM; const size_t gtid = (size_t)bid * 512 + tid, ngtid = (size_t)G * 512;
        for (size_t i = gtid; i < NO; i += ngtid) {
            float acc = 0.f;
#define DG_BF(off, n) do { const bf16_t* q_ = (const bf16_t*)(ws + (off)); for (size_t j = i; j < (size_t)(n); j += NO) acc += bf2f(q_[j]); } while (0)
#define DG_F32(off, n) do { const float* q_ = (const float*)(ws + (off)); for (size_t j = i; j < (size_t)(n); j += NO) acc += q_[j]; } while (0)
#if STOP_AFTER == 0
            DG_BF(WS_WT1, (size_t)16640 * 2048); DG_BF(WS_WT2, (size_t)2048 * 4096); DG_F32(WS_MOD, 5 * 6144);
#elif STOP_AFTER == 1
            DG_BF(WS_H, (size_t)MT * 2048);
#elif STOP_AFTER == 2
            DG_BF(WS_PQKV, (size_t)MT * 6144); DG_BF(WS_ZA, (size_t)MX * 2048); DG_F32(WS_AB, (size_t)MT * 64);
            { const bf16_t* q_ = (const bf16_t*)(ws + WS_Y); const size_t r = i / 2048, c = i % 2048; acc += bf2f(q_[r * 4096 + 2048 + c]); }
#elif STOP_AFTER == 3
            DG_BF(WS_QN, (size_t)64 * NTOK * 128); DG_BF(WS_KN, (size_t)64 * NTOK * 128); DG_BF(WS_KT, (size_t)64 * NTOK * 128); DG_BF(WS_VT, (size_t)64 * NTOK * 128);
            DG_F32(WS_GG, (size_t)128 * NTOK); DG_F32(WS_BETA, (size_t)128 * NTOK);
#elif STOP_AFTER == 4
            DG_BF(WS_TU, (size_t)128 * NCH * 4096); DG_F32(WS_GC, (size_t)128 * NTOK); DG_F32(WS_MOD, 10 * 6144);
            DG_BF(WS_WT3, (size_t)10240 * 2048); DG_BF(WS_WT4, (size_t)2048 * 4096); DG_BF(WS_WTP, (size_t)2048 * 512);
            { const bf16_t* q_ = (const bf16_t*)(ws + WS_AI); for (size_t j = i; j < (size_t)128 * NCH * 4096; j += NO) { const size_t tcq = (j / 4096) % NCH; if (tcq >= 4) acc += bf2f(q_[j]); } }
#elif STOP_AFTER == 5
            DG_BF(WS_OF, (size_t)MX * 2048); DG_BF(WS_OB, (size_t)MX * 2048);
#elif STOP_AFTER == 6
            DG_BF(WS_Y, (size_t)MX * 4096);
#elif STOP_AFTER == 7
            acc = args.out[i];
#elif STOP_AFTER == 8
            DG_BF(WS_H, (size_t)MX * 2048);
#elif STOP_AFTER == 9
            DG_BF(WS_P1, (size_t)MX * N3);
#elif STOP_AFTER == 10
            DG_BF(WS_DIFF, (size_t)MX * 2048); DG_F32(WS_STATS, (size_t)MX * 2);
#elif STOP_AFTER == 11
            DG_BF(WS_Y2, (size_t)MX * 4096);
#else
            acc = args.out[i];
#endif
            if (badf(acc)) acc = 12345.f;
            args.out[i] = acc;
        }
    }
#endif
#undef IN
#undef SEAM
}

extern "C" void kernel_launch(void* const* d_in, const int* in_sizes, int n_in, void* d_out, int out_size, void* d_ws, size_t ws_size, hipStream_t stream) {
    static int grid = 0;
    if (grid == 0) {
        if (n_in != 23 || out_size != MX * DM || ws_size < WS_END) { fprintf(stderr, "kernel_launch: unexpected shapes (n_in %d, out %d, ws %zu < %zu)\n", n_in, out_size, ws_size, (size_t)WS_END); grid = -1; return; }
        int dev = 0, cus = 0, per_cu = 0;
        if (hipGetDevice(&dev) != hipSuccess || hipDeviceGetAttribute(&cus, hipDeviceAttributeMultiprocessorCount, dev) != hipSuccess) { grid = -1; return; }
        if (hipFuncSetAttribute((const void*)fwd_kernel, hipFuncAttributeMaxDynamicSharedMemorySize, LDS_BYTES) != hipSuccess) { fprintf(stderr, "kernel_launch: hipFuncSetAttribute failed\n"); grid = -1; return; }
        if (hipOccupancyMaxActiveBlocksPerMultiprocessor(&per_cu, (const void*)fwd_kernel, 512, LDS_BYTES) != hipSuccess || per_cu < 1) { fprintf(stderr, "kernel_launch: occupancy query says %d\n", per_cu); }
        (void)hipGetLastError();
        grid = cus;
    }
    if (grid < 0) return;
    if (hipMemsetAsync((char*)d_ws + WS_CTL, 0, CTL_BYTES, stream) != hipSuccess) { fprintf(stderr, "kernel_launch: memset failed\n"); return; }
    Args a{};
    for (int i = 0; i < 23; ++i) a.in[i] = (const float*)d_in[i];
    a.out = (float*)d_out; a.ws = (unsigned char*)d_ws; a.never = 0; a.pad = 0;
    const int nl = (STOP_AFTER < 13) ? STOP_AFTER + 2 : MK_N_LAUNCHES;
    for (int li = 0; li < nl; ++li) {
        a.ph_lo = (nl == 1) ? 0 : li; a.ph_hi = (nl == 1) ? NPHASE : li + 1;
        if (STOP_AFTER < 13 && li == nl - 1) { a.ph_lo = 14; a.ph_hi = 15; }
        void* kargs[] = {&a};
        hipError_t e = hipLaunchCooperativeKernel((const void*)fwd_kernel, dim3(grid), dim3(512), kargs, LDS_BYTES, stream);
        if (e != hipSuccess) { fprintf(stderr, "kernel_launch: launch %d failed: %s\n", li, hipGetErrorString(e)); break; }
    }
}
```

```cpp
#include <hip/hip_runtime.h>
#include <hip/hip_cooperative_groups.h>
#include <cstdio>
#include <cstdint>
namespace cg = cooperative_groups;

#ifndef MK_N_LAUNCHES
#define MK_N_LAUNCHES 1
#endif
#ifndef DBG_SEL
#define DBG_SEL 200
#endif
#ifndef MK_STAMP
#define MK_STAMP 0
#endif
#ifndef SEL_A
#define SEL_A 13
#endif
#ifndef SEL_B
#define SEL_B 12
#endif
#ifndef REPEAT_PH
#define REPEAT_PH 99
#endif
#ifndef REPEAT_N
#define REPEAT_N 2
#endif
#ifndef ABLATE
#define ABLATE 0
#endif
#ifndef STOP_AFTER
#define STOP_AFTER 13
#endif

#define LAS __attribute__((address_space(3)))
typedef unsigned short bf16_t;
typedef short bf16x8 __attribute__((ext_vector_type(8)));
typedef float f32x2 __attribute__((ext_vector_type(2)));
typedef float f32x4 __attribute__((ext_vector_type(4)));
typedef float f32x16 __attribute__((ext_vector_type(16)));
typedef unsigned u32x2 __attribute__((ext_vector_type(2)));
typedef unsigned u32x4 __attribute__((ext_vector_type(4)));

constexpr int DM = 2048, NB = 4, SEQ = 2048, CTXL = 256, MX = NB * SEQ, MC = NB * CTXL, MT = MX + MC;
constexpr int NTOK = CTXL + SEQ;
constexpr int NHD = 16, HD = 128, NBH = NB * NHD;
constexpr int N1SRC = 16448, N1P = 16640, N3 = 10240;
constexpr int NCH = NTOK / 64;
constexpr float EPS = 1e-6f;
constexpr int NPHASE = 14;

constexpr size_t MiB = 1u << 20;
constexpr size_t WS_CTL = 0, CTL_BYTES = 1 * MiB;
constexpr size_t WS_MOD = 1 * MiB;
constexpr size_t WS_GG = 2 * MiB, WS_BETA = 4 * MiB, WS_GC = 6 * MiB;
constexpr size_t WS_STATS = 7 * MiB + 512 * 1024;
constexpr size_t WS_WT2 = 8 * MiB;
constexpr size_t WS_WT1 = 24 * MiB;
constexpr size_t WS_WT3 = 24 * MiB, WS_WT4 = 64 * MiB, WS_WTP = 80 * MiB;
constexpr size_t WS_H = 89 * MiB;
constexpr size_t WS_OB = 89 * MiB;
constexpr size_t WS_PQKV = 125 * MiB;
constexpr size_t WS_TU = 125 * MiB, WS_AI = 161 * MiB, WS_OF = 197 * MiB;
constexpr size_t WS_ZA = 233 * MiB;
constexpr size_t WS_AB = 265 * MiB;
constexpr size_t WS_Y = 268 * MiB;
constexpr size_t WS_QN = 332 * MiB, WS_KN = 368 * MiB, WS_KT = 404 * MiB, WS_VT = 440 * MiB;
constexpr size_t WS_P1 = 125 * MiB;
constexpr size_t WS_DIFF = 285 * MiB;
constexpr size_t WS_Y2 = 396 * MiB;
constexpr size_t WS_END = 476 * MiB;
constexpr int CW_BAR = 4096;

constexpr int LDS_BYTES = 147456;
constexpr int MISC_OFF = LDS_BYTES - 256;

__device__ __forceinline__ float bf_lo(unsigned w) { return __uint_as_float(w << 16); }
__device__ __forceinline__ float bf_hi(unsigned w) { return __uint_as_float(w & 0xffff0000u); }
__device__ __forceinline__ float bf2f(bf16_t b) { return __uint_as_float(((unsigned)b) << 16); }
typedef __bf16 bf16v2 __attribute__((ext_vector_type(2)));
__device__ __forceinline__ unsigned cvt_pk_bf16(float lo, float hi) { const f32x2 v = {lo, hi}; const bf16v2 r = __builtin_convertvector(v, bf16v2); return __builtin_bit_cast(unsigned, r); }
__device__ __forceinline__ bf16_t f2bf(float f) { return (bf16_t)(cvt_pk_bf16(f, 0.f) & 0xffffu); }
__device__ __forceinline__ float sigmoid_f(float x) { return __builtin_amdgcn_rcpf(1.0f + __expf(-x)); }
__device__ __forceinline__ float silu_f(float x) { return x * sigmoid_f(x); }
__device__ __forceinline__ float gelu_f(float x) { const float u = 0.7978845608028654f * (x + 0.044715f * x * x * x); return x * sigmoid_f(2.0f * u); }
__device__ __forceinline__ float softplus_f(float x) { return fmaxf(x, 0.f) + log1pf(__expf(-fabsf(x))); }
__device__ __forceinline__ float wave_sum(float v) {
#pragma unroll
    for (int o = 1; o < 64; o <<= 1) v += __shfl_xor(v, o);
    return v;
}
__device__ __forceinline__ float dpp_shr1(float x, float old) { return __builtin_bit_cast(float, __builtin_amdgcn_update_dpp(__builtin_bit_cast(int, old), __builtin_bit_cast(int, x), 0x111, 0xf, 0xf, false)); }
__device__ __forceinline__ float dpp_shl1(float x, float old) { return __builtin_bit_cast(float, __builtin_amdgcn_update_dpp(__builtin_bit_cast(int, old), __builtin_bit_cast(int, x), 0x101, 0xf, 0xf, false)); }
#ifndef MK_DEBUG
#define MK_DEBUG 0
#endif
#define LDS_WAIT() asm volatile("s_waitcnt lgkmcnt(0)" ::: "memory")

#define XB_TMO      128
#define XB_XCNT(j)  (256  + 64 * (j))
#define XB_XSUB(j)  (1280 + 64 * (j))
#define XB_XGEN(j)  (2304 + 64 * (j))
#define XB_TOP      3328
#define XB_TOPGEN   3392
#define XCD_BAR_WORDS 3456
#define XB_SPIN_CAP (1u << 20)
__device__ __forceinline__ unsigned xb_ld(unsigned* p)              { return __hip_atomic_load(p, __ATOMIC_RELAXED, __HIP_MEMORY_SCOPE_AGENT); }
__device__ __forceinline__ unsigned xb_add(unsigned* p, unsigned v) { return __hip_atomic_fetch_add(p, v, __ATOMIC_RELAXED, __HIP_MEMORY_SCOPE_AGENT); }
__device__ __forceinline__ unsigned xb_xcc_id() { return (unsigned)__builtin_amdgcn_s_getreg((3 << 11) | 20) & 0xFu; }
#define XB_SPIN(cond, bar) do { unsigned _sp = 0; while (cond) { __builtin_amdgcn_s_sleep(1); \
    if ((++_sp & 255u) == 0u) { if (xb_ld(&(bar)[XB_TMO])) break; if (_sp > XB_SPIN_CAP) { atomicAdd(&(bar)[XB_TMO], 1u); break; } } } } while (0)
struct XcdBarrier { unsigned* bar; unsigned x; volatile LAS unsigned* st; };
__device__ __forceinline__ XcdBarrier xcd_barrier_post(unsigned* bar, volatile LAS unsigned* st) {
    XcdBarrier b; b.bar = bar; b.x = xb_xcc_id(); b.st = st;
    if (threadIdx.x == 0) (void)xb_add(&bar[XB_XCNT(b.x)], 1u);
    return b;
}
__device__ __forceinline__ void xcd_barrier_complete(unsigned* bar, unsigned x, unsigned& nloc, unsigned& nx) {
    const unsigned G = gridDim.x * gridDim.y * gridDim.z;
    unsigned sum, cnt, mine, sp = 0u;
    for (;;) {
        sum = 0u; cnt = 0u; mine = 0u;
#pragma unroll
        for (unsigned j = 0; j < 16; ++j) { const unsigned c = xb_ld(&bar[XB_XCNT(j)]); sum += c; cnt += (c > 0u) ? 1u : 0u; mine = (j == x) ? c : mine; }
        if (sum == G) break;
        __builtin_amdgcn_s_sleep(1);
        if ((++sp & 255u) == 0u) { if (xb_ld(&bar[XB_TMO])) break; if (sp > XB_SPIN_CAP) { atomicAdd(&bar[XB_TMO], 1u); break; } }
    }
    nloc = mine > 0u ? mine : 1u; nx = cnt > 0u ? cnt : 1u;
}
__device__ __forceinline__ void xcd_barrier(const XcdBarrier& b) {
    asm volatile("s_waitcnt vmcnt(0)" ::: "memory");
    __syncthreads();
    if (threadIdx.x == 0) {
        unsigned* bar = b.bar;
        __builtin_amdgcn_s_waitcnt(0);
        unsigned nloc = b.st[0], nx = b.st[1];
        if (nloc == 0u) { xcd_barrier_complete(bar, b.x, nloc, nx); b.st[0] = nloc; b.st[1] = nx; }
        const unsigned old = xb_add(&bar[XB_XSUB(b.x)], 1u);
        const unsigned gen = old / nloc;
        if (old + 1u == (gen + 1u) * nloc) {
            __builtin_amdgcn_fence(__ATOMIC_RELEASE, "agent");
            asm volatile("s_waitcnt vmcnt(0)" ::: "memory");
            const unsigned og = xb_add(&bar[XB_TOP], 1u);
            const unsigned tg = og / nx;
            if (og + 1u == (tg + 1u) * nx) xb_add(&bar[XB_TOPGEN], 1u);
            else XB_SPIN(xb_ld(&bar[XB_TOPGEN]) == tg, bar);
            __builtin_amdgcn_fence(__ATOMIC_ACQUIRE, "agent");
            xb_add(&bar[XB_XGEN(b.x)], 1u);
            asm volatile("s_waitcnt vmcnt(0)" ::: "memory");
        } else {
            XB_SPIN(xb_ld(&bar[XB_XGEN(b.x)]) == gen, bar);
            __builtin_amdgcn_fence(__ATOMIC_ACQUIRE, "agent");
            asm volatile("s_waitcnt vmcnt(0)" ::: "memory");
        }
    }
    __syncthreads();
}

namespace pg8 {
constexpr int BM = 256, BK = 64, HALF = 128, HTB = HALF * BK * 2, STAGE_BYTES = 8 * HTB, NXCD = 8, WGM = 8;
__host__ __device__ __forceinline__ int lds_byte(int r, int c) { const int st = (r >> 4) * 2 + (c >> 5), rr = r & 15, cc = c & 31, ob = rr * 64 + cc * 2; return st * 1024 + (ob ^ (((ob >> 9) & 1) << 5)); }
__host__ __device__ __forceinline__ void stage_rc(int b, int& R, int& C) { const int st = b / 1024, sb = b % 1024, swz = sb ^ (((sb >> 9) & 1) << 5); R = (st >> 1) * 16 + swz / 64; C = (st & 1) * 32 + (swz % 64) / 2; }
__host__ __device__ __forceinline__ int perm32(int rho) { const int n = rho >> 4, i = rho & 15; return 8 * (i >> 2) + 4 * n + (i & 3); }
struct Unit { int pm, pn, aux; const char* a; const char* b; };
__device__ __forceinline__ void tile_order(int L, int nM, int nN, int& pm, int& pn) {
    const int nwg = nM * nN; int wgid = L;
    { const int q = nwg / NXCD, r = nwg % NXCD, xcd = wgid % NXCD, off = wgid / NXCD; wgid = (xcd < r ? xcd * (q + 1) : r * (q + 1) + (xcd - r) * q) + off; }
    const int nig = WGM * nN, gid = wgid / nig, fm = gid * WGM, gsz = (nM - fm) < WGM ? (nM - fm) : WGM;
    pm = fm + ((wgid % nig) % gsz); pn = (wgid % nig) / gsz;
}
struct StaticOrder {
    int nM, nN, G, c; const char* A; const char* B; size_t ta, tb;
    __device__ __forceinline__ bool next(int i, Unit& u) const {
        const long L = (long)i * G + c; if (L >= (long)nM * nN) return false;
        tile_order((int)L, nM, nN, u.pm, u.pn); u.aux = 0; u.a = A + (size_t)u.pm * ta; u.b = B + (size_t)u.pn * tb; return true;
    }
};
#define PG8_LAS __attribute__((address_space(3)))
template <class Epi, class Sched>
__device__ __forceinline__ void gemm_phase(PG8_LAS unsigned char* lds, const int K, const int lda, const int ldb, const Sched& S, const Epi& E) {
    const int tid = threadIdx.x, wid = __builtin_amdgcn_readfirstlane(tid >> 6), lane = tid & 63, wr = wid >> 2, wc = wid & 3, fr = lane & 15, fq = lane >> 4;
    const int nt = K / BK;
    unsigned voffA[2], voffB[2];
#pragma unroll
    for (int i = 0; i < 2; ++i) { int R, C; stage_rc(tid * 16 + i * 8192, R, C); const int Rb = Epi::PERM ? ((R & ~31) + perm32(R & 31)) : R;
        voffA[i] = (unsigned)(R * lda + C) * 2u; voffB[i] = (unsigned)(Rb * ldb + C) * 2u; }
    const size_t kstep = (size_t)(BK * 2);
    const size_t hstepA = (size_t)HALF * lda * 2, hstepB = (size_t)HALF * ldb * 2;
    const unsigned ldsw = (unsigned)wid * 1024u;
    const int aoff = lds_byte(wr * 64 + fr, fq * 8), boff = lds_byte(wc * 32 + fr, fq * 8);
#define PG8_SA(b, h) (((b) * 2 + (h)) * HTB)
#define PG8_SB(b, h) ((4 + (b) * 2 + (h)) * HTB)
#define PG8_STAGE(bufoff, gbase, voff) do { _Pragma("unroll") for (int _i = 0; _i < 2; ++_i) \
        __builtin_amdgcn_global_load_lds((const unsigned*)((const char*)(gbase) + (voff)[_i]), (PG8_LAS unsigned*)(lds + (bufoff) + ldsw + _i * 8192), 16, 0, 0); } while (0)
#define PG8_LDA(dst, b, h) do { _Pragma("unroll") for (int m = 0; m < 4; ++m) _Pragma("unroll") for (int k = 0; k < 2; ++k) dst[m][k] = *(const PG8_LAS bf16x8*)(lds + PG8_SA(b, h) + aoff + m * 2048 + k * 1024); } while (0)
#define PG8_LDB(dst, b, h) do { _Pragma("unroll") for (int n = 0; n < 2; ++n) _Pragma("unroll") for (int k = 0; k < 2; ++k) dst[n][k] = *(const PG8_LAS bf16x8*)(lds + PG8_SB(b, h) + boff + n * 2048 + k * 1024); } while (0)
#define PG8_MMA(ai, bj, At, Bt) do { __builtin_amdgcn_s_setprio(1); _Pragma("unroll") for (int m = 0; m < 4; ++m) _Pragma("unroll") for (int n = 0; n < 2; ++n) _Pragma("unroll") for (int k = 0; k < 2; ++k) \
        acc[ai][bj][m][n] = __builtin_amdgcn_mfma_f32_16x16x32_bf16(Bt[n][k], At[m][k], acc[ai][bj][m][n], 0, 0, 0); __builtin_amdgcn_s_setprio(0); } while (0)
#define PG8_WAIT_V(n) asm volatile("s_waitcnt vmcnt(" #n ")" ::: "memory")
#define PG8_WAIT_L(n) asm volatile("s_waitcnt lgkmcnt(" #n ")" ::: "memory")
#define PG8_BAR __builtin_amdgcn_s_barrier()
#define PG8_SCHED __builtin_amdgcn_sched_barrier(0)
    Unit cur, nxt; int ui = 0;
    if (!S.next(0, cur)) return;
    f32x4 acc[2][2][4][2];
#pragma unroll
    for (int a = 0; a < 2; ++a)
#pragma unroll
        for (int b = 0; b < 2; ++b)
#pragma unroll
            for (int m = 0; m < 4; ++m)
#pragma unroll
                for (int n = 0; n < 2; ++n) acc[a][b][m][n] = (f32x4){0.f, 0.f, 0.f, 0.f};
    bf16x8 At[4][2], B0[2][2], B1[2][2];
    const char* cA = cur.a; const char* cB = cur.b;
    PG8_STAGE(PG8_SB(0, 0), cB, voffB); PG8_STAGE(PG8_SB(0, 1), cB + hstepB, voffB); PG8_STAGE(PG8_SA(0, 0), cA, voffA); PG8_STAGE(PG8_SA(0, 1), cA + hstepA, voffA);
    if (wr == 1) PG8_BAR;
    PG8_WAIT_V(2); PG8_BAR;
    PG8_STAGE(PG8_SB(1, 0), cB + kstep, voffB); PG8_STAGE(PG8_SA(1, 0), cA + kstep, voffA); PG8_STAGE(PG8_SB(1, 1), cB + hstepB + kstep, voffB);
    PG8_WAIT_V(6); PG8_BAR;
    for (;;) {
        const bool has_next = S.next(ui + 1, nxt);
        const char* nA = has_next ? nxt.a : cA; const char* nB = has_next ? nxt.b : cB;
        for (int t = 0; t < nt; t += 2) {
            const bool last = (t == nt - 2);
            const char* a1 = cA + (size_t)(t + 1) * kstep;
            const char* a2 = last ? nA : cA + (size_t)(t + 2) * kstep; const char* b2 = last ? nB : cB + (size_t)(t + 2) * kstep;
            const char* a3 = a2 + kstep; const char* b3 = b2 + kstep;
            PG8_LDB(B0, 0, 0); PG8_LDB(B1, 0, 1); PG8_SCHED; PG8_LDA(At, 0, 0); PG8_STAGE(PG8_SA(1, 1), a1 + hstepA, voffA);
            PG8_WAIT_V(8); PG8_WAIT_L(0); PG8_BAR; PG8_MMA(0, 0, At, B0); PG8_MMA(0, 1, At, B1); PG8_BAR; PG8_SCHED;
            PG8_LDA(At, 0, 1); PG8_STAGE(PG8_SB(0, 0), b2, voffB); PG8_STAGE(PG8_SB(0, 1), b2 + hstepB, voffB); PG8_STAGE(PG8_SA(0, 0), a2, voffA);
            PG8_WAIT_V(8); PG8_WAIT_L(0); PG8_BAR; PG8_MMA(1, 0, At, B0); PG8_MMA(1, 1, At, B1); PG8_BAR; PG8_SCHED;
            PG8_LDB(B0, 1, 0); PG8_LDB(B1, 1, 1); PG8_SCHED; PG8_LDA(At, 1, 0); PG8_STAGE(PG8_SA(0, 1), a2 + hstepA, voffA);
            PG8_WAIT_V(8); PG8_WAIT_L(0); PG8_BAR; PG8_MMA(0, 0, At, B0); PG8_MMA(0, 1, At, B1); PG8_BAR; PG8_SCHED;
            PG8_LDA(At, 1, 1); PG8_STAGE(PG8_SB(1, 0), b3, voffB); PG8_STAGE(PG8_SB(1, 1), b3 + hstepB, voffB); PG8_STAGE(PG8_SA(1, 0), a3, voffA);
            PG8_WAIT_V(8); PG8_WAIT_L(0); PG8_BAR; PG8_MMA(1, 0, At, B0); PG8_MMA(1, 1, At, B1); PG8_BAR; PG8_SCHED;
        }
        if (wr == 0) PG8_BAR;
        E(acc, cur, wr, wc, fr, fq);
        if (!has_next) break;
#pragma unroll
        for (int a = 0; a < 2; ++a)
#pragma unroll
            for (int b = 0; b < 2; ++b)
#pragma unroll
                for (int m = 0; m < 4; ++m)
#pragma unroll
                    for (int n = 0; n < 2; ++n) acc[a][b][m][n] = (f32x4){0.f, 0.f, 0.f, 0.f};
        cur = nxt; cA = nA; cB = nB; ++ui;
        if (wr == 1) PG8_BAR;
    }
    PG8_WAIT_V(0);
    PG8_BAR;
#undef PG8_SA
#undef PG8_SB
#undef PG8_STAGE
#undef PG8_LDA
#undef PG8_LDB
#undef PG8_MMA
#undef PG8_WAIT_V
#undef PG8_WAIT_L
#undef PG8_BAR
#undef PG8_SCHED
}
}

#if MK_DEBUG
__device__ __forceinline__ bool badf(float v) { return !(fabsf(v) < 1e30f); }
__device__ __forceinline__ void dbg_bf16(const bf16_t* p, int rows, int cols, size_t ld, unsigned* flag, int gt, int ngt) {
    const int cpr = cols / 8; bool bad = false;
    for (size_t i = gt; i < (size_t)rows * cpr; i += ngt) { const size_t r = i / cpr, c = (i % cpr) * 8; const u32x4 a = *(const u32x4*)(p + r * ld + c);
        bad |= badf(bf_lo(a.x)) | badf(bf_hi(a.x)) | badf(bf_lo(a.y)) | badf(bf_hi(a.y)) | badf(bf_lo(a.z)) | badf(bf_hi(a.z)) | badf(bf_lo(a.w)) | badf(bf_hi(a.w)); }
    if (bad) *flag = 1u;
}
__device__ __forceinline__ void dbg_max_bf16(const bf16_t* p, size_t n, unsigned* slot, int gt, int ngt) {
    float m = 0.f;
    for (size_t i = (size_t)gt * 8; i < n; i += (size_t)ngt * 8) { const u32x4 a = *(const u32x4*)(p + i);
        m = fmaxf(m, fmaxf(fmaxf(fmaxf(fabsf(bf_lo(a.x)), fabsf(bf_hi(a.x))), fmaxf(fabsf(bf_lo(a.y)), fabsf(bf_hi(a.y)))), fmaxf(fmaxf(fabsf(bf_lo(a.z)), fabsf(bf_hi(a.z))), fmaxf(fabsf(bf_lo(a.w)), fabsf(bf_hi(a.w)))))); }
    atomicMax(slot, __float_as_uint(m));
}
__device__ __forceinline__ void dbg_f32(const float* p, int rows, int cols, size_t ld, unsigned* flag, int gt, int ngt) {
    const int cpr = cols / 4; bool bad = false;
    for (size_t i = gt; i < (size_t)rows * cpr; i += ngt) { const size_t r = i / cpr, c = (i % cpr) * 4; const f32x4 a = *(const f32x4*)(p + r * ld + c);
        bad |= badf(a.x) | badf(a.y) | badf(a.z) | badf(a.w); }
    if (bad) *flag = 1u;
}
#endif
struct Args { const float* in[23]; float* out; unsigned char* ws; int ph_lo, ph_hi, never, pad; };
enum { I_X = 0, I_C, I_CTX, I_CCTX, I_ADAW, I_ADAB, I_NORMW, I_EWIN, I_ECONVQKV, I_EALOG, I_EDTB, I_EHN, I_ECONVB, I_EWOUT, I_OWIN, I_OLNW, I_OLNB, I_OWS, I_OBS, I_OPW, I_OPS, I_OWOUT, I_FNW };

template <class SrcFn>
__device__ __forceinline__ void conv_item(const float* W, int ldw, int K, bf16_t* WT, int c0, int k0, LAS float* scr, int lane, const SrcFn& src) {
    const int sc = src(c0 + lane);
    const float* wp = W + (size_t)k0 * ldw + (sc >= 0 ? sc : 0);
    float v[64];
#pragma unroll
    for (int i = 0; i < 64; ++i) v[i] = wp[(size_t)i * ldw];
#pragma unroll
    for (int i = 0; i < 64; ++i) scr[i * 65 + lane] = sc >= 0 ? v[i] : 0.f;
    LDS_WAIT(); asm volatile("" ::: "memory");
    const int kc = lane >> 3, cc = lane & 7;
#pragma unroll
    for (int j = 0; j < 8; ++j) { const int c = cc + 8 * j; const LAS float* sp = scr + (8 * kc) * 65 + c;
        u32x4 o; o.x = cvt_pk_bf16(sp[0 * 65], sp[1 * 65]); o.y = cvt_pk_bf16(sp[2 * 65], sp[3 * 65]); o.z = cvt_pk_bf16(sp[4 * 65], sp[5 * 65]); o.w = cvt_pk_bf16(sp[6 * 65], sp[7 * 65]);
        *(u32x4*)(WT + (size_t)(c0 + c) * K + k0 + 8 * kc) = o; }
    LDS_WAIT(); asm volatile("" ::: "memory");
}
struct SrcId { __device__ __forceinline__ int operator()(int c) const { return c; } };
struct SrcW1 { __device__ __forceinline__ int operator()(int c) const {
    if (c < 8192) return c;
    if (c < 16384) { const int cc = c - 8192, T = cc >> 8, cp = cc & 255, bj = cp >> 7, wc = (cp >> 5) & 3, fq = (cp >> 3) & 3, n = (cp >> 2) & 1, j = cp & 3;
        return 8256 + 2048 * (2 * bj + n) + 64 * T + 16 * wc + 4 * fq + j; }
    const int cp = c - 16384; return cp < 64 ? 8192 + cp : -1; } };

__device__ __forceinline__ void mod_task(const float* adaw, const float* adab, float* modl, int n0, const LAS float* tab, LAS float* red, int wave, int lane) {
    const int col = n0 + (lane & 31), kp = lane >> 5;
    float acc[5] = {0.f, 0.f, 0.f, 0.f, 0.f};
    const float* wp = adaw + (size_t)(256 * wave + kp) * 6144 + col;
#pragma unroll 32
    for (int kk = 0; kk < 128; ++kk) { const float wv = wp[(size_t)kk * 2 * 6144]; const int k = 256 * wave + 2 * kk + kp;
#pragma unroll
        for (int r = 0; r < 5; ++r) acc[r] += tab[r * 2048 + k] * wv; }
#pragma unroll
    for (int r = 0; r < 5; ++r) { acc[r] += __shfl_xor(acc[r], 32); if (lane < 32) red[(wave * 5 + r) * 32 + lane] = acc[r]; }
    __syncthreads();
    if (threadIdx.x < 160) { const int r = threadIdx.x >> 5, c = threadIdx.x & 31; float s = adab[n0 + c];
#pragma unroll
        for (int w = 0; w < 8; ++w) s += red[(w * 5 + r) * 32 + c];
        modl[r * 6144 + n0 + c] = s; }
    __syncthreads();
}
__device__ __forceinline__ void silu_table(const float* c, const float* cctx, LAS float* tab) {
    for (int i = threadIdx.x; i < 5 * 2048; i += 512) { const float v = i < 8192 ? c[i] : cctx[i - 8192]; tab[i] = silu_f(v); }
    __syncthreads();
}

__device__ __forceinline__ void hrow(const float* xrow, const float* nw, const float* modr, bf16_t* orow, int lane) {
    const f32x4* xr = (const f32x4*)xrow + lane;
    f32x4 v[8]; float s = 0.f;
#pragma unroll
    for (int j = 0; j < 8; ++j) { v[j] = xr[64 * j]; s += (v[j].x * v[j].x + v[j].y * v[j].y) + (v[j].z * v[j].z + v[j].w * v[j].w); }
    const float rstd = rsqrtf(wave_sum(s) * (1.f / DM) + EPS);
    u32x2* o8 = (u32x2*)orow + lane;
#pragma unroll
    for (int j = 0; j < 8; ++j) { const f32x4 w = ((const f32x4*)nw)[lane + 64 * j], sh = ((const f32x4*)modr)[lane + 64 * j], sc = ((const f32x4*)(modr + 2048))[lane + 64 * j];
        const f32x4 y = v[j] * rstd * w * (sc + 1.0f) + sh; u32x2 p; p.x = cvt_pk_bf16(y.x, y.y); p.y = cvt_pk_bf16(y.z, y.w); o8[64 * j] = p; }
}

typedef f32x4 AccT[2][2][4][2];
struct Sched1 { int G, c; const char* A; const char* B;
    __device__ __forceinline__ bool next(int i, pg8::Unit& u) const {
        const int L = i * G + c; if (L >= 2180) return false;
        if (L < 2080) pg8::tile_order(L, 32, 65, u.pm, u.pn);
        else { const int l = L - 2080; u.pm = 32 + (l & 3); const int t = l >> 2; u.pn = t < 24 ? t : 64; }
        u.aux = 0; u.a = A + (size_t)u.pm * (256 * 2048 * 2); u.b = B + (size_t)u.pn * (256 * 2048 * 2); return true; } };
struct Epi1 { static constexpr bool PERM = true;
    bf16_t* PQKV; bf16_t* ZA; float* AB; bf16_t* Y; const float* convb;
    __device__ __forceinline__ void operator()(const AccT& acc, const pg8::Unit& u, int wr, int wc, int fr, int fq) const {
        const int row0 = u.pm * 256 + wr * 64 + fr;
        if (u.pn < 32) {
            const bool act = u.pn >= 24;
            bf16_t* base = act ? ZA : PQKV; const int ldc = act ? 2048 : 6144; const int col0 = (act ? (u.pn - 24) : u.pn) * 256 + wc * 32 + 8 * fq;
#pragma unroll
            for (int ai = 0; ai < 2; ++ai)
#pragma unroll
                for (int m = 0; m < 4; ++m) { bf16_t* rowp = base + (size_t)(row0 + ai * 128 + m * 16) * ldc + col0;
#pragma unroll
                    for (int bj = 0; bj < 2; ++bj) { f32x4 v0 = acc[ai][bj][m][0], v1 = acc[ai][bj][m][1];
                        if (act) {
#pragma unroll
                            for (int j = 0; j < 4; ++j) { v0[j] = silu_f(v0[j]); v1[j] = silu_f(v1[j]); } }
                        u32x4 w; w.x = cvt_pk_bf16(v0[0], v0[1]); w.y = cvt_pk_bf16(v0[2], v0[3]); w.z = cvt_pk_bf16(v1[0], v1[1]); w.w = cvt_pk_bf16(v1[2], v1[3]);
                        *(u32x4*)(rowp + bj * 128) = w; } }
        } else if (u.pn < 64) {
            const int lane = threadIdx.x & 63;
            const int ch0 = 64 * (u.pn - 32) + 16 * wc + 4 * fq;
            const f32x4 cw0 = *(const f32x4*)(convb + ch0), cw1 = *(const f32x4*)(convb + 2048 + ch0), cw2 = *(const f32x4*)(convb + 4096 + ch0);
#pragma unroll
            for (int ai = 0; ai < 2; ++ai) {
                f32x4 pr[4];
#pragma unroll
                for (int m = 0; m < 4; ++m) pr[m] = acc[ai][0][m][1] * acc[ai][1][m][0];
#pragma unroll
                for (int m = 0; m < 4; ++m) { f32x4 y;
#pragma unroll
                    for (int j = 0; j < 4; ++j) {
                        const float bp = m > 0 ? __shfl(pr[m > 0 ? m - 1 : 0][j], lane | 15) : 0.f;
                        const float bn = m < 3 ? __shfl(pr[m < 3 ? m + 1 : 3][j], lane & ~15) : 0.f;
                        const float up = dpp_shr1(pr[m][j], bp), dn = dpp_shl1(pr[m][j], bn);
                        const float cv = cw0[j] * up + cw1[j] * pr[m][j] + cw2[j] * dn;
                        y[j] = acc[ai][0][m][0][j] * cv * silu_f(acc[ai][1][m][1][j]); if (ABLATE & 2) y[j] = 0.f; }
                    u32x2 w; w.x = cvt_pk_bf16(y[0], y[1]); w.y = cvt_pk_bf16(y[2], y[3]);
                    *(u32x2*)(Y + (size_t)(row0 + ai * 128 + m * 16) * 4096 + 2048 + ch0) = w; } }
        } else {
            if (wc < 2) {
#pragma unroll
                for (int ai = 0; ai < 2; ++ai)
#pragma unroll
                    for (int m = 0; m < 4; ++m)
#pragma unroll
                        for (int n = 0; n < 2; ++n) *(f32x4*)(AB + (size_t)(row0 + ai * 128 + m * 16) * 64 + 32 * wc + 8 * fq + 4 * n) = acc[ai][0][m][n]; }
        }
    } };
struct EpiResid { static constexpr bool PERM = false;
    const float* resid; float* out; const float* gate;
    __device__ __forceinline__ void operator()(const AccT& acc, const pg8::Unit& u, int wr, int wc, int fr, int fq) const {
        const int row0 = u.pm * 256 + wr * 64 + fr, col0 = u.pn * 256 + wc * 32 + 4 * fq; const float* g = gate + (size_t)(u.pm >> 3) * 6144;
        f32x4 gv[2][2];
#pragma unroll
        for (int bj = 0; bj < 2; ++bj)
#pragma unroll
            for (int n = 0; n < 2; ++n) gv[bj][n] = *(const f32x4*)(g + col0 + bj * 128 + n * 16);
#pragma unroll
        for (int ai = 0; ai < 2; ++ai)
#pragma unroll
            for (int m = 0; m < 4; ++m) { const size_t off = (size_t)(row0 + ai * 128 + m * 16) * DM + col0;
#pragma unroll
                for (int bj = 0; bj < 2; ++bj)
#pragma unroll
                    for (int n = 0; n < 2; ++n) { const f32x4 r = *(const f32x4*)(resid + off + bj * 128 + n * 16); *(f32x4*)(out + off + bj * 128 + n * 16) = r + gv[bj][n] * acc[ai][bj][m][n]; }
                asm volatile("" ::: "memory"); }
    } };
struct Epi3 { static constexpr bool PERM = true;
    bf16_t* P1;
    __device__ __forceinline__ void operator()(const AccT& acc, const pg8::Unit& u, int wr, int wc, int fr, int fq) const {
        const int row0 = u.pm * 256 + wr * 64 + fr, col0 = u.pn * 256 + wc * 32 + 8 * fq;
        const int act = u.pn < 16 ? 1 : ((u.pn >= 24 && u.pn < 32) ? 0 : 2);
#pragma unroll
        for (int ai = 0; ai < 2; ++ai)
#pragma unroll
            for (int m = 0; m < 4; ++m) { bf16_t* rowp = P1 + (size_t)(row0 + ai * 128 + m * 16) * N3 + col0;
#pragma unroll
                for (int bj = 0; bj < 2; ++bj) { f32x4 v0 = acc[ai][bj][m][0], v1 = acc[ai][bj][m][1];
                    if (act == 1) {
#pragma unroll
                        for (int j = 0; j < 4; ++j) { v0[j] = gelu_f(v0[j]); v1[j] = gelu_f(v1[j]); } }
                    else if (act == 2) {
#pragma unroll
                        for (int j = 0; j < 4; ++j) { v0[j] = silu_f(v0[j]); v1[j] = silu_f(v1[j]); } }
                    u32x4 w; w.x = cvt_pk_bf16(v0[0], v0[1]); w.y = cvt_pk_bf16(v0[2], v0[3]); w.z = cvt_pk_bf16(v1[0], v1[1]); w.w = cvt_pk_bf16(v1[2], v1[3]);
                    *(u32x4*)(rowp + bj * 128) = w; } }
    } };
struct SchedPool { int G, c; const char* A; const char* B;
    __device__ __forceinline__ bool next(int i, pg8::Unit& u) const {
        const int L = i * G + c; if (L >= 256) return false;
        u.aux = L >> 6; u.pn = (L >> 5) & 1; u.pm = L & 31;
        u.a = A + ((size_t)u.pm * 256 * 2048 + 512 * u.aux) * 2; u.b = B + ((size_t)u.aux * 512 * 512 + (size_t)u.pn * 256 * 512) * 2; return true; } };
struct EpiPool { static constexpr bool PERM = true;
    const bf16_t* P1; bf16_t* Y2; const float* pscale;
    __device__ __forceinline__ void operator()(const AccT& acc, const pg8::Unit& u, int wr, int wc, int fr, int fq) const {
        const int row0 = u.pm * 256 + wr * 64 + fr, colg = 512 * u.aux + 256 * u.pn + wc * 32 + 8 * fq;
        f32x4 ps[2][2];
#pragma unroll
        for (int bj = 0; bj < 2; ++bj)
#pragma unroll
            for (int n = 0; n < 2; ++n) ps[bj][n] = *(const f32x4*)(pscale + colg + bj * 128 + 4 * n);
#pragma unroll
        for (int ai = 0; ai < 2; ++ai)
#pragma unroll
            for (int m = 0; m < 4; ++m) { const size_t row = (size_t)(row0 + ai * 128 + m * 16);
#pragma unroll
                for (int bj = 0; bj < 2; ++bj) { const u32x4 z = *(const u32x4*)(P1 + row * N3 + 8192 + colg + bj * 128);
                    f32x4 v0 = acc[ai][bj][m][0] * ps[bj][0], v1 = acc[ai][bj][m][1] * ps[bj][1]; if (ABLATE & 8) { v0 = v0 * 0.f; v1 = v1 * 0.f; }
                    u32x4 w; w.x = cvt_pk_bf16(v0[0] * bf_lo(z.x), v0[1] * bf_hi(z.x)); w.y = cvt_pk_bf16(v0[2] * bf_lo(z.y), v0[3] * bf_hi(z.y));
                    w.z = cvt_pk_bf16(v1[0] * bf_lo(z.z), v1[1] * bf_hi(z.z)); w.w = cvt_pk_bf16(v1[2] * bf_lo(z.w), v1[3] * bf_hi(z.w));
                    *(u32x4*)(Y2 + row * 4096 + 2048 + colg + bj * 128) = w; } }
    } };

__device__ __forceinline__ void qkv_task(int task, const bf16_t* PQKV, const float* convw, bf16_t* QN, bf16_t* KN, bf16_t* KT, bf16_t* VT, int lane) {
    const int head = task & 15, tens = (task >> 4) % 3, blk = task / 48;
    int b, t0, prow0, tokb; bool isx;
    if (blk < 128) { isx = true; b = blk >> 5; t0 = (blk & 31) * 64; prow0 = b * SEQ + t0; tokb = CTXL + t0; }
    else { isx = false; const int cb = blk - 128; b = cb >> 2; t0 = (cb & 3) * 64; prow0 = MX + b * CTXL + t0; tokb = t0; }
    const int col = tens * 2048 + head * 128 + 2 * lane;
    const f32x2 w0 = *(const f32x2*)(convw + col), w1 = *(const f32x2*)(convw + 6144 + col), w2 = *(const f32x2*)(convw + 12288 + col);
    const bf16_t* p = PQKV + (size_t)prow0 * 6144 + col;
    const int bh = b * NHD + head;
    unsigned v[66];
    v[0] = 0u; v[65] = 0u;
    if (!isx && t0 > 0) v[0] = *(const unsigned*)(p - 6144);
    if (!isx && t0 < 192) v[65] = *(const unsigned*)(p + (size_t)64 * 6144);
#pragma unroll
    for (int i = 0; i < 64; ++i) v[i + 1] = *(const unsigned*)(p + (size_t)i * 6144);
    unsigned tr0[4], tr1[4];
    float hold0 = 0.f, hold1 = 0.f;
#pragma unroll
    for (int i = 0; i < 64; ++i) {
        const unsigned pv = v[i], cu = v[i + 1], nx = v[i + 2];
        float o0 = w0.x * bf_lo(pv) + w1.x * bf_lo(cu) + w2.x * bf_lo(nx);
        float o1 = w0.y * bf_hi(pv) + w1.y * bf_hi(cu) + w2.y * bf_hi(nx);
        o0 = silu_f(o0); o1 = silu_f(o1);
        if (tens < 2) { const float ss = wave_sum(o0 * o0 + o1 * o1); const float sc = rsqrtf(ss + EPS); o0 *= sc; o1 *= sc; }
        const int tok = tokb + i;
        if (tens == 0) *(unsigned*)(QN + ((size_t)bh * NTOK + tok) * HD + 2 * lane) = cvt_pk_bf16(o0, o1);
        if (tens == 1) *(unsigned*)(KN + ((size_t)bh * NTOK + tok) * HD + 2 * lane) = cvt_pk_bf16(o0, o1);
        if (tens >= 1) {
            if (i & 1) { tr0[(i >> 1) & 3] = cvt_pk_bf16(hold0, o0); tr1[(i >> 1) & 3] = cvt_pk_bf16(hold1, o1); } else { hold0 = o0; hold1 = o1; }
            if ((i & 7) == 7) { bf16_t* T = (tens == 1 ? KT : VT) + ((size_t)bh * HD + 2 * lane) * NTOK + tok - 7;
                *(u32x4*)T = (u32x4){tr0[0], tr0[1], tr0[2], tr0[3]}; *(u32x4*)(T + NTOK) = (u32x4){tr1[0], tr1[1], tr1[2], tr1[3]}; } }
    }
}
__device__ __forceinline__ void ab_task(int blk, const float* AB, const float* alog, const float* dtb, float* GG, float* BETA, int lane) {
    int b, prow0, tokb;
    if (blk < 128) { b = blk >> 5; const int t0 = (blk & 31) * 64; prow0 = b * SEQ + t0; tokb = CTXL + t0; }
    else { const int cb = blk - 128; b = cb >> 2; const int t0 = (cb & 3) * 64; prow0 = MX + b * CTXL + t0; tokb = t0; }
    const int kind = lane >> 4, h = lane & 15, d = kind & 1;
    const float A = __expf(alog[d * 16 + h]), db = dtb[d * 16 + h];
    float* dst = (kind < 2 ? GG : BETA) + ((size_t)d * NBH + b * NHD + h) * NTOK + tokb;
#pragma unroll 4
    for (int i = 0; i < 64; ++i) { const float v = AB[(size_t)(prow0 + i) * 64 + lane];
        dst[i] = kind < 2 ? -A * softplus_f(v + db) : sigmoid_f(v); }
}

template <int I> struct FS {
    static __device__ __forceinline__ void run(const LAS float* Ml, float (&Tc)[64], int lane) {
        float a = (lane == I) ? 1.f : 0.f;
#pragma unroll
        for (int jq = 0; jq < (I + 3) / 4; ++jq) { const f32x4 mv = *(const LAS f32x4*)(Ml + I * 68 + 4 * jq);
#pragma unroll
            for (int e = 0; e < 4; ++e) if (4 * jq + e < I) a = fmaf(-mv[e], Tc[4 * jq + e], a); }
        Tc[I] = a;
        __builtin_amdgcn_sched_barrier(0);
        if constexpr (I + 1 < 64) FS<I + 1>::run(Ml, Tc, lane);
    } };
__device__ __forceinline__ void chunk_task(int task, const bf16_t* QN, const bf16_t* KN, const float* GG, const float* BETA, float* GC, bf16_t* TU, bf16_t* AI, LAS float* tab, int lane) {
    const int tc = task % NCH, bh = (task / NCH) & 63, dir = task / (NCH * 64);
    const int tok0 = 64 * tc;
    LAS float* Ml = tab + 128;
    const int mytok = tok0 + (dir ? 63 - lane : lane);
    const size_t gidx = ((size_t)dir * NBH + bh) * NTOK + mytok;
    const float gl = GG[gidx], bl = BETA[gidx];
    float gc = gl;
#pragma unroll
    for (int o = 1; o < 64; o <<= 1) { const float t = __shfl_up(gc, o); if (lane >= o) gc += t; }
    GC[gidx] = gc;
    tab[lane] = gc; tab[64 + lane] = bl;
    LDS_WAIT(); asm volatile("" ::: "memory");
    const int r = lane & 31, hh = lane >> 5;
    bf16x8 ka[2][8];
#pragma unroll
    for (int ib = 0; ib < 2; ++ib) { const int tk = tok0 + (dir ? 63 - (32 * ib + r) : 32 * ib + r); const bf16x8* kp = (const bf16x8*)(KN + ((size_t)bh * NTOK + tk) * HD + 8 * hh);
#pragma unroll
        for (int s = 0; s < 8; ++s) ka[ib][s] = kp[2 * s]; }
    const bool isx = tc >= 4;
    bf16_t* aib = AI + (((size_t)dir * NBH + bh) * NCH + tc) * 4096;
    if (isx) {
#pragma unroll
        for (int ib = 0; ib < 2; ++ib) {
            bf16x8 qa[8]; { const int tk = tok0 + (dir ? 63 - (32 * ib + r) : 32 * ib + r); const bf16x8* qp = (const bf16x8*)(QN + ((size_t)bh * NTOK + tk) * HD + 8 * hh);
#pragma unroll
                for (int s = 0; s < 8; ++s) qa[s] = qp[2 * s]; }
#pragma unroll
            for (int jb = 0; jb < 2; ++jb) {
                f32x16 a = {};
                if (jb <= ib) {
#pragma unroll
                    for (int s = 0; s < 8; ++s) a = __builtin_amdgcn_mfma_f32_32x32x16_bf16(qa[s], ka[jb][s], a, 0, 0, 0); }
                const int jp = 32 * jb + r; const float gcj = tab[jp];
                bf16_t vv[16];
#pragma unroll
                for (int g = 0; g < 4; ++g) { const f32x4 gci = *(const LAS f32x4*)(tab + 32 * ib + 8 * g + 4 * hh);
#pragma unroll
                    for (int e = 0; e < 4; ++e) { const int ip = 32 * ib + 8 * g + 4 * hh + e;
                        vv[4 * g + e] = f2bf((jp <= ip) ? 0.08838834764831845f * a[4 * g + e] * __expf(gci[e] - gcj) : 0.f); } }
                if (dir == 0) { bf16_t* bp = aib + (32 * ib + 4 * hh) * 64 + jp;
#pragma unroll
                    for (int e = 0; e < 16; ++e) bp[((e & 3) + 8 * (e >> 2)) * 64] = vv[e]; }
                else { bf16_t* bp = aib + (63 - 32 * ib - 4 * hh) * 64 + (63 - jp);
#pragma unroll
                    for (int e = 0; e < 16; ++e) bp[-((e & 3) + 8 * (e >> 2)) * 64] = vv[e]; } } }
    }
    f32x16 Mt[3];
#pragma unroll
    for (int t = 0; t < 3; ++t) { const int ib = t > 0, jb = t > 1; f32x16 a = {};
#pragma unroll
        for (int s = 0; s < 8; ++s) a = __builtin_amdgcn_mfma_f32_32x32x16_bf16(ka[ib][s], ka[jb][s], a, 0, 0, 0);
        Mt[t] = a; }
    LAS float* Mlb = Ml + 4 * hh * 68 + r;
#pragma unroll
    for (int t = 0; t < 3; ++t) { const int ib = t > 0, jb = t > 1; const int jp = 32 * jb + r; const float gcj = tab[jp];
#pragma unroll
        for (int g = 0; g < 4; ++g) { const f32x4 gci = *(const LAS f32x4*)(tab + 32 * ib + 8 * g + 4 * hh), bi = *(const LAS f32x4*)(tab + 64 + 32 * ib + 8 * g + 4 * hh);
#pragma unroll
            for (int e = 0; e < 4; ++e) { const int ip = 32 * ib + 8 * g + 4 * hh + e;
                Mt[t][4 * g + e] = (jp < ip) ? bi[e] * Mt[t][4 * g + e] * __expf(gci[e] - gcj) : 0.f;
                Mlb[(32 * ib + 8 * g + e) * 68 + 32 * jb] = Mt[t][4 * g + e]; } } }
    LDS_WAIT(); asm volatile("" ::: "memory");
    float Tc[64];
    FS<0>::run(Ml, Tc, lane);
    bf16_t* tub = TU + (((size_t)dir * NBH + bh) * NCH + tc) * 4096;
    if (dir == 0) { bf16_t* bp = tub + lane;
#pragma unroll
        for (int i = 0; i < 64; ++i) bp[i * 64] = f2bf(Tc[i] * bl); }
    else { bf16_t* bp = tub + 63 * 64 + (63 - lane);
#pragma unroll
        for (int i = 0; i < 64; ++i) bp[-i * 64] = f2bf(Tc[i] * bl); }
    LDS_WAIT(); asm volatile("" ::: "memory");
}

constexpr int F_Q = 0, F_KT = 17408, F_VT = 35840, F_TU = 45056, F_A = 54272, F_W = 63488, F_ST = 80896, F_VN = 98304, F_VNG = 107520, F_TAB = 116736;
__device__ __forceinline__ f32x16 mma_tile(f32x16 acc, const LAS bf16_t* A, int lda, const LAS bf16_t* B, int ldb, int ksteps, int lane) {
    const LAS bf16_t* ap = A + (lane & 31) * lda + 8 * (lane >> 5); const LAS bf16_t* bp = B + (lane & 31) * ldb + 8 * (lane >> 5);
    for (int s = 0; s < ksteps; ++s) acc = __builtin_amdgcn_mfma_f32_32x32x16_bf16(*(const LAS bf16x8*)(ap + 16 * s), *(const LAS bf16x8*)(bp + 16 * s), acc, 0, 0, 0);
    return acc;
}
__device__ __forceinline__ void scan_chain(int chain, LAS unsigned char* lds, const bf16_t* KNdbg, const bf16_t* QN, const bf16_t* KT, const bf16_t* VT, const bf16_t* TU, const bf16_t* AI, const float* GC, bf16_t* OF, bf16_t* OB) {
    const int tid = threadIdx.x, wave = __builtin_amdgcn_readfirstlane(tid >> 6), lane = tid & 63;
    const int half = chain & 1, bh = (chain >> 1) & 63, dir = chain >> 7, b = bh >> 4, h = bh & 15;
    LAS bf16_t* Qs = (LAS bf16_t*)(lds + F_Q); LAS bf16_t* KTs = (LAS bf16_t*)(lds + F_KT); LAS bf16_t* VTs = (LAS bf16_t*)(lds + F_VT);
    LAS bf16_t* TUs = (LAS bf16_t*)(lds + F_TU); LAS bf16_t* As = (LAS bf16_t*)(lds + F_A); LAS bf16_t* Ws = (LAS bf16_t*)(lds + F_W);
    LAS bf16_t* STs = (LAS bf16_t*)(lds + F_ST); LAS bf16_t* VNs = (LAS bf16_t*)(lds + F_VN); LAS bf16_t* VNGs = (LAS bf16_t*)(lds + F_VNG);
    LAS float* tab = (LAS float*)(lds + F_TAB);
    for (int i = tid; i < 17408 / 4; i += 512) ((LAS unsigned*)STs)[i] = 0u;
    f32x16 Sacc = {};
    bf16_t* Od = ((ABLATE & 64) ? !dir : dir) ? OB : OF;
    const int c = lane & 31, hh = lane >> 5;
    __syncthreads();
    for (int step = 0; step < NCH; ++step) {
        const int tc = dir == 0 ? step : (step < 4 ? 3 - step : 39 - step);
        const int tok0 = 64 * tc; const bool isx = tc >= 4;
        if (isx) { for (int i = tid; i < 1024; i += 512) { const int t = i >> 4, ch = i & 15; *(LAS u32x4*)(Qs + t * 136 + ch * 8) = *(const u32x4*)(QN + ((size_t)bh * NTOK + tok0 + t) * HD + ch * 8); } }
        if (ABLATE & 256) { for (int i = tid; i < 8192; i += 512) { const int t = i >> 7, k = i & 127; KTs[k * 72 + t] = KNdbg[((size_t)bh * NTOK + tok0 + t) * HD + k]; } }
        else
        for (int i = tid; i < 1024; i += 512) { const int k = i >> 3, ch = i & 7; *(LAS u32x4*)(KTs + k * 72 + ch * 8) = *(const u32x4*)(KT + ((size_t)bh * HD + k) * NTOK + tok0 + ch * 8); }
        { const int d = tid >> 3, ch = tid & 7; *(LAS u32x4*)(VTs + d * 72 + ch * 8) = *(const u32x4*)(VT + ((size_t)bh * HD + 64 * half + d) * NTOK + tok0 + ch * 8);
          const size_t cb = (((size_t)dir * NBH + bh) * NCH + tc) * 4096;
          *(LAS u32x4*)(TUs + d * 72 + ch * 8) = *(const u32x4*)(TU + cb + d * 64 + ch * 8);
          if (isx) *(LAS u32x4*)(As + d * 72 + ch * 8) = *(const u32x4*)(AI + cb + d * 64 + ch * 8); }
        if (tid < 64) { const float* gp = GC + ((size_t)dir * NBH + bh) * NTOK + tok0; const float g = gp[tid], gl = gp[dir ? 0 : 63];
            tab[tid] = __expf(g); tab[64 + tid] = __expf(gl - g); if (tid == 0) tab[128] = __expf(gl); }
        __syncthreads();
        {
            const int kb = wave & 3, tb = wave >> 2;
            f32x16 a = {};
            const LAS bf16_t* ap = KTs + (32 * kb + c) * 72 + 8 * hh; const LAS bf16_t* bp = TUs + (32 * tb + c) * 72 + 8 * hh;
#pragma unroll
            for (int s = 0; s < 4; ++s) {
                const bf16x8 av = *(const LAS bf16x8*)(ap + 16 * s); const u32x4 bu = *(const LAS u32x4*)(bp + 16 * s);
                const f32x4 e0 = *(const LAS f32x4*)(tab + 16 * s + 8 * hh), e1 = *(const LAS f32x4*)(tab + 16 * s + 8 * hh + 4);
                u32x4 bs; bs.x = cvt_pk_bf16(bf_lo(bu.x) * e0[0], bf_hi(bu.x) * e0[1]); bs.y = cvt_pk_bf16(bf_lo(bu.y) * e0[2], bf_hi(bu.y) * e0[3]);
                bs.z = cvt_pk_bf16(bf_lo(bu.z) * e1[0], bf_hi(bu.z) * e1[1]); bs.w = cvt_pk_bf16(bf_lo(bu.w) * e1[2], bf_hi(bu.w) * e1[3]);
                a = __builtin_amdgcn_mfma_f32_32x32x16_bf16(av, __builtin_bit_cast(bf16x8, bs), a, 0, 0, 0); }
#pragma unroll
            for (int g = 0; g < 4; ++g) { u32x2 w; w.x = cvt_pk_bf16(-a[4 * g], -a[4 * g + 1]); w.y = cvt_pk_bf16(-a[4 * g + 2], -a[4 * g + 3]);
                *(LAS u32x2*)(Ws + (32 * tb + c) * 136 + 32 * kb + 8 * g + 4 * hh) = w; }
        }
        __syncthreads();
        f32x16 oacc = {};
        const int tb2 = (wave >> 1) & 1, db2 = wave & 1;
        if (wave < 4) {
            f32x16 a = {};
            a = mma_tile(a, TUs + 32 * tb2 * 72, 72, VTs + 32 * db2 * 72, 72, 4, lane);
            a = mma_tile(a, Ws + 32 * tb2 * 136, 136, STs + 32 * db2 * 136, 136, 8, lane);
#pragma unroll
            for (int g = 0; g < 4; ++g) { const f32x4 sc = *(const LAS f32x4*)(tab + 64 + 32 * tb2 + 8 * g + 4 * hh);
                u32x2 w, wg; w.x = cvt_pk_bf16(a[4 * g], a[4 * g + 1]); w.y = cvt_pk_bf16(a[4 * g + 2], a[4 * g + 3]);
                wg.x = cvt_pk_bf16(a[4 * g] * sc[0], a[4 * g + 1] * sc[1]); wg.y = cvt_pk_bf16(a[4 * g + 2] * sc[2], a[4 * g + 3] * sc[3]);
                *(LAS u32x2*)(VNs + (32 * db2 + c) * 72 + 32 * tb2 + 8 * g + 4 * hh) = w; *(LAS u32x2*)(VNGs + (32 * db2 + c) * 72 + 32 * tb2 + 8 * g + 4 * hh) = wg; }
        } else if (isx) {
            oacc = mma_tile(oacc, Qs + 32 * tb2 * 136, 136, STs + 32 * db2 * 136, 136, 8, lane);
#pragma unroll
            for (int g = 0; g < 4; ++g) { const f32x4 sc = *(const LAS f32x4*)(tab + 32 * tb2 + 8 * g + 4 * hh);
#pragma unroll
                for (int e = 0; e < 4; ++e) oacc[4 * g + e] *= 0.08838834764831845f * sc[e]; }
        }
        __syncthreads();
        {
            const int kb = wave & 3, db = wave >> 2; const float egl = tab[128];
#pragma unroll
            for (int e = 0; e < 16; ++e) Sacc[e] *= egl;
            Sacc = mma_tile(Sacc, KTs + 32 * kb * 72, 72, VNGs + 32 * db * 72, 72, 4, lane);
            if (wave >= 4 && isx) {
                oacc = mma_tile(oacc, As + 32 * tb2 * 72, 72, VNs + 32 * db2 * 72, 72, 4, lane);
                bf16_t* op = Od + ((size_t)b * SEQ + (tok0 - CTXL) + 32 * tb2) * DM + h * HD + 64 * half + 32 * db2 + c;
#pragma unroll
                for (int e = 0; e < 16; ++e) { const int t = (e & 3) + 8 * (e >> 2) + 4 * hh; op[(size_t)t * DM] = f2bf(oacc[e]); }
            }
            __syncthreads();
#pragma unroll
            for (int g = 0; g < 4; ++g) { u32x2 w; w.x = cvt_pk_bf16(Sacc[4 * g], Sacc[4 * g + 1]); w.y = cvt_pk_bf16(Sacc[4 * g + 2], Sacc[4 * g + 3]);
                *(LAS u32x2*)(STs + (32 * db + c) * 136 + 32 * kb + 8 * g + 4 * hh) = w; }
        }
        __syncthreads();
    }
}

#ifndef DBG_THR
#define DBG_THR 1000.f
#endif
__device__ __forceinline__ void finish_row(int row, const bf16_t* OF, const bf16_t* OB, const bf16_t* ZA, const float* hn, bf16_t* Y, int lane, unsigned* dbgh) {
    const f32x4 h0 = *(const f32x4*)(hn + 8 * (lane & 15)), h1 = *(const f32x4*)(hn + 8 * (lane & 15) + 4);
#pragma unroll
    for (int it = 0; it < 4; ++it) {
        const size_t off = (size_t)row * DM + it * 512 + lane * 8;
        const u32x4 a_ = *(const u32x4*)(OF + off), bq_ = *(const u32x4*)(OB + off), z = *(const u32x4*)(ZA + off);
        u32x4 a = a_, bq = bq_; if (ABLATE & 16) bq = (u32x4){0u, 0u, 0u, 0u}; if (ABLATE & 32) a = (u32x4){0u, 0u, 0u, 0u};
        float o[8] = {bf_lo(a.x) + bf_lo(bq.x), bf_hi(a.x) + bf_hi(bq.x), bf_lo(a.y) + bf_lo(bq.y), bf_hi(a.y) + bf_hi(bq.y), bf_lo(a.z) + bf_lo(bq.z), bf_hi(a.z) + bf_hi(bq.z), bf_lo(a.w) + bf_lo(bq.w), bf_hi(a.w) + bf_hi(bq.w)};
#if MK_DEBUG
        { float mb = 0.f, mf = 0.f; const float ofx[8] = {bf_lo(a.x), bf_hi(a.x), bf_lo(a.y), bf_hi(a.y), bf_lo(a.z), bf_hi(a.z), bf_lo(a.w), bf_hi(a.w)};
          const float obx[8] = {bf_lo(bq.x), bf_hi(bq.x), bf_lo(bq.y), bf_hi(bq.y), bf_lo(bq.z), bf_hi(bq.z), bf_lo(bq.w), bf_hi(bq.w)};
#pragma unroll
          for (int e = 0; e < 8; ++e) { mb = fmaxf(mb, fabsf(obx[e])); mf = fmaxf(mf, fabsf(ofx[e])); }
          const int bhq = (row / SEQ) * 16 + it * 4 + (lane >> 4);
          if (mb > DBG_THR) dbgh[bhq] = 1u; if (mf > DBG_THR) dbgh[64 + bhq] = 1u; }
#endif
        if (ABLATE & 128) { const float of_[8] = {bf_lo(a.x), bf_hi(a.x), bf_lo(a.y), bf_hi(a.y), bf_lo(a.z), bf_hi(a.z), bf_lo(a.w), bf_hi(a.w)};
            const float ob_[8] = {bf_lo(bq.x), bf_hi(bq.x), bf_lo(bq.y), bf_hi(bq.y), bf_lo(bq.z), bf_hi(bq.z), bf_lo(bq.w), bf_hi(bq.w)};
#pragma unroll
            for (int e = 0; e < 8; ++e) o[e] = of_[e] + ob_[e] * (1.f / 4096.f); }
        float ss = 0.f;
#pragma unroll
        for (int e = 0; e < 8; ++e) ss += o[e] * o[e];
        ss += __shfl_xor(ss, 1); ss += __shfl_xor(ss, 2); ss += __shfl_xor(ss, 4); ss += __shfl_xor(ss, 8);
        const float rs = rsqrtf(ss * (1.f / HD) + EPS);
        const float zf[8] = {bf_lo(z.x), bf_hi(z.x), bf_lo(z.y), bf_hi(z.y), bf_lo(z.z), bf_hi(z.z), bf_lo(z.w), bf_hi(z.w)};
        const float hv[8] = {h0[0], h0[1], h0[2], h0[3], h1[0], h1[1], h1[2], h1[3]};
        float y[8];
#pragma unroll
        for (int e = 0; e < 8; ++e) { y[e] = o[e] * rs * hv[e] * zf[e]; if (ABLATE & 1) y[e] = 0.f; }
        u32x4 w; w.x = cvt_pk_bf16(y[0], y[1]); w.y = cvt_pk_bf16(y[2], y[3]); w.z = cvt_pk_bf16(y[4], y[5]); w.w = cvt_pk_bf16(y[6], y[7]);
        *(u32x4*)(Y + (size_t)row * 4096 + it * 512 + lane * 8) = w;
    }
}

__device__ __forceinline__ void stats_row(int row, const bf16_t* P1, float* STATS, int lane) {
    const bf16_t* p = P1 + (size_t)row * N3 + 2048;
    float v[32]; float s = 0.f;
#pragma unroll
    for (int j = 0; j < 4; ++j) { const u32x4 a = *(const u32x4*)(p + j * 512 + lane * 8);
        v[8 * j] = bf_lo(a.x); v[8 * j + 1] = bf_hi(a.x); v[8 * j + 2] = bf_lo(a.y); v[8 * j + 3] = bf_hi(a.y); v[8 * j + 4] = bf_lo(a.z); v[8 * j + 5] = bf_hi(a.z); v[8 * j + 6] = bf_lo(a.w); v[8 * j + 7] = bf_hi(a.w); }
#pragma unroll
    for (int e = 0; e < 32; ++e) s += v[e];
    const float mu = wave_sum(s) * (1.f / DM); float q = 0.f;
#pragma unroll
    for (int e = 0; e < 32; ++e) { const float d = v[e] - mu; q += d * d; }
    const float rstd = rsqrtf(wave_sum(q) * (1.f / DM) + EPS);
    if (lane == 0) { STATS[2 * row] = mu; STATS[2 * row + 1] = rstd; }
}
template <int R> __device__ __forceinline__ void diff_task(const bf16_t* p, bf16_t* o) {
    unsigned v[64];
#pragma unroll
    for (int i = 0; i < 64; ++i) v[i] = *(const unsigned*)(p + (size_t)i * N3);
    float s0 = 0.f, s1 = 0.f;
#pragma unroll
    for (int i = 0; i < R; ++i) { s0 += bf_lo(v[i]); s1 += bf_hi(v[i]); }
#pragma unroll
    for (int i = 0; i < 64; ++i) {
        if (i + R < 64) { s0 += bf_lo(v[i + R]); s1 += bf_hi(v[i + R]); }
        if (i - R - 1 >= 0) { s0 -= bf_lo(v[i - R - 1 >= 0 ? i - R - 1 : 0]); s1 -= bf_hi(v[i - R - 1 >= 0 ? i - R - 1 : 0]); }
        const int hi = (i + R + 1 < 64) ? i + R + 1 : 64, lo = (i - R > 0) ? i - R : 0; const float inv = 1.0f / (float)(hi - lo);
        *(unsigned*)(o + (size_t)i * DM) = cvt_pk_bf16(s0 * inv - bf_lo(v[i]), s1 * inv - bf_hi(v[i]));
    }
}

constexpr int K_W = 0, K_V = 34816;
__device__ __forceinline__ void tmix_task(int task, LAS unsigned char* lds, const float* ws, const float* bs, const float* lnw, const float* lnb, const float* STATS, const bf16_t* P1, bf16_t* Y2) {
    const int tid = threadIdx.x, wave = __builtin_amdgcn_readfirstlane(tid >> 6), lane = tid & 63;
    const int g = task & 15, n = (task >> 4) & 15, b = task >> 8;
    const int row0 = b * SEQ + 128 * n;
    LAS bf16_t* Wsb = (LAS bf16_t*)(lds + K_W); LAS bf16_t* VnT = (LAS bf16_t*)(lds + K_V);
    for (int i = tid; i < 4096; i += 512) { const int p = i >> 5, q4 = (i & 31) * 4; const f32x4 w = *(const f32x4*)(ws + ((size_t)g * 128 + p) * 128 + q4);
        u32x2 o; o.x = cvt_pk_bf16(w.x, w.y); o.y = cvt_pk_bf16(w.z, w.w); *(LAS u32x2*)(Wsb + p * 136 + q4) = o; }
    for (int i = tid; i < 2048; i += 512) { const int q = i >> 4, c8 = (i & 15) * 8;
        const u32x4 a = *(const u32x4*)(P1 + (size_t)(row0 + q) * N3 + 2048 + 128 * g + c8);
        const float mu = STATS[2 * (row0 + q)], rstd = STATS[2 * (row0 + q) + 1];
        const f32x4 w0 = *(const f32x4*)(lnw + 128 * g + c8), w1 = *(const f32x4*)(lnw + 128 * g + c8 + 4), b0 = *(const f32x4*)(lnb + 128 * g + c8), b1 = *(const f32x4*)(lnb + 128 * g + c8 + 4);
        const float x[8] = {bf_lo(a.x), bf_hi(a.x), bf_lo(a.y), bf_hi(a.y), bf_lo(a.z), bf_hi(a.z), bf_lo(a.w), bf_hi(a.w)};
        const float wv[8] = {w0[0], w0[1], w0[2], w0[3], w1[0], w1[1], w1[2], w1[3]}, bv[8] = {b0[0], b0[1], b0[2], b0[3], b1[0], b1[1], b1[2], b1[3]};
#pragma unroll
        for (int e = 0; e < 8; ++e) VnT[(c8 + e) * 136 + q] = f2bf((x[e] - mu) * rstd * wv[e] + bv[e]); }
    __syncthreads();
    const int pb = wave >> 1, c = lane & 31, hh = lane >> 5;
#pragma unroll
    for (int t = 0; t < 2; ++t) { const int cb = 2 * (wave & 1) + t;
        f32x16 a = {};
        a = mma_tile(a, Wsb + 32 * pb * 136, 136, VnT + 32 * cb * 136, 136, 8, lane);
        const int ch = 128 * g + 32 * cb + c;
#pragma unroll
        for (int e = 0; e < 16; ++e) { const int p = 32 * pb + (e & 3) + 8 * (e >> 2) + 4 * hh; const size_t row = (size_t)(row0 + p);
            const float s = a[e] + bs[g * 128 + p];
            const float y = bf2f(P1[row * N3 + ch]) * s * bf2f(P1[row * N3 + 4096 + ch]);
            Y2[row * 4096 + ch] = f2bf((ABLATE & 4) ? 0.f : y); } }
    __syncthreads();
}

__device__ __forceinline__ void final_row(float* xrow, const float* fw, int lane) {
    f32x4* xr = (f32x4*)xrow + lane;
    f32x4 v[8]; float s = 0.f;
#pragma unroll
    for (int j = 0; j < 8; ++j) { v[j] = xr[64 * j]; s += (v[j].x * v[j].x + v[j].y * v[j].y) + (v[j].z * v[j].z + v[j].w * v[j].w); }
    const float rstd = rsqrtf(wave_sum(s) * (1.f / DM) + EPS);
#pragma unroll
    for (int j = 0; j < 8; ++j) xr[64 * j] = v[j] * rstd * ((const f32x4*)fw)[lane + 64 * j];
}

__global__ void __launch_bounds__(512, 2) fwd_kernel(Args args) {
    extern __shared__ __attribute__((aligned(16))) unsigned char lds_raw[];
    LAS unsigned char* lds = (LAS unsigned char*)lds_raw;
    const int tid = threadIdx.x, lane = tid & 63, wave = __builtin_amdgcn_readfirstlane(tid >> 6);
    const int G = gridDim.x, bid = blockIdx.x;
    const int gw = bid * 8 + wave, NGW = G * 8;
    unsigned char* ws = args.ws;
    volatile LAS unsigned* MISC = (volatile LAS unsigned*)(lds + MISC_OFF);
    if (tid < 16) MISC[tid] = 0u;
    __syncthreads();
    if (args.never) cg::this_grid().sync();
    XcdBarrier bar; bar.bar = (unsigned*)(ws + WS_CTL) + CW_BAR; bar.x = 0; bar.st = MISC;
    const int lo = args.ph_lo, hi = args.ph_hi;
    if (hi - lo > 1) bar = xcd_barrier_post((unsigned*)(ws + WS_CTL) + CW_BAR, MISC);
#ifndef PH_MASK
#define PH_MASK 0x3fff
#endif
#define IN(k) ((((PH_MASK) >> (k)) & 1) && lo <= (k) && (k) < hi)
#if MK_STAMP
    unsigned long long* STAMPS = (unsigned long long*)((unsigned*)(ws + WS_CTL) + 3000);
#define STAMP(k) do { if (bid == 0 && tid == 0) STAMPS[k] = __builtin_amdgcn_s_memrealtime(); } while (0)
#else
#define STAMP(k) do { } while (0)
#endif
#define SEAM(k) do { if (IN(k) && IN((k) + 1)) xcd_barrier(bar); STAMP((k) + 1); } while (0)
    STAMP(0);
    float* MOD = (float*)(ws + WS_MOD);
#if MK_DEBUG
    unsigned* DBG = (unsigned*)(ws + WS_CTL) + 2048; const int gt = bid * 512 + tid, ngt = G * 512;
#endif
    bf16_t* WT1 = (bf16_t*)(ws + WS_WT1); bf16_t* WT2 = (bf16_t*)(ws + WS_WT2); bf16_t* WT3 = (bf16_t*)(ws + WS_WT3); bf16_t* WT4 = (bf16_t*)(ws + WS_WT4); bf16_t* WTP = (bf16_t*)(ws + WS_WTP);
    bf16_t* H = (bf16_t*)(ws + WS_H);

    if (IN(0)) for (int rep_ = 0; rep_ < ((REPEAT_PH) == 0 ? (REPEAT_N) : 1); (++rep_, __syncthreads())) {
        if (bid < 192) { LAS float* tab = (LAS float*)lds; silu_table(args.in[I_C], args.in[I_CCTX], tab);
            for (int t = bid; t < 192; t += G) mod_task(args.in[I_ADAW], args.in[I_ADAB], MOD, 32 * t, tab, (LAS float*)(lds + 40960), wave, lane);
            __syncthreads(); }
        LAS float* scr = (LAS float*)(lds + wave * 16640);
        const SrcW1 s1; const SrcId sid;
        for (int it = gw; it < 8320 + 2048; it += NGW) {
            if (it < 8320) { const int cb = it >> 5, kb = it & 31; conv_item(args.in[I_EWIN], N1SRC, 2048, WT1, 64 * cb, 64 * kb, scr, lane, s1); }
            else { const int r = it - 8320, cb = r >> 6, kb = r & 63; conv_item(args.in[I_EWOUT], 2048, 4096, WT2, 64 * cb, 64 * kb, scr, lane, sid); }
        }
    }
    SEAM(0);
    if (IN(1)) for (int rep_ = 0; rep_ < ((REPEAT_PH) == 1 ? (REPEAT_N) : 1); (++rep_, __syncthreads())) {
#if MK_DEBUG
        dbg_f32(MOD, 5, 6144, 6144, DBG + 0, gt, ngt); dbg_bf16(WT1, 16640, 2048, 2048, DBG + 0, gt, ngt); dbg_bf16(WT2, 2048, 4096, 4096, DBG + 0, gt, ngt);
#endif
        for (int m = gw; m < MT; m += NGW) {
            const float* src = m < MX ? args.in[I_X] + (size_t)m * DM : args.in[I_CTX] + (size_t)(m - MX) * DM;
            const int r = m < MX ? m / SEQ : 4;
            hrow(src, args.in[I_NORMW], MOD + r * 6144, H + (size_t)m * DM, lane);
        }
    }
    SEAM(1);
    if (IN(2)) for (int rep_ = 0; rep_ < ((REPEAT_PH) == 2 ? (REPEAT_N) : 1); (++rep_, __syncthreads())) {
#if MK_DEBUG
        dbg_bf16(H, MT, 2048, 2048, DBG + 1, gt, ngt);
#endif
        Sched1 S{G, bid, (const char*)H, (const char*)WT1};
        Epi1 E{(bf16_t*)(ws + WS_PQKV), (bf16_t*)(ws + WS_ZA), (float*)(ws + WS_AB), (bf16_t*)(ws + WS_Y), args.in[I_ECONVB]};
        pg8::gemm_phase<Epi1, Sched1>(lds, 2048, 2048, 2048, S, E);
    }
    SEAM(2);
    if (IN(3)) for (int rep_ = 0; rep_ < ((REPEAT_PH) == 3 ? (REPEAT_N) : 1); (++rep_, __syncthreads())) {
#if MK_DEBUG
        dbg_bf16((const bf16_t*)(ws + WS_PQKV), MT, 6144, 6144, DBG + 2, gt, ngt); dbg_bf16((const bf16_t*)(ws + WS_ZA), MX, 2048, 2048, DBG + 2, gt, ngt);
        dbg_f32((const float*)(ws + WS_AB), MT, 64, 64, DBG + 2, gt, ngt); dbg_bf16((const bf16_t*)(ws + WS_Y) + 2048, MX, 2048, 4096, DBG + 2, gt, ngt);
#endif
        for (int t = gw; t < 6912 + 144; t += NGW) {
            if (t < 6912) qkv_task(t, (const bf16_t*)(ws + WS_PQKV), args.in[I_ECONVQKV], (bf16_t*)(ws + WS_QN), (bf16_t*)(ws + WS_KN), (bf16_t*)(ws + WS_KT), (bf16_t*)(ws + WS_VT), lane);
            else ab_task(t - 6912, (const float*)(ws + WS_AB), args.in[I_EALOG], args.in[I_EDTB], (float*)(ws + WS_GG), (float*)(ws + WS_BETA), lane);
        }
    }
    SEAM(3);
    if (IN(4)) for (int rep_ = 0; rep_ < ((REPEAT_PH) == 4 ? (REPEAT_N) : 1); (++rep_, __syncthreads())) {
#if MK_DEBUG
        dbg_bf16((const bf16_t*)(ws + WS_QN), 64 * NTOK, 128, 128, DBG + 3, gt, ngt); dbg_bf16((const bf16_t*)(ws + WS_KN), 64 * NTOK, 128, 128, DBG + 3, gt, ngt);
        dbg_bf16((const bf16_t*)(ws + WS_KT), 64 * 128, NTOK, NTOK, DBG + 3, gt, ngt); dbg_bf16((const bf16_t*)(ws + WS_VT), 64 * 128, NTOK, NTOK, DBG + 3, gt, ngt);
        dbg_f32((const float*)(ws + WS_GG), 128, NTOK, NTOK, DBG + 3, gt, ngt); dbg_f32((const float*)(ws + WS_BETA), 128, NTOK, NTOK, DBG + 3, gt, ngt);
#endif
        LAS float* tab = (LAS float*)(lds + wave * 17920);
        for (int t = gw; t < 2 * 64 * NCH; t += NGW)
            chunk_task(t, (const bf16_t*)(ws + WS_QN), (const bf16_t*)(ws + WS_KN), (const float*)(ws + WS_GG), (const float*)(ws + WS_BETA), (float*)(ws + WS_GC), (bf16_t*)(ws + WS_TU), (bf16_t*)(ws + WS_AI), tab, lane);
        __syncthreads();
        if (bid < 192) { LAS float* stab = (LAS float*)lds; silu_table(args.in[I_C], args.in[I_CCTX], stab);
            for (int t = bid; t < 192; t += G) mod_task(args.in[I_ADAW] + (size_t)2048 * 6144, args.in[I_ADAB] + 6144, MOD + 5 * 6144, 32 * t, stab, (LAS float*)(lds + 40960), wave, lane);
            __syncthreads(); }
        LAS float* scr = (LAS float*)(lds + wave * 16640);
        const SrcId sid;
        for (int it = gw; it < 5120 + 2048 + 256; it += NGW) {
            if (it < 5120) { const int cb = it >> 5, kb = it & 31; conv_item(args.in[I_OWIN], N3, 2048, WT3, 64 * cb, 64 * kb, scr, lane, sid); }
            else if (it < 7168) { const int r = it - 5120, cb = r >> 6, kb = r & 63; conv_item(args.in[I_OWOUT], 2048, 4096, WT4, 64 * cb, 64 * kb, scr, lane, sid); }
            else { const int r = it - 7168, gq = r >> 6, cb = (r >> 3) & 7, kb = r & 7; conv_item(args.in[I_OPW] + (size_t)gq * 512 * 512, 512, 512, WTP + (size_t)gq * 512 * 512, 64 * cb, 64 * kb, scr, lane, sid); }
        }
    }
    SEAM(4);
    if (IN(5)) for (int rep_ = 0; rep_ < ((REPEAT_PH) == 5 ? (REPEAT_N) : 1); (++rep_, __syncthreads())) {
#if MK_DEBUG
        dbg_bf16((const bf16_t*)(ws + WS_TU), 2 * 64 * NCH, 4096, 4096, DBG + 4, gt, ngt);
        if (gt == 100) {
            const int dirq = 1, bhq = 0, tcq = 20, tok0q = 64 * tcq; const bf16_t* KNq = (const bf16_t*)(ws + WS_KN) + ((size_t)bhq * NTOK + tok0q) * HD;
            const float* gq = (const float*)(ws + WS_GG) + ((size_t)dirq * NBH + bhq) * NTOK + tok0q; const float* bq = (const float*)(ws + WS_BETA) + ((size_t)dirq * NBH + bhq) * NTOK + tok0q;
            const bf16_t* tq = (const bf16_t*)(ws + WS_TU) + (((size_t)dirq * NBH + bhq) * NCH + tcq) * 4096;
            float worst = 0.f;
            for (int a = 0; a < 64; a += 7) for (int b2 = 0; b2 < 64; b2 += 5) {
                float r = 0.f;
                for (int m = 0; m < 64; ++m) {
                    float im = (a == m) ? 1.f : 0.f;
                    if (m > a) { float kk = 0.f; for (int e = 0; e < HD; ++e) kk += bf2f(KNq[a * HD + e]) * bf2f(KNq[m * HD + e]); float gd = 0.f; for (int t = a; t < m; ++t) gd += gq[t]; im = bq[a] * kk * __expf(gd); }
                    const float T = bf2f(tq[m * 64 + b2]) / bq[b2];
                    r += im * T; }
                worst = fmaxf(worst, fabsf(r - ((a == b2) ? 1.f : 0.f))); }
            DBG[980] = __float_as_uint(worst); }
        if (gt < 64) { const int bhq = gt & 63; const bf16_t* tq = (const bf16_t*)(ws + WS_TU) + (((size_t)1 * NBH + bhq) * NCH + 20) * 4096; float so = 0.f;
            for (int i = 0; i < 64; ++i) for (int j = 0; j < 64; ++j) { const float v = fabsf(bf2f(tq[i * 64 + j])); if (i != j) so += v; }
            DBG[910 + bhq] = __float_as_uint(so); }
        dbg_max_bf16((const bf16_t*)(ws + WS_TU), (size_t)128 * NCH * 4096, DBG + 900, gt, ngt);
        dbg_max_bf16((const bf16_t*)(ws + WS_KN), (size_t)64 * NTOK * 128, DBG + 901, gt, ngt);
        dbg_max_bf16((const bf16_t*)(ws + WS_KT), (size_t)64 * NTOK * 128, DBG + 902, gt, ngt);
        dbg_max_bf16((const bf16_t*)(ws + WS_VT), (size_t)64 * NTOK * 128, DBG + 903, gt, ngt);
        dbg_max_bf16((const bf16_t*)(ws + WS_QN), (size_t)64 * NTOK * 128, DBG + 904, gt, ngt);
        for (int q = 0; q < 128; ++q) dbg_bf16((const bf16_t*)(ws + WS_AI) + ((size_t)q * NCH + 4) * 4096, 32, 4096, 4096, DBG + 4, gt, ngt);
        dbg_f32((const float*)(ws + WS_GC), 128, NTOK, NTOK, DBG + 4, gt, ngt); dbg_f32(MOD + 5 * 6144, 4, 6144, 6144, DBG + 4, gt, ngt);
        dbg_bf16(WT3, 10240, 2048, 2048, DBG + 4, gt, ngt); dbg_bf16(WT4, 2048, 4096, 4096, DBG + 4, gt, ngt); dbg_bf16(WTP, 2048, 512, 512, DBG + 4, gt, ngt);
#endif
        for (int ch = bid; ch < 256; ch += G) { scan_chain(ch, lds, (const bf16_t*)(ws + WS_KN), (const bf16_t*)(ws + WS_QN), (const bf16_t*)(ws + WS_KT), (const bf16_t*)(ws + WS_VT), (const bf16_t*)(ws + WS_TU), (const bf16_t*)(ws + WS_AI), (const float*)(ws + WS_GC), (bf16_t*)(ws + WS_OF), (bf16_t*)(ws + WS_OB)); __syncthreads(); }
    }
    SEAM(5);
    if (IN(6)) for (int rep_ = 0; rep_ < ((REPEAT_PH) == 6 ? (REPEAT_N) : 1); (++rep_, __syncthreads())) {
#if MK_DEBUG
        dbg_bf16((const bf16_t*)(ws + WS_OF), MX, 2048, 2048, DBG + 5, gt, ngt); dbg_bf16((const bf16_t*)(ws + WS_OB), MX, 2048, 2048, DBG + 5, gt, ngt);
        dbg_max_bf16((const bf16_t*)(ws + WS_OF), (size_t)MX * 2048, DBG + 905, gt, ngt); dbg_max_bf16((const bf16_t*)(ws + WS_OB), (size_t)MX * 2048, DBG + 906, gt, ngt);
#endif
        for (int m = gw; m < MX; m += NGW) finish_row(m, (const bf16_t*)(ws + WS_OF), (const bf16_t*)(ws + WS_OB), (const bf16_t*)(ws + WS_ZA), args.in[I_EHN], (bf16_t*)(ws + WS_Y), lane, (unsigned*)(ws + WS_CTL) + 3072);
    }
    SEAM(6);
    if (IN(7)) for (int rep_ = 0; rep_ < ((REPEAT_PH) == 7 ? (REPEAT_N) : 1); (++rep_, __syncthreads())) {
#if MK_DEBUG
        dbg_bf16((const bf16_t*)(ws + WS_Y), MX, 2048, 4096, DBG + 6, gt, ngt);
#endif
        pg8::StaticOrder S{32, 8, G, bid, (const char*)(ws + WS_Y), (const char*)WT2, (size_t)256 * 4096 * 2, (size_t)256 * 4096 * 2};
        EpiResid E{args.in[I_X], args.out, MOD + 4096};
        pg8::gemm_phase<EpiResid, pg8::StaticOrder>(lds, 4096, 4096, 4096, S, E);
    }
    SEAM(7);
    if (IN(8)) for (int rep_ = 0; rep_ < ((REPEAT_PH) == 8 ? (REPEAT_N) : 1); (++rep_, __syncthreads())) {
#if MK_DEBUG
        dbg_f32(args.out, MX, 2048, 2048, DBG + 7, gt, ngt);
#endif
        for (int m = gw; m < MX; m += NGW) hrow(args.out + (size_t)m * DM, args.in[I_NORMW] + DM, MOD + 5 * 6144 + (m / SEQ) * 6144, H + (size_t)m * DM, lane);
    }
    SEAM(8);
    if (IN(9)) for (int rep_ = 0; rep_ < ((REPEAT_PH) == 9 ? (REPEAT_N) : 1); (++rep_, __syncthreads())) {
#if MK_DEBUG
        dbg_bf16(H, MX, 2048, 2048, DBG + 8, gt, ngt);
#endif
        pg8::StaticOrder S{32, 40, G, bid, (const char*)H, (const char*)WT3, (size_t)256 * 2048 * 2, (size_t)256 * 2048 * 2};
        Epi3 E{(bf16_t*)(ws + WS_P1)};
        pg8::gemm_phase<Epi3, pg8::StaticOrder>(lds, 2048, 2048, 2048, S, E);
    }
    SEAM(9);
    if (IN(10)) for (int rep_ = 0; rep_ < ((REPEAT_PH) == 10 ? (REPEAT_N) : 1); (++rep_, __syncthreads())) {
#if MK_DEBUG
        dbg_bf16((const bf16_t*)(ws + WS_P1), MX, N3, N3, DBG + 9, gt, ngt);
#endif
        for (int m = gw; m < MX; m += NGW) stats_row(m, (const bf16_t*)(ws + WS_P1), (float*)(ws + WS_STATS), lane);
        for (int t = gw; t < 128 * 16; t += NGW) { const int blk = t >> 4, cc = t & 15, grp = cc >> 2;
            const bf16_t* p = (const bf16_t*)(ws + WS_P1) + (size_t)(64 * blk) * N3 + 6144 + 128 * cc + 2 * lane; bf16_t* o = (bf16_t*)(ws + WS_DIFF) + (size_t)(64 * blk) * DM + 128 * cc + 2 * lane;
            if (grp == 0) diff_task<1>(p, o); else if (grp == 1) diff_task<2>(p, o); else if (grp == 2) diff_task<4>(p, o); else diff_task<8>(p, o); }
    }
    SEAM(10);
    if (IN(11)) for (int rep_ = 0; rep_ < ((REPEAT_PH) == 11 ? (REPEAT_N) : 1); (++rep_, __syncthreads())) {
#if MK_DEBUG
        dbg_f32((const float*)(ws + WS_STATS), 1, 2 * MX, 2 * MX, DBG + 10, gt, ngt); dbg_bf16((const bf16_t*)(ws + WS_DIFF), MX, 2048, 2048, DBG + 10, gt, ngt);
#endif
        SchedPool S{G, bid, (const char*)(ws + WS_DIFF), (const char*)WTP};
        EpiPool E{(const bf16_t*)(ws + WS_P1), (bf16_t*)(ws + WS_Y2), args.in[I_OPS]};
        pg8::gemm_phase<EpiPool, SchedPool>(lds, 512, 2048, 512, S, E);
        __syncthreads();
        for (int t = bid; t < 1024; t += G) tmix_task(t, lds, args.in[I_OWS], args.in[I_OBS], args.in[I_OLNW], args.in[I_OLNB], (const float*)(ws + WS_STATS), (const bf16_t*)(ws + WS_P1), (bf16_t*)(ws + WS_Y2));
    }
    SEAM(11);
    if (IN(12)) {
#if MK_DEBUG
        dbg_bf16((const bf16_t*)(ws + WS_Y2), MX, 4096, 4096, DBG + 11, gt, ngt);
#endif
        pg8::StaticOrder S{32, 8, G, bid, (const char*)(ws + WS_Y2), (const char*)WT4, (size_t)256 * 4096 * 2, (size_t)256 * 4096 * 2};
        EpiResid E{args.out, args.out, MOD + 5 * 6144 + 4096};
        pg8::gemm_phase<EpiResid, pg8::StaticOrder>(lds, 4096, 4096, 4096, S, E);
    }
    SEAM(12);
    if (IN(13)) {
#if MK_DEBUG
        dbg_f32(args.out, MX, 2048, 2048, DBG + 12, gt, ngt);
        for (size_t i = gt; i < (size_t)MX * DM; i += ngt) { const float v = args.out[i]; if (badf(v)) args.out[i] = 0.f; }
        asm volatile("s_waitcnt vmcnt(0)" ::: "memory"); __syncthreads();
#endif
        for (int m = gw; m < MX; m += NGW) final_row(args.out + (size_t)m * DM, args.in[I_FNW], lane);
#if MK_DEBUG
        asm volatile("s_waitcnt vmcnt(0)" ::: "memory"); __syncthreads();
        if (bid == 0 && tid == 0) { int first = -1; unsigned mask = 0; for (int k = 12; k >= 0; --k) if (__hip_atomic_load(DBG + k, __ATOMIC_RELAXED, __HIP_MEMORY_SCOPE_AGENT)) { first = k; mask |= 1u << k; }
            if (first >= 0) args.out[0] = 1000.f * (float)(first + 1);
            { int cb = 0, cf = 0; for (int q = 0; q < 64; ++q) { cb += (int)__hip_atomic_load(DBG + 1024 + q, __ATOMIC_RELAXED, __HIP_MEMORY_SCOPE_AGENT); cf += (int)__hip_atomic_load(DBG + 1024 + 64 + q, __ATOMIC_RELAXED, __HIP_MEMORY_SCOPE_AGENT); }
              args.out[0] = 1000.f * (float)(DBG_SEL ? cf : cb) + 500.f;
              if (DBG_SEL == 30 || DBG_SEL == 31) { const int dsel = DBG_SEL - 30; int fb = -1; for (int q = 0; q < 64; ++q) if (__hip_atomic_load(DBG + 1024 + (dsel ? 0 : 64) + q, __ATOMIC_RELAXED, __HIP_MEMORY_SCOPE_AGENT)) { fb = q; break; }
                  float mg = 0.f; if (fb >= 0) { const float* gq = (const float*)(ws + WS_GG) + ((size_t)dsel * NBH + fb) * NTOK; for (int i = 256; i < NTOK; ++i) mg += gq[i]; mg = -mg / 2048.f; }
                  args.out[0] = 1.0e4f * mg + 1000.f * 1000.f * (float)(fb & 15); }
              else if (DBG_SEL == 200) { args.out[0] = 1.0e5f * __uint_as_float(__hip_atomic_load(DBG + 980, __ATOMIC_RELAXED, __HIP_MEMORY_SCOPE_AGENT)) + 1000.f; }
              else if (DBG_SEL >= 60 && DBG_SEL < 124) { args.out[0] = 1.0e3f * __uint_as_float(__hip_atomic_load(DBG + 910 + (DBG_SEL - 60), __ATOMIC_RELAXED, __HIP_MEMORY_SCOPE_AGENT)); }
              else if (DBG_SEL >= 40 && DBG_SEL < 60) { const int bhq = DBG_SEL - 40; const bf16_t* tq = (const bf16_t*)(ws + WS_TU) + (((size_t)1 * NBH + bhq) * NCH + 20) * 4096; float so = 0.f, sd = 0.f;
                  for (int i = 0; i < 64; ++i) for (int j = 0; j < 64; ++j) { const float v = fabsf(bf2f(tq[i * 64 + j])); if (i == j) sd += v; else so += v; }
                  args.out[0] = 1.0e4f * so + 1.0e8f; }
              else if (DBG_SEL >= 10) args.out[0] = 1.0e2f * __uint_as_float(__hip_atomic_load(DBG + 900 + (DBG_SEL - 10), __ATOMIC_RELAXED, __HIP_MEMORY_SCOPE_AGENT)); } }
#endif
    }
#if MK_STAMP
    if (IN(13)) {
        asm volatile("s_waitcnt vmcnt(0)" ::: "memory"); __syncthreads();
        if (bid == 0) {
            const unsigned long long t14 = __builtin_amdgcn_s_memrealtime();
            const float tA = (float)((SEL_A == 13 ? t14 : STAMPS[SEL_A + 1]) - STAMPS[SEL_A]) * 0.01f, tB = (float)((SEL_B == 13 ? t14 : STAMPS[SEL_B + 1]) - STAMPS[SEL_B]) * 0.01f;
            __syncthreads();
            for (int i = 1 + tid; i <= 4194304; i += 512) args.out[i] = 10.f * tB;
            if (tid == 0) args.out[0] = 1000.f * tA;
        }
    }
#endif
#if STOP_AFTER < 13
    if (lo == 14) {
        const size_t NO = (size_t)MX * DM; const size_t gtid = (size_t)bid * 512 + tid, ngtid = (size_t)G * 512;
        for (size_t i = gtid; i < NO; i += ngtid) {
            float acc = 0.f;
#define DG_BF(off, n) do { const bf16_t* q_ = (const bf16_t*)(ws + (off)); for (size_t j = i; j < (size_t)(n); j += NO) acc += bf2f(q_[j]); } while (0)
#define DG_F32(off, n) do { const float* q_ = (const float*)(ws + (off)); for (size_t j = i; j < (size_t)(n); j += NO) acc += q_[j]; } while (0)
#if STOP_AFTER == 0
            DG_BF(WS_WT1, (size_t)16640 * 2048); DG_BF(WS_WT2, (size_t)2048 * 4096); DG_F32(WS_MOD, 5 * 6144);
#elif STOP_AFTER == 1
            DG_BF(WS_H, (size_t)MT * 2048);
#elif STOP_AFTER == 2
            DG_BF(WS_PQKV, (size_t)MT * 6144); DG_BF(WS_ZA, (size_t)MX * 2048); DG_F32(WS_AB, (size_t)MT * 64);
            { const bf16_t* q_ = (const bf16_t*)(ws + WS_Y); const size_t r = i / 2048, c = i % 2048; acc += bf2f(q_[r * 4096 + 2048 + c]); }
#elif STOP_AFTER == 3
            DG_BF(WS_QN, (size_t)64 * NTOK * 128); DG_BF(WS_KN, (size_t)64 * NTOK * 128); DG_BF(WS_KT, (size_t)64 * NTOK * 128); DG_BF(WS_VT, (size_t)64 * NTOK * 128);
            DG_F32(WS_GG, (size_t)128 * NTOK); DG_F32(WS_BETA, (size_t)128 * NTOK);
#elif STOP_AFTER == 4
            DG_BF(WS_TU, (size_t)128 * NCH * 4096); DG_F32(WS_GC, (size_t)128 * NTOK); DG_F32(WS_MOD, 10 * 6144);
            DG_BF(WS_WT3, (size_t)10240 * 2048); DG_BF(WS_WT4, (size_t)2048 * 4096); DG_BF(WS_WTP, (size_t)2048 * 512);
            { const bf16_t* q_ = (const bf16_t*)(ws + WS_AI); for (size_t j = i; j < (size_t)128 * NCH * 4096; j += NO) { const size_t tcq = (j / 4096) % NCH; if (tcq >= 4) acc += bf2f(q_[j]); } }
#elif STOP_AFTER == 5
            DG_BF(WS_OF, (size_t)MX * 2048); DG_BF(WS_OB, (size_t)MX * 2048);
#elif STOP_AFTER == 6
            DG_BF(WS_Y, (size_t)MX * 4096);
#elif STOP_AFTER == 7
            acc = args.out[i];
#elif STOP_AFTER == 8
            DG_BF(WS_H, (size_t)MX * 2048);
#elif STOP_AFTER == 9
            DG_BF(WS_P1, (size_t)MX * N3);
#elif STOP_AFTER == 10
            DG_BF(WS_DIFF, (size_t)MX * 2048); DG_F32(WS_STATS, (size_t)MX * 2);
#elif STOP_AFTER == 11
            DG_BF(WS_Y2, (size_t)MX * 4096);
#else
            acc = args.out[i];
#endif
            if (badf(acc)) acc = 12345.f;
            args.out[i] = acc;
        }
    }
#endif
#undef IN
#undef SEAM
}

extern "C" void kernel_launch(void* const* d_in, const int* in_sizes, int n_in, void* d_out, int out_size, void* d_ws, size_t ws_size, hipStream_t stream) {
    static int grid = 0;
    if (grid == 0) {
        if (n_in != 23 || out_size != MX * DM || ws_size < WS_END) { fprintf(stderr, "kernel_launch: unexpected shapes (n_in %d, out %d, ws %zu < %zu)\n", n_in, out_size, ws_size, (size_t)WS_END); grid = -1; return; }
        int dev = 0, cus = 0, per_cu = 0;
        if (hipGetDevice(&dev) != hipSuccess || hipDeviceGetAttribute(&cus, hipDeviceAttributeMultiprocessorCount, dev) != hipSuccess) { grid = -1; return; }
        if (hipFuncSetAttribute((const void*)fwd_kernel, hipFuncAttributeMaxDynamicSharedMemorySize, LDS_BYTES) != hipSuccess) { fprintf(stderr, "kernel_launch: hipFuncSetAttribute failed\n"); grid = -1; return; }
        if (hipOccupancyMaxActiveBlocksPerMultiprocessor(&per_cu, (const void*)fwd_kernel, 512, LDS_BYTES) != hipSuccess || per_cu < 1) { fprintf(stderr, "kernel_launch: occupancy query says %d\n", per_cu); }
        (void)hipGetLastError();
        grid = cus;
    }
    if (grid < 0) return;
    if (hipMemsetAsync((char*)d_ws + WS_CTL, 0, CTL_BYTES, stream) != hipSuccess) { fprintf(stderr, "kernel_launch: memset failed\n"); return; }
    Args a{};
    for (int i = 0; i < 23; ++i) a.in[i] = (const float*)d_in[i];
    a.out = (float*)d_out; a.ws = (unsigned char*)d_ws; a.never = 0; a.pad = 0;
    const int nl = (STOP_AFTER < 13) ? STOP_AFTER + 2 : MK_N_LAUNCHES;
    for (int li = 0; li < nl; ++li) {
        a.ph_lo = (nl == 1) ? 0 : li; a.ph_hi = (nl == 1) ? NPHASE : li + 1;
        if (STOP_AFTER < 13 && li == nl - 1) { a.ph_lo = 14; a.ph_hi = 15; }
        void* kargs[] = {&a};
        hipError_t e = hipLaunchCooperativeKernel((const void*)fwd_kernel, dim3(grid), dim3(512), kargs, LDS_BYTES, stream);
        if (e != hipSuccess) { fprintf(stderr, "kernel_launch: launch %d failed: %s\n", li, hipGetErrorString(e)); break; }
    }
}
```

```cpp
#include <hip/hip_runtime.h>
#include <hip/hip_cooperative_groups.h>
#include <cstdio>
#include <cstdint>
namespace cg = cooperative_groups;

#ifndef MK_N_LAUNCHES
#define MK_N_LAUNCHES 1
#endif
#ifndef DBG_SEL
#define DBG_SEL 200
#endif
#ifndef MK_STAMP
#define MK_STAMP 0
#endif
#ifndef SEL_A
#define SEL_A 0
#endif
#ifndef SEL_B
#define SEL_B 2
#endif
#ifndef REPEAT_PH
#define REPEAT_PH 99
#endif
#ifndef REPEAT_N
#define REPEAT_N 2
#endif
#ifndef ABLATE
#define ABLATE 0
#endif
#ifndef STOP_AFTER
#define STOP_AFTER 13
#endif

#define LAS __attribute__((address_space(3)))
typedef unsigned short bf16_t;
typedef short bf16x8 __attribute__((ext_vector_type(8)));
typedef float f32x2 __attribute__((ext_vector_type(2)));
typedef float f32x4 __attribute__((ext_vector_type(4)));
typedef float f32x16 __attribute__((ext_vector_type(16)));
typedef unsigned u32x2 __attribute__((ext_vector_type(2)));
typedef unsigned u32x4 __attribute__((ext_vector_type(4)));

constexpr int DM = 2048, NB = 4, SEQ = 2048, CTXL = 256, MX = NB * SEQ, MC = NB * CTXL, MT = MX + MC;
constexpr int NTOK = CTXL + SEQ;
constexpr int NHD = 16, HD = 128, NBH = NB * NHD;
constexpr int N1SRC = 16448, N1P = 16640, N3 = 10240;
constexpr int NCH = NTOK / 64;
constexpr float EPS = 1e-6f;
constexpr int NPHASE = 14;

constexpr size_t MiB = 1u << 20;
constexpr size_t WS_CTL = 0, CTL_BYTES = 1 * MiB;
constexpr size_t WS_MOD = 1 * MiB;
constexpr size_t WS_GG = 2 * MiB, WS_BETA = 4 * MiB, WS_GC = 6 * MiB;
constexpr size_t WS_STATS = 7 * MiB + 512 * 1024;
constexpr size_t WS_WT2 = 8 * MiB;
constexpr size_t WS_WT1 = 24 * MiB;
constexpr size_t WS_WT3 = 24 * MiB, WS_WT4 = 64 * MiB, WS_WTP = 80 * MiB;
constexpr size_t WS_H = 89 * MiB;
constexpr size_t WS_OB = 89 * MiB;
constexpr size_t WS_PQKV = 125 * MiB;
constexpr size_t WS_TU = 125 * MiB, WS_AI = 161 * MiB, WS_OF = 197 * MiB;
constexpr size_t WS_ZA = 233 * MiB;
constexpr size_t WS_AB = 265 * MiB;
constexpr size_t WS_Y = 268 * MiB;
constexpr size_t WS_QN = 332 * MiB, WS_KN = 368 * MiB, WS_KT = 404 * MiB, WS_VT = 440 * MiB;
constexpr size_t WS_P1 = 125 * MiB;
constexpr size_t WS_DIFF = 285 * MiB;
constexpr size_t WS_Y2 = 396 * MiB;
constexpr size_t WS_END = 476 * MiB;
constexpr int CW_BAR = 4096;

constexpr int LDS_BYTES = 147456;
constexpr int MISC_OFF = LDS_BYTES - 256;

__device__ __forceinline__ float bf_lo(unsigned w) { return __uint_as_float(w << 16); }
__device__ __forceinline__ float bf_hi(unsigned w) { return __uint_as_float(w & 0xffff0000u); }
__device__ __forceinline__ float bf2f(bf16_t b) { return __uint_as_float(((unsigned)b) << 16); }
typedef __bf16 bf16v2 __attribute__((ext_vector_type(2)));
__device__ __forceinline__ unsigned cvt_pk_bf16(float lo, float hi) { const f32x2 v = {lo, hi}; const bf16v2 r = __builtin_convertvector(v, bf16v2); return __builtin_bit_cast(unsigned, r); }
__device__ __forceinline__ bf16_t f2bf(float f) { return (bf16_t)(cvt_pk_bf16(f, 0.f) & 0xffffu); }
__device__ __forceinline__ float sigmoid_f(float x) { return __builtin_amdgcn_rcpf(1.0f + __expf(-x)); }
__device__ __forceinline__ float silu_f(float x) { return x * sigmoid_f(x); }
__device__ __forceinline__ float gelu_f(float x) { const float u = 0.7978845608028654f * (x + 0.044715f * x * x * x); return x * sigmoid_f(2.0f * u); }
__device__ __forceinline__ float softplus_f(float x) { return fmaxf(x, 0.f) + log1pf(__expf(-fabsf(x))); }
__device__ __forceinline__ float wave_sum(float v) {
#pragma unroll
    for (int o = 1; o < 64; o <<= 1) v += __shfl_xor(v, o);
    return v;
}
__device__ __forceinline__ float dpp_shr1(float x, float old) { return __builtin_bit_cast(float, __builtin_amdgcn_update_dpp(__builtin_bit_cast(int, old), __builtin_bit_cast(int, x), 0x111, 0xf, 0xf, false)); }
__device__ __forceinline__ float dpp_shl1(float x, float old) { return __builtin_bit_cast(float, __builtin_amdgcn_update_dpp(__builtin_bit_cast(int, old), __builtin_bit_cast(int, x), 0x101, 0xf, 0xf, false)); }
#ifndef MK_DEBUG
#define MK_DEBUG 0
#endif
#define LDS_WAIT() asm volatile("s_waitcnt lgkmcnt(0)" ::: "memory")

#define XB_TMO      128
#define XB_XCNT(j)  (256  + 64 * (j))
#define XB_XSUB(j)  (1280 + 64 * (j))
#define XB_XGEN(j)  (2304 + 64 * (j))
#define XB_TOP      3328
#define XB_TOPGEN   3392
#define XCD_BAR_WORDS 3456
#define XB_SPIN_CAP (1u << 20)
__device__ __forceinline__ unsigned xb_ld(unsigned* p)              { return __hip_atomic_load(p, __ATOMIC_RELAXED, __HIP_MEMORY_SCOPE_AGENT); }
__device__ __forceinline__ unsigned xb_add(unsigned* p, unsigned v) { return __hip_atomic_fetch_add(p, v, __ATOMIC_RELAXED, __HIP_MEMORY_SCOPE_AGENT); }
__device__ __forceinline__ unsigned xb_xcc_id() { return (unsigned)__builtin_amdgcn_s_getreg((3 << 11) | 20) & 0xFu; }
#define XB_SPIN(cond, bar) do { unsigned _sp = 0; while (cond) { __builtin_amdgcn_s_sleep(1); \
    if ((++_sp & 255u) == 0u) { if (xb_ld(&(bar)[XB_TMO])) break; if (_sp > XB_SPIN_CAP) { atomicAdd(&(bar)[XB_TMO], 1u); break; } } } } while (0)
struct XcdBarrier { unsigned* bar; unsigned x; volatile LAS unsigned* st; };
__device__ __forceinline__ XcdBarrier xcd_barrier_post(unsigned* bar, volatile LAS unsigned* st) {
    XcdBarrier b; b.bar = bar; b.x = xb_xcc_id(); b.st = st;
    if (threadIdx.x == 0) (void)xb_add(&bar[XB_XCNT(b.x)], 1u);
    return b;
}
__device__ __forceinline__ void xcd_barrier_complete(unsigned* bar, unsigned x, unsigned& nloc, unsigned& nx) {
    const unsigned G = gridDim.x * gridDim.y * gridDim.z;
    unsigned sum, cnt, mine, sp = 0u;
    for (;;) {
        sum = 0u; cnt = 0u; mine = 0u;
#pragma unroll
        for (unsigned j = 0; j < 16; ++j) { const unsigned c = xb_ld(&bar[XB_XCNT(j)]); sum += c; cnt += (c > 0u) ? 1u : 0u; mine = (j == x) ? c : mine; }
        if (sum == G) break;
        __builtin_amdgcn_s_sleep(1);
        if ((++sp & 255u) == 0u) { if (xb_ld(&bar[XB_TMO])) break; if (sp > XB_SPIN_CAP) { atomicAdd(&bar[XB_TMO], 1u); break; } }
    }
    nloc = mine > 0u ? mine : 1u; nx = cnt > 0u ? cnt : 1u;
}
__device__ __forceinline__ void xcd_barrier(const XcdBarrier& b) {
    asm volatile("s_waitcnt vmcnt(0)" ::: "memory");
    __syncthreads();
    if (threadIdx.x == 0) {
        unsigned* bar = b.bar;
        __builtin_amdgcn_s_waitcnt(0);
        unsigned nloc = b.st[0], nx = b.st[1];
        if (nloc == 0u) { xcd_barrier_complete(bar, b.x, nloc, nx); b.st[0] = nloc; b.st[1] = nx; }
        const unsigned old = xb_add(&bar[XB_XSUB(b.x)], 1u);
        const unsigned gen = old / nloc;
        if (old + 1u == (gen + 1u) * nloc) {
            __builtin_amdgcn_fence(__ATOMIC_RELEASE, "agent");
            asm volatile("s_waitcnt vmcnt(0)" ::: "memory");
            const unsigned og = xb_add(&bar[XB_TOP], 1u);
            const unsigned tg = og / nx;
            if (og + 1u == (tg + 1u) * nx) xb_add(&bar[XB_TOPGEN], 1u);
            else XB_SPIN(xb_ld(&bar[XB_TOPGEN]) == tg, bar);
            __builtin_amdgcn_fence(__ATOMIC_ACQUIRE, "agent");
            xb_add(&bar[XB_XGEN(b.x)], 1u);
            asm volatile("s_waitcnt vmcnt(0)" ::: "memory");
        } else {
            XB_SPIN(xb_ld(&bar[XB_XGEN(b.x)]) == gen, bar);
            __builtin_amdgcn_fence(__ATOMIC_ACQUIRE, "agent");
            asm volatile("s_waitcnt vmcnt(0)" ::: "memory");
        }
    }
    __syncthreads();
}

namespace pg8 {
constexpr int BM = 256, BK = 64, HALF = 128, HTB = HALF * BK * 2, STAGE_BYTES = 8 * HTB, NXCD = 8, WGM = 8;
__host__ __device__ __forceinline__ int lds_byte(int r, int c) { const int st = (r >> 4) * 2 + (c >> 5), rr = r & 15, cc = c & 31, ob = rr * 64 + cc * 2; return st * 1024 + (ob ^ (((ob >> 9) & 1) << 5)); }
__host__ __device__ __forceinline__ void stage_rc(int b, int& R, int& C) { const int st = b / 1024, sb = b % 1024, swz = sb ^ (((sb >> 9) & 1) << 5); R = (st >> 1) * 16 + swz / 64; C = (st & 1) * 32 + (swz % 64) / 2; }
__host__ __device__ __forceinline__ int perm32(int rho) { const int n = rho >> 4, i = rho & 15; return 8 * (i >> 2) + 4 * n + (i & 3); }
struct Unit { int pm, pn, aux; const char* a; const char* b; };
__device__ __forceinline__ void tile_order(int L, int nM, int nN, int& pm, int& pn) {
    const int nwg = nM * nN; int wgid = L;
    { const int q = nwg / NXCD, r = nwg % NXCD, xcd = wgid % NXCD, off = wgid / NXCD; wgid = (xcd < r ? xcd * (q + 1) : r * (q + 1) + (xcd - r) * q) + off; }
    const int nig = WGM * nN, gid = wgid / nig, fm = gid * WGM, gsz = (nM - fm) < WGM ? (nM - fm) : WGM;
    pm = fm + ((wgid % nig) % gsz); pn = (wgid % nig) / gsz;
}
struct StaticOrder {
    int nM, nN, G, c; const char* A; const char* B; size_t ta, tb;
    __device__ __forceinline__ bool next(int i, Unit& u) const {
        const long L = (long)i * G + c; if (L >= (long)nM * nN) return false;
        tile_order((int)L, nM, nN, u.pm, u.pn); u.aux = 0; u.a = A + (size_t)u.pm * ta; u.b = B + (size_t)u.pn * tb; return true;
    }
};
#define PG8_LAS __attribute__((address_space(3)))
template <class Epi, class Sched>
__device__ __forceinline__ void gemm_phase(PG8_LAS unsigned char* lds, const int K, const int lda, const int ldb, const Sched& S, const Epi& E) {
    const int tid = threadIdx.x, wid = __builtin_amdgcn_readfirstlane(tid >> 6), lane = tid & 63, wr = wid >> 2, wc = wid & 3, fr = lane & 15, fq = lane >> 4;
    const int nt = K / BK;
    unsigned voffA[2], voffB[2];
#pragma unroll
    for (int i = 0; i < 2; ++i) { int R, C; stage_rc(tid * 16 + i * 8192, R, C); const int Rb = Epi::PERM ? ((R & ~31) + perm32(R & 31)) : R;
        voffA[i] = (unsigned)(R * lda + C) * 2u; voffB[i] = (unsigned)(Rb * ldb + C) * 2u; }
    const size_t kstep = (size_t)(BK * 2);
    const size_t hstepA = (size_t)HALF * lda * 2, hstepB = (size_t)HALF * ldb * 2;
    const unsigned ldsw = (unsigned)wid * 1024u;
    const int aoff = lds_byte(wr * 64 + fr, fq * 8), boff = lds_byte(wc * 32 + fr, fq * 8);
#define PG8_SA(b, h) (((b) * 2 + (h)) * HTB)
#define PG8_SB(b, h) ((4 + (b) * 2 + (h)) * HTB)
#define PG8_STAGE(bufoff, gbase, voff) do { _Pragma("unroll") for (int _i = 0; _i < 2; ++_i) \
        __builtin_amdgcn_global_load_lds((const unsigned*)((const char*)(gbase) + (voff)[_i]), (PG8_LAS unsigned*)(lds + (bufoff) + ldsw + _i * 8192), 16, 0, 0); } while (0)
#define PG8_LDA(dst, b, h) do { _Pragma("unroll") for (int m = 0; m < 4; ++m) _Pragma("unroll") for (int k = 0; k < 2; ++k) dst[m][k] = *(const PG8_LAS bf16x8*)(lds + PG8_SA(b, h) + aoff + m * 2048 + k * 1024); } while (0)
#define PG8_LDB(dst, b, h) do { _Pragma("unroll") for (int n = 0; n < 2; ++n) _Pragma("unroll") for (int k = 0; k < 2; ++k) dst[n][k] = *(const PG8_LAS bf16x8*)(lds + PG8_SB(b, h) + boff + n * 2048 + k * 1024); } while (0)
#define PG8_MMA(ai, bj, At, Bt) do { __builtin_amdgcn_s_setprio(1); _Pragma("unroll") for (int m = 0; m < 4; ++m) _Pragma("unroll") for (int n = 0; n < 2; ++n) _Pragma("unroll") for (int k = 0; k < 2; ++k) \
        acc[ai][bj][m][n] = __builtin_amdgcn_mfma_f32_16x16x32_bf16(Bt[n][k], At[m][k], acc[ai][bj][m][n], 0, 0, 0); __builtin_amdgcn_s_setprio(0); } while (0)
#define PG8_WAIT_V(n) asm volatile("s_waitcnt vmcnt(" #n ")" ::: "memory")
#define PG8_WAIT_L(n) asm volatile("s_waitcnt lgkmcnt(" #n ")" ::: "memory")
#define PG8_BAR __builtin_amdgcn_s_barrier()
#define PG8_SCHED __builtin_amdgcn_sched_barrier(0)
    Unit cur, nxt; int ui = 0;
    if (!S.next(0, cur)) return;
    f32x4 acc[2][2][4][2];
#pragma unroll
    for (int a = 0; a < 2; ++a)
#pragma unroll
        for (int b = 0; b < 2; ++b)
#pragma unroll
            for (int m = 0; m < 4; ++m)
#pragma unroll
                for (int n = 0; n < 2; ++n) acc[a][b][m][n] = (f32x4){0.f, 0.f, 0.f, 0.f};
    bf16x8 At[4][2], B0[2][2], B1[2][2];
    const char* cA = cur.a; const char* cB = cur.b;
    PG8_STAGE(PG8_SB(0, 0), cB, voffB); PG8_STAGE(PG8_SB(0, 1), cB + hstepB, voffB); PG8_STAGE(PG8_SA(0, 0), cA, voffA); PG8_STAGE(PG8_SA(0, 1), cA + hstepA, voffA);
    if (wr == 1) PG8_BAR;
    PG8_WAIT_V(2); PG8_BAR;
    PG8_STAGE(PG8_SB(1, 0), cB + kstep, voffB); PG8_STAGE(PG8_SA(1, 0), cA + kstep, voffA); PG8_STAGE(PG8_SB(1, 1), cB + hstepB + kstep, voffB);
    PG8_WAIT_V(6); PG8_BAR;
    for (;;) {
        const bool has_next = S.next(ui + 1, nxt);
        const char* nA = has_next ? nxt.a : cA; const char* nB = has_next ? nxt.b : cB;
        for (int t = 0; t < nt; t += 2) {
            const bool last = (t == nt - 2);
            const char* a1 = cA + (size_t)(t + 1) * kstep;
            const char* a2 = last ? nA : cA + (size_t)(t + 2) * kstep; const char* b2 = last ? nB : cB + (size_t)(t + 2) * kstep;
            const char* a3 = a2 + kstep; const char* b3 = b2 + kstep;
            PG8_LDB(B0, 0, 0); PG8_LDB(B1, 0, 1); PG8_SCHED; PG8_LDA(At, 0, 0); PG8_STAGE(PG8_SA(1, 1), a1 + hstepA, voffA);
            PG8_WAIT_V(8); PG8_WAIT_L(0); PG8_BAR; PG8_MMA(0, 0, At, B0); PG8_MMA(0, 1, At, B1); PG8_BAR; PG8_SCHED;
            PG8_LDA(At, 0, 1); PG8_STAGE(PG8_SB(0, 0), b2, voffB); PG8_STAGE(PG8_SB(0, 1), b2 + hstepB, voffB); PG8_STAGE(PG8_SA(0, 0), a2, voffA);
            PG8_WAIT_V(8); PG8_WAIT_L(0); PG8_BAR; PG8_MMA(1, 0, At, B0); PG8_MMA(1, 1, At, B1); PG8_BAR; PG8_SCHED;
            PG8_LDB(B0, 1, 0); PG8_LDB(B1, 1, 1); PG8_SCHED; PG8_LDA(At, 1, 0); PG8_STAGE(PG8_SA(0, 1), a2 + hstepA, voffA);
            PG8_WAIT_V(8); PG8_WAIT_L(0); PG8_BAR; PG8_MMA(0, 0, At, B0); PG8_MMA(0, 1, At, B1); PG8_BAR; PG8_SCHED;
            PG8_LDA(At, 1, 1); PG8_STAGE(PG8_SB(1, 0), b3, voffB); PG8_STAGE(PG8_SB(1, 1), b3 + hstepB, voffB); PG8_STAGE(PG8_SA(1, 0), a3, voffA);
            PG8_WAIT_V(8); PG8_WAIT_L(0); PG8_BAR; PG8_MMA(1, 0, At, B0); PG8_MMA(1, 1, At, B1); PG8_BAR; PG8_SCHED;
        }
        if (wr == 0) PG8_BAR;
        E(acc, cur, wr, wc, fr, fq);
        if (!has_next) break;
#pragma unroll
        for (int a = 0; a < 2; ++a)
#pragma unroll
            for (int b = 0; b < 2; ++b)
#pragma unroll
                for (int m = 0; m < 4; ++m)
#pragma unroll
                    for (int n = 0; n < 2; ++n) acc[a][b][m][n] = (f32x4){0.f, 0.f, 0.f, 0.f};
        cur = nxt; cA = nA; cB = nB; ++ui;
        if (wr == 1) PG8_BAR;
    }
    PG8_WAIT_V(0);
    PG8_BAR;
#undef PG8_SA
#undef PG8_SB
#undef PG8_STAGE
#undef PG8_LDA
#undef PG8_LDB
#undef PG8_MMA
#undef PG8_WAIT_V
#undef PG8_WAIT_L
#undef PG8_BAR
#undef PG8_SCHED
}
}

#if MK_DEBUG
__device__ __forceinline__ bool badf(float v) { return !(fabsf(v) < 1e30f); }
__device__ __forceinline__ void dbg_bf16(const bf16_t* p, int rows, int cols, size_t ld, unsigned* flag, int gt, int ngt) {
    const int cpr = cols / 8; bool bad = false;
    for (size_t i = gt; i < (size_t)rows * cpr; i += ngt) { const size_t r = i / cpr, c = (i % cpr) * 8; const u32x4 a = *(const u32x4*)(p + r * ld + c);
        bad |= badf(bf_lo(a.x)) | badf(bf_hi(a.x)) | badf(bf_lo(a.y)) | badf(bf_hi(a.y)) | badf(bf_lo(a.z)) | badf(bf_hi(a.z)) | badf(bf_lo(a.w)) | badf(bf_hi(a.w)); }
    if (bad) *flag = 1u;
}
__device__ __forceinline__ void dbg_max_bf16(const bf16_t* p, size_t n, unsigned* slot, int gt, int ngt) {
    float m = 0.f;
    for (size_t i = (size_t)gt * 8; i < n; i += (size_t)ngt * 8) { const u32x4 a = *(const u32x4*)(p + i);
        m = fmaxf(m, fmaxf(fmaxf(fmaxf(fabsf(bf_lo(a.x)), fabsf(bf_hi(a.x))), fmaxf(fabsf(bf_lo(a.y)), fabsf(bf_hi(a.y)))), fmaxf(fmaxf(fabsf(bf_lo(a.z)), fabsf(bf_hi(a.z))), fmaxf(fabsf(bf_lo(a.w)), fabsf(bf_hi(a.w)))))); }
    atomicMax(slot, __float_as_uint(m));
}
__device__ __forceinline__ void dbg_f32(const float* p, int rows, int cols, size_t ld, unsigned* flag, int gt, int ngt) {
    const int cpr = cols / 4; bool bad = false;
    for (size_t i = gt; i < (size_t)rows * cpr; i += ngt) { const size_t r = i / cpr, c = (i % cpr) * 4; const f32x4 a = *(const f32x4*)(p + r * ld + c);
        bad |= badf(a.x) | badf(a.y) | badf(a.z) | badf(a.w); }
    if (bad) *flag = 1u;
}
#endif
struct Args { const float* in[23]; float* out; unsigned char* ws; int ph_lo, ph_hi, never, pad; };
enum { I_X = 0, I_C, I_CTX, I_CCTX, I_ADAW, I_ADAB, I_NORMW, I_EWIN, I_ECONVQKV, I_EALOG, I_EDTB, I_EHN, I_ECONVB, I_EWOUT, I_OWIN, I_OLNW, I_OLNB, I_OWS, I_OBS, I_OPW, I_OPS, I_OWOUT, I_FNW };

template <class SrcFn>
__device__ __forceinline__ void conv_item(const float* W, int ldw, int K, bf16_t* WT, int c0, int k0, LAS float* scr, int lane, const SrcFn& src) {
    const int sc = src(c0 + lane);
    const float* wp = W + (size_t)k0 * ldw + (sc >= 0 ? sc : 0);
    float v[64];
#pragma unroll
    for (int i = 0; i < 64; ++i) v[i] = wp[(size_t)i * ldw];
#pragma unroll
    for (int i = 0; i < 64; ++i) scr[i * 65 + lane] = sc >= 0 ? v[i] : 0.f;
    LDS_WAIT(); asm volatile("" ::: "memory");
    const int kc = lane >> 3, cc = lane & 7;
#pragma unroll
    for (int j = 0; j < 8; ++j) { const int c = cc + 8 * j; const LAS float* sp = scr + (8 * kc) * 65 + c;
        u32x4 o; o.x = cvt_pk_bf16(sp[0 * 65], sp[1 * 65]); o.y = cvt_pk_bf16(sp[2 * 65], sp[3 * 65]); o.z = cvt_pk_bf16(sp[4 * 65], sp[5 * 65]); o.w = cvt_pk_bf16(sp[6 * 65], sp[7 * 65]);
        *(u32x4*)(WT + (size_t)(c0 + c) * K + k0 + 8 * kc) = o; }
    LDS_WAIT(); asm volatile("" ::: "memory");
}
struct SrcId { __device__ __forceinline__ int operator()(int c) const { return c; } };
struct SrcW1 { __device__ __forceinline__ int operator()(int c) const {
    if (c < 8192) return c;
    if (c < 16384) { const int cc = c - 8192, T = cc >> 8, cp = cc & 255, bj = cp >> 7, wc = (cp >> 5) & 3, fq = (cp >> 3) & 3, n = (cp >> 2) & 1, j = cp & 3;
        return 8256 + 2048 * (2 * bj + n) + 64 * T + 16 * wc + 4 * fq + j; }
    const int cp = c - 16384; return cp < 64 ? 8192 + cp : -1; } };

__device__ __forceinline__ void mod_task(const float* adaw, const float* adab, float* modl, int n0, const LAS float* tab, LAS float* red, int wave, int lane) {
    const int col = n0 + (lane & 31), kp = lane >> 5;
    float acc[5] = {0.f, 0.f, 0.f, 0.f, 0.f};
    const float* wp = adaw + (size_t)(256 * wave + kp) * 6144 + col;
#pragma unroll 32
    for (int kk = 0; kk < 128; ++kk) { const float wv = wp[(size_t)kk * 2 * 6144]; const int k = 256 * wave + 2 * kk + kp;
#pragma unroll
        for (int r = 0; r < 5; ++r) acc[r] += tab[r * 2048 + k] * wv; }
#pragma unroll
    for (int r = 0; r < 5; ++r) { acc[r] += __shfl_xor(acc[r], 32); if (lane < 32) red[(wave * 5 + r) * 32 + lane] = acc[r]; }
    __syncthreads();
    if (threadIdx.x < 160) { const int r = threadIdx.x >> 5, c = threadIdx.x & 31; float s = adab[n0 + c];
#pragma unroll
        for (int w = 0; w < 8; ++w) s += red[(w * 5 + r) * 32 + c];
        modl[r * 6144 + n0 + c] = s; }
    __syncthreads();
}
__device__ __forceinline__ void silu_table(const float* c, const float* cctx, LAS float* tab) {
    for (int i = threadIdx.x; i < 5 * 2048; i += 512) { const float v = i < 8192 ? c[i] : cctx[i - 8192]; tab[i] = silu_f(v); }
    __syncthreads();
}

__device__ __forceinline__ void hrow(const float* xrow, const float* nw, const float* modr, bf16_t* orow, int lane) {
    const f32x4* xr = (const f32x4*)xrow + lane;
    f32x4 v[8]; float s = 0.f;
#pragma unroll
    for (int j = 0; j < 8; ++j) { v[j] = xr[64 * j]; s += (v[j].x * v[j].x + v[j].y * v[j].y) + (v[j].z * v[j].z + v[j].w * v[j].w); }
    const float rstd = rsqrtf(wave_sum(s) * (1.f / DM) + EPS);
    u32x2* o8 = (u32x2*)orow + lane;
#pragma unroll
    for (int j = 0; j < 8; ++j) { const f32x4 w = ((const f32x4*)nw)[lane + 64 * j], sh = ((const f32x4*)modr)[lane + 64 * j], sc = ((const f32x4*)(modr + 2048))[lane + 64 * j];
        const f32x4 y = v[j] * rstd * w * (sc + 1.0f) + sh; u32x2 p; p.x = cvt_pk_bf16(y.x, y.y); p.y = cvt_pk_bf16(y.z, y.w); o8[64 * j] = p; }
}

typedef f32x4 AccT[2][2][4][2];
struct Sched1 { int G, c; const char* A; const char* B;
    __device__ __forceinline__ bool next(int i, pg8::Unit& u) const {
        const int L = i * G + c; if (L >= 2180) return false;
        if (L < 2080) pg8::tile_order(L, 32, 65, u.pm, u.pn);
        else { const int l = L - 2080; u.pm = 32 + (l & 3); const int t = l >> 2; u.pn = t < 24 ? t : 64; }
        u.aux = 0; u.a = A + (size_t)u.pm * (256 * 2048 * 2); u.b = B + (size_t)u.pn * (256 * 2048 * 2); return true; } };
struct Epi1 { static constexpr bool PERM = true;
    bf16_t* PQKV; bf16_t* ZA; float* AB; bf16_t* Y; const float* convb;
    __device__ __forceinline__ void operator()(const AccT& acc, const pg8::Unit& u, int wr, int wc, int fr, int fq) const {
        const int row0 = u.pm * 256 + wr * 64 + fr;
        if (u.pn < 32) {
            const bool act = u.pn >= 24;
            bf16_t* base = act ? ZA : PQKV; const int ldc = act ? 2048 : 6144; const int col0 = (act ? (u.pn - 24) : u.pn) * 256 + wc * 32 + 8 * fq;
#pragma unroll
            for (int ai = 0; ai < 2; ++ai)
#pragma unroll
                for (int m = 0; m < 4; ++m) { bf16_t* rowp = base + (size_t)(row0 + ai * 128 + m * 16) * ldc + col0;
#pragma unroll
                    for (int bj = 0; bj < 2; ++bj) { f32x4 v0 = acc[ai][bj][m][0], v1 = acc[ai][bj][m][1];
                        if (act) {
#pragma unroll
                            for (int j = 0; j < 4; ++j) { v0[j] = silu_f(v0[j]); v1[j] = silu_f(v1[j]); } }
                        u32x4 w; w.x = cvt_pk_bf16(v0[0], v0[1]); w.y = cvt_pk_bf16(v0[2], v0[3]); w.z = cvt_pk_bf16(v1[0], v1[1]); w.w = cvt_pk_bf16(v1[2], v1[3]);
                        *(u32x4*)(rowp + bj * 128) = w; } }
        } else if (u.pn < 64) {
            const int lane = threadIdx.x & 63;
            const int ch0 = 64 * (u.pn - 32) + 16 * wc + 4 * fq;
            const f32x4 cw0 = *(const f32x4*)(convb + ch0), cw1 = *(const f32x4*)(convb + 2048 + ch0), cw2 = *(const f32x4*)(convb + 4096 + ch0);
#pragma unroll
            for (int ai = 0; ai < 2; ++ai) {
                f32x4 pr[4];
#pragma unroll
                for (int m = 0; m < 4; ++m) pr[m] = acc[ai][0][m][1] * acc[ai][1][m][0];
#pragma unroll
                for (int m = 0; m < 4; ++m) { f32x4 y;
#pragma unroll
                    for (int j = 0; j < 4; ++j) {
                        const float bp = m > 0 ? __shfl(pr[m > 0 ? m - 1 : 0][j], lane | 15) : 0.f;
                        const float bn = m < 3 ? __shfl(pr[m < 3 ? m + 1 : 3][j], lane & ~15) : 0.f;
                        const float up = dpp_shr1(pr[m][j], bp), dn = dpp_shl1(pr[m][j], bn);
                        const float cv = cw0[j] * up + cw1[j] * pr[m][j] + cw2[j] * dn;
                        y[j] = acc[ai][0][m][0][j] * cv * silu_f(acc[ai][1][m][1][j]); if (ABLATE & 2) y[j] = 0.f; }
                    u32x2 w; w.x = cvt_pk_bf16(y[0], y[1]); w.y = cvt_pk_bf16(y[2], y[3]);
                    *(u32x2*)(Y + (size_t)(row0 + ai * 128 + m * 16) * 4096 + 2048 + ch0) = w; } }
        } else {
            if (wc < 2) {
#pragma unroll
                for (int ai = 0; ai < 2; ++ai)
#pragma unroll
                    for (int m = 0; m < 4; ++m)
#pragma unroll
                        for (int n = 0; n < 2; ++n) *(f32x4*)(AB + (size_t)(row0 + ai * 128 + m * 16) * 64 + 32 * wc + 8 * fq + 4 * n) = acc[ai][0][m][n]; }
        }
    } };
struct EpiResid { static constexpr bool PERM = false;
    const float* resid; float* out; const float* gate;
    __device__ __forceinline__ void operator()(const AccT& acc, const pg8::Unit& u, int wr, int wc, int fr, int fq) const {
        const int row0 = u.pm * 256 + wr * 64 + fr, col0 = u.pn * 256 + wc * 32 + 4 * fq; const float* g = gate + (size_t)(u.pm >> 3) * 6144;
        f32x4 gv[2][2];
#pragma unroll
        for (int bj = 0; bj < 2; ++bj)
#pragma unroll
            for (int n = 0; n < 2; ++n) gv[bj][n] = *(const f32x4*)(g + col0 + bj * 128 + n * 16);
#pragma unroll
        for (int ai = 0; ai < 2; ++ai)
#pragma unroll
            for (int m = 0; m < 4; ++m) { const size_t off = (size_t)(row0 + ai * 128 + m * 16) * DM + col0;
#pragma unroll
                for (int bj = 0; bj < 2; ++bj)
#pragma unroll
                    for (int n = 0; n < 2; ++n) { const f32x4 r = *(const f32x4*)(resid + off + bj * 128 + n * 16); *(f32x4*)(out + off + bj * 128 + n * 16) = r + gv[bj][n] * acc[ai][bj][m][n]; }
                asm volatile("" ::: "memory"); }
    } };
struct Epi3 { static constexpr bool PERM = true;
    bf16_t* P1;
    __device__ __forceinline__ void operator()(const AccT& acc, const pg8::Unit& u, int wr, int wc, int fr, int fq) const {
        const int row0 = u.pm * 256 + wr * 64 + fr, col0 = u.pn * 256 + wc * 32 + 8 * fq;
        const int act = u.pn < 16 ? 1 : ((u.pn >= 24 && u.pn < 32) ? 0 : 2);
#pragma unroll
        for (int ai = 0; ai < 2; ++ai)
#pragma unroll
            for (int m = 0; m < 4; ++m) { bf16_t* rowp = P1 + (size_t)(row0 + ai * 128 + m * 16) * N3 + col0;
#pragma unroll
                for (int bj = 0; bj < 2; ++bj) { f32x4 v0 = acc[ai][bj][m][0], v1 = acc[ai][bj][m][1];
                    if (act == 1) {
#pragma unroll
                        for (int j = 0; j < 4; ++j) { v0[j] = gelu_f(v0[j]); v1[j] = gelu_f(v1[j]); } }
                    else if (act == 2) {
#pragma unroll
                        for (int j = 0; j < 4; ++j) { v0[j] = silu_f(v0[j]); v1[j] = silu_f(v1[j]); } }
                    u32x4 w; w.x = cvt_pk_bf16(v0[0], v0[1]); w.y = cvt_pk_bf16(v0[2], v0[3]); w.z = cvt_pk_bf16(v1[0], v1[1]); w.w = cvt_pk_bf16(v1[2], v1[3]);
                    *(u32x4*)(rowp + bj * 128) = w; } }
    } };
struct SchedPool { int G, c; const char* A; const char* B;
    __device__ __forceinline__ bool next(int i, pg8::Unit& u) const {
        const int L = i * G + c; if (L >= 256) return false;
        u.aux = L >> 6; u.pn = (L >> 5) & 1; u.pm = L & 31;
        u.a = A + ((size_t)u.pm * 256 * 2048 + 512 * u.aux) * 2; u.b = B + ((size_t)u.aux * 512 * 512 + (size_t)u.pn * 256 * 512) * 2; return true; } };
struct EpiPool { static constexpr bool PERM = true;
    const bf16_t* P1; bf16_t* Y2; const float* pscale;
    __device__ __forceinline__ void operator()(const AccT& acc, const pg8::Unit& u, int wr, int wc, int fr, int fq) const {
        const int row0 = u.pm * 256 + wr * 64 + fr, colg = 512 * u.aux + 256 * u.pn + wc * 32 + 8 * fq;
        f32x4 ps[2][2];
#pragma unroll
        for (int bj = 0; bj < 2; ++bj)
#pragma unroll
            for (int n = 0; n < 2; ++n) ps[bj][n] = *(const f32x4*)(pscale + colg + bj * 128 + 4 * n);
#pragma unroll
        for (int ai = 0; ai < 2; ++ai)
#pragma unroll
            for (int m = 0; m < 4; ++m) { const size_t row = (size_t)(row0 + ai * 128 + m * 16);
#pragma unroll
                for (int bj = 0; bj < 2; ++bj) { const u32x4 z = *(const u32x4*)(P1 + row * N3 + 8192 + colg + bj * 128);
                    f32x4 v0 = acc[ai][bj][m][0] * ps[bj][0], v1 = acc[ai][bj][m][1] * ps[bj][1]; if (ABLATE & 8) { v0 = v0 * 0.f; v1 = v1 * 0.f; }
                    u32x4 w; w.x = cvt_pk_bf16(v0[0] * bf_lo(z.x), v0[1] * bf_hi(z.x)); w.y = cvt_pk_bf16(v0[2] * bf_lo(z.y), v0[3] * bf_hi(z.y));
                    w.z = cvt_pk_bf16(v1[0] * bf_lo(z.z), v1[1] * bf_hi(z.z)); w.w = cvt_pk_bf16(v1[2] * bf_lo(z.w), v1[3] * bf_hi(z.w));
                    *(u32x4*)(Y2 + row * 4096 + 2048 + colg + bj * 128) = w; } }
    } };

__device__ __forceinline__ void qkv_task(int task, const bf16_t* PQKV, const float* convw, bf16_t* QN, bf16_t* KN, bf16_t* KT, bf16_t* VT, int lane) {
    const int head = task & 15, tens = (task >> 4) % 3, blk = task / 48;
    int b, t0, prow0, tokb; bool isx;
    if (blk < 128) { isx = true; b = blk >> 5; t0 = (blk & 31) * 64; prow0 = b * SEQ + t0; tokb = CTXL + t0; }
    else { isx = false; const int cb = blk - 128; b = cb >> 2; t0 = (cb & 3) * 64; prow0 = MX + b * CTXL + t0; tokb = t0; }
    const int col = tens * 2048 + head * 128 + 2 * lane;
    const f32x2 w0 = *(const f32x2*)(convw + col), w1 = *(const f32x2*)(convw + 6144 + col), w2 = *(const f32x2*)(convw + 12288 + col);
    const bf16_t* p = PQKV + (size_t)prow0 * 6144 + col;
    const int bh = b * NHD + head;
    unsigned v[66];
    v[0] = 0u; v[65] = 0u;
    if (!isx && t0 > 0) v[0] = *(const unsigned*)(p - 6144);
    if (!isx && t0 < 192) v[65] = *(const unsigned*)(p + (size_t)64 * 6144);
#pragma unroll
    for (int i = 0; i < 64; ++i) v[i + 1] = *(const unsigned*)(p + (size_t)i * 6144);
    unsigned tr0[4], tr1[4];
    float hold0 = 0.f, hold1 = 0.f;
#pragma unroll
    for (int i = 0; i < 64; ++i) {
        const unsigned pv = v[i], cu = v[i + 1], nx = v[i + 2];
        float o0 = w0.x * bf_lo(pv) + w1.x * bf_lo(cu) + w2.x * bf_lo(nx);
        float o1 = w0.y * bf_hi(pv) + w1.y * bf_hi(cu) + w2.y * bf_hi(nx);
        o0 = silu_f(o0); o1 = silu_f(o1);
        if (tens < 2) { const float ss = wave_sum(o0 * o0 + o1 * o1); const float sc = rsqrtf(ss + EPS); o0 *= sc; o1 *= sc; }
        const int tok = tokb + i;
        if (tens == 0) *(unsigned*)(QN + ((size_t)bh * NTOK + tok) * HD + 2 * lane) = cvt_pk_bf16(o0, o1);
        if (tens == 1) *(unsigned*)(KN + ((size_t)bh * NTOK + tok) * HD + 2 * lane) = cvt_pk_bf16(o0, o1);
        if (tens >= 1) {
            if (i & 1) { tr0[(i >> 1) & 3] = cvt_pk_bf16(hold0, o0); tr1[(i >> 1) & 3] = cvt_pk_bf16(hold1, o1); } else { hold0 = o0; hold1 = o1; }
            if ((i & 7) == 7) { bf16_t* T = (tens == 1 ? KT : VT) + ((size_t)bh * HD + 2 * lane) * NTOK + tok - 7;
                *(u32x4*)T = (u32x4){tr0[0], tr0[1], tr0[2], tr0[3]}; *(u32x4*)(T + NTOK) = (u32x4){tr1[0], tr1[1], tr1[2], tr1[3]}; } }
    }
}
__device__ __forceinline__ void ab_task(int blk, const float* AB, const float* alog, const float* dtb, float* GG, float* BETA, int lane) {
    int b, prow0, tokb;
    if (blk < 128) { b = blk >> 5; const int t0 = (blk & 31) * 64; prow0 = b * SEQ + t0; tokb = CTXL + t0; }
    else { const int cb = blk - 128; b = cb >> 2; const int t0 = (cb & 3) * 64; prow0 = MX + b * CTXL + t0; tokb = t0; }
    const int kind = lane >> 4, h = lane & 15, d = kind & 1;
    const float A = __expf(alog[d * 16 + h]), db = dtb[d * 16 + h];
    float* dst = (kind < 2 ? GG : BETA) + ((size_t)d * NBH + b * NHD + h) * NTOK + tokb;
#pragma unroll 4
    for (int i = 0; i < 64; ++i) { const float v = AB[(size_t)(prow0 + i) * 64 + lane];
        dst[i] = kind < 2 ? -A * softplus_f(v + db) : sigmoid_f(v); }
}

template <int I> struct FS {
    static __device__ __forceinline__ void run(const LAS float* Ml, float (&Tc)[64], int lane) {
        float a = (lane == I) ? 1.f : 0.f;
#pragma unroll
        for (int jq = 0; jq < (I + 3) / 4; ++jq) { const f32x4 mv = *(const LAS f32x4*)(Ml + I * 68 + 4 * jq);
#pragma unroll
            for (int e = 0; e < 4; ++e) if (4 * jq + e < I) a = fmaf(-mv[e], Tc[4 * jq + e], a); }
        Tc[I] = a;
        __builtin_amdgcn_sched_barrier(0);
        if constexpr (I + 1 < 64) FS<I + 1>::run(Ml, Tc, lane);
    } };
__device__ __forceinline__ void chunk_task(int task, const bf16_t* QN, const bf16_t* KN, const float* GG, const float* BETA, float* GC, bf16_t* TU, bf16_t* AI, LAS float* tab, int lane) {
    const int tc = task % NCH, bh = (task / NCH) & 63, dir = task / (NCH * 64);
    const int tok0 = 64 * tc;
    LAS float* Ml = tab + 128;
    const int mytok = tok0 + (dir ? 63 - lane : lane);
    const size_t gidx = ((size_t)dir * NBH + bh) * NTOK + mytok;
    const float gl = GG[gidx], bl = BETA[gidx];
    float gc = gl;
#pragma unroll
    for (int o = 1; o < 64; o <<= 1) { const float t = __shfl_up(gc, o); if (lane >= o) gc += t; }
    GC[gidx] = gc;
    tab[lane] = gc; tab[64 + lane] = bl;
    LDS_WAIT(); asm volatile("" ::: "memory");
    const int r = lane & 31, hh = lane >> 5;
    bf16x8 ka[2][8];
#pragma unroll
    for (int ib = 0; ib < 2; ++ib) { const int tk = tok0 + (dir ? 63 - (32 * ib + r) : 32 * ib + r); const bf16x8* kp = (const bf16x8*)(KN + ((size_t)bh * NTOK + tk) * HD + 8 * hh);
#pragma unroll
        for (int s = 0; s < 8; ++s) ka[ib][s] = kp[2 * s]; }
    const bool isx = tc >= 4;
    bf16_t* aib = AI + (((size_t)dir * NBH + bh) * NCH + tc) * 4096;
    if (isx) {
#pragma unroll
        for (int ib = 0; ib < 2; ++ib) {
            bf16x8 qa[8]; { const int tk = tok0 + (dir ? 63 - (32 * ib + r) : 32 * ib + r); const bf16x8* qp = (const bf16x8*)(QN + ((size_t)bh * NTOK + tk) * HD + 8 * hh);
#pragma unroll
                for (int s = 0; s < 8; ++s) qa[s] = qp[2 * s]; }
#pragma unroll
            for (int jb = 0; jb < 2; ++jb) {
                f32x16 a = {};
                if (jb <= ib) {
#pragma unroll
                    for (int s = 0; s < 8; ++s) a = __builtin_amdgcn_mfma_f32_32x32x16_bf16(qa[s], ka[jb][s], a, 0, 0, 0); }
                const int jp = 32 * jb + r; const float gcj = tab[jp];
                bf16_t vv[16];
#pragma unroll
                for (int g = 0; g < 4; ++g) { const f32x4 gci = *(const LAS f32x4*)(tab + 32 * ib + 8 * g + 4 * hh);
#pragma unroll
                    for (int e = 0; e < 4; ++e) { const int ip = 32 * ib + 8 * g + 4 * hh + e;
                        vv[4 * g + e] = f2bf((jp <= ip) ? 0.08838834764831845f * a[4 * g + e] * __expf(gci[e] - gcj) : 0.f); } }
                if (dir == 0) { bf16_t* bp = aib + (32 * ib + 4 * hh) * 64 + jp;
#pragma unroll
                    for (int e = 0; e < 16; ++e) bp[((e & 3) + 8 * (e >> 2)) * 64] = vv[e]; }
                else { bf16_t* bp = aib + (63 - 32 * ib - 4 * hh) * 64 + (63 - jp);
#pragma unroll
                    for (int e = 0; e < 16; ++e) bp[-((e & 3) + 8 * (e >> 2)) * 64] = vv[e]; } } }
    }
    f32x16 Mt[3];
#pragma unroll
    for (int t = 0; t < 3; ++t) { const int ib = t > 0, jb = t > 1; f32x16 a = {};
#pragma unroll
        for (int s = 0; s < 8; ++s) a = __builtin_amdgcn_mfma_f32_32x32x16_bf16(ka[ib][s], ka[jb][s], a, 0, 0, 0);
        Mt[t] = a; }
    LAS float* Mlb = Ml + 4 * hh * 68 + r;
#pragma unroll
    for (int t = 0; t < 3; ++t) { const int ib = t > 0, jb = t > 1; const int jp = 32 * jb + r; const float gcj = tab[jp];
#pragma unroll
        for (int g = 0; g < 4; ++g) { const f32x4 gci = *(const LAS f32x4*)(tab + 32 * ib + 8 * g + 4 * hh), bi = *(const LAS f32x4*)(tab + 64 + 32 * ib + 8 * g + 4 * hh);
#pragma unroll
            for (int e = 0; e < 4; ++e) { const int ip = 32 * ib + 8 * g + 4 * hh + e;
                Mt[t][4 * g + e] = (jp < ip) ? bi[e] * Mt[t][4 * g + e] * __expf(gci[e] - gcj) : 0.f;
                Mlb[(32 * ib + 8 * g + e) * 68 + 32 * jb] = Mt[t][4 * g + e]; } } }
    LDS_WAIT(); asm volatile("" ::: "memory");
    float Tc[64];
    FS<0>::run(Ml, Tc, lane);
    bf16_t* tub = TU + (((size_t)dir * NBH + bh) * NCH + tc) * 4096;
    if (dir == 0) { bf16_t* bp = tub + lane;
#pragma unroll
        for (int i = 0; i < 64; ++i) bp[i * 64] = f2bf(Tc[i] * bl); }
    else { bf16_t* bp = tub + 63 * 64 + (63 - lane);
#pragma unroll
        for (int i = 0; i < 64; ++i) bp[-i * 64] = f2bf(Tc[i] * bl); }
    LDS_WAIT(); asm volatile("" ::: "memory");
}

constexpr int G_KT = 0, G_VT = 36864, G_TU = 55296, G_W = 73728, G_ST = 91136, G_VN = 108544, G_VNG = 117760, G_TAB = 126976;
__device__ __forceinline__ f32x16 mma_tile(f32x16 acc, const LAS bf16_t* A, int lda, const LAS bf16_t* B, int ldb, int ksteps, int lane) {
    const LAS bf16_t* ap = A + (lane & 31) * lda + 8 * (lane >> 5); const LAS bf16_t* bp = B + (lane & 31) * ldb + 8 * (lane >> 5);
    for (int s = 0; s < ksteps; ++s) acc = __builtin_amdgcn_mfma_f32_32x32x16_bf16(*(const LAS bf16x8*)(ap + 16 * s), *(const LAS bf16x8*)(bp + 16 * s), acc, 0, 0, 0);
    return acc;
}
__device__ __forceinline__ void scan_chain(int chain, LAS unsigned char* lds, const bf16_t* QN, const bf16_t* KT, const bf16_t* VT, const bf16_t* TU, const bf16_t* AI, const float* GC, bf16_t* OF, bf16_t* OB) {
    const int tid = threadIdx.x, wave = __builtin_amdgcn_readfirstlane(tid >> 6), lane = tid & 63;
    const int half = chain & 1, bh = (chain >> 1) & 63, dir = chain >> 7, b = bh >> 4, h = bh & 15;
    LAS bf16_t* Ws = (LAS bf16_t*)(lds + G_W); LAS bf16_t* STs = (LAS bf16_t*)(lds + G_ST); LAS bf16_t* VNs = (LAS bf16_t*)(lds + G_VN); LAS bf16_t* VNGs = (LAS bf16_t*)(lds + G_VNG);
    for (int i = tid; i < 17408 / 4; i += 512) ((LAS unsigned*)STs)[i] = 0u;
    f32x16 Sacc = {};
    bf16_t* Od = dir ? OB : OF;
    const int c = lane & 31, hh = lane >> 5;
    const int sr = tid >> 3, sc8 = (tid & 7) * 8;
    const int kbw = wave & 3, tbw = wave >> 2;
    const int tb2 = (wave >> 1) & 1, db2 = wave & 1;
    u32x4 rk0, rk1, rv, rt; float rg = 0.f, rgl = 0.f;
#define SC_TC(st) (dir == 0 ? (st) : ((st) < 4 ? 3 - (st) : 39 - (st)))
#define SC_GLOAD(st) do { const int tc_ = SC_TC(st), tok0_ = 64 * tc_; \
        rk0 = *(const u32x4*)(KT + ((size_t)bh * HD + sr) * NTOK + tok0_ + sc8); rk1 = *(const u32x4*)(KT + ((size_t)bh * HD + 64 + sr) * NTOK + tok0_ + sc8); \
        rv = *(const u32x4*)(VT + ((size_t)bh * HD + 64 * half + sr) * NTOK + tok0_ + sc8); rt = *(const u32x4*)(TU + (((size_t)dir * NBH + bh) * NCH + tc_) * 4096 + sr * 64 + sc8); \
        if (tid < 64) { const float* gp_ = GC + ((size_t)dir * NBH + bh) * NTOK + tok0_; rg = gp_[tid]; rgl = gp_[dir ? 0 : 63]; } } while (0)
#define SC_LSTORE(p) do { LAS bf16_t* kt_ = (LAS bf16_t*)(lds + G_KT + (p) * 18432); \
        *(LAS u32x4*)(kt_ + sr * 72 + sc8) = rk0; *(LAS u32x4*)(kt_ + (64 + sr) * 72 + sc8) = rk1; \
        *(LAS u32x4*)((LAS bf16_t*)(lds + G_VT + (p) * 9216) + sr * 72 + sc8) = rv; *(LAS u32x4*)((LAS bf16_t*)(lds + G_TU + (p) * 9216) + sr * 72 + sc8) = rt; \
        if (tid < 64) { LAS float* tb_ = (LAS float*)(lds + G_TAB + (p) * 544); tb_[tid] = __expf(rg); tb_[64 + tid] = __expf(rgl - rg); if (tid == 0) tb_[128] = __expf(rgl); } } while (0)
#define SC_W(p) do { const LAS bf16_t* ap_ = (const LAS bf16_t*)(lds + G_KT + (p) * 18432) + (32 * kbw + c) * 72 + 8 * hh; const LAS bf16_t* bp_ = (const LAS bf16_t*)(lds + G_TU + (p) * 9216) + (32 * tbw + c) * 72 + 8 * hh; \
        const LAS float* tb_ = (const LAS float*)(lds + G_TAB + (p) * 544); f32x16 a_ = {}; \
        _Pragma("unroll") for (int s_ = 0; s_ < 4; ++s_) { const bf16x8 av_ = *(const LAS bf16x8*)(ap_ + 16 * s_); const u32x4 bu_ = *(const LAS u32x4*)(bp_ + 16 * s_); \
            const f32x4 e0_ = *(const LAS f32x4*)(tb_ + 16 * s_ + 8 * hh), e1_ = *(const LAS f32x4*)(tb_ + 16 * s_ + 8 * hh + 4); u32x4 bs_; \
            bs_.x = cvt_pk_bf16(bf_lo(bu_.x) * e0_[0], bf_hi(bu_.x) * e0_[1]); bs_.y = cvt_pk_bf16(bf_lo(bu_.y) * e0_[2], bf_hi(bu_.y) * e0_[3]); \
            bs_.z = cvt_pk_bf16(bf_lo(bu_.z) * e1_[0], bf_hi(bu_.z) * e1_[1]); bs_.w = cvt_pk_bf16(bf_lo(bu_.w) * e1_[2], bf_hi(bu_.w) * e1_[3]); \
            a_ = __builtin_amdgcn_mfma_f32_32x32x16_bf16(av_, __builtin_bit_cast(bf16x8, bs_), a_, 0, 0, 0); } \
        _Pragma("unroll") for (int g_ = 0; g_ < 4; ++g_) { u32x2 w_; w_.x = cvt_pk_bf16(-a_[4 * g_], -a_[4 * g_ + 1]); w_.y = cvt_pk_bf16(-a_[4 * g_ + 2], -a_[4 * g_ + 3]); \
            *(LAS u32x2*)(Ws + (32 * tbw + c) * 136 + 32 * kbw + 8 * g_ + 4 * hh) = w_; } } while (0)
    SC_GLOAD(0);
    __syncthreads();
    SC_LSTORE(0);
    SC_GLOAD(1);
    __syncthreads();
    SC_W(0);
    bf16x8 qf[8], af[4];
#pragma unroll
    for (int s = 0; s < 8; ++s) qf[s] = (bf16x8){0, 0, 0, 0, 0, 0, 0, 0};
#pragma unroll
    for (int s = 0; s < 4; ++s) af[s] = (bf16x8){0, 0, 0, 0, 0, 0, 0, 0};
    if (wave >= 4 && SC_TC(0) >= 4) { const bf16x8* qp = (const bf16x8*)(QN + ((size_t)bh * NTOK + 64 * SC_TC(0) + 32 * tb2 + c) * HD + 8 * hh);
#pragma unroll
        for (int s = 0; s < 8; ++s) qf[s] = qp[2 * s];
        const bf16x8* ap = (const bf16x8*)(AI + (((size_t)dir * NBH + bh) * NCH + SC_TC(0)) * 4096 + (32 * tb2 + c) * 64 + 8 * hh);
#pragma unroll
        for (int s = 0; s < 4; ++s) af[s] = ap[2 * s]; }
    __syncthreads();
    for (int step = 0; step < NCH; ++step) {
        const int p = step & 1, tc = SC_TC(step), tok0 = 64 * tc; const bool isx = tc >= 4;
        const LAS float* tab = (const LAS float*)(lds + G_TAB + p * 544);
        if (step + 1 < NCH) SC_LSTORE(p ^ 1);
        if (step + 2 < NCH) SC_GLOAD(step + 2);
        f32x16 oacc = {};
        if (wave < 4) {
            f32x16 a = {};
            a = mma_tile(a, (const LAS bf16_t*)(lds + G_TU + p * 9216) + 32 * tb2 * 72, 72, (const LAS bf16_t*)(lds + G_VT + p * 9216) + 32 * db2 * 72, 72, 4, lane);
            a = mma_tile(a, Ws + 32 * tb2 * 136, 136, STs + 32 * db2 * 136, 136, 8, lane);
#pragma unroll
            for (int g = 0; g < 4; ++g) { const f32x4 sc = *(const LAS f32x4*)(tab + 64 + 32 * tb2 + 8 * g + 4 * hh);
                u32x2 w, wg; w.x = cvt_pk_bf16(a[4 * g], a[4 * g + 1]); w.y = cvt_pk_bf16(a[4 * g + 2], a[4 * g + 3]);
                wg.x = cvt_pk_bf16(a[4 * g] * sc[0], a[4 * g + 1] * sc[1]); wg.y = cvt_pk_bf16(a[4 * g + 2] * sc[2], a[4 * g + 3] * sc[3]);
                *(LAS u32x2*)(VNs + (32 * db2 + c) * 72 + 32 * tb2 + 8 * g + 4 * hh) = w; *(LAS u32x2*)(VNGs + (32 * db2 + c) * 72 + 32 * tb2 + 8 * g + 4 * hh) = wg; }
        } else if (isx) {
            const LAS bf16_t* bp = STs + (32 * db2 + c) * 136 + 8 * hh;
#pragma unroll
            for (int s = 0; s < 8; ++s) oacc = __builtin_amdgcn_mfma_f32_32x32x16_bf16(qf[s], *(const LAS bf16x8*)(bp + 16 * s), oacc, 0, 0, 0);
#pragma unroll
            for (int g = 0; g < 4; ++g) { const f32x4 sc = *(const LAS f32x4*)(tab + 32 * tb2 + 8 * g + 4 * hh);
#pragma unroll
                for (int e = 0; e < 4; ++e) oacc[4 * g + e] *= 0.08838834764831845f * sc[e]; }
        }
        if (wave >= 4 && step + 1 < NCH && SC_TC(step + 1) >= 4) { const bf16x8* qp = (const bf16x8*)(QN + ((size_t)bh * NTOK + 64 * SC_TC(step + 1) + 32 * tb2 + c) * HD + 8 * hh);
#pragma unroll
            for (int s = 0; s < 8; ++s) qf[s] = qp[2 * s]; }
        __syncthreads();
        {
            const int kb = wave & 3, db = wave >> 2; const float egl = tab[128];
#pragma unroll
            for (int e = 0; e < 16; ++e) Sacc[e] *= egl;
            Sacc = mma_tile(Sacc, (const LAS bf16_t*)(lds + G_KT + p * 18432) + 32 * kb * 72, 72, VNGs + 32 * db * 72, 72, 4, lane);
#pragma unroll
            for (int g = 0; g < 4; ++g) { u32x2 w; w.x = cvt_pk_bf16(Sacc[4 * g], Sacc[4 * g + 1]); w.y = cvt_pk_bf16(Sacc[4 * g + 2], Sacc[4 * g + 3]);
                *(LAS u32x2*)(STs + (32 * db + c) * 136 + 32 * kb + 8 * g + 4 * hh) = w; }
        }
        if (step + 1 < NCH) SC_W(p ^ 1);
        if (wave >= 4 && isx) {
            const LAS bf16_t* bp = VNs + (32 * db2 + c) * 72 + 8 * hh;
#pragma unroll
            for (int s = 0; s < 4; ++s) oacc = __builtin_amdgcn_mfma_f32_32x32x16_bf16(af[s], *(const LAS bf16x8*)(bp + 16 * s), oacc, 0, 0, 0);
            bf16_t* op = Od + ((size_t)b * SEQ + (tok0 - CTXL) + 32 * tb2) * DM + h * HD + 64 * half + 32 * db2 + c;
#pragma unroll
            for (int e = 0; e < 16; ++e) { const int t = (e & 3) + 8 * (e >> 2) + 4 * hh; op[(size_t)t * DM] = f2bf(oacc[e]); }
        }
        if (wave >= 4 && step + 1 < NCH && SC_TC(step + 1) >= 4) { const bf16x8* ap = (const bf16x8*)(AI + (((size_t)dir * NBH + bh) * NCH + SC_TC(step + 1)) * 4096 + (32 * tb2 + c) * 64 + 8 * hh);
#pragma unroll
            for (int s = 0; s < 4; ++s) af[s] = ap[2 * s]; }
        __syncthreads();
    }
#undef SC_TC
#undef SC_GLOAD
#undef SC_LSTORE
#undef SC_W
}

#ifndef DBG_THR
#define DBG_THR 1000.f
#endif
__device__ __forceinline__ void finish_row(int row, const bf16_t* OF, const bf16_t* OB, const bf16_t* ZA, const float* hn, bf16_t* Y, int lane, unsigned* dbgh) {
    const f32x4 h0 = *(const f32x4*)(hn + 8 * (lane & 15)), h1 = *(const f32x4*)(hn + 8 * (lane & 15) + 4);
#pragma unroll
    for (int it = 0; it < 4; ++it) {
        const size_t off = (size_t)row * DM + it * 512 + lane * 8;
        const u32x4 a_ = *(const u32x4*)(OF + off), bq_ = *(const u32x4*)(OB + off), z = *(const u32x4*)(ZA + off);
        u32x4 a = a_, bq = bq_; if (ABLATE & 16) bq = (u32x4){0u, 0u, 0u, 0u}; if (ABLATE & 32) a = (u32x4){0u, 0u, 0u, 0u};
        float o[8] = {bf_lo(a.x) + bf_lo(bq.x), bf_hi(a.x) + bf_hi(bq.x), bf_lo(a.y) + bf_lo(bq.y), bf_hi(a.y) + bf_hi(bq.y), bf_lo(a.z) + bf_lo(bq.z), bf_hi(a.z) + bf_hi(bq.z), bf_lo(a.w) + bf_lo(bq.w), bf_hi(a.w) + bf_hi(bq.w)};
#if MK_DEBUG
        { float mb = 0.f, mf = 0.f; const float ofx[8] = {bf_lo(a.x), bf_hi(a.x), bf_lo(a.y), bf_hi(a.y), bf_lo(a.z), bf_hi(a.z), bf_lo(a.w), bf_hi(a.w)};
          const float obx[8] = {bf_lo(bq.x), bf_hi(bq.x), bf_lo(bq.y), bf_hi(bq.y), bf_lo(bq.z), bf_hi(bq.z), bf_lo(bq.w), bf_hi(bq.w)};
#pragma unroll
          for (int e = 0; e < 8; ++e) { mb = fmaxf(mb, fabsf(obx[e])); mf = fmaxf(mf, fabsf(ofx[e])); }
          const int bhq = (row / SEQ) * 16 + it * 4 + (lane >> 4);
          if (mb > DBG_THR) dbgh[bhq] = 1u; if (mf > DBG_THR) dbgh[64 + bhq] = 1u; }
#endif
        if (ABLATE & 128) { const float of_[8] = {bf_lo(a.x), bf_hi(a.x), bf_lo(a.y), bf_hi(a.y), bf_lo(a.z), bf_hi(a.z), bf_lo(a.w), bf_hi(a.w)};
            const float ob_[8] = {bf_lo(bq.x), bf_hi(bq.x), bf_lo(bq.y), bf_hi(bq.y), bf_lo(bq.z), bf_hi(bq.z), bf_lo(bq.w), bf_hi(bq.w)};
#pragma unroll
            for (int e = 0; e < 8; ++e) o[e] = of_[e] + ob_[e] * (1.f / 4096.f); }
        float ss = 0.f;
#pragma unroll
        for (int e = 0; e < 8; ++e) ss += o[e] * o[e];
        ss += __shfl_xor(ss, 1); ss += __shfl_xor(ss, 2); ss += __shfl_xor(ss, 4); ss += __shfl_xor(ss, 8);
        const float rs = rsqrtf(ss * (1.f / HD) + EPS);
        const float zf[8] = {bf_lo(z.x), bf_hi(z.x), bf_lo(z.y), bf_hi(z.y), bf_lo(z.z), bf_hi(z.z), bf_lo(z.w), bf_hi(z.w)};
        const float hv[8] = {h0[0], h0[1], h0[2], h0[3], h1[0], h1[1], h1[2], h1[3]};
        float y[8];
#pragma unroll
        for (int e = 0; e < 8; ++e) { y[e] = o[e] * rs * hv[e] * zf[e]; if (ABLATE & 1) y[e] = 0.f; }
        u32x4 w; w.x = cvt_pk_bf16(y[0], y[1]); w.y = cvt_pk_bf16(y[2], y[3]); w.z = cvt_pk_bf16(y[4], y[5]); w.w = cvt_pk_bf16(y[6], y[7]);
        *(u32x4*)(Y + (size_t)row * 4096 + it * 512 + lane * 8) = w;
    }
}

__device__ __forceinline__ void stats_row(int row, const bf16_t* P1, float* STATS, int lane) {
    const bf16_t* p = P1 + (size_t)row * N3 + 2048;
    float v[32]; float s = 0.f;
#pragma unroll
    for (int j = 0; j < 4; ++j) { const u32x4 a = *(const u32x4*)(p + j * 512 + lane * 8);
        v[8 * j] = bf_lo(a.x); v[8 * j + 1] = bf_hi(a.x); v[8 * j + 2] = bf_lo(a.y); v[8 * j + 3] = bf_hi(a.y); v[8 * j + 4] = bf_lo(a.z); v[8 * j + 5] = bf_hi(a.z); v[8 * j + 6] = bf_lo(a.w); v[8 * j + 7] = bf_hi(a.w); }
#pragma unroll
    for (int e = 0; e < 32; ++e) s += v[e];
    const float mu = wave_sum(s) * (1.f / DM); float q = 0.f;
#pragma unroll
    for (int e = 0; e < 32; ++e) { const float d = v[e] - mu; q += d * d; }
    const float rstd = rsqrtf(wave_sum(q) * (1.f / DM) + EPS);
    if (lane == 0) { STATS[2 * row] = mu; STATS[2 * row + 1] = rstd; }
}
template <int R> __device__ __forceinline__ void diff_task(const bf16_t* p, bf16_t* o) {
    unsigned v[64];
#pragma unroll
    for (int i = 0; i < 64; ++i) v[i] = *(const unsigned*)(p + (size_t)i * N3);
    float s0 = 0.f, s1 = 0.f;
#pragma unroll
    for (int i = 0; i < R; ++i) { s0 += bf_lo(v[i]); s1 += bf_hi(v[i]); }
#pragma unroll
    for (int i = 0; i < 64; ++i) {
        if (i + R < 64) { s0 += bf_lo(v[i + R]); s1 += bf_hi(v[i + R]); }
        if (i - R - 1 >= 0) { s0 -= bf_lo(v[i - R - 1 >= 0 ? i - R - 1 : 0]); s1 -= bf_hi(v[i - R - 1 >= 0 ? i - R - 1 : 0]); }
        const int hi = (i + R + 1 < 64) ? i + R + 1 : 64, lo = (i - R > 0) ? i - R : 0; const float inv = 1.0f / (float)(hi - lo);
        *(unsigned*)(o + (size_t)i * DM) = cvt_pk_bf16(s0 * inv - bf_lo(v[i]), s1 * inv - bf_hi(v[i]));
    }
}

constexpr int K_W = 0, K_V = 34816;
__device__ __forceinline__ void tmix_task(int task, LAS unsigned char* lds, const float* ws, const float* bs, const float* lnw, const float* lnb, const float* STATS, const bf16_t* P1, bf16_t* Y2) {
    const int tid = threadIdx.x, wave = __builtin_amdgcn_readfirstlane(tid >> 6), lane = tid & 63;
    const int g = task & 15, n = (task >> 4) & 15, b = task >> 8;
    const int row0 = b * SEQ + 128 * n;
    LAS bf16_t* Wsb = (LAS bf16_t*)(lds + K_W); LAS bf16_t* VnT = (LAS bf16_t*)(lds + K_V);
    for (int i = tid; i < 4096; i += 512) { const int p = i >> 5, q4 = (i & 31) * 4; const f32x4 w = *(const f32x4*)(ws + ((size_t)g * 128 + p) * 128 + q4);
        u32x2 o; o.x = cvt_pk_bf16(w.x, w.y); o.y = cvt_pk_bf16(w.z, w.w); *(LAS u32x2*)(Wsb + p * 136 + q4) = o; }
    for (int i = tid; i < 2048; i += 512) { const int q = i >> 4, c8 = (i & 15) * 8;
        const u32x4 a = *(const u32x4*)(P1 + (size_t)(row0 + q) * N3 + 2048 + 128 * g + c8);
        const float mu = STATS[2 * (row0 + q)], rstd = STATS[2 * (row0 + q) + 1];
        const f32x4 w0 = *(const f32x4*)(lnw + 128 * g + c8), w1 = *(const f32x4*)(lnw + 128 * g + c8 + 4), b0 = *(const f32x4*)(lnb + 128 * g + c8), b1 = *(const f32x4*)(lnb + 128 * g + c8 + 4);
        const float x[8] = {bf_lo(a.x), bf_hi(a.x), bf_lo(a.y), bf_hi(a.y), bf_lo(a.z), bf_hi(a.z), bf_lo(a.w), bf_hi(a.w)};
        const float wv[8] = {w0[0], w0[1], w0[2], w0[3], w1[0], w1[1], w1[2], w1[3]}, bv[8] = {b0[0], b0[1], b0[2], b0[3], b1[0], b1[1], b1[2], b1[3]};
#pragma unroll
        for (int e = 0; e < 8; ++e) VnT[(c8 + e) * 136 + q] = f2bf((x[e] - mu) * rstd * wv[e] + bv[e]); }
    __syncthreads();
    const int pb = wave >> 1, c = lane & 31, hh = lane >> 5;
#pragma unroll
    for (int t = 0; t < 2; ++t) { const int cb = 2 * (wave & 1) + t;
        f32x16 a = {};
        a = mma_tile(a, Wsb + 32 * pb * 136, 136, VnT + 32 * cb * 136, 136, 8, lane);
        const int ch = 128 * g + 32 * cb + c;
#pragma unroll
        for (int e = 0; e < 16; ++e) { const int p = 32 * pb + (e & 3) + 8 * (e >> 2) + 4 * hh; const size_t row = (size_t)(row0 + p);
            const float s = a[e] + bs[g * 128 + p];
            const float y = bf2f(P1[row * N3 + ch]) * s * bf2f(P1[row * N3 + 4096 + ch]);
            Y2[row * 4096 + ch] = f2bf((ABLATE & 4) ? 0.f : y); } }
    __syncthreads();
}

__device__ __forceinline__ void final_row(float* xrow, const float* fw, int lane) {
    f32x4* xr = (f32x4*)xrow + lane;
    f32x4 v[8]; float s = 0.f;
#pragma unroll
    for (int j = 0; j < 8; ++j) { v[j] = xr[64 * j]; s += (v[j].x * v[j].x + v[j].y * v[j].y) + (v[j].z * v[j].z + v[j].w * v[j].w); }
    const float rstd = rsqrtf(wave_sum(s) * (1.f / DM) + EPS);
#pragma unroll
    for (int j = 0; j < 8; ++j) xr[64 * j] = v[j] * rstd * ((const f32x4*)fw)[lane + 64 * j];
}

__global__ void __launch_bounds__(512, 2) fwd_kernel(Args args) {
    extern __shared__ __attribute__((aligned(16))) unsigned char lds_raw[];
    LAS unsigned char* lds = (LAS unsigned char*)lds_raw;
    const int tid = threadIdx.x, lane = tid & 63, wave = __builtin_amdgcn_readfirstlane(tid >> 6);
    const int G = gridDim.x, bid = blockIdx.x;
    const int gw = bid * 8 + wave, NGW = G * 8;
    unsigned char* ws = args.ws;
    volatile LAS unsigned* MISC = (volatile LAS unsigned*)(lds + MISC_OFF);
    if (tid < 16) MISC[tid] = 0u;
    __syncthreads();
    if (args.never) cg::this_grid().sync();
    XcdBarrier bar; bar.bar = (unsigned*)(ws + WS_CTL) + CW_BAR; bar.x = 0; bar.st = MISC;
    const int lo = args.ph_lo, hi = args.ph_hi;
    if (hi - lo > 1) bar = xcd_barrier_post((unsigned*)(ws + WS_CTL) + CW_BAR, MISC);
#ifndef PH_MASK
#define PH_MASK 0x3fff
#endif
#define IN(k) ((((PH_MASK) >> (k)) & 1) && lo <= (k) && (k) < hi)
#if MK_STAMP
    unsigned long long* STAMPS = (unsigned long long*)((unsigned*)(ws + WS_CTL) + 3000);
#define STAMP(k) do { if (bid == 0 && tid == 0) STAMPS[k] = __builtin_amdgcn_s_memrealtime(); } while (0)
#else
#define STAMP(k) do { } while (0)
#endif
#define SEAM(k) do { if (IN(k) && IN((k) + 1)) xcd_barrier(bar); STAMP((k) + 1); } while (0)
    STAMP(0);
    float* MOD = (float*)(ws + WS_MOD);
#if MK_DEBUG
    unsigned* DBG = (unsigned*)(ws + WS_CTL) + 2048; const int gt = bid * 512 + tid, ngt = G * 512;
#endif
    bf16_t* WT1 = (bf16_t*)(ws + WS_WT1); bf16_t* WT2 = (bf16_t*)(ws + WS_WT2); bf16_t* WT3 = (bf16_t*)(ws + WS_WT3); bf16_t* WT4 = (bf16_t*)(ws + WS_WT4); bf16_t* WTP = (bf16_t*)(ws + WS_WTP);
    bf16_t* H = (bf16_t*)(ws + WS_H);

    if (IN(0)) for (int rep_ = 0; rep_ < ((REPEAT_PH) == 0 ? (REPEAT_N) : 1); (++rep_, __syncthreads())) {
        if (bid < 192) { LAS float* tab = (LAS float*)lds; silu_table(args.in[I_C], args.in[I_CCTX], tab);
            for (int t = bid; t < 192; t += G) mod_task(args.in[I_ADAW], args.in[I_ADAB], MOD, 32 * t, tab, (LAS float*)(lds + 40960), wave, lane);
            __syncthreads(); }
        LAS float* scr = (LAS float*)(lds + wave * 16640);
        const SrcW1 s1; const SrcId sid;
        for (int it = gw; it < 8320 + 2048; it += NGW) {
            if (it < 8320) { const int cb = it >> 5, kb = it & 31; conv_item(args.in[I_EWIN], N1SRC, 2048, WT1, 64 * cb, 64 * kb, scr, lane, s1); }
            else { const int r = it - 8320, cb = r >> 6, kb = r & 63; conv_item(args.in[I_EWOUT], 2048, 4096, WT2, 64 * cb, 64 * kb, scr, lane, sid); }
        }
    }
    SEAM(0);
    if (IN(1)) for (int rep_ = 0; rep_ < ((REPEAT_PH) == 1 ? (REPEAT_N) : 1); (++rep_, __syncthreads())) {
#if MK_DEBUG
        dbg_f32(MOD, 5, 6144, 6144, DBG + 0, gt, ngt); dbg_bf16(WT1, 16640, 2048, 2048, DBG + 0, gt, ngt); dbg_bf16(WT2, 2048, 4096, 4096, DBG + 0, gt, ngt);
#endif
        for (int m = gw; m < MT; m += NGW) {
            const float* src = m < MX ? args.in[I_X] + (size_t)m * DM : args.in[I_CTX] + (size_t)(m - MX) * DM;
            const int r = m < MX ? m / SEQ : 4;
            hrow(src, args.in[I_NORMW], MOD + r * 6144, H + (size_t)m * DM, lane);
        }
    }
    SEAM(1);
    if (IN(2)) for (int rep_ = 0; rep_ < ((REPEAT_PH) == 2 ? (REPEAT_N) : 1); (++rep_, __syncthreads())) {
#if MK_DEBUG
        dbg_bf16(H, MT, 2048, 2048, DBG + 1, gt, ngt);
#endif
        Sched1 S{G, bid, (const char*)H, (const char*)WT1};
        Epi1 E{(bf16_t*)(ws + WS_PQKV), (bf16_t*)(ws + WS_ZA), (float*)(ws + WS_AB), (bf16_t*)(ws + WS_Y), args.in[I_ECONVB]};
        pg8::gemm_phase<Epi1, Sched1>(lds, 2048, 2048, 2048, S, E);
    }
    SEAM(2);
    if (IN(3)) for (int rep_ = 0; rep_ < ((REPEAT_PH) == 3 ? (REPEAT_N) : 1); (++rep_, __syncthreads())) {
#if MK_DEBUG
        dbg_bf16((const bf16_t*)(ws + WS_PQKV), MT, 6144, 6144, DBG + 2, gt, ngt); dbg_bf16((const bf16_t*)(ws + WS_ZA), MX, 2048, 2048, DBG + 2, gt, ngt);
        dbg_f32((const float*)(ws + WS_AB), MT, 64, 64, DBG + 2, gt, ngt); dbg_bf16((const bf16_t*)(ws + WS_Y) + 2048, MX, 2048, 4096, DBG + 2, gt, ngt);
#endif
        for (int t = gw; t < 6912 + 144; t += NGW) {
            if (t < 6912) qkv_task(t, (const bf16_t*)(ws + WS_PQKV), args.in[I_ECONVQKV], (bf16_t*)(ws + WS_QN), (bf16_t*)(ws + WS_KN), (bf16_t*)(ws + WS_KT), (bf16_t*)(ws + WS_VT), lane);
            else ab_task(t - 6912, (const float*)(ws + WS_AB), args.in[I_EALOG], args.in[I_EDTB], (float*)(ws + WS_GG), (float*)(ws + WS_BETA), lane);
        }
    }
    SEAM(3);
    if (IN(4)) for (int rep_ = 0; rep_ < ((REPEAT_PH) == 4 ? (REPEAT_N) : 1); (++rep_, __syncthreads())) {
#if MK_DEBUG
        dbg_bf16((const bf16_t*)(ws + WS_QN), 64 * NTOK, 128, 128, DBG + 3, gt, ngt); dbg_bf16((const bf16_t*)(ws + WS_KN), 64 * NTOK, 128, 128, DBG + 3, gt, ngt);
        dbg_bf16((const bf16_t*)(ws + WS_KT), 64 * 128, NTOK, NTOK, DBG + 3, gt, ngt); dbg_bf16((const bf16_t*)(ws + WS_VT), 64 * 128, NTOK, NTOK, DBG + 3, gt, ngt);
        dbg_f32((const float*)(ws + WS_GG), 128, NTOK, NTOK, DBG + 3, gt, ngt); dbg_f32((const float*)(ws + WS_BETA), 128, NTOK, NTOK, DBG + 3, gt, ngt);
#endif
        LAS float* tab = (LAS float*)(lds + wave * 17920);
        const SrcId sid;
        auto copy_item = [&](int it) {
            if (it < 5120) { const int cb = it >> 5, kb = it & 31; conv_item(args.in[I_OWIN], N3, 2048, WT3, 64 * cb, 64 * kb, tab, lane, sid); }
            else if (it < 7168) { const int r = it - 5120, cb = r >> 6, kb = r & 63; conv_item(args.in[I_OWOUT], 2048, 4096, WT4, 64 * cb, 64 * kb, tab, lane, sid); }
            else { const int r = it - 7168, gq = r >> 6, cb = (r >> 3) & 7, kb = r & 7; conv_item(args.in[I_OPW] + (size_t)gq * 512 * 512, 512, 512, WTP + (size_t)gq * 512 * 512, 64 * cb, 64 * kb, tab, lane, sid); } };
        auto chunk = [&](int t) { chunk_task(t, (const bf16_t*)(ws + WS_QN), (const bf16_t*)(ws + WS_KN), (const float*)(ws + WS_GG), (const float*)(ws + WS_BETA), (float*)(ws + WS_GC), (bf16_t*)(ws + WS_TU), (bf16_t*)(ws + WS_AI), tab, lane); };
        constexpr int NCT = 2 * 64 * NCH, NCI = 5120 + 2048 + 256;
        const bool bal = (NGW == 2048);
        const int nslots = bal ? 8 : (NCT + NCI + NGW - 1) / NGW + 1;
        for (int i = 0; i < nslots; ++i) {
            int ct = -1, ci = -1;
            if (bal) {
                if (i == 0) ct = gw; else if (i == 6) ct = gw + 2048; else if (i == 7) { if (gw < 512) ct = gw + 4096; }
                else if (i <= 4) { if (gw >= 512) ci = (gw - 512) + 1536 * (i - 1); } else { if (gw < 1280) ci = 6144 + gw; }
            } else { const int L = gw + i * NGW; if (L < NCT) ct = L; else if (L < NCT + NCI) ci = L - NCT; }
            if (ct >= 0) chunk(ct);
            if (ci >= 0) copy_item(ci);
        }
    }
    SEAM(4);
    if (IN(5)) for (int rep_ = 0; rep_ < ((REPEAT_PH) == 5 ? (REPEAT_N) : 1); (++rep_, __syncthreads())) {
#if MK_DEBUG
        dbg_bf16((const bf16_t*)(ws + WS_TU), 2 * 64 * NCH, 4096, 4096, DBG + 4, gt, ngt);
        if (gt == 100) {
            const int dirq = 1, bhq = 0, tcq = 20, tok0q = 64 * tcq; const bf16_t* KNq = (const bf16_t*)(ws + WS_KN) + ((size_t)bhq * NTOK + tok0q) * HD;
            const float* gq = (const float*)(ws + WS_GG) + ((size_t)dirq * NBH + bhq) * NTOK + tok0q; const float* bq = (const float*)(ws + WS_BETA) + ((size_t)dirq * NBH + bhq) * NTOK + tok0q;
            const bf16_t* tq = (const bf16_t*)(ws + WS_TU) + (((size_t)dirq * NBH + bhq) * NCH + tcq) * 4096;
            float worst = 0.f;
            for (int a = 0; a < 64; a += 7) for (int b2 = 0; b2 < 64; b2 += 5) {
                float r = 0.f;
                for (int m = 0; m < 64; ++m) {
                    float im = (a == m) ? 1.f : 0.f;
                    if (m > a) { float kk = 0.f; for (int e = 0; e < HD; ++e) kk += bf2f(KNq[a * HD + e]) * bf2f(KNq[m * HD + e]); float gd = 0.f; for (int t = a; t < m; ++t) gd += gq[t]; im = bq[a] * kk * __expf(gd); }
                    const float T = bf2f(tq[m * 64 + b2]) / bq[b2];
                    r += im * T; }
                worst = fmaxf(worst, fabsf(r - ((a == b2) ? 1.f : 0.f))); }
            DBG[980] = __float_as_uint(worst); }
        if (gt < 64) { const int bhq = gt & 63; const bf16_t* tq = (const bf16_t*)(ws + WS_TU) + (((size_t)1 * NBH + bhq) * NCH + 20) * 4096; float so = 0.f;
            for (int i = 0; i < 64; ++i) for (int j = 0; j < 64; ++j) { const float v = fabsf(bf2f(tq[i * 64 + j])); if (i != j) so += v; }
            DBG[910 + bhq] = __float_as_uint(so); }
        dbg_max_bf16((const bf16_t*)(ws + WS_TU), (size_t)128 * NCH * 4096, DBG + 900, gt, ngt);
        dbg_max_bf16((const bf16_t*)(ws + WS_KN), (size_t)64 * NTOK * 128, DBG + 901, gt, ngt);
        dbg_max_bf16((const bf16_t*)(ws + WS_KT), (size_t)64 * NTOK * 128, DBG + 902, gt, ngt);
        dbg_max_bf16((const bf16_t*)(ws + WS_VT), (size_t)64 * NTOK * 128, DBG + 903, gt, ngt);
        dbg_max_bf16((const bf16_t*)(ws + WS_QN), (size_t)64 * NTOK * 128, DBG + 904, gt, ngt);
        for (int q = 0; q < 128; ++q) dbg_bf16((const bf16_t*)(ws + WS_AI) + ((size_t)q * NCH + 4) * 4096, 32, 4096, 4096, DBG + 4, gt, ngt);
        dbg_f32((const float*)(ws + WS_GC), 128, NTOK, NTOK, DBG + 4, gt, ngt); dbg_f32(MOD + 5 * 6144, 4, 6144, 6144, DBG + 4, gt, ngt);
        dbg_bf16(WT3, 10240, 2048, 2048, DBG + 4, gt, ngt); dbg_bf16(WT4, 2048, 4096, 4096, DBG + 4, gt, ngt); dbg_bf16(WTP, 2048, 512, 512, DBG + 4, gt, ngt);
#endif
        for (int ch = bid; ch < 256; ch += G) { scan_chain(ch, lds, (const bf16_t*)(ws + WS_QN), (const bf16_t*)(ws + WS_KT), (const bf16_t*)(ws + WS_VT), (const bf16_t*)(ws + WS_TU), (const bf16_t*)(ws + WS_AI), (const float*)(ws + WS_GC), (bf16_t*)(ws + WS_OF), (bf16_t*)(ws + WS_OB)); __syncthreads(); }
    }
    SEAM(5);
    if (IN(6)) for (int rep_ = 0; rep_ < ((REPEAT_PH) == 6 ? (REPEAT_N) : 1); (++rep_, __syncthreads())) {
        if (bid < 192) { LAS float* stab = (LAS float*)lds; silu_table(args.in[I_C], args.in[I_CCTX], stab);
            for (int t = bid; t < 192; t += G) mod_task(args.in[I_ADAW] + (size_t)2048 * 6144, args.in[I_ADAB] + 6144, MOD + 5 * 6144, 32 * t, stab, (LAS float*)(lds + 40960), wave, lane);
            __syncthreads(); }
#if MK_DEBUG
        dbg_bf16((const bf16_t*)(ws + WS_OF), MX, 2048, 2048, DBG + 5, gt, ngt); dbg_bf16((const bf16_t*)(ws + WS_OB), MX, 2048, 2048, DBG + 5, gt, ngt);
        dbg_max_bf16((const bf16_t*)(ws + WS_OF), (size_t)MX * 2048, DBG + 905, gt, ngt); dbg_max_bf16((const bf16_t*)(ws + WS_OB), (size_t)MX * 2048, DBG + 906, gt, ngt);
#endif
        for (int m = gw; m < MX; m += NGW) finish_row(m, (const bf16_t*)(ws + WS_OF), (const bf16_t*)(ws + WS_OB), (const bf16_t*)(ws + WS_ZA), args.in[I_EHN], (bf16_t*)(ws + WS_Y), lane, (unsigned*)(ws + WS_CTL) + 3072);
    }
    SEAM(6);
    if (IN(7)) for (int rep_ = 0; rep_ < ((REPEAT_PH) == 7 ? (REPEAT_N) : 1); (++rep_, __syncthreads())) {
#if MK_DEBUG
        dbg_bf16((const bf16_t*)(ws + WS_Y), MX, 2048, 4096, DBG + 6, gt, ngt);
#endif
        pg8::StaticOrder S{32, 8, G, bid, (const char*)(ws + WS_Y), (const char*)WT2, (size_t)256 * 4096 * 2, (size_t)256 * 4096 * 2};
        EpiResid E{args.in[I_X], args.out, MOD + 4096};
        pg8::gemm_phase<EpiResid, pg8::StaticOrder>(lds, 4096, 4096, 4096, S, E);
    }
    SEAM(7);
    if (IN(8)) for (int rep_ = 0; rep_ < ((REPEAT_PH) == 8 ? (REPEAT_N) : 1); (++rep_, __syncthreads())) {
#if MK_DEBUG
        dbg_f32(args.out, MX, 2048, 2048, DBG + 7, gt, ngt);
#endif
        for (int m = gw; m < MX; m += NGW) hrow(args.out + (size_t)m * DM, args.in[I_NORMW] + DM, MOD + 5 * 6144 + (m / SEQ) * 6144, H + (size_t)m * DM, lane);
    }
    SEAM(8);
    if (IN(9)) for (int rep_ = 0; rep_ < ((REPEAT_PH) == 9 ? (REPEAT_N) : 1); (++rep_, __syncthreads())) {
#if MK_DEBUG
        dbg_bf16(H, MX, 2048, 2048, DBG + 8, gt, ngt);
#endif
        pg8::StaticOrder S{32, 40, G, bid, (const char*)H, (const char*)WT3, (size_t)256 * 2048 * 2, (size_t)256 * 2048 * 2};
        Epi3 E{(bf16_t*)(ws + WS_P1)};
        pg8::gemm_phase<Epi3, pg8::StaticOrder>(lds, 2048, 2048, 2048, S, E);
    }
    SEAM(9);
    if (IN(10)) for (int rep_ = 0; rep_ < ((REPEAT_PH) == 10 ? (REPEAT_N) : 1); (++rep_, __syncthreads())) {
#if MK_DEBUG
        dbg_bf16((const bf16_t*)(ws + WS_P1), MX, N3, N3, DBG + 9, gt, ngt);
#endif
        for (int m = gw; m < MX; m += NGW) stats_row(m, (const bf16_t*)(ws + WS_P1), (float*)(ws + WS_STATS), lane);
        for (int t = gw; t < 128 * 16; t += NGW) { const int blk = t >> 4, cc = t & 15, grp = cc >> 2;
            const bf16_t* p = (const bf16_t*)(ws + WS_P1) + (size_t)(64 * blk) * N3 + 6144 + 128 * cc + 2 * lane; bf16_t* o = (bf16_t*)(ws + WS_DIFF) + (size_t)(64 * blk) * DM + 128 * cc + 2 * lane;
            if (grp == 0) diff_task<1>(p, o); else if (grp == 1) diff_task<2>(p, o); else if (grp == 2) diff_task<4>(p, o); else diff_task<8>(p, o); }
    }
    SEAM(10);
    if (IN(11)) for (int rep_ = 0; rep_ < ((REPEAT_PH) == 11 ? (REPEAT_N) : 1); (++rep_, __syncthreads())) {
#if MK_DEBUG
        dbg_f32((const float*)(ws + WS_STATS), 1, 2 * MX, 2 * MX, DBG + 10, gt, ngt); dbg_bf16((const bf16_t*)(ws + WS_DIFF), MX, 2048, 2048, DBG + 10, gt, ngt);
#endif
        SchedPool S{G, bid, (const char*)(ws + WS_DIFF), (const char*)WTP};
        EpiPool E{(const bf16_t*)(ws + WS_P1), (bf16_t*)(ws + WS_Y2), args.in[I_OPS]};
        pg8::gemm_phase<EpiPool, SchedPool>(lds, 512, 2048, 512, S, E);
        __syncthreads();
        for (int t = bid; t < 1024; t += G) tmix_task(t, lds, args.in[I_OWS], args.in[I_OBS], args.in[I_OLNW], args.in[I_OLNB], (const float*)(ws + WS_STATS), (const bf16_t*)(ws + WS_P1), (bf16_t*)(ws + WS_Y2));
    }
    SEAM(11);
    if (IN(12)) {
#if MK_DEBUG
        dbg_bf16((const bf16_t*)(ws + WS_Y2), MX, 4096, 4096, DBG + 11, gt, ngt);
#endif
        pg8::StaticOrder S{32, 8, G, bid, (const char*)(ws + WS_Y2), (const char*)WT4, (size_t)256 * 4096 * 2, (size_t)256 * 4096 * 2};
        EpiResid E{args.out, args.out, MOD + 5 * 6144 + 4096};
        pg8::gemm_phase<EpiResid, pg8::StaticOrder>(lds, 4096, 4096, 4096, S, E);
    }
    SEAM(12);
    if (IN(13)) {
#if MK_DEBUG
        dbg_f32(args.out, MX, 2048, 2048, DBG + 12, gt, ngt);
        for (size_t i = gt; i < (size_t)MX * DM; i += ngt) { const float v = args.out[i]; if (badf(v)) args.out[i] = 0.f; }
        asm volatile("s_waitcnt vmcnt(0)" ::: "memory"); __syncthreads();
#endif
        for (int m = gw; m < MX; m += NGW) final_row(args.out + (size_t)m * DM, args.in[I_FNW], lane);
#if MK_DEBUG
        asm volatile("s_waitcnt vmcnt(0)" ::: "memory"); __syncthreads();
        if (bid == 0 && tid == 0) { int first = -1; unsigned mask = 0; for (int k = 12; k >= 0; --k) if (__hip_atomic_load(DBG + k, __ATOMIC_RELAXED, __HIP_MEMORY_SCOPE_AGENT)) { first = k; mask |= 1u << k; }
            if (first >= 0) args.out[0] = 1000.f * (float)(first + 1);
            { int cb = 0, cf = 0; for (int q = 0; q < 64; ++q) { cb += (int)__hip_atomic_load(DBG + 1024 + q, __ATOMIC_RELAXED, __HIP_MEMORY_SCOPE_AGENT); cf += (int)__hip_atomic_load(DBG + 1024 + 64 + q, __ATOMIC_RELAXED, __HIP_MEMORY_SCOPE_AGENT); }
              args.out[0] = 1000.f * (float)(DBG_SEL ? cf : cb) + 500.f;
              if (DBG_SEL == 30 || DBG_SEL == 31) { const int dsel = DBG_SEL - 30; int fb = -1; for (int q = 0; q < 64; ++q) if (__hip_atomic_load(DBG + 1024 + (dsel ? 0 : 64) + q, __ATOMIC_RELAXED, __HIP_MEMORY_SCOPE_AGENT)) { fb = q; break; }
                  float mg = 0.f; if (fb >= 0) { const float* gq = (const float*)(ws + WS_GG) + ((size_t)dsel * NBH + fb) * NTOK; for (int i = 256; i < NTOK; ++i) mg += gq[i]; mg = -mg / 2048.f; }
                  args.out[0] = 1.0e4f * mg + 1000.f * 1000.f * (float)(fb & 15); }
              else if (DBG_SEL == 200) { args.out[0] = 1.0e5f * __uint_as_float(__hip_atomic_load(DBG + 980, __ATOMIC_RELAXED, __HIP_MEMORY_SCOPE_AGENT)) + 1000.f; }
              else if (DBG_SEL >= 60 && DBG_SEL < 124) { args.out[0] = 1.0e3f * __uint_as_float(__hip_atomic_load(DBG + 910 + (DBG_SEL - 60), __ATOMIC_RELAXED, __HIP_MEMORY_SCOPE_AGENT)); }
              else if (DBG_SEL >= 40 && DBG_SEL < 60) { const int bhq = DBG_SEL - 40; const bf16_t* tq = (const bf16_t*)(ws + WS_TU) + (((size_t)1 * NBH + bhq) * NCH + 20) * 4096; float so = 0.f, sd = 0.f;
                  for (int i = 0; i < 64; ++i) for (int j = 0; j < 64; ++j) { const float v = fabsf(bf2f(tq[i * 64 + j])); if (i == j) sd += v; else so += v; }
                  args.out[0] = 1.0e4f * so + 1.0e8f; }
              else if (DBG_SEL >= 10) args.out[0] = 1.0e2f * __uint_as_float(__hip_atomic_load(DBG + 900 + (DBG_SEL - 10), __ATOMIC_RELAXED, __HIP_MEMORY_SCOPE_AGENT)); } }
#endif
    }
#if MK_STAMP
    if (IN(13)) {
        asm volatile("s_waitcnt vmcnt(0)" ::: "memory"); __syncthreads();
        if (bid == 0) {
            const unsigned long long t14 = __builtin_amdgcn_s_memrealtime();
            const float tA = (float)((SEL_A == 13 ? t14 : STAMPS[SEL_A + 1]) - STAMPS[SEL_A]) * 0.01f, tB = (float)((SEL_B == 13 ? t14 : STAMPS[SEL_B + 1]) - STAMPS[SEL_B]) * 0.01f;
            __syncthreads();
            for (int i = 1 + tid; i <= 1048576; i += 512) args.out[i] += tB * (1.f / 2000.f);
            if (tid == 0) args.out[0] += tA * (1.f / 100.f);
        }
    }
#endif
#if STOP_AFTER < 13
    if (lo == 14) {
        const size_t NO = (size_t)MX * DM; const size_t gtid = (size_t)bid * 512 + tid, ngtid = (size_t)G * 512;
        for (size_t i = gtid; i < NO; i += ngtid) {
            float acc = 0.f;
#define DG_BF(off, n) do { const bf16_t* q_ = (const bf16_t*)(ws + (off)); for (size_t j = i; j < (size_t)(n); j += NO) acc += bf2f(q_[j]); } while (0)
#define DG_F32(off, n) do { const float* q_ = (const float*)(ws + (off)); for (size_t j = i; j < (size_t)(n); j += NO) acc += q_[j]; } while (0)
#if STOP_AFTER == 0
            DG_BF(WS_WT1, (size_t)16640 * 2048); DG_BF(WS_WT2, (size_t)2048 * 4096); DG_F32(WS_MOD, 5 * 6144);
#elif STOP_AFTER == 1
            DG_BF(WS_H, (size_t)MT * 2048);
#elif STOP_AFTER == 2
            DG_BF(WS_PQKV, (size_t)MT * 6144); DG_BF(WS_ZA, (size_t)MX * 2048); DG_F32(WS_AB, (size_t)MT * 64);
            { const bf16_t* q_ = (const bf16_t*)(ws + WS_Y); const size_t r = i / 2048, c = i % 2048; acc += bf2f(q_[r * 4096 + 2048 + c]); }
#elif STOP_AFTER == 3
            DG_BF(WS_QN, (size_t)64 * NTOK * 128); DG_BF(WS_KN, (size_t)64 * NTOK * 128); DG_BF(WS_KT, (size_t)64 * NTOK * 128); DG_BF(WS_VT, (size_t)64 * NTOK * 128);
            DG_F32(WS_GG, (size_t)128 * NTOK); DG_F32(WS_BETA, (size_t)128 * NTOK);
#elif STOP_AFTER == 4
            DG_BF(WS_TU, (size_t)128 * NCH * 4096); DG_F32(WS_GC, (size_t)128 * NTOK); DG_F32(WS_MOD, 10 * 6144);
            DG_BF(WS_WT3, (size_t)10240 * 2048); DG_BF(WS_WT4, (size_t)2048 * 4096); DG_BF(WS_WTP, (size_t)2048 * 512);
            { const bf16_t* q_ = (const bf16_t*)(ws + WS_AI); for (size_t j = i; j < (size_t)128 * NCH * 4096; j += NO) { const size_t tcq = (j / 4096) % NCH; if (tcq >= 4) acc += bf2f(q_[j]); } }
#elif STOP_AFTER == 5
            DG_BF(WS_OF, (size_t)MX * 2048); DG_BF(WS_OB, (size_t)MX * 2048);
#elif STOP_AFTER == 6
            DG_BF(WS_Y, (size_t)MX * 4096);
#elif STOP_AFTER == 7
            acc = args.out[i];
#elif STOP_AFTER == 8
            DG_BF(WS_H, (size_t)MX * 2048);
#elif STOP_AFTER == 9
            DG_BF(WS_P1, (size_t)MX * N3);
#elif STOP_AFTER == 10
            DG_BF(WS_DIFF, (size_t)MX * 2048); DG_F32(WS_STATS, (size_t)MX * 2);
#elif STOP_AFTER == 11
            DG_BF(WS_Y2, (size_t)MX * 4096);
#else
            acc = args.out[i];
#endif
            if (badf(acc)) acc = 12345.f;
            args.out[i] = acc;
        }
    }
#endif
#undef IN
#undef SEAM
}

extern "C" void kernel_launch(void* const* d_in, const int* in_sizes, int n_in, void* d_out, int out_size, void* d_ws, size_t ws_size, hipStream_t stream) {
    static int grid = 0;
    if (grid == 0) {
        if (n_in != 23 || out_size != MX * DM || ws_size < WS_END) { fprintf(stderr, "kernel_launch: unexpected shapes (n_in %d, out %d, ws %zu < %zu)\n", n_in, out_size, ws_size, (size_t)WS_END); grid = -1; return; }
        int dev = 0, cus = 0, per_cu = 0;
        if (hipGetDevice(&dev) != hipSuccess || hipDeviceGetAttribute(&cus, hipDeviceAttributeMultiprocessorCount, dev) != hipSuccess) { grid = -1; return; }
        if (hipFuncSetAttribute((const void*)fwd_kernel, hipFuncAttributeMaxDynamicSharedMemorySize, LDS_BYTES) != hipSuccess) { fprintf(stderr, "kernel_launch: hipFuncSetAttribute failed\n"); grid = -1; return; }
        if (hipOccupancyMaxActiveBlocksPerMultiprocessor(&per_cu, (const void*)fwd_kernel, 512, LDS_BYTES) != hipSuccess || per_cu < 1) { fprintf(stderr, "kernel_launch: occupancy query says %d\n", per_cu); }
        (void)hipGetLastError();
        grid = cus;
    }
    if (grid < 0) return;
    if (hipMemsetAsync((char*)d_ws + WS_CTL, 0, CTL_BYTES, stream) != hipSuccess) { fprintf(stderr, "kernel_launch: memset failed\n"); return; }
    Args a{};
    for (int i = 0; i < 23; ++i) a.in[i] = (const float*)d_in[i];
    a.out = (float*)d_out; a.ws = (unsigned char*)d_ws; a.never = 0; a.pad = 0;
    const int nl = (STOP_AFTER < 13) ? STOP_AFTER + 2 : MK_N_LAUNCHES;
    for (int li = 0; li < nl; ++li) {
        a.ph_lo = (nl == 1) ? 0 : li; a.ph_hi = (nl == 1) ? NPHASE : li + 1;
        if (STOP_AFTER < 13 && li == nl - 1) { a.ph_lo = 14; a.ph_hi = 15; }
        void* kargs[] = {&a};
        hipError_t e = hipLaunchCooperativeKernel((const void*)fwd_kernel, dim3(grid), dim3(512), kargs, LDS_BYTES, stream);
        if (e != hipSuccess) { fprintf(stderr, "kernel_launch: launch %d failed: %s\n", li, hipGetErrorString(e)); break; }
    }
}
```

```cpp
#include <hip/hip_runtime.h>
#include <hip/hip_cooperative_groups.h>
#include <cstdio>
#include <cstdint>
namespace cg = cooperative_groups;

#ifndef MK_N_LAUNCHES
#define MK_N_LAUNCHES 1
#endif
#ifndef DBG_SEL
#define DBG_SEL 200
#endif
#ifndef MK_STAMP
#define MK_STAMP 0
#endif
#ifndef SEL_A
#define SEL_A 4
#endif
#ifndef SEL_B
#define SEL_B 2
#endif
#ifndef REPEAT_PH
#define REPEAT_PH 99
#endif
#ifndef REPEAT_N
#define REPEAT_N 2
#endif
#ifndef ABLATE
#define ABLATE 0
#endif
#ifndef STOP_AFTER
#define STOP_AFTER 13
#endif

#define LAS __attribute__((address_space(3)))
typedef unsigned short bf16_t;
typedef short bf16x8 __attribute__((ext_vector_type(8)));
typedef float f32x2 __attribute__((ext_vector_type(2)));
typedef float f32x4 __attribute__((ext_vector_type(4)));
typedef float f32x16 __attribute__((ext_vector_type(16)));
typedef unsigned u32x2 __attribute__((ext_vector_type(2)));
typedef unsigned u32x4 __attribute__((ext_vector_type(4)));

constexpr int DM = 2048, NB = 4, SEQ = 2048, CTXL = 256, MX = NB * SEQ, MC = NB * CTXL, MT = MX + MC;
constexpr int NTOK = CTXL + SEQ;
constexpr int NHD = 16, HD = 128, NBH = NB * NHD;
constexpr int N1SRC = 16448, N1P = 16640, N3 = 10240;
constexpr int NCH = NTOK / 64;
constexpr float EPS = 1e-6f;
constexpr int NPHASE = 14;

constexpr size_t MiB = 1u << 20;
constexpr size_t WS_CTL = 0, CTL_BYTES = 1 * MiB;
constexpr size_t WS_MOD = 1 * MiB;
constexpr size_t WS_GG = 2 * MiB, WS_BETA = 4 * MiB, WS_GC = 6 * MiB;
constexpr size_t WS_STATS = 7 * MiB + 512 * 1024;
constexpr size_t WS_WT2 = 8 * MiB;
constexpr size_t WS_WT1 = 24 * MiB;
constexpr size_t WS_WT3 = 24 * MiB, WS_WT4 = 64 * MiB, WS_WTP = 80 * MiB;
constexpr size_t WS_H = 89 * MiB;
constexpr size_t WS_OB = 89 * MiB;
constexpr size_t WS_PQKV = 125 * MiB;
constexpr size_t WS_TU = 125 * MiB, WS_AI = 161 * MiB, WS_OF = 197 * MiB;
constexpr size_t WS_ZA = 233 * MiB;
constexpr size_t WS_AB = 265 * MiB;
constexpr size_t WS_Y = 268 * MiB;
constexpr size_t WS_QN = 332 * MiB, WS_KN = 368 * MiB, WS_KT = 404 * MiB, WS_VT = 440 * MiB;
constexpr size_t WS_P1 = 125 * MiB;
constexpr size_t WS_DIFF = 285 * MiB;
constexpr size_t WS_Y2 = 396 * MiB;
constexpr size_t WS_END = 476 * MiB;
constexpr int CW_BAR = 4096;

constexpr int LDS_BYTES = 155648;
constexpr int MISC_OFF = LDS_BYTES - 256;

__device__ __forceinline__ float bf_lo(unsigned w) { return __uint_as_float(w << 16); }
__device__ __forceinline__ float bf_hi(unsigned w) { return __uint_as_float(w & 0xffff0000u); }
__device__ __forceinline__ float bf2f(bf16_t b) { return __uint_as_float(((unsigned)b) << 16); }
typedef __bf16 bf16v2 __attribute__((ext_vector_type(2)));
__device__ __forceinline__ unsigned cvt_pk_bf16(float lo, float hi) { const f32x2 v = {lo, hi}; const bf16v2 r = __builtin_convertvector(v, bf16v2); return __builtin_bit_cast(unsigned, r); }
__device__ __forceinline__ bf16_t f2bf(float f) { return (bf16_t)(cvt_pk_bf16(f, 0.f) & 0xffffu); }
__device__ __forceinline__ float sigmoid_f(float x) { return __builtin_amdgcn_rcpf(1.0f + __expf(-x)); }
__device__ __forceinline__ float silu_f(float x) { return x * sigmoid_f(x); }
__device__ __forceinline__ float gelu_f(float x) { const float u = 0.7978845608028654f * (x + 0.044715f * x * x * x); return x * sigmoid_f(2.0f * u); }
__device__ __forceinline__ float softplus_f(float x) { const float e = __expf(-fabsf(x)); const float l = e < 1e-3f ? e * (1.f - 0.5f * e) : __logf(1.f + e); return fmaxf(x, 0.f) + l; }
__device__ __forceinline__ float wave_sum(float v) {
#pragma unroll
    for (int o = 1; o < 64; o <<= 1) v += __shfl_xor(v, o);
    return v;
}
__device__ __forceinline__ float dpp_shr1(float x, float old) { return __builtin_bit_cast(float, __builtin_amdgcn_update_dpp(__builtin_bit_cast(int, old), __builtin_bit_cast(int, x), 0x111, 0xf, 0xf, false)); }
__device__ __forceinline__ float dpp_shl1(float x, float old) { return __builtin_bit_cast(float, __builtin_amdgcn_update_dpp(__builtin_bit_cast(int, old), __builtin_bit_cast(int, x), 0x101, 0xf, 0xf, false)); }
#ifndef MK_DEBUG
#define MK_DEBUG 0
#endif
__device__ __forceinline__ float dpp_ror1(float x) { return __builtin_bit_cast(float, __builtin_amdgcn_update_dpp(0, __builtin_bit_cast(int, x), 0x121, 0xf, 0xf, false)); }
__device__ __forceinline__ float dpp_ror15(float x) { return __builtin_bit_cast(float, __builtin_amdgcn_update_dpp(0, __builtin_bit_cast(int, x), 0x12f, 0xf, 0xf, false)); }
#define LDS_WAIT() asm volatile("s_waitcnt lgkmcnt(0)" ::: "memory")

#define XB_TMO      128
#define XB_XCNT(j)  (256  + 64 * (j))
#define XB_XSUB(j)  (1280 + 64 * (j))
#define XB_XGEN(j)  (2304 + 64 * (j))
#define XB_TOP      3328
#define XB_TOPGEN   3392
#define XCD_BAR_WORDS 3456
#define XB_SPIN_CAP (1u << 20)
__device__ __forceinline__ unsigned xb_ld(unsigned* p)              { return __hip_atomic_load(p, __ATOMIC_RELAXED, __HIP_MEMORY_SCOPE_AGENT); }
__device__ __forceinline__ unsigned xb_add(unsigned* p, unsigned v) { return __hip_atomic_fetch_add(p, v, __ATOMIC_RELAXED, __HIP_MEMORY_SCOPE_AGENT); }
__device__ __forceinline__ unsigned xb_xcc_id() { return (unsigned)__builtin_amdgcn_s_getreg((3 << 11) | 20) & 0xFu; }
#define XB_SPIN(cond, bar) do { unsigned _sp = 0; while (cond) { __builtin_amdgcn_s_sleep(1); \
    if ((++_sp & 255u) == 0u) { if (xb_ld(&(bar)[XB_TMO])) break; if (_sp > XB_SPIN_CAP) { atomicAdd(&(bar)[XB_TMO], 1u); break; } } } } while (0)
struct XcdBarrier { unsigned* bar; unsigned x; volatile LAS unsigned* st; };
__device__ __forceinline__ XcdBarrier xcd_barrier_post(unsigned* bar, volatile LAS unsigned* st) {
    XcdBarrier b; b.bar = bar; b.x = xb_xcc_id(); b.st = st;
    if (threadIdx.x == 0) (void)xb_add(&bar[XB_XCNT(b.x)], 1u);
    return b;
}
__device__ __forceinline__ void xcd_barrier_complete(unsigned* bar, unsigned x, unsigned& nloc, unsigned& nx) {
    const unsigned G = gridDim.x * gridDim.y * gridDim.z;
    unsigned sum, cnt, mine, sp = 0u;
    for (;;) {
        sum = 0u; cnt = 0u; mine = 0u;
#pragma unroll
        for (unsigned j = 0; j < 16; ++j) { const unsigned c = xb_ld(&bar[XB_XCNT(j)]); sum += c; cnt += (c > 0u) ? 1u : 0u; mine = (j == x) ? c : mine; }
        if (sum == G) break;
        __builtin_amdgcn_s_sleep(1);
        if ((++sp & 255u) == 0u) { if (xb_ld(&bar[XB_TMO])) break; if (sp > XB_SPIN_CAP) { atomicAdd(&bar[XB_TMO], 1u); break; } }
    }
    nloc = mine > 0u ? mine : 1u; nx = cnt > 0u ? cnt : 1u;
}
__device__ __forceinline__ void xcd_barrier(const XcdBarrier& b) {
    asm volatile("s_waitcnt vmcnt(0)" ::: "memory");
    __syncthreads();
    if (threadIdx.x == 0) {
        unsigned* bar = b.bar;
        __builtin_amdgcn_s_waitcnt(0);
        unsigned nloc = b.st[0], nx = b.st[1];
        if (nloc == 0u) { xcd_barrier_complete(bar, b.x, nloc, nx); b.st[0] = nloc; b.st[1] = nx; }
        const unsigned old = xb_add(&bar[XB_XSUB(b.x)], 1u);
        const unsigned gen = old / nloc;
        if (old + 1u == (gen + 1u) * nloc) {
            __builtin_amdgcn_fence(__ATOMIC_RELEASE, "agent");
            asm volatile("s_waitcnt vmcnt(0)" ::: "memory");
            const unsigned og = xb_add(&bar[XB_TOP], 1u);
            const unsigned tg = og / nx;
            if (og + 1u == (tg + 1u) * nx) xb_add(&bar[XB_TOPGEN], 1u);
            else XB_SPIN(xb_ld(&bar[XB_TOPGEN]) == tg, bar);
            __builtin_amdgcn_fence(__ATOMIC_ACQUIRE, "agent");
            xb_add(&bar[XB_XGEN(b.x)], 1u);
            asm volatile("s_waitcnt vmcnt(0)" ::: "memory");
        } else {
            XB_SPIN(xb_ld(&bar[XB_XGEN(b.x)]) == gen, bar);
            __builtin_amdgcn_fence(__ATOMIC_ACQUIRE, "agent");
            asm volatile("s_waitcnt vmcnt(0)" ::: "memory");
        }
    }
    __syncthreads();
}

namespace pg8 {
constexpr int BM = 256, BK = 64, HALF = 128, HTB = HALF * BK * 2, STAGE_BYTES = 8 * HTB, NXCD = 8, WGM = 8;
__host__ __device__ __forceinline__ int lds_byte(int r, int c) { const int st = (r >> 4) * 2 + (c >> 5), rr = r & 15, cc = c & 31, ob = rr * 64 + cc * 2; return st * 1024 + (ob ^ (((ob >> 9) & 1) << 5)); }
__host__ __device__ __forceinline__ void stage_rc(int b, int& R, int& C) { const int st = b / 1024, sb = b % 1024, swz = sb ^ (((sb >> 9) & 1) << 5); R = (st >> 1) * 16 + swz / 64; C = (st & 1) * 32 + (swz % 64) / 2; }
__host__ __device__ __forceinline__ int perm32(int rho) { const int n = rho >> 4, i = rho & 15; return 8 * (i >> 2) + 4 * n + (i & 3); }
struct Unit { int pm, pn, aux; const char* a; const char* b; };
__device__ __forceinline__ void tile_order(int L, int nM, int nN, int& pm, int& pn) {
    const int nwg = nM * nN; int wgid = L;
    { const int q = nwg / NXCD, r = nwg % NXCD, xcd = wgid % NXCD, off = wgid / NXCD; wgid = (xcd < r ? xcd * (q + 1) : r * (q + 1) + (xcd - r) * q) + off; }
    const int nig = WGM * nN, gid = wgid / nig, fm = gid * WGM, gsz = (nM - fm) < WGM ? (nM - fm) : WGM;
    pm = fm + ((wgid % nig) % gsz); pn = (wgid % nig) / gsz;
}
struct StaticOrder {
    int nM, nN, G, c; const char* A; const char* B; size_t ta, tb;
    __device__ __forceinline__ bool next(int i, Unit& u) const {
        const long L = (long)i * G + c; if (L >= (long)nM * nN) return false;
        tile_order((int)L, nM, nN, u.pm, u.pn); u.aux = 0; u.a = A + (size_t)u.pm * ta; u.b = B + (size_t)u.pn * tb; return true;
    }
};
#define PG8_LAS __attribute__((address_space(3)))
template <class Epi, class Sched>
__device__ __forceinline__ void gemm_phase(PG8_LAS unsigned char* lds, const int K, const int lda, const int ldb, const Sched& S, const Epi& E) {
    const int tid = threadIdx.x, wid = __builtin_amdgcn_readfirstlane(tid >> 6), lane = tid & 63, wr = wid >> 2, wc = wid & 3, fr = lane & 15, fq = lane >> 4;
    const int nt = K / BK;
    unsigned voffA[2], voffB[2];
#pragma unroll
    for (int i = 0; i < 2; ++i) { int R, C; stage_rc(tid * 16 + i * 8192, R, C); const int Rb = Epi::PERM ? ((R & ~31) + perm32(R & 31)) : R;
        voffA[i] = (unsigned)(R * lda + C) * 2u; voffB[i] = (unsigned)(Rb * ldb + C) * 2u; }
    const size_t kstep = (size_t)(BK * 2);
    const size_t hstepA = (size_t)HALF * lda * 2, hstepB = (size_t)HALF * ldb * 2;
    const unsigned ldsw = (unsigned)wid * 1024u;
    const int aoff = lds_byte(wr * 64 + fr, fq * 8), boff = lds_byte(wc * 32 + fr, fq * 8);
#define PG8_SA(b, h) (((b) * 2 + (h)) * HTB)
#define PG8_SB(b, h) ((4 + (b) * 2 + (h)) * HTB)
#define PG8_STAGE(bufoff, gbase, voff) do { _Pragma("unroll") for (int _i = 0; _i < 2; ++_i) \
        __builtin_amdgcn_global_load_lds((const unsigned*)((const char*)(gbase) + (voff)[_i]), (PG8_LAS unsigned*)(lds + (bufoff) + ldsw + _i * 8192), 16, 0, 0); } while (0)
#define PG8_LDA(dst, b, h) do { _Pragma("unroll") for (int m = 0; m < 4; ++m) _Pragma("unroll") for (int k = 0; k < 2; ++k) dst[m][k] = *(const PG8_LAS bf16x8*)(lds + PG8_SA(b, h) + aoff + m * 2048 + k * 1024); } while (0)
#define PG8_LDB(dst, b, h) do { _Pragma("unroll") for (int n = 0; n < 2; ++n) _Pragma("unroll") for (int k = 0; k < 2; ++k) dst[n][k] = *(const PG8_LAS bf16x8*)(lds + PG8_SB(b, h) + boff + n * 2048 + k * 1024); } while (0)
#define PG8_MMA(ai, bj, At, Bt) do { __builtin_amdgcn_s_setprio(1); _Pragma("unroll") for (int m = 0; m < 4; ++m) _Pragma("unroll") for (int n = 0; n < 2; ++n) _Pragma("unroll") for (int k = 0; k < 2; ++k) \
        acc[ai][bj][m][n] = __builtin_amdgcn_mfma_f32_16x16x32_bf16(Bt[n][k], At[m][k], acc[ai][bj][m][n], 0, 0, 0); __builtin_amdgcn_s_setprio(0); } while (0)
#define PG8_WAIT_V(n) asm volatile("s_waitcnt vmcnt(" #n ")" ::: "memory")
#define PG8_WAIT_L(n) asm volatile("s_waitcnt lgkmcnt(" #n ")" ::: "memory")
#define PG8_BAR __builtin_amdgcn_s_barrier()
#define PG8_SCHED __builtin_amdgcn_sched_barrier(0)
    Unit cur, nxt; int ui = 0;
    if (!S.next(0, cur)) return;
    f32x4 acc[2][2][4][2];
#pragma unroll
    for (int a = 0; a < 2; ++a)
#pragma unroll
        for (int b = 0; b < 2; ++b)
#pragma unroll
            for (int m = 0; m < 4; ++m)
#pragma unroll
                for (int n = 0; n < 2; ++n) acc[a][b][m][n] = (f32x4){0.f, 0.f, 0.f, 0.f};
    bf16x8 At[4][2], B0[2][2], B1[2][2];
    const char* cA = cur.a; const char* cB = cur.b;
    PG8_STAGE(PG8_SB(0, 0), cB, voffB); PG8_STAGE(PG8_SB(0, 1), cB + hstepB, voffB); PG8_STAGE(PG8_SA(0, 0), cA, voffA); PG8_STAGE(PG8_SA(0, 1), cA + hstepA, voffA);
    if (wr == 1) PG8_BAR;
    PG8_WAIT_V(2); PG8_BAR;
    PG8_STAGE(PG8_SB(1, 0), cB + kstep, voffB); PG8_STAGE(PG8_SA(1, 0), cA + kstep, voffA); PG8_STAGE(PG8_SB(1, 1), cB + hstepB + kstep, voffB);
    PG8_WAIT_V(6); PG8_BAR;
    for (;;) {
        const bool has_next = S.next(ui + 1, nxt);
        const char* nA = has_next ? nxt.a : cA; const char* nB = has_next ? nxt.b : cB;
        for (int t = 0; t < nt; t += 2) {
            const bool last = (t == nt - 2);
            const char* a1 = cA + (size_t)(t + 1) * kstep;
            const char* a2 = last ? nA : cA + (size_t)(t + 2) * kstep; const char* b2 = last ? nB : cB + (size_t)(t + 2) * kstep;
            const char* a3 = a2 + kstep; const char* b3 = b2 + kstep;
            PG8_LDB(B0, 0, 0); PG8_LDB(B1, 0, 1); PG8_SCHED; PG8_LDA(At, 0, 0); PG8_STAGE(PG8_SA(1, 1), a1 + hstepA, voffA);
            PG8_WAIT_V(8); PG8_WAIT_L(0); PG8_BAR; PG8_MMA(0, 0, At, B0); PG8_MMA(0, 1, At, B1); PG8_BAR; PG8_SCHED;
            PG8_LDA(At, 0, 1); PG8_STAGE(PG8_SB(0, 0), b2, voffB); PG8_STAGE(PG8_SB(0, 1), b2 + hstepB, voffB); PG8_STAGE(PG8_SA(0, 0), a2, voffA);
            PG8_WAIT_V(8); PG8_WAIT_L(0); PG8_BAR; PG8_MMA(1, 0, At, B0); PG8_MMA(1, 1, At, B1); PG8_BAR; PG8_SCHED;
            PG8_LDB(B0, 1, 0); PG8_LDB(B1, 1, 1); PG8_SCHED; PG8_LDA(At, 1, 0); PG8_STAGE(PG8_SA(0, 1), a2 + hstepA, voffA);
            PG8_WAIT_V(8); PG8_WAIT_L(0); PG8_BAR; PG8_MMA(0, 0, At, B0); PG8_MMA(0, 1, At, B1); PG8_BAR; PG8_SCHED;
            PG8_LDA(At, 1, 1); PG8_STAGE(PG8_SB(1, 0), b3, voffB); PG8_STAGE(PG8_SB(1, 1), b3 + hstepB, voffB); PG8_STAGE(PG8_SA(1, 0), a3, voffA);
            PG8_WAIT_V(8); PG8_WAIT_L(0); PG8_BAR; PG8_MMA(1, 0, At, B0); PG8_MMA(1, 1, At, B1); PG8_BAR; PG8_SCHED;
        }
        if (wr == 0) PG8_BAR;
        E(acc, cur, wr, wc, fr, fq);
        if (!has_next) break;
#pragma unroll
        for (int a = 0; a < 2; ++a)
#pragma unroll
            for (int b = 0; b < 2; ++b)
#pragma unroll
                for (int m = 0; m < 4; ++m)
#pragma unroll
                    for (int n = 0; n < 2; ++n) acc[a][b][m][n] = (f32x4){0.f, 0.f, 0.f, 0.f};
        cur = nxt; cA = nA; cB = nB; ++ui;
        if (wr == 1) PG8_BAR;
    }
    PG8_WAIT_V(0);
    PG8_BAR;
#undef PG8_SA
#undef PG8_SB
#undef PG8_STAGE
#undef PG8_LDA
#undef PG8_LDB
#undef PG8_MMA
#undef PG8_WAIT_V
#undef PG8_WAIT_L
#undef PG8_BAR
#undef PG8_SCHED
}
}

#if MK_DEBUG
__device__ __forceinline__ bool badf(float v) { return !(fabsf(v) < 1e30f); }
__device__ __forceinline__ void dbg_bf16(const bf16_t* p, int rows, int cols, size_t ld, unsigned* flag, int gt, int ngt) {
    const int cpr = cols / 8; bool bad = false;
    for (size_t i = gt; i < (size_t)rows * cpr; i += ngt) { const size_t r = i / cpr, c = (i % cpr) * 8; const u32x4 a = *(const u32x4*)(p + r * ld + c);
        bad |= badf(bf_lo(a.x)) | badf(bf_hi(a.x)) | badf(bf_lo(a.y)) | badf(bf_hi(a.y)) | badf(bf_lo(a.z)) | badf(bf_hi(a.z)) | badf(bf_lo(a.w)) | badf(bf_hi(a.w)); }
    if (bad) *flag = 1u;
}
__device__ __forceinline__ void dbg_max_bf16(const bf16_t* p, size_t n, unsigned* slot, int gt, int ngt) {
    float m = 0.f;
    for (size_t i = (size_t)gt * 8; i < n; i += (size_t)ngt * 8) { const u32x4 a = *(const u32x4*)(p + i);
        m = fmaxf(m, fmaxf(fmaxf(fmaxf(fabsf(bf_lo(a.x)), fabsf(bf_hi(a.x))), fmaxf(fabsf(bf_lo(a.y)), fabsf(bf_hi(a.y)))), fmaxf(fmaxf(fabsf(bf_lo(a.z)), fabsf(bf_hi(a.z))), fmaxf(fabsf(bf_lo(a.w)), fabsf(bf_hi(a.w)))))); }
    atomicMax(slot, __float_as_uint(m));
}
__device__ __forceinline__ void dbg_f32(const float* p, int rows, int cols, size_t ld, unsigned* flag, int gt, int ngt) {
    const int cpr = cols / 4; bool bad = false;
    for (size_t i = gt; i < (size_t)rows * cpr; i += ngt) { const size_t r = i / cpr, c = (i % cpr) * 4; const f32x4 a = *(const f32x4*)(p + r * ld + c);
        bad |= badf(a.x) | badf(a.y) | badf(a.z) | badf(a.w); }
    if (bad) *flag = 1u;
}
#endif
struct Args { const float* in[23]; float* out; unsigned char* ws; int ph_lo, ph_hi, never, pad; };
enum { I_X = 0, I_C, I_CTX, I_CCTX, I_ADAW, I_ADAB, I_NORMW, I_EWIN, I_ECONVQKV, I_EALOG, I_EDTB, I_EHN, I_ECONVB, I_EWOUT, I_OWIN, I_OLNW, I_OLNB, I_OWS, I_OBS, I_OPW, I_OPS, I_OWOUT, I_FNW };

template <class SrcFn>
__device__ __forceinline__ void conv_item(const float* W, int ldw, int K, bf16_t* WT, int c0, int k0, LAS float* scr, int lane, const SrcFn& src) {
    const int sc = src(c0 + lane);
    const float* wp = W + (size_t)k0 * ldw + (sc >= 0 ? sc : 0);
    float v[64];
#pragma unroll
    for (int i = 0; i < 64; ++i) v[i] = wp[(size_t)i * ldw];
#pragma unroll
    for (int i = 0; i < 64; ++i) scr[i * 65 + lane] = sc >= 0 ? v[i] : 0.f;
    LDS_WAIT(); asm volatile("" ::: "memory");
    const int kc = lane >> 3, cc = lane & 7;
#pragma unroll
    for (int j = 0; j < 8; ++j) { const int c = cc + 8 * j; const LAS float* sp = scr + (8 * kc) * 65 + c;
        u32x4 o; o.x = cvt_pk_bf16(sp[0 * 65], sp[1 * 65]); o.y = cvt_pk_bf16(sp[2 * 65], sp[3 * 65]); o.z = cvt_pk_bf16(sp[4 * 65], sp[5 * 65]); o.w = cvt_pk_bf16(sp[6 * 65], sp[7 * 65]);
        *(u32x4*)(WT + (size_t)(c0 + c) * K + k0 + 8 * kc) = o; }
    LDS_WAIT(); asm volatile("" ::: "memory");
}
struct SrcId { __device__ __forceinline__ int operator()(int c) const { return c; } };
struct SrcW1 { __device__ __forceinline__ int operator()(int c) const {
    if (c < 8192) return c;
    if (c < 16384) { const int cc = c - 8192, T = cc >> 8, cp = cc & 255, bj = cp >> 7, wc = (cp >> 5) & 3, fq = (cp >> 3) & 3, n = (cp >> 2) & 1, j = cp & 3;
        return 8256 + 2048 * (2 * bj + n) + 64 * T + 16 * wc + 4 * fq + j; }
    const int cp = c - 16384; return cp < 64 ? 8192 + cp : -1; } };

__device__ __forceinline__ void mod_task(const float* adaw, const float* adab, float* modl, int n0, const LAS float* tab, LAS float* red, int wave, int lane) {
    const int col = n0 + (lane & 31), kp = lane >> 5;
    float acc[5] = {0.f, 0.f, 0.f, 0.f, 0.f};
    const float* wp = adaw + (size_t)(256 * wave + kp) * 6144 + col;
#pragma unroll 32
    for (int kk = 0; kk < 128; ++kk) { const float wv = wp[(size_t)kk * 2 * 6144]; const int k = 256 * wave + 2 * kk + kp;
#pragma unroll
        for (int r = 0; r < 5; ++r) acc[r] += tab[r * 2048 + k] * wv; }
#pragma unroll
    for (int r = 0; r < 5; ++r) { acc[r] += __shfl_xor(acc[r], 32); if (lane < 32) red[(wave * 5 + r) * 32 + lane] = acc[r]; }
    __syncthreads();
    if (threadIdx.x < 160) { const int r = threadIdx.x >> 5, c = threadIdx.x & 31; float s = adab[n0 + c];
#pragma unroll
        for (int w = 0; w < 8; ++w) s += red[(w * 5 + r) * 32 + c];
        modl[r * 6144 + n0 + c] = s; }
    __syncthreads();
}
__device__ __forceinline__ void silu_table(const float* c, const float* cctx, LAS float* tab) {
    for (int i = threadIdx.x; i < 5 * 2048; i += 512) { const float v = i < 8192 ? c[i] : cctx[i - 8192]; tab[i] = silu_f(v); }
    __syncthreads();
}

__device__ __forceinline__ void hrow(const float* xrow, const float* nw, const float* modr, bf16_t* orow, int lane) {
    const f32x4* xr = (const f32x4*)xrow + lane;
    f32x4 v[8]; float s = 0.f;
#pragma unroll
    for (int j = 0; j < 8; ++j) { v[j] = xr[64 * j]; s += (v[j].x * v[j].x + v[j].y * v[j].y) + (v[j].z * v[j].z + v[j].w * v[j].w); }
    const float rstd = rsqrtf(wave_sum(s) * (1.f / DM) + EPS);
    u32x2* o8 = (u32x2*)orow + lane;
#pragma unroll
    for (int j = 0; j < 8; ++j) { const f32x4 w = ((const f32x4*)nw)[lane + 64 * j], sh = ((const f32x4*)modr)[lane + 64 * j], sc = ((const f32x4*)(modr + 2048))[lane + 64 * j];
        const f32x4 y = v[j] * rstd * w * (sc + 1.0f) + sh; u32x2 p; p.x = cvt_pk_bf16(y.x, y.y); p.y = cvt_pk_bf16(y.z, y.w); o8[64 * j] = p; }
}

typedef f32x4 AccT[2][2][4][2];
struct Sched1 { int G, c; const char* A; const char* B;
    __device__ __forceinline__ bool next(int i, pg8::Unit& u) const {
        const int L = i * G + c; if (L >= 2148) return false;
        if (L < 2080) { int pv; pg8::tile_order(L, 32, 65, u.pm, pv);
            const int hc = (pv * 24) / 65, hn = ((pv + 1) * 24) / 65; u.pn = hn > hc ? hc : 24 + (pv - hc); }
        else { const int l = L - 2080; u.pm = 32 + (l & 3); const int t = l >> 2; u.pn = t < 16 ? 8 + t : 64; }
        u.aux = 0; u.a = A + (size_t)u.pm * (256 * 2048 * 2); u.b = B + (size_t)u.pn * (256 * 2048 * 2); return true; } };
struct Epi1 { static constexpr bool PERM = true;
    unsigned char* wsb; const float* convb; const float* convq; LAS unsigned char* lds;
#define E1_ZA ((bf16_t*)(wsb + WS_ZA))
#define E1_Y ((bf16_t*)(wsb + WS_Y))
#define E1_QN ((bf16_t*)(wsb + WS_QN))
#define E1_KN ((bf16_t*)(wsb + WS_KN))
#define E1_KT ((bf16_t*)(wsb + WS_KT))
#define E1_VT ((bf16_t*)(wsb + WS_VT))
#define E1_GG ((float*)(wsb + WS_GG))
#define E1_BETA ((float*)(wsb + WS_BETA))
    template <int M> __device__ __forceinline__ f32x4 conv4(const AccT& acc, int ai, int bj, int n, const f32x4& w0, const f32x4& w1, const f32x4& w2, const f32x4& hp, const f32x4& hn, int lane) const {
        f32x4 y;
#pragma unroll
        for (int j = 0; j < 4; ++j) {
            const float x = acc[ai][bj][M][n][j];
            const float bp = M > 0 ? dpp_ror1(acc[ai][bj][M > 0 ? M - 1 : 0][n][j]) : hp[j];
            const float bn = M < 3 ? dpp_ror15(acc[ai][bj][M < 3 ? M + 1 : 3][n][j]) : hn[j];
            const float up = dpp_shr1(x, bp), dn = dpp_shl1(x, bn);
            y[j] = silu_f(w0[j] * up + w1[j] * x + w2[j] * dn); }
        return y;
    }
    __device__ __forceinline__ void qkv(const bool CTX, const AccT& acc, const pg8::Unit& u, int wr, int wc, int fr, int fq) const {
        const int lane = 16 * fq + fr, tens = u.pn >> 3, hd0 = (u.pn & 7) * 2;
        LAS float* part = (LAS float*)(lds + 131072);
        LAS float* bnd = (LAS float*)(lds + 139264);
        LAS float* cwl = (LAS float*)(lds + 147456);
        { const int t_ = (int)threadIdx.x; const float* cq = convq + tens * 2048 + hd0 * 128;
          cwl[t_] = cq[(t_ >> 8) * 6144 + (t_ & 255)]; if (t_ < 256) cwl[512 + t_] = cq[2 * 6144 + t_]; }
        if (CTX) {
#pragma unroll
            for (int ai = 0; ai < 2; ++ai)
#pragma unroll
                for (int bj = 0; bj < 2; ++bj)
#pragma unroll
                    for (int n = 0; n < 2; ++n) { const int col = 128 * bj + 32 * wc + 8 * fq + 4 * n, g = 2 * ai + wr;
                        if (fr == 0) *(LAS f32x4*)(bnd + (g * 2 + 0) * 256 + col) = acc[ai][bj][0][n];
                        if (fr == 15) *(LAS f32x4*)(bnd + (g * 2 + 1) * 256 + col) = acc[ai][bj][3][n]; }
        }
        asm volatile("s_waitcnt lgkmcnt(0)" ::: "memory"); __builtin_amdgcn_s_barrier(); asm volatile("" ::: "memory");
        const int b = CTX ? (u.pm - 32) : (u.pm >> 3);
#pragma unroll
        for (int pass = 0; pass < 2; ++pass) {
            if (pass == 0 && tens == 2) continue;
#pragma unroll
            for (int ai = 0; ai < 2; ++ai)
#pragma unroll
                for (int bj = 0; bj < 2; ++bj) {
                    const int cg = tens * 2048 + (hd0 + bj) * 128 + 32 * wc + 8 * fq, col = 128 * bj + 32 * wc + 8 * fq, g = 2 * ai + wr, bh = b * NHD + hd0 + bj;
                    float ss[4] = {0.f, 0.f, 0.f, 0.f};
#pragma unroll
                    for (int n = 0; n < 2; ++n) {
                        const f32x4 w0 = *(const LAS f32x4*)(cwl + col + 4 * n), w1 = *(const LAS f32x4*)(cwl + 256 + col + 4 * n), w2 = *(const LAS f32x4*)(cwl + 512 + col + 4 * n);
                        f32x4 hp = {0.f, 0.f, 0.f, 0.f}, hn = {0.f, 0.f, 0.f, 0.f};
                        if (CTX) { if (g > 0) hp = *(const LAS f32x4*)(bnd + ((g - 1) * 2 + 1) * 256 + col + 4 * n);
                                   if (g < 3) hn = *(const LAS f32x4*)(bnd + ((g + 1) * 2 + 0) * 256 + col + 4 * n); }
                        const int ch = 32 * wc + 8 * fq + 4 * n;
#define E1_ROW(M) do { f32x4 y = conv4<M>(acc, ai, bj, n, w0, w1, w2, hp, hn, lane); \
                        if (pass == 0) ss[M] += (y[0] * y[0] + y[1] * y[1]) + (y[2] * y[2] + y[3] * y[3]); \
                        else { const int r = 128 * ai + 64 * wr + 16 * (M) + fr; const int tok = CTX ? r : CTXL + ((u.pm & 7) * 256 + r); \
                            if (tens < 2) { const f32x4 ps = *(const LAS f32x4*)(part + r * 8 + bj * 4); const float rs = rsqrtf((ps[0] + ps[1]) + (ps[2] + ps[3]) + EPS); y = y * rs; } \
                            u32x2 w; w.x = cvt_pk_bf16(y[0], y[1]); w.y = cvt_pk_bf16(y[2], y[3]); \
                            if (tens == 0) *(u32x2*)(E1_QN + ((size_t)bh * NTOK + tok) * HD + ch) = w; \
                            if (tens == 1) *(u32x2*)(E1_KN + ((size_t)bh * NTOK + tok) * HD + ch) = w; \
                            if (tens >= 1) { bf16_t* T = (tens == 1 ? E1_KT : E1_VT) + ((size_t)bh * HD + ch) * NTOK + tok; \
                                T[0] = (bf16_t)(w.x & 0xffffu); T[NTOK] = (bf16_t)(w.x >> 16); T[2 * NTOK] = (bf16_t)(w.y & 0xffffu); T[3 * NTOK] = (bf16_t)(w.y >> 16); } } \
                        } while (0)
                        E1_ROW(0); E1_ROW(1); E1_ROW(2); E1_ROW(3);
                        asm volatile("" ::: "memory"); __builtin_amdgcn_sched_barrier(0);
#undef E1_ROW
                    }
                    if (pass == 0) {
#pragma unroll
                        for (int m = 0; m < 4; ++m) { float t = ss[m]; t += __shfl_xor(t, 16); t += __shfl_xor(t, 32);
                            if (fq == 0) part[(128 * ai + 64 * wr + 16 * m + fr) * 8 + bj * 4 + wc] = t; } }
                }
            if (pass == 0) { asm volatile("s_waitcnt lgkmcnt(0)" ::: "memory"); __builtin_amdgcn_s_barrier(); asm volatile("" ::: "memory"); }
        }
    }
    __device__ __forceinline__ void operator()(const AccT& acc, const pg8::Unit& u, int wr, int wc, int fr_in, int fq_in) const {
        int fr = fr_in, fq = fq_in; asm volatile("" : "+v"(fr), "+v"(fq));
        const int row0 = u.pm * 256 + wr * 64 + fr;
        if (u.pn < 24) { qkv(u.pm >= 32, acc, u, wr, wc, fr, fq); }
        else if (u.pn < 32) {
            const int col0 = (u.pn - 24) * 256 + wc * 32 + 8 * fq;
#pragma unroll
            for (int ai = 0; ai < 2; ++ai)
#pragma unroll
                for (int m = 0; m < 4; ++m) { bf16_t* rowp = E1_ZA + (size_t)(row0 + ai * 128 + m * 16) * 2048 + col0;
#pragma unroll
                    for (int bj = 0; bj < 2; ++bj) { f32x4 v0 = acc[ai][bj][m][0], v1 = acc[ai][bj][m][1];
#pragma unroll
                        for (int j = 0; j < 4; ++j) { v0[j] = silu_f(v0[j]); v1[j] = silu_f(v1[j]); }
                        u32x4 w; w.x = cvt_pk_bf16(v0[0], v0[1]); w.y = cvt_pk_bf16(v0[2], v0[3]); w.z = cvt_pk_bf16(v1[0], v1[1]); w.w = cvt_pk_bf16(v1[2], v1[3]);
                        *(u32x4*)(rowp + bj * 128) = w; } }
        } else if (u.pn < 64) {
            const int lane = 16 * fq + fr;
            const int ch0 = 64 * (u.pn - 32) + 16 * wc + 4 * fq;
            const f32x4 cw0 = *(const f32x4*)(convb + ch0), cw1 = *(const f32x4*)(convb + 2048 + ch0), cw2 = *(const f32x4*)(convb + 4096 + ch0);
#pragma unroll
            for (int ai = 0; ai < 2; ++ai) {
                f32x4 pr[4];
#pragma unroll
                for (int m = 0; m < 4; ++m) pr[m] = acc[ai][0][m][1] * acc[ai][1][m][0];
#pragma unroll
                for (int m = 0; m < 4; ++m) { f32x4 y;
#pragma unroll
                    for (int j = 0; j < 4; ++j) {
                        const float bp = m > 0 ? dpp_ror1(pr[m > 0 ? m - 1 : 0][j]) : 0.f;
                        const float bn = m < 3 ? dpp_ror15(pr[m < 3 ? m + 1 : 3][j]) : 0.f;
                        const float up = dpp_shr1(pr[m][j], bp), dn = dpp_shl1(pr[m][j], bn);
                        const float cv = cw0[j] * up + cw1[j] * pr[m][j] + cw2[j] * dn;
                        y[j] = acc[ai][0][m][0][j] * cv * silu_f(acc[ai][1][m][1][j]); }
                    u32x2 w; w.x = cvt_pk_bf16(y[0], y[1]); w.y = cvt_pk_bf16(y[2], y[3]);
                    *(u32x2*)(E1_Y + (size_t)(row0 + ai * 128 + m * 16) * 4096 + 2048 + ch0) = w; } }
        } else {
            if (wc < 2) {
#pragma unroll
                for (int ai = 0; ai < 2; ++ai)
#pragma unroll
                    for (int m = 0; m < 4; ++m)
#pragma unroll
                        for (int n = 0; n < 2; ++n) *(f32x4*)((float*)(wsb + WS_AB) + (size_t)(row0 + ai * 128 + m * 16) * 64 + 32 * wc + 8 * fq + 4 * n) = acc[ai][0][m][n]; }
        }
    } };
struct EpiResid { static constexpr bool PERM = false;
    const float* resid; float* out; const float* gate;
    __device__ __forceinline__ void operator()(const AccT& acc, const pg8::Unit& u, int wr, int wc, int fr, int fq) const {
        const int row0 = u.pm * 256 + wr * 64 + fr, col0 = u.pn * 256 + wc * 32 + 4 * fq; const float* g = gate + (size_t)(u.pm >> 3) * 6144;
        f32x4 gv[2][2];
#pragma unroll
        for (int bj = 0; bj < 2; ++bj)
#pragma unroll
            for (int n = 0; n < 2; ++n) gv[bj][n] = *(const f32x4*)(g + col0 + bj * 128 + n * 16);
#pragma unroll
        for (int ai = 0; ai < 2; ++ai)
#pragma unroll
            for (int m = 0; m < 4; ++m) { const size_t off = (size_t)(row0 + ai * 128 + m * 16) * DM + col0;
#pragma unroll
                for (int bj = 0; bj < 2; ++bj)
#pragma unroll
                    for (int n = 0; n < 2; ++n) { const f32x4 r = *(const f32x4*)(resid + off + bj * 128 + n * 16); *(f32x4*)(out + off + bj * 128 + n * 16) = r + gv[bj][n] * acc[ai][bj][m][n]; }
                asm volatile("" ::: "memory"); }
    } };
struct Epi3 { static constexpr bool PERM = true;
    bf16_t* P1;
    __device__ __forceinline__ void operator()(const AccT& acc, const pg8::Unit& u, int wr, int wc, int fr, int fq) const {
        const int row0 = u.pm * 256 + wr * 64 + fr, col0 = u.pn * 256 + wc * 32 + 8 * fq;
        const int act = u.pn < 16 ? 1 : ((u.pn >= 24 && u.pn < 32) ? 0 : 2);
#pragma unroll
        for (int ai = 0; ai < 2; ++ai)
#pragma unroll
            for (int m = 0; m < 4; ++m) { bf16_t* rowp = P1 + (size_t)(row0 + ai * 128 + m * 16) * N3 + col0;
#pragma unroll
                for (int bj = 0; bj < 2; ++bj) { f32x4 v0 = acc[ai][bj][m][0], v1 = acc[ai][bj][m][1];
                    if (act == 1) {
#pragma unroll
                        for (int j = 0; j < 4; ++j) { v0[j] = gelu_f(v0[j]); v1[j] = gelu_f(v1[j]); } }
                    else if (act == 2) {
#pragma unroll
                        for (int j = 0; j < 4; ++j) { v0[j] = silu_f(v0[j]); v1[j] = silu_f(v1[j]); } }
                    u32x4 w; w.x = cvt_pk_bf16(v0[0], v0[1]); w.y = cvt_pk_bf16(v0[2], v0[3]); w.z = cvt_pk_bf16(v1[0], v1[1]); w.w = cvt_pk_bf16(v1[2], v1[3]);
                    *(u32x4*)(rowp + bj * 128) = w; } }
    } };
struct SchedPool { int G, c; const char* A; const char* B;
    __device__ __forceinline__ bool next(int i, pg8::Unit& u) const {
        const int L = i * G + c; if (L >= 256) return false;
        u.aux = L >> 6; u.pn = (L >> 5) & 1; u.pm = L & 31;
        u.a = A + ((size_t)u.pm * 256 * 2048 + 512 * u.aux) * 2; u.b = B + ((size_t)u.aux * 512 * 512 + (size_t)u.pn * 256 * 512) * 2; return true; } };
struct EpiPool { static constexpr bool PERM = true;
    const bf16_t* P1; bf16_t* Y2; const float* pscale;
    __device__ __forceinline__ void operator()(const AccT& acc, const pg8::Unit& u, int wr, int wc, int fr, int fq) const {
        const int row0 = u.pm * 256 + wr * 64 + fr, colg = 512 * u.aux + 256 * u.pn + wc * 32 + 8 * fq;
        f32x4 ps[2][2];
#pragma unroll
        for (int bj = 0; bj < 2; ++bj)
#pragma unroll
            for (int n = 0; n < 2; ++n) ps[bj][n] = *(const f32x4*)(pscale + colg + bj * 128 + 4 * n);
#pragma unroll
        for (int ai = 0; ai < 2; ++ai)
#pragma unroll
            for (int m = 0; m < 4; ++m) { const size_t row = (size_t)(row0 + ai * 128 + m * 16);
#pragma unroll
                for (int bj = 0; bj < 2; ++bj) { const u32x4 z = *(const u32x4*)(P1 + row * N3 + 8192 + colg + bj * 128);
                    f32x4 v0 = acc[ai][bj][m][0] * ps[bj][0], v1 = acc[ai][bj][m][1] * ps[bj][1]; if (ABLATE & 8) { v0 = v0 * 0.f; v1 = v1 * 0.f; }
                    u32x4 w; w.x = cvt_pk_bf16(v0[0] * bf_lo(z.x), v0[1] * bf_hi(z.x)); w.y = cvt_pk_bf16(v0[2] * bf_lo(z.y), v0[3] * bf_hi(z.y));
                    w.z = cvt_pk_bf16(v1[0] * bf_lo(z.z), v1[1] * bf_hi(z.z)); w.w = cvt_pk_bf16(v1[2] * bf_lo(z.w), v1[3] * bf_hi(z.w));
                    *(u32x4*)(Y2 + row * 4096 + 2048 + colg + bj * 128) = w; } }
    } };

__device__ __forceinline__ void qkv_task(int task, const bf16_t* PQKV, const float* convw, bf16_t* QN, bf16_t* KN, bf16_t* KT, bf16_t* VT, int lane) {
    const int head = task & 15, tens = (task >> 4) % 3, blk = task / 48;
    int b, t0, prow0, tokb; bool isx;
    if (blk < 128) { isx = true; b = blk >> 5; t0 = (blk & 31) * 64; prow0 = b * SEQ + t0; tokb = CTXL + t0; }
    else { isx = false; const int cb = blk - 128; b = cb >> 2; t0 = (cb & 3) * 64; prow0 = MX + b * CTXL + t0; tokb = t0; }
    const int col = tens * 2048 + head * 128 + 2 * lane;
    const f32x2 w0 = *(const f32x2*)(convw + col), w1 = *(const f32x2*)(convw + 6144 + col), w2 = *(const f32x2*)(convw + 12288 + col);
    const bf16_t* p = PQKV + (size_t)prow0 * 6144 + col;
    const int bh = b * NHD + head;
    unsigned v[66];
    v[0] = 0u; v[65] = 0u;
    if (!isx && t0 > 0) v[0] = *(const unsigned*)(p - 6144);
    if (!isx && t0 < 192) v[65] = *(const unsigned*)(p + (size_t)64 * 6144);
#pragma unroll
    for (int i = 0; i < 64; ++i) v[i + 1] = *(const unsigned*)(p + (size_t)i * 6144);
    unsigned tr0[4], tr1[4];
    float hold0 = 0.f, hold1 = 0.f;
#pragma unroll
    for (int i = 0; i < 64; ++i) {
        const unsigned pv = v[i], cu = v[i + 1], nx = v[i + 2];
        float o0 = w0.x * bf_lo(pv) + w1.x * bf_lo(cu) + w2.x * bf_lo(nx);
        float o1 = w0.y * bf_hi(pv) + w1.y * bf_hi(cu) + w2.y * bf_hi(nx);
        o0 = silu_f(o0); o1 = silu_f(o1);
        if (tens < 2) { const float ss = wave_sum(o0 * o0 + o1 * o1); const float sc = rsqrtf(ss + EPS); o0 *= sc; o1 *= sc; }
        const int tok = tokb + i;
        if (tens == 0) *(unsigned*)(QN + ((size_t)bh * NTOK + tok) * HD + 2 * lane) = cvt_pk_bf16(o0, o1);
        if (tens == 1) *(unsigned*)(KN + ((size_t)bh * NTOK + tok) * HD + 2 * lane) = cvt_pk_bf16(o0, o1);
        if (tens >= 1) {
            if (i & 1) { tr0[(i >> 1) & 3] = cvt_pk_bf16(hold0, o0); tr1[(i >> 1) & 3] = cvt_pk_bf16(hold1, o1); } else { hold0 = o0; hold1 = o1; }
            if ((i & 7) == 7) { bf16_t* T = (tens == 1 ? KT : VT) + ((size_t)bh * HD + 2 * lane) * NTOK + tok - 7;
                *(u32x4*)T = (u32x4){tr0[0], tr0[1], tr0[2], tr0[3]}; *(u32x4*)(T + NTOK) = (u32x4){tr1[0], tr1[1], tr1[2], tr1[3]}; } }
    }
}
__device__ __forceinline__ void ab_task(int blk, const float* AB, const float* alog, const float* dtb, float* GG, float* BETA, int lane) {
    int b, prow0, tokb;
    if (blk < 128) { b = blk >> 5; const int t0 = (blk & 31) * 64; prow0 = b * SEQ + t0; tokb = CTXL + t0; }
    else { const int cb = blk - 128; b = cb >> 2; const int t0 = (cb & 3) * 64; prow0 = MX + b * CTXL + t0; tokb = t0; }
    const int kind = lane >> 4, h = lane & 15, d = kind & 1;
    const float A = __expf(alog[d * 16 + h]), db = dtb[d * 16 + h];
    float* dst = (kind < 2 ? GG : BETA) + ((size_t)d * NBH + b * NHD + h) * NTOK + tokb;
#pragma unroll 4
    for (int i = 0; i < 64; ++i) { const float v = AB[(size_t)(prow0 + i) * 64 + lane];
        dst[i] = kind < 2 ? -A * softplus_f(v + db) : sigmoid_f(v); }
}

template <int I> struct FS {
    static __device__ __forceinline__ void run(const LAS float* Ml, float (&Tc)[64], int lane) {
        float a = (lane == I) ? 1.f : 0.f;
#pragma unroll
        for (int jq = 0; jq < (I + 3) / 4; ++jq) { const f32x4 mv = *(const LAS f32x4*)(Ml + I * 68 + 4 * jq);
#pragma unroll
            for (int e = 0; e < 4; ++e) if (4 * jq + e < I) a = fmaf(-mv[e], Tc[4 * jq + e], a); }
        Tc[I] = a;
        __builtin_amdgcn_sched_barrier(0);
        if constexpr (I + 1 < 64) FS<I + 1>::run(Ml, Tc, lane);
    } };
__device__ __forceinline__ void chunk_task(int task, const bf16_t* QN, const bf16_t* KN, const float* AB, const float* alog, const float* dtb, float* GC, bf16_t* TU, bf16_t* AI, LAS float* tab, int lane) {
    const int tc = task % NCH, bh = (task / NCH) & 63, dir = task / (NCH * 64);
    const int tok0 = 64 * tc;
    LAS float* Ml = tab + 128;
    const int mytok = tok0 + (dir ? 63 - lane : lane);
    const size_t gidx = ((size_t)dir * NBH + bh) * NTOK + mytok;
    const int hq = bh & 15, bq = bh >> 4;
    const float* abr = AB + (size_t)(mytok < CTXL ? MX + bq * CTXL + mytok : bq * SEQ + (mytok - CTXL)) * 64;
    const float gl = -__expf(alog[dir * 16 + hq]) * softplus_f(abr[dir * 16 + hq] + dtb[dir * 16 + hq]), bl = sigmoid_f(abr[32 + dir * 16 + hq]);
    float gc = gl;
#pragma unroll
    for (int o = 1; o < 64; o <<= 1) { const float t = __shfl_up(gc, o); if (lane >= o) gc += t; }
    GC[gidx] = gc;
    tab[lane] = gc; tab[64 + lane] = bl;
    LDS_WAIT(); asm volatile("" ::: "memory");
    const int r = lane & 31, hh = lane >> 5;
    bf16x8 ka[2][8];
#pragma unroll
    for (int ib = 0; ib < 2; ++ib) { const int tk = tok0 + (dir ? 63 - (32 * ib + r) : 32 * ib + r); const bf16x8* kp = (const bf16x8*)(KN + ((size_t)bh * NTOK + tk) * HD + 8 * hh);
#pragma unroll
        for (int s = 0; s < 8; ++s) ka[ib][s] = kp[2 * s]; }
    const bool isx = tc >= 4;
    bf16_t* aib = AI + (((size_t)dir * NBH + bh) * NCH + tc) * 4096;
    if (isx) {
#pragma unroll
        for (int ib = 0; ib < 2; ++ib) {
            bf16x8 qa[8]; { const int tk = tok0 + (dir ? 63 - (32 * ib + r) : 32 * ib + r); const bf16x8* qp = (const bf16x8*)(QN + ((size_t)bh * NTOK + tk) * HD + 8 * hh);
#pragma unroll
                for (int s = 0; s < 8; ++s) qa[s] = qp[2 * s]; }
#pragma unroll
            for (int jb = 0; jb < 2; ++jb) {
                f32x16 a = {};
                if (jb <= ib) {
#pragma unroll
                    for (int s = 0; s < 8; ++s) a = __builtin_amdgcn_mfma_f32_32x32x16_bf16(qa[s], ka[jb][s], a, 0, 0, 0); }
                const int jp = 32 * jb + r; const float gcj = tab[jp];
                bf16_t vv[16];
#pragma unroll
                for (int g = 0; g < 4; ++g) { const f32x4 gci = *(const LAS f32x4*)(tab + 32 * ib + 8 * g + 4 * hh);
#pragma unroll
                    for (int e = 0; e < 4; ++e) { const int ip = 32 * ib + 8 * g + 4 * hh + e;
                        vv[4 * g + e] = f2bf((jp <= ip) ? 0.08838834764831845f * a[4 * g + e] * __expf(gci[e] - gcj) : 0.f); } }
                if (dir == 0) { bf16_t* bp = aib + (32 * ib + 4 * hh) * 64 + jp;
#pragma unroll
                    for (int e = 0; e < 16; ++e) bp[((e & 3) + 8 * (e >> 2)) * 64] = vv[e]; }
                else { bf16_t* bp = aib + (63 - 32 * ib - 4 * hh) * 64 + (63 - jp);
#pragma unroll
                    for (int e = 0; e < 16; ++e) bp[-((e & 3) + 8 * (e >> 2)) * 64] = vv[e]; } } }
    }
    f32x16 Mt[3];
#pragma unroll
    for (int t = 0; t < 3; ++t) { const int ib = t > 0, jb = t > 1; f32x16 a = {};
#pragma unroll
        for (int s = 0; s < 8; ++s) a = __builtin_amdgcn_mfma_f32_32x32x16_bf16(ka[ib][s], ka[jb][s], a, 0, 0, 0);
        Mt[t] = a; }
    LAS float* Mlb = Ml + 4 * hh * 68 + r;
#pragma unroll
    for (int t = 0; t < 3; ++t) { const int ib = t > 0, jb = t > 1; const int jp = 32 * jb + r; const float gcj = tab[jp];
#pragma unroll
        for (int g = 0; g < 4; ++g) { const f32x4 gci = *(const LAS f32x4*)(tab + 32 * ib + 8 * g + 4 * hh), bi = *(const LAS f32x4*)(tab + 64 + 32 * ib + 8 * g + 4 * hh);
#pragma unroll
            for (int e = 0; e < 4; ++e) { const int ip = 32 * ib + 8 * g + 4 * hh + e;
                Mt[t][4 * g + e] = (jp < ip) ? bi[e] * Mt[t][4 * g + e] * __expf(gci[e] - gcj) : 0.f;
                Mlb[(32 * ib + 8 * g + e) * 68 + 32 * jb] = Mt[t][4 * g + e]; } } }
    LDS_WAIT(); asm volatile("" ::: "memory");
    float Tc[64];
    FS<0>::run(Ml, Tc, lane);
    bf16_t* tub = TU + (((size_t)dir * NBH + bh) * NCH + tc) * 4096;
    if (dir == 0) { bf16_t* bp = tub + lane;
#pragma unroll
        for (int i = 0; i < 64; ++i) bp[i * 64] = f2bf(Tc[i] * bl); }
    else { bf16_t* bp = tub + 63 * 64 + (63 - lane);
#pragma unroll
        for (int i = 0; i < 64; ++i) bp[-i * 64] = f2bf(Tc[i] * bl); }
    LDS_WAIT(); asm volatile("" ::: "memory");
}

constexpr int G_KT = 0, G_VT = 36864, G_TU = 55296, G_W = 73728, G_ST = 91136, G_VN = 108544, G_VNG = 117760, G_TAB = 126976;
__device__ __forceinline__ f32x16 mma_tile(f32x16 acc, const LAS bf16_t* A, int lda, const LAS bf16_t* B, int ldb, int ksteps, int lane) {
    const LAS bf16_t* ap = A + (lane & 31) * lda + 8 * (lane >> 5); const LAS bf16_t* bp = B + (lane & 31) * ldb + 8 * (lane >> 5);
    for (int s = 0; s < ksteps; ++s) acc = __builtin_amdgcn_mfma_f32_32x32x16_bf16(*(const LAS bf16x8*)(ap + 16 * s), *(const LAS bf16x8*)(bp + 16 * s), acc, 0, 0, 0);
    return acc;
}
__device__ __forceinline__ void scan_chain(int chain, LAS unsigned char* lds, const bf16_t* QN, const bf16_t* KT, const bf16_t* VT, const bf16_t* TU, const bf16_t* AI, const float* GC, bf16_t* OF, bf16_t* OB) {
    const int tid = threadIdx.x, wave = __builtin_amdgcn_readfirstlane(tid >> 6), lane = tid & 63;
    const int half = chain & 1, bh = (chain >> 1) & 63, dir = chain >> 7, b = bh >> 4, h = bh & 15;
    LAS bf16_t* Ws = (LAS bf16_t*)(lds + G_W); LAS bf16_t* STs = (LAS bf16_t*)(lds + G_ST); LAS bf16_t* VNs = (LAS bf16_t*)(lds + G_VN); LAS bf16_t* VNGs = (LAS bf16_t*)(lds + G_VNG);
    for (int i = tid; i < 17408 / 4; i += 512) ((LAS unsigned*)STs)[i] = 0u;
    f32x16 Sacc = {};
    bf16_t* Od = dir ? OB : OF;
    const int c = lane & 31, hh = lane >> 5;
    const int sr = tid >> 3, sc8 = (tid & 7) * 8;
    const int kbw = wave & 3, tbw = wave >> 2;
    const int tb2 = (wave >> 1) & 1, db2 = wave & 1;
    u32x4 rk0, rk1, rv, rt; float rg = 0.f, rgl = 0.f;
#define SC_TC(st) (dir == 0 ? (st) : ((st) < 4 ? 3 - (st) : 39 - (st)))
#define SC_GLOAD(st) do { const int tc_ = SC_TC(st), tok0_ = 64 * tc_; \
        rk0 = *(const u32x4*)(KT + ((size_t)bh * HD + sr) * NTOK + tok0_ + sc8); rk1 = *(const u32x4*)(KT + ((size_t)bh * HD + 64 + sr) * NTOK + tok0_ + sc8); \
        rv = *(const u32x4*)(VT + ((size_t)bh * HD + 64 * half + sr) * NTOK + tok0_ + sc8); rt = *(const u32x4*)(TU + (((size_t)dir * NBH + bh) * NCH + tc_) * 4096 + sr * 64 + sc8); \
        if (tid < 64) { const float* gp_ = GC + ((size_t)dir * NBH + bh) * NTOK + tok0_; rg = gp_[tid]; rgl = gp_[dir ? 0 : 63]; } } while (0)
#define SC_LSTORE(p) do { LAS bf16_t* kt_ = (LAS bf16_t*)(lds + G_KT + (p) * 18432); \
        *(LAS u32x4*)(kt_ + sr * 72 + sc8) = rk0; *(LAS u32x4*)(kt_ + (64 + sr) * 72 + sc8) = rk1; \
        *(LAS u32x4*)((LAS bf16_t*)(lds + G_VT + (p) * 9216) + sr * 72 + sc8) = rv; *(LAS u32x4*)((LAS bf16_t*)(lds + G_TU + (p) * 9216) + sr * 72 + sc8) = rt; \
        if (tid < 64) { LAS float* tb_ = (LAS float*)(lds + G_TAB + (p) * 544); tb_[tid] = __expf(rg); tb_[64 + tid] = __expf(rgl - rg); if (tid == 0) tb_[128] = __expf(rgl); } } while (0)
#define SC_W(p) do { const LAS bf16_t* ap_ = (const LAS bf16_t*)(lds + G_KT + (p) * 18432) + (32 * kbw + c) * 72 + 8 * hh; const LAS bf16_t* bp_ = (const LAS bf16_t*)(lds + G_TU + (p) * 9216) + (32 * tbw + c) * 72 + 8 * hh; \
        const LAS float* tb_ = (const LAS float*)(lds + G_TAB + (p) * 544); f32x16 a_ = {}; \
        _Pragma("unroll") for (int s_ = 0; s_ < 4; ++s_) { const bf16x8 av_ = *(const LAS bf16x8*)(ap_ + 16 * s_); const u32x4 bu_ = *(const LAS u32x4*)(bp_ + 16 * s_); \
            const f32x4 e0_ = *(const LAS f32x4*)(tb_ + 16 * s_ + 8 * hh), e1_ = *(const LAS f32x4*)(tb_ + 16 * s_ + 8 * hh + 4); u32x4 bs_; \
            bs_.x = cvt_pk_bf16(bf_lo(bu_.x) * e0_[0], bf_hi(bu_.x) * e0_[1]); bs_.y = cvt_pk_bf16(bf_lo(bu_.y) * e0_[2], bf_hi(bu_.y) * e0_[3]); \
            bs_.z = cvt_pk_bf16(bf_lo(bu_.z) * e1_[0], bf_hi(bu_.z) * e1_[1]); bs_.w = cvt_pk_bf16(bf_lo(bu_.w) * e1_[2], bf_hi(bu_.w) * e1_[3]); \
            a_ = __builtin_amdgcn_mfma_f32_32x32x16_bf16(av_, __builtin_bit_cast(bf16x8, bs_), a_, 0, 0, 0); } \
        _Pragma("unroll") for (int g_ = 0; g_ < 4; ++g_) { u32x2 w_; w_.x = cvt_pk_bf16(-a_[4 * g_], -a_[4 * g_ + 1]); w_.y = cvt_pk_bf16(-a_[4 * g_ + 2], -a_[4 * g_ + 3]); \
            *(LAS u32x2*)(Ws + (32 * tbw + c) * 136 + 32 * kbw + 8 * g_ + 4 * hh) = w_; } } while (0)
    SC_GLOAD(0);
    __syncthreads();
    SC_LSTORE(0);
    SC_GLOAD(1);
    __syncthreads();
    SC_W(0);
    bf16x8 qf[8], af[4];
#pragma unroll
    for (int s = 0; s < 8; ++s) qf[s] = (bf16x8){0, 0, 0, 0, 0, 0, 0, 0};
#pragma unroll
    for (int s = 0; s < 4; ++s) af[s] = (bf16x8){0, 0, 0, 0, 0, 0, 0, 0};
    if (wave >= 4 && SC_TC(0) >= 4) { const bf16x8* qp = (const bf16x8*)(QN + ((size_t)bh * NTOK + 64 * SC_TC(0) + 32 * tb2 + c) * HD + 8 * hh);
#pragma unroll
        for (int s = 0; s < 8; ++s) qf[s] = qp[2 * s];
        const bf16x8* ap = (const bf16x8*)(AI + (((size_t)dir * NBH + bh) * NCH + SC_TC(0)) * 4096 + (32 * tb2 + c) * 64 + 8 * hh);
#pragma unroll
        for (int s = 0; s < 4; ++s) af[s] = ap[2 * s]; }
    __syncthreads();
    for (int step = 0; step < NCH; ++step) {
        const int p = step & 1, tc = SC_TC(step), tok0 = 64 * tc; const bool isx = tc >= 4;
        const LAS float* tab = (const LAS float*)(lds + G_TAB + p * 544);
        if (step + 1 < NCH) SC_LSTORE(p ^ 1);
        if (step + 2 < NCH) SC_GLOAD(step + 2);
        f32x16 oacc = {};
        if (wave < 4) {
            f32x16 a = {};
            a = mma_tile(a, (const LAS bf16_t*)(lds + G_TU + p * 9216) + 32 * tb2 * 72, 72, (const LAS bf16_t*)(lds + G_VT + p * 9216) + 32 * db2 * 72, 72, 4, lane);
            a = mma_tile(a, Ws + 32 * tb2 * 136, 136, STs + 32 * db2 * 136, 136, 8, lane);
#pragma unroll
            for (int g = 0; g < 4; ++g) { const f32x4 sc = *(const LAS f32x4*)(tab + 64 + 32 * tb2 + 8 * g + 4 * hh);
                u32x2 w, wg; w.x = cvt_pk_bf16(a[4 * g], a[4 * g + 1]); w.y = cvt_pk_bf16(a[4 * g + 2], a[4 * g + 3]);
                wg.x = cvt_pk_bf16(a[4 * g] * sc[0], a[4 * g + 1] * sc[1]); wg.y = cvt_pk_bf16(a[4 * g + 2] * sc[2], a[4 * g + 3] * sc[3]);
                *(LAS u32x2*)(VNs + (32 * db2 + c) * 72 + 32 * tb2 + 8 * g + 4 * hh) = w; *(LAS u32x2*)(VNGs + (32 * db2 + c) * 72 + 32 * tb2 + 8 * g + 4 * hh) = wg; }
        } else if (isx) {
            const LAS bf16_t* bp = STs + (32 * db2 + c) * 136 + 8 * hh;
#pragma unroll
            for (int s = 0; s < 8; ++s) oacc = __builtin_amdgcn_mfma_f32_32x32x16_bf16(qf[s], *(const LAS bf16x8*)(bp + 16 * s), oacc, 0, 0, 0);
#pragma unroll
            for (int g = 0; g < 4; ++g) { const f32x4 sc = *(const LAS f32x4*)(tab + 32 * tb2 + 8 * g + 4 * hh);
#pragma unroll
                for (int e = 0; e < 4; ++e) oacc[4 * g + e] *= 0.08838834764831845f * sc[e]; }
        }
        if (wave >= 4 && step + 1 < NCH && SC_TC(step + 1) >= 4) { const bf16x8* qp = (const bf16x8*)(QN + ((size_t)bh * NTOK + 64 * SC_TC(step + 1) + 32 * tb2 + c) * HD + 8 * hh);
#pragma unroll
            for (int s = 0; s < 8; ++s) qf[s] = qp[2 * s]; }
        __syncthreads();
        {
            const int kb = wave & 3, db = wave >> 2; const float egl = tab[128];
#pragma unroll
            for (int e = 0; e < 16; ++e) Sacc[e] *= egl;
            Sacc = mma_tile(Sacc, (const LAS bf16_t*)(lds + G_KT + p * 18432) + 32 * kb * 72, 72, VNGs + 32 * db * 72, 72, 4, lane);
#pragma unroll
            for (int g = 0; g < 4; ++g) { u32x2 w; w.x = cvt_pk_bf16(Sacc[4 * g], Sacc[4 * g + 1]); w.y = cvt_pk_bf16(Sacc[4 * g + 2], Sacc[4 * g + 3]);
                *(LAS u32x2*)(STs + (32 * db + c) * 136 + 32 * kb + 8 * g + 4 * hh) = w; }
        }
        if (step + 1 < NCH) SC_W(p ^ 1);
        if (wave >= 4 && isx) {
            const LAS bf16_t* bp = VNs + (32 * db2 + c) * 72 + 8 * hh;
#pragma unroll
            for (int s = 0; s < 4; ++s) oacc = __builtin_amdgcn_mfma_f32_32x32x16_bf16(af[s], *(const LAS bf16x8*)(bp + 16 * s), oacc, 0, 0, 0);
            bf16_t* op = Od + ((size_t)b * SEQ + (tok0 - CTXL) + 32 * tb2) * DM + h * HD + 64 * half + 32 * db2 + c;
#pragma unroll
            for (int e = 0; e < 16; ++e) { const int t = (e & 3) + 8 * (e >> 2) + 4 * hh; op[(size_t)t * DM] = f2bf(oacc[e]); }
        }
        if (wave >= 4 && step + 1 < NCH && SC_TC(step + 1) >= 4) { const bf16x8* ap = (const bf16x8*)(AI + (((size_t)dir * NBH + bh) * NCH + SC_TC(step + 1)) * 4096 + (32 * tb2 + c) * 64 + 8 * hh);
#pragma unroll
            for (int s = 0; s < 4; ++s) af[s] = ap[2 * s]; }
        __syncthreads();
    }
#undef SC_TC
#undef SC_GLOAD
#undef SC_LSTORE
#undef SC_W
}

#ifndef DBG_THR
#define DBG_THR 1000.f
#endif
__device__ __forceinline__ void finish_row(int row, const bf16_t* OF, const bf16_t* OB, const bf16_t* ZA, const float* hn, bf16_t* Y, int lane, unsigned* dbgh) {
    const f32x4 h0 = *(const f32x4*)(hn + 8 * (lane & 15)), h1 = *(const f32x4*)(hn + 8 * (lane & 15) + 4);
#pragma unroll
    for (int it = 0; it < 4; ++it) {
        const size_t off = (size_t)row * DM + it * 512 + lane * 8;
        const u32x4 a_ = *(const u32x4*)(OF + off), bq_ = *(const u32x4*)(OB + off), z = *(const u32x4*)(ZA + off);
        u32x4 a = a_, bq = bq_; if (ABLATE & 16) bq = (u32x4){0u, 0u, 0u, 0u}; if (ABLATE & 32) a = (u32x4){0u, 0u, 0u, 0u};
        float o[8] = {bf_lo(a.x) + bf_lo(bq.x), bf_hi(a.x) + bf_hi(bq.x), bf_lo(a.y) + bf_lo(bq.y), bf_hi(a.y) + bf_hi(bq.y), bf_lo(a.z) + bf_lo(bq.z), bf_hi(a.z) + bf_hi(bq.z), bf_lo(a.w) + bf_lo(bq.w), bf_hi(a.w) + bf_hi(bq.w)};
#if MK_DEBUG
        { float mb = 0.f, mf = 0.f; const float ofx[8] = {bf_lo(a.x), bf_hi(a.x), bf_lo(a.y), bf_hi(a.y), bf_lo(a.z), bf_hi(a.z), bf_lo(a.w), bf_hi(a.w)};
          const float obx[8] = {bf_lo(bq.x), bf_hi(bq.x), bf_lo(bq.y), bf_hi(bq.y), bf_lo(bq.z), bf_hi(bq.z), bf_lo(bq.w), bf_hi(bq.w)};
#pragma unroll
          for (int e = 0; e < 8; ++e) { mb = fmaxf(mb, fabsf(obx[e])); mf = fmaxf(mf, fabsf(ofx[e])); }
          const int bhq = (row / SEQ) * 16 + it * 4 + (lane >> 4);
          if (mb > DBG_THR) dbgh[bhq] = 1u; if (mf > DBG_THR) dbgh[64 + bhq] = 1u; }
#endif
        if (ABLATE & 128) { const float of_[8] = {bf_lo(a.x), bf_hi(a.x), bf_lo(a.y), bf_hi(a.y), bf_lo(a.z), bf_hi(a.z), bf_lo(a.w), bf_hi(a.w)};
            const float ob_[8] = {bf_lo(bq.x), bf_hi(bq.x), bf_lo(bq.y), bf_hi(bq.y), bf_lo(bq.z), bf_hi(bq.z), bf_lo(bq.w), bf_hi(bq.w)};
#pragma unroll
            for (int e = 0; e < 8; ++e) o[e] = of_[e] + ob_[e] * (1.f / 4096.f); }
        float ss = 0.f;
#pragma unroll
        for (int e = 0; e < 8; ++e) ss += o[e] * o[e];
        ss += __shfl_xor(ss, 1); ss += __shfl_xor(ss, 2); ss += __shfl_xor(ss, 4); ss += __shfl_xor(ss, 8);
        const float rs = rsqrtf(ss * (1.f / HD) + EPS);
        const float zf[8] = {bf_lo(z.x), bf_hi(z.x), bf_lo(z.y), bf_hi(z.y), bf_lo(z.z), bf_hi(z.z), bf_lo(z.w), bf_hi(z.w)};
        const float hv[8] = {h0[0], h0[1], h0[2], h0[3], h1[0], h1[1], h1[2], h1[3]};
        float y[8];
#pragma unroll
        for (int e = 0; e < 8; ++e) { y[e] = o[e] * rs * hv[e] * zf[e]; if (ABLATE & 1) y[e] = 0.f; }
        u32x4 w; w.x = cvt_pk_bf16(y[0], y[1]); w.y = cvt_pk_bf16(y[2], y[3]); w.z = cvt_pk_bf16(y[4], y[5]); w.w = cvt_pk_bf16(y[6], y[7]);
        *(u32x4*)(Y + (size_t)row * 4096 + it * 512 + lane * 8) = w;
    }
}

__device__ __forceinline__ void stats_row(int row, const bf16_t* P1, float* STATS, int lane) {
    const bf16_t* p = P1 + (size_t)row * N3 + 2048;
    float v[32]; float s = 0.f;
#pragma unroll
    for (int j = 0; j < 4; ++j) { const u32x4 a = *(const u32x4*)(p + j * 512 + lane * 8);
        v[8 * j] = bf_lo(a.x); v[8 * j + 1] = bf_hi(a.x); v[8 * j + 2] = bf_lo(a.y); v[8 * j + 3] = bf_hi(a.y); v[8 * j + 4] = bf_lo(a.z); v[8 * j + 5] = bf_hi(a.z); v[8 * j + 6] = bf_lo(a.w); v[8 * j + 7] = bf_hi(a.w); }
#pragma unroll
    for (int e = 0; e < 32; ++e) s += v[e];
    const float mu = wave_sum(s) * (1.f / DM); float q = 0.f;
#pragma unroll
    for (int e = 0; e < 32; ++e) { const float d = v[e] - mu; q += d * d; }
    const float rstd = rsqrtf(wave_sum(q) * (1.f / DM) + EPS);
    if (lane == 0) { STATS[2 * row] = mu; STATS[2 * row + 1] = rstd; }
}
template <int R> __device__ __forceinline__ void diff_task(const bf16_t* p, bf16_t* o) {
    unsigned v[64];
#pragma unroll
    for (int i = 0; i < 64; ++i) v[i] = *(const unsigned*)(p + (size_t)i * N3);
    float s0 = 0.f, s1 = 0.f;
#pragma unroll
    for (int i = 0; i < R; ++i) { s0 += bf_lo(v[i]); s1 += bf_hi(v[i]); }
#pragma unroll
    for (int i = 0; i < 64; ++i) {
        if (i + R < 64) { s0 += bf_lo(v[i + R]); s1 += bf_hi(v[i + R]); }
        if (i - R - 1 >= 0) { s0 -= bf_lo(v[i - R - 1 >= 0 ? i - R - 1 : 0]); s1 -= bf_hi(v[i - R - 1 >= 0 ? i - R - 1 : 0]); }
        const int hi = (i + R + 1 < 64) ? i + R + 1 : 64, lo = (i - R > 0) ? i - R : 0; const float inv = 1.0f / (float)(hi - lo);
        *(unsigned*)(o + (size_t)i * DM) = cvt_pk_bf16(s0 * inv - bf_lo(v[i]), s1 * inv - bf_hi(v[i]));
    }
}

constexpr int K_W = 0, K_V = 34816;
__device__ __forceinline__ void tmix_task(int task, LAS unsigned char* lds, const float* ws, const float* bs, const float* lnw, const float* lnb, const float* STATS, const bf16_t* P1, bf16_t* Y2) {
    const int tid = threadIdx.x, wave = __builtin_amdgcn_readfirstlane(tid >> 6), lane = tid & 63;
    const int g = task & 15, n = (task >> 4) & 15, b = task >> 8;
    const int row0 = b * SEQ + 128 * n;
    LAS bf16_t* Wsb = (LAS bf16_t*)(lds + K_W); LAS bf16_t* VnT = (LAS bf16_t*)(lds + K_V);
    for (int i = tid; i < 4096; i += 512) { const int p = i >> 5, q4 = (i & 31) * 4; const f32x4 w = *(const f32x4*)(ws + ((size_t)g * 128 + p) * 128 + q4);
        u32x2 o; o.x = cvt_pk_bf16(w.x, w.y); o.y = cvt_pk_bf16(w.z, w.w); *(LAS u32x2*)(Wsb + p * 136 + q4) = o; }
    for (int i = tid; i < 2048; i += 512) { const int q = i >> 4, c8 = (i & 15) * 8;
        const u32x4 a = *(const u32x4*)(P1 + (size_t)(row0 + q) * N3 + 2048 + 128 * g + c8);
        const float mu = STATS[2 * (row0 + q)], rstd = STATS[2 * (row0 + q) + 1];
        const f32x4 w0 = *(const f32x4*)(lnw + 128 * g + c8), w1 = *(const f32x4*)(lnw + 128 * g + c8 + 4), b0 = *(const f32x4*)(lnb + 128 * g + c8), b1 = *(const f32x4*)(lnb + 128 * g + c8 + 4);
        const float x[8] = {bf_lo(a.x), bf_hi(a.x), bf_lo(a.y), bf_hi(a.y), bf_lo(a.z), bf_hi(a.z), bf_lo(a.w), bf_hi(a.w)};
        const float wv[8] = {w0[0], w0[1], w0[2], w0[3], w1[0], w1[1], w1[2], w1[3]}, bv[8] = {b0[0], b0[1], b0[2], b0[3], b1[0], b1[1], b1[2], b1[3]};
#pragma unroll
        for (int e = 0; e < 8; ++e) VnT[(c8 + e) * 136 + q] = f2bf((x[e] - mu) * rstd * wv[e] + bv[e]); }
    __syncthreads();
    const int pb = wave >> 1, c = lane & 31, hh = lane >> 5;
#pragma unroll
    for (int t = 0; t < 2; ++t) { const int cb = 2 * (wave & 1) + t;
        f32x16 a = {};
        a = mma_tile(a, Wsb + 32 * pb * 136, 136, VnT + 32 * cb * 136, 136, 8, lane);
        const int ch = 128 * g + 32 * cb + c;
#pragma unroll
        for (int e = 0; e < 16; ++e) { const int p = 32 * pb + (e & 3) + 8 * (e >> 2) + 4 * hh; const size_t row = (size_t)(row0 + p);
            const float s = a[e] + bs[g * 128 + p];
            const float y = bf2f(P1[row * N3 + ch]) * s * bf2f(P1[row * N3 + 4096 + ch]);
            Y2[row * 4096 + ch] = f2bf((ABLATE & 4) ? 0.f : y); } }
    __syncthreads();
}

__device__ __forceinline__ void final_row(float* xrow, const float* fw, int lane) {
    f32x4* xr = (f32x4*)xrow + lane;
    f32x4 v[8]; float s = 0.f;
#pragma unroll
    for (int j = 0; j < 8; ++j) { v[j] = xr[64 * j]; s += (v[j].x * v[j].x + v[j].y * v[j].y) + (v[j].z * v[j].z + v[j].w * v[j].w); }
    const float rstd = rsqrtf(wave_sum(s) * (1.f / DM) + EPS);
#pragma unroll
    for (int j = 0; j < 8; ++j) xr[64 * j] = v[j] * rstd * ((const f32x4*)fw)[lane + 64 * j];
}

__global__ void __launch_bounds__(512, 2) fwd_kernel(Args args) {
    extern __shared__ __attribute__((aligned(16))) unsigned char lds_raw[];
    LAS unsigned char* lds = (LAS unsigned char*)lds_raw;
    const int tid = threadIdx.x, lane = tid & 63, wave = __builtin_amdgcn_readfirstlane(tid >> 6);
    const int G = gridDim.x, bid = blockIdx.x;
    const int gw = bid * 8 + wave, NGW = G * 8;
    unsigned char* ws = args.ws;
    volatile LAS unsigned* MISC = (volatile LAS unsigned*)(lds + MISC_OFF);
    if (tid < 16) MISC[tid] = 0u;
    __syncthreads();
    if (args.never) cg::this_grid().sync();
    XcdBarrier bar; bar.bar = (unsigned*)(ws + WS_CTL) + CW_BAR; bar.x = 0; bar.st = MISC;
    const int lo = args.ph_lo, hi = args.ph_hi;
    if (hi - lo > 1) bar = xcd_barrier_post((unsigned*)(ws + WS_CTL) + CW_BAR, MISC);
#ifndef PH_MASK
#define PH_MASK 0x3fff
#endif
#define IN(k) ((((PH_MASK) >> (k)) & 1) && lo <= (k) && (k) < hi)
#if MK_STAMP
    unsigned long long* STAMPS = (unsigned long long*)((unsigned*)(ws + WS_CTL) + 3000);
#define STAMP(k) do { if (bid == 0 && tid == 0) STAMPS[k] = __builtin_amdgcn_s_memrealtime(); } while (0)
#else
#define STAMP(k) do { } while (0)
#endif
#define SEAM(k) do { if (IN(k) && IN((k) + 1)) xcd_barrier(bar); STAMP((k) + 1); } while (0)
    STAMP(0);
#define MOD ((float*)(ws + WS_MOD))
#if MK_DEBUG
    unsigned* DBG = (unsigned*)(ws + WS_CTL) + 2048; const int gt = bid * 512 + tid, ngt = G * 512;
#endif
#define WT1 ((bf16_t*)(ws + WS_WT1))
#define WT2 ((bf16_t*)(ws + WS_WT2))
#define WT3 ((bf16_t*)(ws + WS_WT3))
#define WT4 ((bf16_t*)(ws + WS_WT4))
#define WTP ((bf16_t*)(ws + WS_WTP))
#define H ((bf16_t*)(ws + WS_H))

    if (IN(0)) for (int rep_ = 0; rep_ < ((REPEAT_PH) == 0 ? (REPEAT_N) : 1); (++rep_, __syncthreads())) {
        if (bid < 192) { LAS float* tab = (LAS float*)lds; silu_table(args.in[I_C], args.in[I_CCTX], tab);
            for (int t = bid; t < 192; t += G) mod_task(args.in[I_ADAW], args.in[I_ADAB], MOD, 32 * t, tab, (LAS float*)(lds + 40960), wave, lane);
            __syncthreads(); }
        LAS float* scr = (LAS float*)(lds + wave * 16640);
        const SrcW1 s1; const SrcId sid;
        for (int it = gw; it < 8320 + 2048; it += NGW) {
            if (it < 8320) { const int cb = it >> 5, kb = it & 31; conv_item(args.in[I_EWIN], N1SRC, 2048, WT1, 64 * cb, 64 * kb, scr, lane, s1); }
            else { const int r = it - 8320, cb = r >> 6, kb = r & 63; conv_item(args.in[I_EWOUT], 2048, 4096, WT2, 64 * cb, 64 * kb, scr, lane, sid); }
        }
    }
    SEAM(0);
    if (IN(1)) for (int rep_ = 0; rep_ < ((REPEAT_PH) == 1 ? (REPEAT_N) : 1); (++rep_, __syncthreads())) {
#if MK_DEBUG
        dbg_f32(MOD, 5, 6144, 6144, DBG + 0, gt, ngt); dbg_bf16(WT1, 16640, 2048, 2048, DBG + 0, gt, ngt); dbg_bf16(WT2, 2048, 4096, 4096, DBG + 0, gt, ngt);
#endif
        for (int m = gw; m < MT; m += NGW) {
            const float* src = m < MX ? args.in[I_X] + (size_t)m * DM : args.in[I_CTX] + (size_t)(m - MX) * DM;
            const int r = m < MX ? m / SEQ : 4;
            hrow(src, args.in[I_NORMW], MOD + r * 6144, H + (size_t)m * DM, lane);
        }
    }
    SEAM(1);
    if (IN(2)) for (int rep_ = 0; rep_ < ((REPEAT_PH) == 2 ? (REPEAT_N) : 1); (++rep_, __syncthreads())) {
#if MK_DEBUG
        dbg_bf16(H, MT, 2048, 2048, DBG + 1, gt, ngt);
#endif
        Sched1 S{G, bid, (const char*)H, (const char*)WT1};
        Epi1 E{ws, args.in[I_ECONVB], args.in[I_ECONVQKV], lds};
        pg8::gemm_phase<Epi1, Sched1>(lds, 2048, 2048, 2048, S, E);
    }
    SEAM(2);
    if (IN(3)) for (int rep_ = 0; rep_ < ((REPEAT_PH) == 3 ? (REPEAT_N) : 1); (++rep_, __syncthreads())) {
#if MK_DEBUG
        dbg_bf16((const bf16_t*)(ws + WS_PQKV), MT, 6144, 6144, DBG + 2, gt, ngt); dbg_bf16((const bf16_t*)(ws + WS_ZA), MX, 2048, 2048, DBG + 2, gt, ngt);
        dbg_f32((const float*)(ws + WS_AB), MT, 64, 64, DBG + 2, gt, ngt); dbg_bf16((const bf16_t*)(ws + WS_Y) + 2048, MX, 2048, 4096, DBG + 2, gt, ngt);
#endif
    }
    STAMP(4);
    if (IN(4)) for (int rep_ = 0; rep_ < ((REPEAT_PH) == 4 ? (REPEAT_N) : 1); (++rep_, __syncthreads())) {
#if MK_DEBUG
        dbg_bf16((const bf16_t*)(ws + WS_QN), 64 * NTOK, 128, 128, DBG + 3, gt, ngt); dbg_bf16((const bf16_t*)(ws + WS_KN), 64 * NTOK, 128, 128, DBG + 3, gt, ngt);
        dbg_bf16((const bf16_t*)(ws + WS_KT), 64 * 128, NTOK, NTOK, DBG + 3, gt, ngt); dbg_bf16((const bf16_t*)(ws + WS_VT), 64 * 128, NTOK, NTOK, DBG + 3, gt, ngt);
        dbg_f32((const float*)(ws + WS_GG), 128, NTOK, NTOK, DBG + 3, gt, ngt); dbg_f32((const float*)(ws + WS_BETA), 128, NTOK, NTOK, DBG + 3, gt, ngt);
#endif
        LAS float* tab = (LAS float*)(lds + wave * 17920);
        const SrcId sid;
        auto copy_item = [&](int it) {
            if (it < 5120) { const int cb = it >> 5, kb = it & 31; conv_item(args.in[I_OWIN], N3, 2048, WT3, 64 * cb, 64 * kb, tab, lane, sid); }
            else if (it < 7168) { const int r = it - 5120, cb = r >> 6, kb = r & 63; conv_item(args.in[I_OWOUT], 2048, 4096, WT4, 64 * cb, 64 * kb, tab, lane, sid); }
            else { const int r = it - 7168, gq = r >> 6, cb = (r >> 3) & 7, kb = r & 7; conv_item(args.in[I_OPW] + (size_t)gq * 512 * 512, 512, 512, WTP + (size_t)gq * 512 * 512, 64 * cb, 64 * kb, tab, lane, sid); } };
        auto chunk = [&](int t) { chunk_task(t, (const bf16_t*)(ws + WS_QN), (const bf16_t*)(ws + WS_KN), (const float*)(ws + WS_AB), args.in[I_EALOG], args.in[I_EDTB], (float*)(ws + WS_GC), (bf16_t*)(ws + WS_TU), (bf16_t*)(ws + WS_AI), tab, lane); };
        constexpr int NCT = 2 * 64 * NCH, NCI = 5120 + 2048 + 256;
        const bool bal = (NGW == 2048);
        const int nslots = bal ? 8 : (NCT + NCI + NGW - 1) / NGW + 1;
        for (int i = 0; i < nslots; ++i) {
            int ct = -1, ci = -1;
            if (bal) {
                if (i == 0) ct = gw; else if (i == 6) ct = gw + 2048; else if (i == 7) { if (gw < 512) ct = gw + 4096; }
                else if (i <= 4) { if (gw >= 512) ci = (gw - 512) + 1536 * (i - 1); } else { if (gw < 1280) ci = 6144 + gw; }
            } else { const int L = gw + i * NGW; if (L < NCT) ct = L; else if (L < NCT + NCI) ci = L - NCT; }
            if (ct >= 0) chunk(ct);
            if (ci >= 0) copy_item(ci);
        }
    }
    SEAM(4);
    if (IN(5)) for (int rep_ = 0; rep_ < ((REPEAT_PH) == 5 ? (REPEAT_N) : 1); (++rep_, __syncthreads())) {
#if MK_DEBUG
        dbg_bf16((const bf16_t*)(ws + WS_TU), 2 * 64 * NCH, 4096, 4096, DBG + 4, gt, ngt);
        if (gt == 100) {
            const int dirq = 1, bhq = 0, tcq = 20, tok0q = 64 * tcq; const bf16_t* KNq = (const bf16_t*)(ws + WS_KN) + ((size_t)bhq * NTOK + tok0q) * HD;
            const float* gq = (const float*)(ws + WS_GG) + ((size_t)dirq * NBH + bhq) * NTOK + tok0q; const float* bq = (const float*)(ws + WS_BETA) + ((size_t)dirq * NBH + bhq) * NTOK + tok0q;
            const bf16_t* tq = (const bf16_t*)(ws + WS_TU) + (((size_t)dirq * NBH + bhq) * NCH + tcq) * 4096;
            float worst = 0.f;
            for (int a = 0; a < 64; a += 7) for (int b2 = 0; b2 < 64; b2 += 5) {
                float r = 0.f;
                for (int m = 0; m < 64; ++m) {
                    float im = (a == m) ? 1.f : 0.f;
                    if (m > a) { float kk = 0.f; for (int e = 0; e < HD; ++e) kk += bf2f(KNq[a * HD + e]) * bf2f(KNq[m * HD + e]); float gd = 0.f; for (int t = a; t < m; ++t) gd += gq[t]; im = bq[a] * kk * __expf(gd); }
                    const float T = bf2f(tq[m * 64 + b2]) / bq[b2];
                    r += im * T; }
                worst = fmaxf(worst, fabsf(r - ((a == b2) ? 1.f : 0.f))); }
            DBG[980] = __float_as_uint(worst); }
        if (gt < 64) { const int bhq = gt & 63; const bf16_t* tq = (const bf16_t*)(ws + WS_TU) + (((size_t)1 * NBH + bhq) * NCH + 20) * 4096; float so = 0.f;
            for (int i = 0; i < 64; ++i) for (int j = 0; j < 64; ++j) { const float v = fabsf(bf2f(tq[i * 64 + j])); if (i != j) so += v; }
            DBG[910 + bhq] = __float_as_uint(so); }
        dbg_max_bf16((const bf16_t*)(ws + WS_TU), (size_t)128 * NCH * 4096, DBG + 900, gt, ngt);
        dbg_max_bf16((const bf16_t*)(ws + WS_KN), (size_t)64 * NTOK * 128, DBG + 901, gt, ngt);
        dbg_max_bf16((const bf16_t*)(ws + WS_KT), (size_t)64 * NTOK * 128, DBG + 902, gt, ngt);
        dbg_max_bf16((const bf16_t*)(ws + WS_VT), (size_t)64 * NTOK * 128, DBG + 903, gt, ngt);
        dbg_max_bf16((const bf16_t*)(ws + WS_QN), (size_t)64 * NTOK * 128, DBG + 904, gt, ngt);
        for (int q = 0; q < 128; ++q) dbg_bf16((const bf16_t*)(ws + WS_AI) + ((size_t)q * NCH + 4) * 4096, 32, 4096, 4096, DBG + 4, gt, ngt);
        dbg_f32((const float*)(ws + WS_GC), 128, NTOK, NTOK, DBG + 4, gt, ngt); dbg_f32(MOD + 5 * 6144, 4, 6144, 6144, DBG + 4, gt, ngt);
        dbg_bf16(WT3, 10240, 2048, 2048, DBG + 4, gt, ngt); dbg_bf16(WT4, 2048, 4096, 4096, DBG + 4, gt, ngt); dbg_bf16(WTP, 2048, 512, 512, DBG + 4, gt, ngt);
#endif
        for (int ch = bid; ch < 256; ch += G) { scan_chain(ch, lds, (const bf16_t*)(ws + WS_QN), (const bf16_t*)(ws + WS_KT), (const bf16_t*)(ws + WS_VT), (const bf16_t*)(ws + WS_TU), (const bf16_t*)(ws + WS_AI), (const float*)(ws + WS_GC), (bf16_t*)(ws + WS_OF), (bf16_t*)(ws + WS_OB)); __syncthreads(); }
    }
    SEAM(5);
    if (IN(6)) for (int rep_ = 0; rep_ < ((REPEAT_PH) == 6 ? (REPEAT_N) : 1); (++rep_, __syncthreads())) {
        if (bid < 192) { LAS float* stab = (LAS float*)lds; silu_table(args.in[I_C], args.in[I_CCTX], stab);
            for (int t = bid; t < 192; t += G) mod_task(args.in[I_ADAW] + (size_t)2048 * 6144, args.in[I_ADAB] + 6144, MOD + 5 * 6144, 32 * t, stab, (LAS float*)(lds + 40960), wave, lane);
            __syncthreads(); }
#if MK_DEBUG
        dbg_bf16((const bf16_t*)(ws + WS_OF), MX, 2048, 2048, DBG + 5, gt, ngt); dbg_bf16((const bf16_t*)(ws + WS_OB), MX, 2048, 2048, DBG + 5, gt, ngt);
        dbg_max_bf16((const bf16_t*)(ws + WS_OF), (size_t)MX * 2048, DBG + 905, gt, ngt); dbg_max_bf16((const bf16_t*)(ws + WS_OB), (size_t)MX * 2048, DBG + 906, gt, ngt);
#endif
        for (int m = gw; m < MX; m += NGW) finish_row(m, (const bf16_t*)(ws + WS_OF), (const bf16_t*)(ws + WS_OB), (const bf16_t*)(ws + WS_ZA), args.in[I_EHN], (bf16_t*)(ws + WS_Y), lane, (unsigned*)(ws + WS_CTL) + 3072);
    }
    SEAM(6);
    if (IN(7)) for (int rep_ = 0; rep_ < ((REPEAT_PH) == 7 ? (REPEAT_N) : 1); (++rep_, __syncthreads())) {
#if MK_DEBUG
        dbg_bf16((const bf16_t*)(ws + WS_Y), MX, 2048, 4096, DBG + 6, gt, ngt);
#endif
        pg8::StaticOrder S{32, 8, G, bid, (const char*)(ws + WS_Y), (const char*)WT2, (size_t)256 * 4096 * 2, (size_t)256 * 4096 * 2};
        EpiResid E{args.in[I_X], args.out, MOD + 4096};
        pg8::gemm_phase<EpiResid, pg8::StaticOrder>(lds, 4096, 4096, 4096, S, E);
    }
    SEAM(7);
    if (IN(8)) for (int rep_ = 0; rep_ < ((REPEAT_PH) == 8 ? (REPEAT_N) : 1); (++rep_, __syncthreads())) {
#if MK_DEBUG
        dbg_f32(args.out, MX, 2048, 2048, DBG + 7, gt, ngt);
#endif
        for (int m = gw; m < MX; m += NGW) hrow(args.out + (size_t)m * DM, args.in[I_NORMW] + DM, MOD + 5 * 6144 + (m / SEQ) * 6144, H + (size_t)m * DM, lane);
    }
    SEAM(8);
    if (IN(9)) for (int rep_ = 0; rep_ < ((REPEAT_PH) == 9 ? (REPEAT_N) : 1); (++rep_, __syncthreads())) {
#if MK_DEBUG
        dbg_bf16(H, MX, 2048, 2048, DBG + 8, gt, ngt);
#endif
        pg8::StaticOrder S{32, 40, G, bid, (const char*)H, (const char*)WT3, (size_t)256 * 2048 * 2, (size_t)256 * 2048 * 2};
        Epi3 E{(bf16_t*)(ws + WS_P1)};
        pg8::gemm_phase<Epi3, pg8::StaticOrder>(lds, 2048, 2048, 2048, S, E);
    }
    SEAM(9);
    if (IN(10)) for (int rep_ = 0; rep_ < ((REPEAT_PH) == 10 ? (REPEAT_N) : 1); (++rep_, __syncthreads())) {
#if MK_DEBUG
        dbg_bf16((const bf16_t*)(ws + WS_P1), MX, N3, N3, DBG + 9, gt, ngt);
#endif
        for (int m = gw; m < MX; m += NGW) stats_row(m, (const bf16_t*)(ws + WS_P1), (float*)(ws + WS_STATS), lane);
        for (int t = gw; t < 128 * 16; t += NGW) { const int blk = t >> 4, cc = t & 15, grp = cc >> 2;
            const bf16_t* p = (const bf16_t*)(ws + WS_P1) + (size_t)(64 * blk) * N3 + 6144 + 128 * cc + 2 * lane; bf16_t* o = (bf16_t*)(ws + WS_DIFF) + (size_t)(64 * blk) * DM + 128 * cc + 2 * lane;
            if (grp == 0) diff_task<1>(p, o); else if (grp == 1) diff_task<2>(p, o); else if (grp == 2) diff_task<4>(p, o); else diff_task<8>(p, o); }
    }
    SEAM(10);
    if (IN(11)) for (int rep_ = 0; rep_ < ((REPEAT_PH) == 11 ? (REPEAT_N) : 1); (++rep_, __syncthreads())) {
#if MK_DEBUG
        dbg_f32((const float*)(ws + WS_STATS), 1, 2 * MX, 2 * MX, DBG + 10, gt, ngt); dbg_bf16((const bf16_t*)(ws + WS_DIFF), MX, 2048, 2048, DBG + 10, gt, ngt);
#endif
        SchedPool S{G, bid, (const char*)(ws + WS_DIFF), (const char*)WTP};
        EpiPool E{(const bf16_t*)(ws + WS_P1), (bf16_t*)(ws + WS_Y2), args.in[I_OPS]};
        pg8::gemm_phase<EpiPool, SchedPool>(lds, 512, 2048, 512, S, E);
        __syncthreads();
        for (int t = bid; t < 1024; t += G) tmix_task(t, lds, args.in[I_OWS], args.in[I_OBS], args.in[I_OLNW], args.in[I_OLNB], (const float*)(ws + WS_STATS), (const bf16_t*)(ws + WS_P1), (bf16_t*)(ws + WS_Y2));
    }
    SEAM(11);
    if (IN(12)) {
#if MK_DEBUG
        dbg_bf16((const bf16_t*)(ws + WS_Y2), MX, 4096, 4096, DBG + 11, gt, ngt);
#endif
        pg8::StaticOrder S{32, 8, G, bid, (const char*)(ws + WS_Y2), (const char*)WT4, (size_t)256 * 4096 * 2, (size_t)256 * 4096 * 2};
        EpiResid E{args.out, args.out, MOD + 5 * 6144 + 4096};
        pg8::gemm_phase<EpiResid, pg8::StaticOrder>(lds, 4096, 4096, 4096, S, E);
    }
    SEAM(12);
    if (IN(13)) {
#if MK_DEBUG
        dbg_f32(args.out, MX, 2048, 2048, DBG + 12, gt, ngt);
        for (size_t i = gt; i < (size_t)MX * DM; i += ngt) { const float v = args.out[i]; if (badf(v)) args.out[i] = 0.f; }
        asm volatile("s_waitcnt vmcnt(0)" ::: "memory"); __syncthreads();
#endif
        for (int m = gw; m < MX; m += NGW) final_row(args.out + (size_t)m * DM, args.in[I_FNW], lane);
#if MK_DEBUG
        asm volatile("s_waitcnt vmcnt(0)" ::: "memory"); __syncthreads();
        if (bid == 0 && tid == 0) { int first = -1; unsigned mask = 0; for (int k = 12; k >= 0; --k) if (__hip_atomic_load(DBG + k, __ATOMIC_RELAXED, __HIP_MEMORY_SCOPE_AGENT)) { first = k; mask |= 1u << k; }
            if (first >= 0) args.out[0] = 1000.f * (float)(first + 1);
            { int cb = 0, cf = 0; for (int q = 0; q < 64; ++q) { cb += (int)__hip_atomic_load(DBG + 1024 + q, __ATOMIC_RELAXED, __HIP_MEMORY_SCOPE_AGENT); cf += (int)__hip_atomic_load(DBG + 1024 + 64 + q, __ATOMIC_RELAXED, __HIP_MEMORY_SCOPE_AGENT); }
              args.out[0] = 1000.f * (float)(DBG_SEL ? cf : cb) + 500.f;
              if (DBG_SEL == 30 || DBG_SEL == 31) { const int dsel = DBG_SEL - 30; int fb = -1; for (int q = 0; q < 64; ++q) if (__hip_atomic_load(DBG + 1024 + (dsel ? 0 : 64) + q, __ATOMIC_RELAXED, __HIP_MEMORY_SCOPE_AGENT)) { fb = q; break; }
                  float mg = 0.f; if (fb >= 0) { const float* gq = (const float*)(ws + WS_GG) + ((size_t)dsel * NBH + fb) * NTOK; for (int i = 256; i < NTOK; ++i) mg += gq[i]; mg = -mg / 2048.f; }
                  args.out[0] = 1.0e4f * mg + 1000.f * 1000.f * (float)(fb & 15); }
              else if (DBG_SEL == 200) { args.out[0] = 1.0e5f * __uint_as_float(__hip_atomic_load(DBG + 980, __ATOMIC_RELAXED, __HIP_MEMORY_SCOPE_AGENT)) + 1000.f; }
              else if (DBG_SEL >= 60 && DBG_SEL < 124) { args.out[0] = 1.0e3f * __uint_as_float(__hip_atomic_load(DBG + 910 + (DBG_SEL - 60), __ATOMIC_RELAXED, __HIP_MEMORY_SCOPE_AGENT)); }
              else if (DBG_SEL >= 40 && DBG_SEL < 60) { const int bhq = DBG_SEL - 40; const bf16_t* tq = (const bf16_t*)(ws + WS_TU) + (((size_t)1 * NBH + bhq) * NCH + 20) * 4096; float so = 0.f, sd = 0.f;
                  for (int i = 0; i < 64; ++i) for (int j = 0; j < 64; ++j) { const float v = fabsf(bf2f(tq[i * 64 + j])); if (i == j) sd += v; else so += v; }
                  args.out[0] = 1.0e4f * so + 1.0e8f; }
              else if (DBG_SEL >= 10) args.out[0] = 1.0e2f * __uint_as_float(__hip_atomic_load(DBG + 900 + (DBG_SEL - 10), __ATOMIC_RELAXED, __HIP_MEMORY_SCOPE_AGENT)); } }
#endif
    }
#if MK_STAMP
    if (IN(13)) {
        asm volatile("s_waitcnt vmcnt(0)" ::: "memory"); __syncthreads();
        if (bid == 0) {
            const unsigned long long t14 = __builtin_amdgcn_s_memrealtime();
            const float tA = (float)((SEL_A == 13 ? t14 : STAMPS[SEL_A + 1]) - STAMPS[SEL_A]) * 0.01f, tB = (float)((SEL_B == 13 ? t14 : STAMPS[SEL_B + 1]) - STAMPS[SEL_B]) * 0.01f;
            __syncthreads();
            for (int i = 1 + tid; i <= 1048576; i += 512) args.out[i] += tB * (1.f / 2000.f);
            if (tid == 0) args.out[0] += tA * (1.f / 100.f);
        }
    }
#endif
#if STOP_AFTER < 13
    if (lo == 14) {
        const size_t NO = (size_t)MX * DM; const size_t gtid = (size_t)bid * 512 + tid, ngtid = (size_t)G * 512;
        for (size_t i = gtid; i < NO; i += ngtid) {
            float acc = 0.f;
#define DG_BF(off, n) do { const bf16_t* q_ = (const bf16_t*)(ws + (off)); for (size_t j = i; j < (size_t)(n); j += NO) acc += bf2f(q_[j]); } while (0)
#define DG_F32(off, n) do { const float* q_ = (const float*)(ws + (off)); for (size_t j = i; j < (size_t)(n); j += NO) acc += q_[j]; } while (0)
#if STOP_AFTER == 0
            DG_BF(WS_WT1, (size_t)16640 * 2048); DG_BF(WS_WT2, (size_t)2048 * 4096); DG_F32(WS_MOD, 5 * 6144);
#elif STOP_AFTER == 1
            DG_BF(WS_H, (size_t)MT * 2048);
#elif STOP_AFTER == 2
            DG_BF(WS_PQKV, (size_t)MT * 6144); DG_BF(WS_ZA, (size_t)MX * 2048); DG_F32(WS_AB, (size_t)MT * 64);
            { const bf16_t* q_ = (const bf16_t*)(ws + WS_Y); const size_t r = i / 2048, c = i % 2048; acc += bf2f(q_[r * 4096 + 2048 + c]); }
#elif STOP_AFTER == 3
            DG_BF(WS_QN, (size_t)64 * NTOK * 128); DG_BF(WS_KN, (size_t)64 * NTOK * 128); DG_BF(WS_KT, (size_t)64 * NTOK * 128); DG_BF(WS_VT, (size_t)64 * NTOK * 128);
            DG_F32(WS_GG, (size_t)128 * NTOK); DG_F32(WS_BETA, (size_t)128 * NTOK);
#elif STOP_AFTER == 4
            DG_BF(WS_TU, (size_t)128 * NCH * 4096); DG_F32(WS_GC, (size_t)128 * NTOK); DG_F32(WS_MOD, 10 * 6144);
            DG_BF(WS_WT3, (size_t)10240 * 2048); DG_BF(WS_WT4, (size_t)2048 * 4096); DG_BF(WS_WTP, (size_t)2048 * 512);
            { const bf16_t* q_ = (const bf16_t*)(ws + WS_AI); for (size_t j = i; j < (size_t)128 * NCH * 4096; j += NO) { const size_t tcq = (j / 4096) % NCH; if (tcq >= 4) acc += bf2f(q_[j]); } }
#elif STOP_AFTER == 5
            DG_BF(WS_OF, (size_t)MX * 2048); DG_BF(WS_OB, (size_t)MX * 2048);
#elif STOP_AFTER == 6
            DG_BF(WS_Y, (size_t)MX * 4096);
#elif STOP_AFTER == 7
            acc = args.out[i];
#elif STOP_AFTER == 8
            DG_BF(WS_H, (size_t)MX * 2048);
#elif STOP_AFTER == 9
            DG_BF(WS_P1, (size_t)MX * N3);
#elif STOP_AFTER == 10
            DG_BF(WS_DIFF, (size_t)MX * 2048); DG_F32(WS_STATS, (size_t)MX * 2);
#elif STOP_AFTER == 11
            DG_BF(WS_Y2, (size_t)MX * 4096);
#else
            acc = args.out[i];
#endif
            if (badf(acc)) acc = 12345.f;
            args.out[i] = acc;
        }
    }
#endif
#undef IN
#undef SEAM
}

extern "C" void kernel_launch(void* const* d_in, const int* in_sizes, int n_in, void* d_out, int out_size, void* d_ws, size_t ws_size, hipStream_t stream) {
    static int grid = 0;
    if (grid == 0) {
        if (n_in != 23 || out_size != MX * DM || ws_size < WS_END) { fprintf(stderr, "kernel_launch: unexpected shapes (n_in %d, out %d, ws %zu < %zu)\n", n_in, out_size, ws_size, (size_t)WS_END); grid = -1; return; }
        int dev = 0, cus = 0, per_cu = 0;
        if (hipGetDevice(&dev) != hipSuccess || hipDeviceGetAttribute(&cus, hipDeviceAttributeMultiprocessorCount, dev) != hipSuccess) { grid = -1; return; }
        if (hipFuncSetAttribute((const void*)fwd_kernel, hipFuncAttributeMaxDynamicSharedMemorySize, LDS_BYTES) != hipSuccess) { fprintf(stderr, "kernel_launch: hipFuncSetAttribute failed\n"); grid = -1; return; }
        if (hipOccupancyMaxActiveBlocksPerMultiprocessor(&per_cu, (const void*)fwd_kernel, 512, LDS_BYTES) != hipSuccess || per_cu < 1) { fprintf(stderr, "kernel_launch: occupancy query says %d\n", per_cu); }
        (void)hipGetLastError();
        grid = cus;
    }
    if (grid < 0) return;
    if (hipMemsetAsync((char*)d_ws + WS_CTL, 0, CTL_BYTES, stream) != hipSuccess) { fprintf(stderr, "kernel_launch: memset failed\n"); return; }
    Args a{};
    for (int i = 0; i < 23; ++i) a.in[i] = (const float*)d_in[i];
    a.out = (float*)d_out; a.ws = (unsigned char*)d_ws; a.never = 0; a.pad = 0;
    const int nl = (STOP_AFTER < 13) ? STOP_AFTER + 2 : MK_N_LAUNCHES;
    for (int li = 0; li < nl; ++li) {
        a.ph_lo = (nl == 1) ? 0 : li; a.ph_hi = (nl == 1) ? NPHASE : li + 1;
        if (STOP_AFTER < 13 && li == nl - 1) { a.ph_lo = 14; a.ph_hi = 15; }
        void* kargs[] = {&a};
        hipError_t e = hipLaunchCooperativeKernel((const void*)fwd_kernel, dim3(grid), dim3(512), kargs, LDS_BYTES, stream);
        if (e != hipSuccess) { fprintf(stderr, "kernel_launch: launch %d failed: %s\n", li, hipGetErrorString(e)); break; }
    }
}
```

```cpp
#include <hip/hip_runtime.h>
#include <hip/hip_cooperative_groups.h>
#include <cstdio>
#include <cstdint>
namespace cg = cooperative_groups;

#ifndef MK_N_LAUNCHES
#define MK_N_LAUNCHES 1
#endif
#ifndef DBG_SEL
#define DBG_SEL 200
#endif
#ifndef MK_STAMP
#define MK_STAMP 0
#endif
#ifndef SEL_A
#define SEL_A 6
#endif
#ifndef SEL_B
#define SEL_B 5
#endif
#ifndef REPEAT_PH
#define REPEAT_PH 99
#endif
#ifndef REPEAT_N
#define REPEAT_N 2
#endif
#ifndef ABLATE
#define ABLATE 0
#endif
#ifndef STOP_AFTER
#define STOP_AFTER 13
#endif

#define LAS __attribute__((address_space(3)))
typedef unsigned short bf16_t;
typedef short bf16x8 __attribute__((ext_vector_type(8)));
typedef float f32x2 __attribute__((ext_vector_type(2)));
typedef float f32x4 __attribute__((ext_vector_type(4)));
typedef float f32x16 __attribute__((ext_vector_type(16)));
typedef unsigned u32x2 __attribute__((ext_vector_type(2)));
typedef unsigned u32x4 __attribute__((ext_vector_type(4)));

constexpr int DM = 2048, NB = 4, SEQ = 2048, CTXL = 256, MX = NB * SEQ, MC = NB * CTXL, MT = MX + MC;
constexpr int NTOK = CTXL + SEQ;
constexpr int NHD = 16, HD = 128, NBH = NB * NHD;
constexpr int N1SRC = 16448, N1P = 16640, N3 = 10240;
constexpr int NCH = NTOK / 64;
constexpr float EPS = 1e-6f;
constexpr int NPHASE = 14;

constexpr size_t MiB = 1u << 20;
constexpr size_t WS_CTL = 0, CTL_BYTES = 1 * MiB;
constexpr size_t WS_MOD = 1 * MiB;
constexpr size_t WS_GG = 2 * MiB, WS_BETA = 4 * MiB, WS_GC = 6 * MiB;
constexpr size_t WS_STATS = 7 * MiB + 512 * 1024;
constexpr size_t WS_WT2 = 8 * MiB;
constexpr size_t WS_WT1 = 24 * MiB;
constexpr size_t WS_WT3 = 24 * MiB, WS_WT4 = 64 * MiB, WS_WTP = 80 * MiB;
constexpr size_t WS_H = 89 * MiB;
constexpr size_t WS_OB = 89 * MiB;
constexpr size_t WS_PQKV = 125 * MiB;
constexpr size_t WS_TU = 125 * MiB, WS_AI = 161 * MiB, WS_OF = 197 * MiB;
constexpr size_t WS_ZA = 233 * MiB;
constexpr size_t WS_AB = 265 * MiB;
constexpr size_t WS_Y = 268 * MiB;
constexpr size_t WS_QN = 332 * MiB, WS_KN = 368 * MiB, WS_KT = 404 * MiB, WS_VT = 440 * MiB;
constexpr size_t WS_P1 = 125 * MiB;
constexpr size_t WS_DIFF = 285 * MiB;
constexpr size_t WS_Y2 = 396 * MiB;
constexpr size_t WS_END = 476 * MiB;
constexpr int CW_BAR = 4096;

constexpr int LDS_BYTES = 155648;
constexpr int MISC_OFF = LDS_BYTES - 256;

__device__ __forceinline__ float bf_lo(unsigned w) { return __uint_as_float(w << 16); }
__device__ __forceinline__ float bf_hi(unsigned w) { return __uint_as_float(w & 0xffff0000u); }
__device__ __forceinline__ float bf2f(bf16_t b) { return __uint_as_float(((unsigned)b) << 16); }
typedef __bf16 bf16v2 __attribute__((ext_vector_type(2)));
__device__ __forceinline__ unsigned cvt_pk_bf16(float lo, float hi) { const f32x2 v = {lo, hi}; const bf16v2 r = __builtin_convertvector(v, bf16v2); return __builtin_bit_cast(unsigned, r); }
__device__ __forceinline__ bf16_t f2bf(float f) { return (bf16_t)(cvt_pk_bf16(f, 0.f) & 0xffffu); }
__device__ __forceinline__ float sigmoid_f(float x) { return __builtin_amdgcn_rcpf(1.0f + __expf(-x)); }
__device__ __forceinline__ float silu_f(float x) { return x * sigmoid_f(x); }
__device__ __forceinline__ float gelu_f(float x) { const float u = 0.7978845608028654f * (x + 0.044715f * x * x * x); return x * sigmoid_f(2.0f * u); }
__device__ __forceinline__ float softplus_f(float x) { const float e = __expf(-fabsf(x)); const float l = e < 1e-3f ? e * (1.f - 0.5f * e) : __logf(1.f + e); return fmaxf(x, 0.f) + l; }
__device__ __forceinline__ float wave_sum(float v) {
#pragma unroll
    for (int o = 1; o < 64; o <<= 1) v += __shfl_xor(v, o);
    return v;
}
__device__ __forceinline__ float dpp_shr1(float x, float old) { return __builtin_bit_cast(float, __builtin_amdgcn_update_dpp(__builtin_bit_cast(int, old), __builtin_bit_cast(int, x), 0x111, 0xf, 0xf, false)); }
__device__ __forceinline__ float dpp_shl1(float x, float old) { return __builtin_bit_cast(float, __builtin_amdgcn_update_dpp(__builtin_bit_cast(int, old), __builtin_bit_cast(int, x), 0x101, 0xf, 0xf, false)); }
#ifndef MK_DEBUG
#define MK_DEBUG 0
#endif
__device__ __forceinline__ float dpp_ror1(float x) { return __builtin_bit_cast(float, __builtin_amdgcn_update_dpp(0, __builtin_bit_cast(int, x), 0x121, 0xf, 0xf, false)); }
__device__ __forceinline__ float dpp_ror15(float x) { return __builtin_bit_cast(float, __builtin_amdgcn_update_dpp(0, __builtin_bit_cast(int, x), 0x12f, 0xf, 0xf, false)); }
#define LDS_WAIT() asm volatile("s_waitcnt lgkmcnt(0)" ::: "memory")

#define XB_TMO      128
#define XB_XCNT(j)  (256  + 64 * (j))
#define XB_XSUB(j)  (1280 + 64 * (j))
#define XB_XGEN(j)  (2304 + 64 * (j))
#define XB_TOP      3328
#define XB_TOPGEN   3392
#define XCD_BAR_WORDS 3456
#define XB_SPIN_CAP (1u << 20)
__device__ __forceinline__ unsigned xb_ld(unsigned* p)              { return __hip_atomic_load(p, __ATOMIC_RELAXED, __HIP_MEMORY_SCOPE_AGENT); }
__device__ __forceinline__ unsigned xb_add(unsigned* p, unsigned v) { return __hip_atomic_fetch_add(p, v, __ATOMIC_RELAXED, __HIP_MEMORY_SCOPE_AGENT); }
__device__ __forceinline__ unsigned xb_xcc_id() { return (unsigned)__builtin_amdgcn_s_getreg((3 << 11) | 20) & 0xFu; }
#define XB_SPIN(cond, bar) do { unsigned _sp = 0; while (cond) { __builtin_amdgcn_s_sleep(1); \
    if ((++_sp & 255u) == 0u) { if (xb_ld(&(bar)[XB_TMO])) break; if (_sp > XB_SPIN_CAP) { atomicAdd(&(bar)[XB_TMO], 1u); break; } } } } while (0)
struct XcdBarrier { unsigned* bar; unsigned x; volatile LAS unsigned* st; };
__device__ __forceinline__ XcdBarrier xcd_barrier_post(unsigned* bar, volatile LAS unsigned* st) {
    XcdBarrier b; b.bar = bar; b.x = xb_xcc_id(); b.st = st;
    if (threadIdx.x == 0) (void)xb_add(&bar[XB_XCNT(b.x)], 1u);
    return b;
}
__device__ __forceinline__ void xcd_barrier_complete(unsigned* bar, unsigned x, unsigned& nloc, unsigned& nx) {
    const unsigned G = gridDim.x * gridDim.y * gridDim.z;
    unsigned sum, cnt, mine, sp = 0u;
    for (;;) {
        sum = 0u; cnt = 0u; mine = 0u;
#pragma unroll
        for (unsigned j = 0; j < 16; ++j) { const unsigned c = xb_ld(&bar[XB_XCNT(j)]); sum += c; cnt += (c > 0u) ? 1u : 0u; mine = (j == x) ? c : mine; }
        if (sum == G) break;
        __builtin_amdgcn_s_sleep(1);
        if ((++sp & 255u) == 0u) { if (xb_ld(&bar[XB_TMO])) break; if (sp > XB_SPIN_CAP) { atomicAdd(&bar[XB_TMO], 1u); break; } }
    }
    nloc = mine > 0u ? mine : 1u; nx = cnt > 0u ? cnt : 1u;
}
__device__ __forceinline__ void xcd_barrier(const XcdBarrier& b) {
    asm volatile("s_waitcnt vmcnt(0)" ::: "memory");
    __syncthreads();
    if (threadIdx.x == 0) {
        unsigned* bar = b.bar;
        __builtin_amdgcn_s_waitcnt(0);
        unsigned nloc = b.st[0], nx = b.st[1];
        if (nloc == 0u) { xcd_barrier_complete(bar, b.x, nloc, nx); b.st[0] = nloc; b.st[1] = nx; }
        const unsigned old = xb_add(&bar[XB_XSUB(b.x)], 1u);
        const unsigned gen = old / nloc;
        if (old + 1u == (gen + 1u) * nloc) {
            __builtin_amdgcn_fence(__ATOMIC_RELEASE, "agent");
            asm volatile("s_waitcnt vmcnt(0)" ::: "memory");
            const unsigned og = xb_add(&bar[XB_TOP], 1u);
            const unsigned tg = og / nx;
            if (og + 1u == (tg + 1u) * nx) xb_add(&bar[XB_TOPGEN], 1u);
            else XB_SPIN(xb_ld(&bar[XB_TOPGEN]) == tg, bar);
            __builtin_amdgcn_fence(__ATOMIC_ACQUIRE, "agent");
            xb_add(&bar[XB_XGEN(b.x)], 1u);
            asm volatile("s_waitcnt vmcnt(0)" ::: "memory");
        } else {
            XB_SPIN(xb_ld(&bar[XB_XGEN(b.x)]) == gen, bar);
            __builtin_amdgcn_fence(__ATOMIC_ACQUIRE, "agent");
            asm volatile("s_waitcnt vmcnt(0)" ::: "memory");
        }
    }
    __syncthreads();
}

namespace pg8 {
constexpr int BM = 256, BK = 64, HALF = 128, HTB = HALF * BK * 2, STAGE_BYTES = 8 * HTB, NXCD = 8, WGM = 8;
__host__ __device__ __forceinline__ int lds_byte(int r, int c) { const int st = (r >> 4) * 2 + (c >> 5), rr = r & 15, cc = c & 31, ob = rr * 64 + cc * 2; return st * 1024 + (ob ^ (((ob >> 9) & 1) << 5)); }
__host__ __device__ __forceinline__ void stage_rc(int b, int& R, int& C) { const int st = b / 1024, sb = b % 1024, swz = sb ^ (((sb >> 9) & 1) << 5); R = (st >> 1) * 16 + swz / 64; C = (st & 1) * 32 + (swz % 64) / 2; }
__host__ __device__ __forceinline__ int perm32(int rho) { const int n = rho >> 4, i = rho & 15; return 8 * (i >> 2) + 4 * n + (i & 3); }
struct Unit { int pm, pn, aux; const char* a; const char* b; };
__device__ __forceinline__ void tile_order(int L, int nM, int nN, int& pm, int& pn) {
    const int nwg = nM * nN; int wgid = L;
    { const int q = nwg / NXCD, r = nwg % NXCD, xcd = wgid % NXCD, off = wgid / NXCD; wgid = (xcd < r ? xcd * (q + 1) : r * (q + 1) + (xcd - r) * q) + off; }
    const int nig = WGM * nN, gid = wgid / nig, fm = gid * WGM, gsz = (nM - fm) < WGM ? (nM - fm) : WGM;
    pm = fm + ((wgid % nig) % gsz); pn = (wgid % nig) / gsz;
}
struct StaticOrder {
    int nM, nN, G, c; const char* A; const char* B; size_t ta, tb;
    __device__ __forceinline__ bool next(int i, Unit& u) const {
        const long L = (long)i * G + c; if (L >= (long)nM * nN) return false;
        tile_order((int)L, nM, nN, u.pm, u.pn); u.aux = 0; u.a = A + (size_t)u.pm * ta; u.b = B + (size_t)u.pn * tb; return true;
    }
};
#define PG8_LAS __attribute__((address_space(3)))
template <class Epi, class Sched>
__device__ __forceinline__ void gemm_phase(PG8_LAS unsigned char* lds, const int K, const int lda, const int ldb, const Sched& S, const Epi& E) {
    const int tid = threadIdx.x, wid = __builtin_amdgcn_readfirstlane(tid >> 6), lane = tid & 63, wr = wid >> 2, wc = wid & 3, fr = lane & 15, fq = lane >> 4;
    const int nt = K / BK;
    unsigned voffA[2], voffB[2];
#pragma unroll
    for (int i = 0; i < 2; ++i) { int R, C; stage_rc(tid * 16 + i * 8192, R, C); const int Rb = Epi::PERM ? ((R & ~31) + perm32(R & 31)) : R;
        voffA[i] = (unsigned)(R * lda + C) * 2u; voffB[i] = (unsigned)(Rb * ldb + C) * 2u; }
    const size_t kstep = (size_t)(BK * 2);
    const size_t hstepA = (size_t)HALF * lda * 2, hstepB = (size_t)HALF * ldb * 2;
    const unsigned ldsw = (unsigned)wid * 1024u;
    const int aoff = lds_byte(wr * 64 + fr, fq * 8), boff = lds_byte(wc * 32 + fr, fq * 8);
#define PG8_SA(b, h) (((b) * 2 + (h)) * HTB)
#define PG8_SB(b, h) ((4 + (b) * 2 + (h)) * HTB)
#define PG8_STAGE(bufoff, gbase, voff) do { _Pragma("unroll") for (int _i = 0; _i < 2; ++_i) \
        __builtin_amdgcn_global_load_lds((const unsigned*)((const char*)(gbase) + (voff)[_i]), (PG8_LAS unsigned*)(lds + (bufoff) + ldsw + _i * 8192), 16, 0, 0); } while (0)
#define PG8_LDA(dst, b, h) do { _Pragma("unroll") for (int m = 0; m < 4; ++m) _Pragma("unroll") for (int k = 0; k < 2; ++k) dst[m][k] = *(const PG8_LAS bf16x8*)(lds + PG8_SA(b, h) + aoff + m * 2048 + k * 1024); } while (0)
#define PG8_LDB(dst, b, h) do { _Pragma("unroll") for (int n = 0; n < 2; ++n) _Pragma("unroll") for (int k = 0; k < 2; ++k) dst[n][k] = *(const PG8_LAS bf16x8*)(lds + PG8_SB(b, h) + boff + n * 2048 + k * 1024); } while (0)
#define PG8_MMA(ai, bj, At, Bt) do { __builtin_amdgcn_s_setprio(1); _Pragma("unroll") for (int m = 0; m < 4; ++m) _Pragma("unroll") for (int n = 0; n < 2; ++n) _Pragma("unroll") for (int k = 0; k < 2; ++k) \
        acc[ai][bj][m][n] = __builtin_amdgcn_mfma_f32_16x16x32_bf16(Bt[n][k], At[m][k], acc[ai][bj][m][n], 0, 0, 0); __builtin_amdgcn_s_setprio(0); } while (0)
#define PG8_WAIT_V(n) asm volatile("s_waitcnt vmcnt(" #n ")" ::: "memory")
#define PG8_WAIT_L(n) asm volatile("s_waitcnt lgkmcnt(" #n ")" ::: "memory")
#define PG8_BAR __builtin_amdgcn_s_barrier()
#define PG8_SCHED __builtin_amdgcn_sched_barrier(0)
    Unit cur, nxt; int ui = 0;
    if (!S.next(0, cur)) return;
    f32x4 acc[2][2][4][2];
#pragma unroll
    for (int a = 0; a < 2; ++a)
#pragma unroll
        for (int b = 0; b < 2; ++b)
#pragma unroll
            for (int m = 0; m < 4; ++m)
#pragma unroll
                for (int n = 0; n < 2; ++n) acc[a][b][m][n] = (f32x4){0.f, 0.f, 0.f, 0.f};
    bf16x8 At[4][2], B0[2][2], B1[2][2];
    const char* cA = cur.a; const char* cB = cur.b;
    PG8_STAGE(PG8_SB(0, 0), cB, voffB); PG8_STAGE(PG8_SB(0, 1), cB + hstepB, voffB); PG8_STAGE(PG8_SA(0, 0), cA, voffA); PG8_STAGE(PG8_SA(0, 1), cA + hstepA, voffA);
    if (wr == 1) PG8_BAR;
    PG8_WAIT_V(2); PG8_BAR;
    PG8_STAGE(PG8_SB(1, 0), cB + kstep, voffB); PG8_STAGE(PG8_SA(1, 0), cA + kstep, voffA); PG8_STAGE(PG8_SB(1, 1), cB + hstepB + kstep, voffB);
    PG8_WAIT_V(6); PG8_BAR;
    for (;;) {
        const bool has_next = S.next(ui + 1, nxt);
        const char* nA = has_next ? nxt.a : cA; const char* nB = has_next ? nxt.b : cB;
        for (int t = 0; t < nt; t += 2) {
            const bool last = (t == nt - 2);
            const char* a1 = cA + (size_t)(t + 1) * kstep;
            const char* a2 = last ? nA : cA + (size_t)(t + 2) * kstep; const char* b2 = last ? nB : cB + (size_t)(t + 2) * kstep;
            const char* a3 = a2 + kstep; const char* b3 = b2 + kstep;
            PG8_LDB(B0, 0, 0); PG8_LDB(B1, 0, 1); PG8_SCHED; PG8_LDA(At, 0, 0); PG8_STAGE(PG8_SA(1, 1), a1 + hstepA, voffA);
            PG8_WAIT_V(8); PG8_WAIT_L(0); PG8_BAR; PG8_MMA(0, 0, At, B0); PG8_MMA(0, 1, At, B1); PG8_BAR; PG8_SCHED;
            PG8_LDA(At, 0, 1); PG8_STAGE(PG8_SB(0, 0), b2, voffB); PG8_STAGE(PG8_SB(0, 1), b2 + hstepB, voffB); PG8_STAGE(PG8_SA(0, 0), a2, voffA);
            PG8_WAIT_V(8); PG8_WAIT_L(0); PG8_BAR; PG8_MMA(1, 0, At, B0); PG8_MMA(1, 1, At, B1); PG8_BAR; PG8_SCHED;
            PG8_LDB(B0, 1, 0); PG8_LDB(B1, 1, 1); PG8_SCHED; PG8_LDA(At, 1, 0); PG8_STAGE(PG8_SA(0, 1), a2 + hstepA, voffA);
            PG8_WAIT_V(8); PG8_WAIT_L(0); PG8_BAR; PG8_MMA(0, 0, At, B0); PG8_MMA(0, 1, At, B1); PG8_BAR; PG8_SCHED;
            PG8_LDA(At, 1, 1); PG8_STAGE(PG8_SB(1, 0), b3, voffB); PG8_STAGE(PG8_SB(1, 1), b3 + hstepB, voffB); PG8_STAGE(PG8_SA(1, 0), a3, voffA);
            PG8_WAIT_V(8); PG8_WAIT_L(0); PG8_BAR; PG8_MMA(1, 0, At, B0); PG8_MMA(1, 1, At, B1); PG8_BAR; PG8_SCHED;
        }
        if (wr == 0) PG8_BAR;
        E(acc, cur, wr, wc, fr, fq);
        if (!has_next) break;
#pragma unroll
        for (int a = 0; a < 2; ++a)
#pragma unroll
            for (int b = 0; b < 2; ++b)
#pragma unroll
                for (int m = 0; m < 4; ++m)
#pragma unroll
                    for (int n = 0; n < 2; ++n) acc[a][b][m][n] = (f32x4){0.f, 0.f, 0.f, 0.f};
        cur = nxt; cA = nA; cB = nB; ++ui;
        if (wr == 1) PG8_BAR;
    }
    PG8_WAIT_V(0);
    PG8_BAR;
#undef PG8_SA
#undef PG8_SB
#undef PG8_STAGE
#undef PG8_LDA
#undef PG8_LDB
#undef PG8_MMA
#undef PG8_WAIT_V
#undef PG8_WAIT_L
#undef PG8_BAR
#undef PG8_SCHED
}
}

#if MK_DEBUG
__device__ __forceinline__ bool badf(float v) { return !(fabsf(v) < 1e30f); }
__device__ __forceinline__ void dbg_bf16(const bf16_t* p, int rows, int cols, size_t ld, unsigned* flag, int gt, int ngt) {
    const int cpr = cols / 8; bool bad = false;
    for (size_t i = gt; i < (size_t)rows * cpr; i += ngt) { const size_t r = i / cpr, c = (i % cpr) * 8; const u32x4 a = *(const u32x4*)(p + r * ld + c);
        bad |= badf(bf_lo(a.x)) | badf(bf_hi(a.x)) | badf(bf_lo(a.y)) | badf(bf_hi(a.y)) | badf(bf_lo(a.z)) | badf(bf_hi(a.z)) | badf(bf_lo(a.w)) | badf(bf_hi(a.w)); }
    if (bad) *flag = 1u;
}
__device__ __forceinline__ void dbg_max_bf16(const bf16_t* p, size_t n, unsigned* slot, int gt, int ngt) {
    float m = 0.f;
    for (size_t i = (size_t)gt * 8; i < n; i += (size_t)ngt * 8) { const u32x4 a = *(const u32x4*)(p + i);
        m = fmaxf(m, fmaxf(fmaxf(fmaxf(fabsf(bf_lo(a.x)), fabsf(bf_hi(a.x))), fmaxf(fabsf(bf_lo(a.y)), fabsf(bf_hi(a.y)))), fmaxf(fmaxf(fabsf(bf_lo(a.z)), fabsf(bf_hi(a.z))), fmaxf(fabsf(bf_lo(a.w)), fabsf(bf_hi(a.w)))))); }
    atomicMax(slot, __float_as_uint(m));
}
__device__ __forceinline__ void dbg_f32(const float* p, int rows, int cols, size_t ld, unsigned* flag, int gt, int ngt) {
    const int cpr = cols / 4; bool bad = false;
    for (size_t i = gt; i < (size_t)rows * cpr; i += ngt) { const size_t r = i / cpr, c = (i % cpr) * 4; const f32x4 a = *(const f32x4*)(p + r * ld + c);
        bad |= badf(a.x) | badf(a.y) | badf(a.z) | badf(a.w); }
    if (bad) *flag = 1u;
}
#endif
struct Args { const float* in[23]; float* out; unsigned char* ws; int ph_lo, ph_hi, never, pad; };
enum { I_X = 0, I_C, I_CTX, I_CCTX, I_ADAW, I_ADAB, I_NORMW, I_EWIN, I_ECONVQKV, I_EALOG, I_EDTB, I_EHN, I_ECONVB, I_EWOUT, I_OWIN, I_OLNW, I_OLNB, I_OWS, I_OBS, I_OPW, I_OPS, I_OWOUT, I_FNW };

template <class SrcFn>
__device__ __forceinline__ void conv_item(const float* W, int ldw, int K, bf16_t* WT, int c0, int k0, LAS float* scr, int lane, const SrcFn& src) {
    const int sc = src(c0 + lane);
    const float* wp = W + (size_t)k0 * ldw + (sc >= 0 ? sc : 0);
    float v[64];
#pragma unroll
    for (int i = 0; i < 64; ++i) v[i] = wp[(size_t)i * ldw];
#pragma unroll
    for (int i = 0; i < 64; ++i) scr[i * 65 + lane] = sc >= 0 ? v[i] : 0.f;
    LDS_WAIT(); asm volatile("" ::: "memory");
    const int kc = lane >> 3, cc = lane & 7;
#pragma unroll
    for (int j = 0; j < 8; ++j) { const int c = cc + 8 * j; const LAS float* sp = scr + (8 * kc) * 65 + c;
        u32x4 o; o.x = cvt_pk_bf16(sp[0 * 65], sp[1 * 65]); o.y = cvt_pk_bf16(sp[2 * 65], sp[3 * 65]); o.z = cvt_pk_bf16(sp[4 * 65], sp[5 * 65]); o.w = cvt_pk_bf16(sp[6 * 65], sp[7 * 65]);
        *(u32x4*)(WT + (size_t)(c0 + c) * K + k0 + 8 * kc) = o; }
    LDS_WAIT(); asm volatile("" ::: "memory");
}
struct SrcId { __device__ __forceinline__ int operator()(int c) const { return c; } };
struct SrcW1 { __device__ __forceinline__ int operator()(int c) const {
    if (c < 8192) return c;
    if (c < 16384) { const int cc = c - 8192, T = cc >> 8, cp = cc & 255, bj = cp >> 7, wc = (cp >> 5) & 3, fq = (cp >> 3) & 3, n = (cp >> 2) & 1, j = cp & 3;
        return 8256 + 2048 * (2 * bj + n) + 64 * T + 16 * wc + 4 * fq + j; }
    const int cp = c - 16384; return cp < 64 ? 8192 + cp : -1; } };

__device__ __forceinline__ void mod_task(const float* adaw, const float* adab, float* modl, int n0, const LAS float* tab, LAS float* red, int wave, int lane) {
    const int col = n0 + (lane & 31), kp = lane >> 5;
    float acc[5] = {0.f, 0.f, 0.f, 0.f, 0.f};
    const float* wp = adaw + (size_t)(256 * wave + kp) * 6144 + col;
#pragma unroll 32
    for (int kk = 0; kk < 128; ++kk) { const float wv = wp[(size_t)kk * 2 * 6144]; const int k = 256 * wave + 2 * kk + kp;
#pragma unroll
        for (int r = 0; r < 5; ++r) acc[r] += tab[r * 2048 + k] * wv; }
#pragma unroll
    for (int r = 0; r < 5; ++r) { acc[r] += __shfl_xor(acc[r], 32); if (lane < 32) red[(wave * 5 + r) * 32 + lane] = acc[r]; }
    __syncthreads();
    if (threadIdx.x < 160) { const int r = threadIdx.x >> 5, c = threadIdx.x & 31; float s = adab[n0 + c];
#pragma unroll
        for (int w = 0; w < 8; ++w) s += red[(w * 5 + r) * 32 + c];
        modl[r * 6144 + n0 + c] = s; }
    __syncthreads();
}
__device__ __forceinline__ void silu_table(const float* c, const float* cctx, LAS float* tab) {
    for (int i = threadIdx.x; i < 5 * 2048; i += 512) { const float v = i < 8192 ? c[i] : cctx[i - 8192]; tab[i] = silu_f(v); }
    __syncthreads();
}

__device__ __forceinline__ void hrow(const float* xrow, const float* nw, const float* modr, bf16_t* orow, int lane) {
    const f32x4* xr = (const f32x4*)xrow + lane;
    f32x4 v[8]; float s = 0.f;
#pragma unroll
    for (int j = 0; j < 8; ++j) { v[j] = xr[64 * j]; s += (v[j].x * v[j].x + v[j].y * v[j].y) + (v[j].z * v[j].z + v[j].w * v[j].w); }
    const float rstd = rsqrtf(wave_sum(s) * (1.f / DM) + EPS);
    u32x2* o8 = (u32x2*)orow + lane;
#pragma unroll
    for (int j = 0; j < 8; ++j) { const f32x4 w = ((const f32x4*)nw)[lane + 64 * j], sh = ((const f32x4*)modr)[lane + 64 * j], sc = ((const f32x4*)(modr + 2048))[lane + 64 * j];
        const f32x4 y = v[j] * rstd * w * (sc + 1.0f) + sh; u32x2 p; p.x = cvt_pk_bf16(y.x, y.y); p.y = cvt_pk_bf16(y.z, y.w); o8[64 * j] = p; }
}

__device__ __forceinline__ void hrows4(const float* x0, const float* nw, const float* modr, bf16_t* o0, int lane) {
    f32x4 g[8], sh[8];
#pragma unroll
    for (int j = 0; j < 8; ++j) { const f32x4 w = ((const f32x4*)nw)[lane + 64 * j], sc = ((const f32x4*)(modr + 2048))[lane + 64 * j]; g[j] = w * (sc + 1.0f); sh[j] = ((const f32x4*)modr)[lane + 64 * j]; }
    f32x4 v[8], nx[8];
#pragma unroll
    for (int j = 0; j < 8; ++j) v[j] = ((const f32x4*)x0)[lane + 64 * j];
#pragma unroll 1
    for (int k = 0; k < 4; ++k) {
        if (k < 3) {
#pragma unroll
            for (int j = 0; j < 8; ++j) nx[j] = ((const f32x4*)(x0 + (size_t)(k + 1) * DM))[lane + 64 * j]; }
        float s = 0.f;
#pragma unroll
        for (int j = 0; j < 8; ++j) s += (v[j].x * v[j].x + v[j].y * v[j].y) + (v[j].z * v[j].z + v[j].w * v[j].w);
        const float rstd = rsqrtf(wave_sum(s) * (1.f / DM) + EPS);
        u32x2* o8 = (u32x2*)(o0 + (size_t)k * DM) + lane;
#pragma unroll
        for (int j = 0; j < 8; ++j) { const f32x4 y = v[j] * rstd * g[j] + sh[j]; u32x2 p; p.x = cvt_pk_bf16(y.x, y.y); p.y = cvt_pk_bf16(y.z, y.w); o8[64 * j] = p; }
#pragma unroll
        for (int j = 0; j < 8; ++j) v[j] = nx[j];
    }
}

typedef f32x4 AccT[2][2][4][2];
struct Sched1 { int G, c; const char* A; const char* B;
    __device__ __forceinline__ bool next(int i, pg8::Unit& u) const {
        const int L = i * G + c; if (L >= 2148) return false;
        if (L < 2080) { int pv; pg8::tile_order(L, 32, 65, u.pm, pv);
            const int hc = (pv * 24) / 65, hn = ((pv + 1) * 24) / 65; u.pn = hn > hc ? hc : 24 + (pv - hc); }
        else { const int l = L - 2080; u.pm = 32 + (l & 3); const int t = l >> 2; u.pn = t < 16 ? 8 + t : 64; }
        u.aux = 0; u.a = A + (size_t)u.pm * (256 * 2048 * 2); u.b = B + (size_t)u.pn * (256 * 2048 * 2); return true; } };
struct Epi1 { static constexpr bool PERM = true;
    unsigned char* wsb; const float* convb; const float* convq; LAS unsigned char* lds;
#define E1_ZA ((bf16_t*)(wsb + WS_ZA))
#define E1_Y ((bf16_t*)(wsb + WS_Y))
#define E1_QN ((bf16_t*)(wsb + WS_QN))
#define E1_KN ((bf16_t*)(wsb + WS_KN))
#define E1_KT ((bf16_t*)(wsb + WS_KT))
#define E1_VT ((bf16_t*)(wsb + WS_VT))
#define E1_GG ((float*)(wsb + WS_GG))
#define E1_BETA ((float*)(wsb + WS_BETA))
    template <int M> __device__ __forceinline__ f32x4 conv4(const AccT& acc, int ai, int bj, int n, const f32x4& w0, const f32x4& w1, const f32x4& w2, const f32x4& hp, const f32x4& hn, int lane) const {
        f32x4 y;
#pragma unroll
        for (int j = 0; j < 4; ++j) {
            const float x = acc[ai][bj][M][n][j];
            const float bp = M > 0 ? dpp_ror1(acc[ai][bj][M > 0 ? M - 1 : 0][n][j]) : hp[j];
            const float bn = M < 3 ? dpp_ror15(acc[ai][bj][M < 3 ? M + 1 : 3][n][j]) : hn[j];
            const float up = dpp_shr1(x, bp), dn = dpp_shl1(x, bn);
            y[j] = silu_f(w0[j] * up + w1[j] * x + w2[j] * dn); }
        return y;
    }
    __device__ __forceinline__ void qkv(const bool CTX, const AccT& acc, const pg8::Unit& u, int wr, int wc, int fr, int fq) const {
        const int lane = 16 * fq + fr, tens = u.pn >> 3, hd0 = (u.pn & 7) * 2;
        LAS float* part = (LAS float*)(lds + 131072);
        LAS float* bnd = (LAS float*)(lds + 139264);
        LAS float* cwl = (LAS float*)(lds + 147456);
        { const int t_ = (int)threadIdx.x; const float* cq = convq + tens * 2048 + hd0 * 128;
          cwl[t_] = cq[(t_ >> 8) * 6144 + (t_ & 255)]; if (t_ < 256) cwl[512 + t_] = cq[2 * 6144 + t_]; }
        if (CTX) {
#pragma unroll
            for (int ai = 0; ai < 2; ++ai)
#pragma unroll
                for (int bj = 0; bj < 2; ++bj)
#pragma unroll
                    for (int n = 0; n < 2; ++n) { const int col = 128 * bj + 32 * wc + 8 * fq + 4 * n, g = 2 * ai + wr;
                        if (fr == 0) *(LAS f32x4*)(bnd + (g * 2 + 0) * 256 + col) = acc[ai][bj][0][n];
                        if (fr == 15) *(LAS f32x4*)(bnd + (g * 2 + 1) * 256 + col) = acc[ai][bj][3][n]; }
        }
        asm volatile("s_waitcnt lgkmcnt(0)" ::: "memory"); __builtin_amdgcn_s_barrier(); asm volatile("" ::: "memory");
        const int b = CTX ? (u.pm - 32) : (u.pm >> 3);
#pragma unroll
        for (int pass = 0; pass < 2; ++pass) {
            if (pass == 0 && tens == 2) continue;
#pragma unroll
            for (int ai = 0; ai < 2; ++ai)
#pragma unroll
                for (int bj = 0; bj < 2; ++bj) {
                    const int cg = tens * 2048 + (hd0 + bj) * 128 + 32 * wc + 8 * fq, col = 128 * bj + 32 * wc + 8 * fq, g = 2 * ai + wr, bh = b * NHD + hd0 + bj;
                    float ss[4] = {0.f, 0.f, 0.f, 0.f};
#pragma unroll
                    for (int n = 0; n < 2; ++n) {
                        const f32x4 w0 = *(const LAS f32x4*)(cwl + col + 4 * n), w1 = *(const LAS f32x4*)(cwl + 256 + col + 4 * n), w2 = *(const LAS f32x4*)(cwl + 512 + col + 4 * n);
                        f32x4 hp = {0.f, 0.f, 0.f, 0.f}, hn = {0.f, 0.f, 0.f, 0.f};
                        if (CTX) { if (g > 0) hp = *(const LAS f32x4*)(bnd + ((g - 1) * 2 + 1) * 256 + col + 4 * n);
                                   if (g < 3) hn = *(const LAS f32x4*)(bnd + ((g + 1) * 2 + 0) * 256 + col + 4 * n); }
                        const int ch = 32 * wc + 8 * fq + 4 * n;
#define E1_ROW(M) do { f32x4 y = conv4<M>(acc, ai, bj, n, w0, w1, w2, hp, hn, lane); \
                        if (pass == 0) ss[M] += (y[0] * y[0] + y[1] * y[1]) + (y[2] * y[2] + y[3] * y[3]); \
                        else { const int r = 128 * ai + 64 * wr + 16 * (M) + fr; const int tok = CTX ? r : CTXL + ((u.pm & 7) * 256 + r); \
                            if (tens < 2) { const f32x4 ps = *(const LAS f32x4*)(part + r * 8 + bj * 4); const float rs = rsqrtf((ps[0] + ps[1]) + (ps[2] + ps[3]) + EPS); y = y * rs; } \
                            u32x2 w; w.x = cvt_pk_bf16(y[0], y[1]); w.y = cvt_pk_bf16(y[2], y[3]); \
                            if (tens == 0) *(u32x2*)(E1_QN + ((size_t)bh * NTOK + tok) * HD + ch) = w; \
                            if (tens == 1) *(u32x2*)(E1_KN + ((size_t)bh * NTOK + tok) * HD + ch) = w; \
                            if (tens >= 1) { bf16_t* T = (tens == 1 ? E1_KT : E1_VT) + ((size_t)bh * HD + ch) * NTOK + tok; \
                                T[0] = (bf16_t)(w.x & 0xffffu); T[NTOK] = (bf16_t)(w.x >> 16); T[2 * NTOK] = (bf16_t)(w.y & 0xffffu); T[3 * NTOK] = (bf16_t)(w.y >> 16); } } \
                        } while (0)
                        E1_ROW(0); E1_ROW(1); E1_ROW(2); E1_ROW(3);
                        asm volatile("" ::: "memory"); __builtin_amdgcn_sched_barrier(0);
#undef E1_ROW
                    }
                    if (pass == 0) {
#pragma unroll
                        for (int m = 0; m < 4; ++m) { float t = ss[m]; t += __shfl_xor(t, 16); t += __shfl_xor(t, 32);
                            if (fq == 0) part[(128 * ai + 64 * wr + 16 * m + fr) * 8 + bj * 4 + wc] = t; } }
                }
            if (pass == 0) { asm volatile("s_waitcnt lgkmcnt(0)" ::: "memory"); __builtin_amdgcn_s_barrier(); asm volatile("" ::: "memory"); }
        }
    }
    __device__ __forceinline__ void operator()(const AccT& acc, const pg8::Unit& u, int wr, int wc, int fr_in, int fq_in) const {
        int fr = fr_in, fq = fq_in; asm volatile("" : "+v"(fr), "+v"(fq));
        const int row0 = u.pm * 256 + wr * 64 + fr;
        if (u.pn < 24) { qkv(u.pm >= 32, acc, u, wr, wc, fr, fq); }
        else if (u.pn < 32) {
            const int col0 = (u.pn - 24) * 256 + wc * 32 + 8 * fq;
#pragma unroll
            for (int ai = 0; ai < 2; ++ai)
#pragma unroll
                for (int m = 0; m < 4; ++m) { bf16_t* rowp = E1_ZA + (size_t)(row0 + ai * 128 + m * 16) * 2048 + col0;
#pragma unroll
                    for (int bj = 0; bj < 2; ++bj) { f32x4 v0 = acc[ai][bj][m][0], v1 = acc[ai][bj][m][1];
#pragma unroll
                        for (int j = 0; j < 4; ++j) { v0[j] = silu_f(v0[j]); v1[j] = silu_f(v1[j]); }
                        u32x4 w; w.x = cvt_pk_bf16(v0[0], v0[1]); w.y = cvt_pk_bf16(v0[2], v0[3]); w.z = cvt_pk_bf16(v1[0], v1[1]); w.w = cvt_pk_bf16(v1[2], v1[3]);
                        *(u32x4*)(rowp + bj * 128) = w; } }
        } else if (u.pn < 64) {
            const int lane = 16 * fq + fr;
            const int ch0 = 64 * (u.pn - 32) + 16 * wc + 4 * fq;
            const f32x4 cw0 = *(const f32x4*)(convb + ch0), cw1 = *(const f32x4*)(convb + 2048 + ch0), cw2 = *(const f32x4*)(convb + 4096 + ch0);
#pragma unroll
            for (int ai = 0; ai < 2; ++ai) {
                f32x4 pr[4];
#pragma unroll
                for (int m = 0; m < 4; ++m) pr[m] = acc[ai][0][m][1] * acc[ai][1][m][0];
#pragma unroll
                for (int m = 0; m < 4; ++m) { f32x4 y;
#pragma unroll
                    for (int j = 0; j < 4; ++j) {
                        const float bp = m > 0 ? dpp_ror1(pr[m > 0 ? m - 1 : 0][j]) : 0.f;
                        const float bn = m < 3 ? dpp_ror15(pr[m < 3 ? m + 1 : 3][j]) : 0.f;
                        const float up = dpp_shr1(pr[m][j], bp), dn = dpp_shl1(pr[m][j], bn);
                        const float cv = cw0[j] * up + cw1[j] * pr[m][j] + cw2[j] * dn;
                        y[j] = acc[ai][0][m][0][j] * cv * silu_f(acc[ai][1][m][1][j]); }
                    u32x2 w; w.x = cvt_pk_bf16(y[0], y[1]); w.y = cvt_pk_bf16(y[2], y[3]);
                    *(u32x2*)(E1_Y + (size_t)(row0 + ai * 128 + m * 16) * 4096 + 2048 + ch0) = w; } }
        } else {
            if (wc < 2) {
#pragma unroll
                for (int ai = 0; ai < 2; ++ai)
#pragma unroll
                    for (int m = 0; m < 4; ++m)
#pragma unroll
                        for (int n = 0; n < 2; ++n) *(f32x4*)((float*)(wsb + WS_AB) + (size_t)(row0 + ai * 128 + m * 16) * 64 + 32 * wc + 8 * fq + 4 * n) = acc[ai][0][m][n]; }
        }
    } };
struct EpiResid { static constexpr bool PERM = false;
    const float* resid; float* out; const float* gate;
    __device__ __forceinline__ void operator()(const AccT& acc, const pg8::Unit& u, int wr, int wc, int fr, int fq) const {
        const int row0 = u.pm * 256 + wr * 64 + fr, col0 = u.pn * 256 + wc * 32 + 4 * fq; const float* g = gate + (size_t)(u.pm >> 3) * 6144;
        f32x4 gv[2][2];
#pragma unroll
        for (int bj = 0; bj < 2; ++bj)
#pragma unroll
            for (int n = 0; n < 2; ++n) gv[bj][n] = *(const f32x4*)(g + col0 + bj * 128 + n * 16);
#pragma unroll
        for (int ai = 0; ai < 2; ++ai)
#pragma unroll
            for (int m = 0; m < 4; ++m) { const size_t off = (size_t)(row0 + ai * 128 + m * 16) * DM + col0;
#pragma unroll
                for (int bj = 0; bj < 2; ++bj)
#pragma unroll
                    for (int n = 0; n < 2; ++n) { const f32x4 r = *(const f32x4*)(resid + off + bj * 128 + n * 16); *(f32x4*)(out + off + bj * 128 + n * 16) = r + gv[bj][n] * acc[ai][bj][m][n]; }
                asm volatile("" ::: "memory"); }
    } };
struct Epi3 { static constexpr bool PERM = true;
    bf16_t* P1;
    __device__ __forceinline__ void operator()(const AccT& acc, const pg8::Unit& u, int wr, int wc, int fr, int fq) const {
        const int row0 = u.pm * 256 + wr * 64 + fr, col0 = u.pn * 256 + wc * 32 + 8 * fq;
        const int act = u.pn < 16 ? 1 : ((u.pn >= 24 && u.pn < 32) ? 0 : 2);
#pragma unroll
        for (int ai = 0; ai < 2; ++ai)
#pragma unroll
            for (int m = 0; m < 4; ++m) { bf16_t* rowp = P1 + (size_t)(row0 + ai * 128 + m * 16) * N3 + col0;
#pragma unroll
                for (int bj = 0; bj < 2; ++bj) { f32x4 v0 = acc[ai][bj][m][0], v1 = acc[ai][bj][m][1];
                    if (act == 1) {
#pragma unroll
                        for (int j = 0; j < 4; ++j) { v0[j] = gelu_f(v0[j]); v1[j] = gelu_f(v1[j]); } }
                    else if (act == 2) {
#pragma unroll
                        for (int j = 0; j < 4; ++j) { v0[j] = silu_f(v0[j]); v1[j] = silu_f(v1[j]); } }
                    u32x4 w; w.x = cvt_pk_bf16(v0[0], v0[1]); w.y = cvt_pk_bf16(v0[2], v0[3]); w.z = cvt_pk_bf16(v1[0], v1[1]); w.w = cvt_pk_bf16(v1[2], v1[3]);
                    *(u32x4*)(rowp + bj * 128) = w; } }
    } };
struct SchedPool { int G, c; const char* A; const char* B;
    __device__ __forceinline__ bool next(int i, pg8::Unit& u) const {
        const int L = i * G + c; if (L >= 256) return false;
        u.aux = L >> 6; u.pn = (L >> 5) & 1; u.pm = L & 31;
        u.a = A + ((size_t)u.pm * 256 * 2048 + 512 * u.aux) * 2; u.b = B + ((size_t)u.aux * 512 * 512 + (size_t)u.pn * 256 * 512) * 2; return true; } };
struct EpiPool { static constexpr bool PERM = true;
    const bf16_t* P1; bf16_t* Y2; const float* pscale;
    __device__ __forceinline__ void operator()(const AccT& acc, const pg8::Unit& u, int wr, int wc, int fr, int fq) const {
        const int row0 = u.pm * 256 + wr * 64 + fr, colg = 512 * u.aux + 256 * u.pn + wc * 32 + 8 * fq;
        f32x4 ps[2][2];
#pragma unroll
        for (int bj = 0; bj < 2; ++bj)
#pragma unroll
            for (int n = 0; n < 2; ++n) ps[bj][n] = *(const f32x4*)(pscale + colg + bj * 128 + 4 * n);
#pragma unroll
        for (int ai = 0; ai < 2; ++ai)
#pragma unroll
            for (int m = 0; m < 4; ++m) { const size_t row = (size_t)(row0 + ai * 128 + m * 16);
#pragma unroll
                for (int bj = 0; bj < 2; ++bj) { const u32x4 z = *(const u32x4*)(P1 + row * N3 + 8192 + colg + bj * 128);
                    f32x4 v0 = acc[ai][bj][m][0] * ps[bj][0], v1 = acc[ai][bj][m][1] * ps[bj][1]; if (ABLATE & 8) { v0 = v0 * 0.f; v1 = v1 * 0.f; }
                    u32x4 w; w.x = cvt_pk_bf16(v0[0] * bf_lo(z.x), v0[1] * bf_hi(z.x)); w.y = cvt_pk_bf16(v0[2] * bf_lo(z.y), v0[3] * bf_hi(z.y));
                    w.z = cvt_pk_bf16(v1[0] * bf_lo(z.z), v1[1] * bf_hi(z.z)); w.w = cvt_pk_bf16(v1[2] * bf_lo(z.w), v1[3] * bf_hi(z.w));
                    *(u32x4*)(Y2 + row * 4096 + 2048 + colg + bj * 128) = w; } }
    } };

__device__ __forceinline__ void qkv_task(int task, const bf16_t* PQKV, const float* convw, bf16_t* QN, bf16_t* KN, bf16_t* KT, bf16_t* VT, int lane) {
    const int head = task & 15, tens = (task >> 4) % 3, blk = task / 48;
    int b, t0, prow0, tokb; bool isx;
    if (blk < 128) { isx = true; b = blk >> 5; t0 = (blk & 31) * 64; prow0 = b * SEQ + t0; tokb = CTXL + t0; }
    else { isx = false; const int cb = blk - 128; b = cb >> 2; t0 = (cb & 3) * 64; prow0 = MX + b * CTXL + t0; tokb = t0; }
    const int col = tens * 2048 + head * 128 + 2 * lane;
    const f32x2 w0 = *(const f32x2*)(convw + col), w1 = *(const f32x2*)(convw + 6144 + col), w2 = *(const f32x2*)(convw + 12288 + col);
    const bf16_t* p = PQKV + (size_t)prow0 * 6144 + col;
    const int bh = b * NHD + head;
    unsigned v[66];
    v[0] = 0u; v[65] = 0u;
    if (!isx && t0 > 0) v[0] = *(const unsigned*)(p - 6144);
    if (!isx && t0 < 192) v[65] = *(const unsigned*)(p + (size_t)64 * 6144);
#pragma unroll
    for (int i = 0; i < 64; ++i) v[i + 1] = *(const unsigned*)(p + (size_t)i * 6144);
    unsigned tr0[4], tr1[4];
    float hold0 = 0.f, hold1 = 0.f;
#pragma unroll
    for (int i = 0; i < 64; ++i) {
        const unsigned pv = v[i], cu = v[i + 1], nx = v[i + 2];
        float o0 = w0.x * bf_lo(pv) + w1.x * bf_lo(cu) + w2.x * bf_lo(nx);
        float o1 = w0.y * bf_hi(pv) + w1.y * bf_hi(cu) + w2.y * bf_hi(nx);
        o0 = silu_f(o0); o1 = silu_f(o1);
        if (tens < 2) { const float ss = wave_sum(o0 * o0 + o1 * o1); const float sc = rsqrtf(ss + EPS); o0 *= sc; o1 *= sc; }
        const int tok = tokb + i;
        if (tens == 0) *(unsigned*)(QN + ((size_t)bh * NTOK + tok) * HD + 2 * lane) = cvt_pk_bf16(o0, o1);
        if (tens == 1) *(unsigned*)(KN + ((size_t)bh * NTOK + tok) * HD + 2 * lane) = cvt_pk_bf16(o0, o1);
        if (tens >= 1) {
            if (i & 1) { tr0[(i >> 1) & 3] = cvt_pk_bf16(hold0, o0); tr1[(i >> 1) & 3] = cvt_pk_bf16(hold1, o1); } else { hold0 = o0; hold1 = o1; }
            if ((i & 7) == 7) { bf16_t* T = (tens == 1 ? KT : VT) + ((size_t)bh * HD + 2 * lane) * NTOK + tok - 7;
                *(u32x4*)T = (u32x4){tr0[0], tr0[1], tr0[2], tr0[3]}; *(u32x4*)(T + NTOK) = (u32x4){tr1[0], tr1[1], tr1[2], tr1[3]}; } }
    }
}
__device__ __forceinline__ void ab_task(int blk, const float* AB, const float* alog, const float* dtb, float* GG, float* BETA, int lane) {
    int b, prow0, tokb;
    if (blk < 128) { b = blk >> 5; const int t0 = (blk & 31) * 64; prow0 = b * SEQ + t0; tokb = CTXL + t0; }
    else { const int cb = blk - 128; b = cb >> 2; const int t0 = (cb & 3) * 64; prow0 = MX + b * CTXL + t0; tokb = t0; }
    const int kind = lane >> 4, h = lane & 15, d = kind & 1;
    const float A = __expf(alog[d * 16 + h]), db = dtb[d * 16 + h];
    float* dst = (kind < 2 ? GG : BETA) + ((size_t)d * NBH + b * NHD + h) * NTOK + tokb;
#pragma unroll 4
    for (int i = 0; i < 64; ++i) { const float v = AB[(size_t)(prow0 + i) * 64 + lane];
        dst[i] = kind < 2 ? -A * softplus_f(v + db) : sigmoid_f(v); }
}

template <int I> struct FS {
    static __device__ __forceinline__ void run(const LAS float* Ml, float (&Tc)[64], int lane) {
        float a = (lane == I) ? 1.f : 0.f;
#pragma unroll
        for (int jq = 0; jq < (I + 3) / 4; ++jq) { const f32x4 mv = *(const LAS f32x4*)(Ml + I * 68 + 4 * jq);
#pragma unroll
            for (int e = 0; e < 4; ++e) if (4 * jq + e < I) a = fmaf(-mv[e], Tc[4 * jq + e], a); }
        Tc[I] = a;
        __builtin_amdgcn_sched_barrier(0);
        if constexpr (I + 1 < 64) FS<I + 1>::run(Ml, Tc, lane);
    } };
__device__ __forceinline__ void chunk_task(int task, const bf16_t* QN, const bf16_t* KN, const float* AB, const float* alog, const float* dtb, float* GC, bf16_t* TU, bf16_t* AI, LAS float* tab, int lane) {
    const int tc = task % NCH, bh = (task / NCH) & 63, dir = task / (NCH * 64);
    const int tok0 = 64 * tc;
    LAS float* Ml = tab + 128;
    const int mytok = tok0 + (dir ? 63 - lane : lane);
    const size_t gidx = ((size_t)dir * NBH + bh) * NTOK + mytok;
    const int hq = bh & 15, bq = bh >> 4;
    const float* abr = AB + (size_t)(mytok < CTXL ? MX + bq * CTXL + mytok : bq * SEQ + (mytok - CTXL)) * 64;
    const float gl = -__expf(alog[dir * 16 + hq]) * softplus_f(abr[dir * 16 + hq] + dtb[dir * 16 + hq]), bl = sigmoid_f(abr[32 + dir * 16 + hq]);
    float gc = gl;
#pragma unroll
    for (int o = 1; o < 64; o <<= 1) { const float t = __shfl_up(gc, o); if (lane >= o) gc += t; }
    GC[gidx] = gc;
    tab[lane] = gc; tab[64 + lane] = bl;
    LDS_WAIT(); asm volatile("" ::: "memory");
    const int r = lane & 31, hh = lane >> 5;
    bf16x8 ka[2][8];
#pragma unroll
    for (int ib = 0; ib < 2; ++ib) { const int tk = tok0 + (dir ? 63 - (32 * ib + r) : 32 * ib + r); const bf16x8* kp = (const bf16x8*)(KN + ((size_t)bh * NTOK + tk) * HD + 8 * hh);
#pragma unroll
        for (int s = 0; s < 8; ++s) ka[ib][s] = kp[2 * s]; }
    const bool isx = tc >= 4;
    bf16_t* aib = AI + (((size_t)dir * NBH + bh) * NCH + tc) * 4096;
    if (isx) {
#pragma unroll
        for (int ib = 0; ib < 2; ++ib) {
            bf16x8 qa[8]; { const int tk = tok0 + (dir ? 63 - (32 * ib + r) : 32 * ib + r); const bf16x8* qp = (const bf16x8*)(QN + ((size_t)bh * NTOK + tk) * HD + 8 * hh);
#pragma unroll
                for (int s = 0; s < 8; ++s) qa[s] = qp[2 * s]; }
#pragma unroll
            for (int jb = 0; jb < 2; ++jb) {
                f32x16 a = {};
                if (jb <= ib) {
#pragma unroll
                    for (int s = 0; s < 8; ++s) a = __builtin_amdgcn_mfma_f32_32x32x16_bf16(qa[s], ka[jb][s], a, 0, 0, 0); }
                const int jp = 32 * jb + r; const float gcj = tab[jp];
                bf16_t vv[16];
#pragma unroll
                for (int g = 0; g < 4; ++g) { const f32x4 gci = *(const LAS f32x4*)(tab + 32 * ib + 8 * g + 4 * hh);
#pragma unroll
                    for (int e = 0; e < 4; ++e) { const int ip = 32 * ib + 8 * g + 4 * hh + e;
                        vv[4 * g + e] = f2bf((jp <= ip) ? 0.08838834764831845f * a[4 * g + e] * __expf(gci[e] - gcj) : 0.f); } }
                if (dir == 0) { bf16_t* bp = aib + (32 * ib + 4 * hh) * 64 + jp;
#pragma unroll
                    for (int e = 0; e < 16; ++e) bp[((e & 3) + 8 * (e >> 2)) * 64] = vv[e]; }
                else { bf16_t* bp = aib + (63 - 32 * ib - 4 * hh) * 64 + (63 - jp);
#pragma unroll
                    for (int e = 0; e < 16; ++e) bp[-((e & 3) + 8 * (e >> 2)) * 64] = vv[e]; } } }
    }
    f32x16 Mt[3];
#pragma unroll
    for (int t = 0; t < 3; ++t) { const int ib = t > 0, jb = t > 1; f32x16 a = {};
#pragma unroll
        for (int s = 0; s < 8; ++s) a = __builtin_amdgcn_mfma_f32_32x32x16_bf16(ka[ib][s], ka[jb][s], a, 0, 0, 0);
        Mt[t] = a; }
    LAS float* Mlb = Ml + 4 * hh * 68 + r;
#pragma unroll
    for (int t = 0; t < 3; ++t) { const int ib = t > 0, jb = t > 1; const int jp = 32 * jb + r; const float gcj = tab[jp];
#pragma unroll
        for (int g = 0; g < 4; ++g) { const f32x4 gci = *(const LAS f32x4*)(tab + 32 * ib + 8 * g + 4 * hh), bi = *(const LAS f32x4*)(tab + 64 + 32 * ib + 8 * g + 4 * hh);
#pragma unroll
            for (int e = 0; e < 4; ++e) { const int ip = 32 * ib + 8 * g + 4 * hh + e;
                Mt[t][4 * g + e] = (jp < ip) ? bi[e] * Mt[t][4 * g + e] * __expf(gci[e] - gcj) : 0.f;
                Mlb[(32 * ib + 8 * g + e) * 68 + 32 * jb] = Mt[t][4 * g + e]; } } }
    LDS_WAIT(); asm volatile("" ::: "memory");
    float Tc[64];
    FS<0>::run(Ml, Tc, lane);
    bf16_t* tub = TU + (((size_t)dir * NBH + bh) * NCH + tc) * 4096;
    if (dir == 0) { bf16_t* bp = tub + lane;
#pragma unroll
        for (int i = 0; i < 64; ++i) bp[i * 64] = f2bf(Tc[i] * bl); }
    else { bf16_t* bp = tub + 63 * 64 + (63 - lane);
#pragma unroll
        for (int i = 0; i < 64; ++i) bp[-i * 64] = f2bf(Tc[i] * bl); }
    LDS_WAIT(); asm volatile("" ::: "memory");
}

constexpr int G_KT = 0, G_VT = 36864, G_TU = 55296, G_W = 73728, G_ST = 91136, G_VN = 108544, G_VNG = 117760, G_TAB = 126976;
template <int KSTEPS> __device__ __forceinline__ f32x16 mma_tile_t(f32x16 acc, const LAS bf16_t* A, int lda, const LAS bf16_t* B, int ldb, int lane) {
    const LAS bf16_t* ap = A + (lane & 31) * lda + 8 * (lane >> 5); const LAS bf16_t* bp = B + (lane & 31) * ldb + 8 * (lane >> 5);
    bf16x8 af_[KSTEPS], bf_[KSTEPS];
#pragma unroll
    for (int s = 0; s < KSTEPS; ++s) { af_[s] = *(const LAS bf16x8*)(ap + 16 * s); bf_[s] = *(const LAS bf16x8*)(bp + 16 * s); }
#pragma unroll
    for (int s = 0; s < KSTEPS; ++s) acc = __builtin_amdgcn_mfma_f32_32x32x16_bf16(af_[s], bf_[s], acc, 0, 0, 0);
    return acc;
}
__device__ __forceinline__ f32x16 mma_tile(f32x16 acc, const LAS bf16_t* A, int lda, const LAS bf16_t* B, int ldb, int ksteps, int lane) {
    return ksteps == 8 ? mma_tile_t<8>(acc, A, lda, B, ldb, lane) : mma_tile_t<4>(acc, A, lda, B, ldb, lane);
}
__device__ __forceinline__ void scan_chain(int chain, LAS unsigned char* lds, const bf16_t* QN, const bf16_t* KT, const bf16_t* VT, const bf16_t* TU, const bf16_t* AI, const float* GC, bf16_t* OF, bf16_t* OB) {
#define SC_BAR() do { asm volatile("s_waitcnt lgkmcnt(0)" ::: "memory"); __builtin_amdgcn_s_barrier(); asm volatile("" ::: "memory"); } while (0)
    const int tid = threadIdx.x, wave = __builtin_amdgcn_readfirstlane(tid >> 6), lane = tid & 63;
    const int half = chain & 1, bh = (chain >> 1) & 63, dir = chain >> 7, b = bh >> 4, h = bh & 15;
    LAS bf16_t* Ws = (LAS bf16_t*)(lds + G_W); LAS bf16_t* STs = (LAS bf16_t*)(lds + G_ST); LAS bf16_t* VNs = (LAS bf16_t*)(lds + G_VN); LAS bf16_t* VNGs = (LAS bf16_t*)(lds + G_VNG);
    for (int i = tid; i < 17408 / 4; i += 512) ((LAS unsigned*)STs)[i] = 0u;
    f32x16 Sacc = {};
    bf16_t* Od = dir ? OB : OF;
    const int c = lane & 31, hh = lane >> 5;
    const int sr = tid >> 3, sc8 = (tid & 7) * 8;
    const int kbw = wave & 3, tbw = wave >> 2;
    const int tb2 = (wave >> 1) & 1, db2 = wave & 1;
    u32x4 rk0, rk1, rv, rt; float rg = 0.f, rgl = 0.f;
#define SC_TC(st) (dir == 0 ? (st) : ((st) < 4 ? 3 - (st) : 39 - (st)))
#define SC_GLOAD(st) do { const int tc_ = SC_TC(st), tok0_ = 64 * tc_; \
        rk0 = *(const u32x4*)(KT + ((size_t)bh * HD + sr) * NTOK + tok0_ + sc8); rk1 = *(const u32x4*)(KT + ((size_t)bh * HD + 64 + sr) * NTOK + tok0_ + sc8); \
        rv = *(const u32x4*)(VT + ((size_t)bh * HD + 64 * half + sr) * NTOK + tok0_ + sc8); rt = *(const u32x4*)(TU + (((size_t)dir * NBH + bh) * NCH + tc_) * 4096 + sr * 64 + sc8); \
        if (tid < 64) { const float* gp_ = GC + ((size_t)dir * NBH + bh) * NTOK + tok0_; rg = gp_[tid]; rgl = gp_[dir ? 0 : 63]; } } while (0)
#define SC_LSTORE(p) do { LAS bf16_t* kt_ = (LAS bf16_t*)(lds + G_KT + (p) * 18432); \
        *(LAS u32x4*)(kt_ + sr * 72 + sc8) = rk0; *(LAS u32x4*)(kt_ + (64 + sr) * 72 + sc8) = rk1; \
        *(LAS u32x4*)((LAS bf16_t*)(lds + G_VT + (p) * 9216) + sr * 72 + sc8) = rv; *(LAS u32x4*)((LAS bf16_t*)(lds + G_TU + (p) * 9216) + sr * 72 + sc8) = rt; \
        if (tid < 64) { LAS float* tb_ = (LAS float*)(lds + G_TAB + (p) * 544); tb_[tid] = __expf(rg); tb_[64 + tid] = __expf(rgl - rg); if (tid == 0) tb_[128] = __expf(rgl); } } while (0)
#define SC_W(p) do { const LAS bf16_t* ap_ = (const LAS bf16_t*)(lds + G_KT + (p) * 18432) + (32 * kbw + c) * 72 + 8 * hh; const LAS bf16_t* bp_ = (const LAS bf16_t*)(lds + G_TU + (p) * 9216) + (32 * tbw + c) * 72 + 8 * hh; \
        const LAS float* tb_ = (const LAS float*)(lds + G_TAB + (p) * 544); f32x16 a_ = {}; \
        _Pragma("unroll") for (int s_ = 0; s_ < 4; ++s_) { const bf16x8 av_ = *(const LAS bf16x8*)(ap_ + 16 * s_); const u32x4 bu_ = *(const LAS u32x4*)(bp_ + 16 * s_); \
            const f32x4 e0_ = *(const LAS f32x4*)(tb_ + 16 * s_ + 8 * hh), e1_ = *(const LAS f32x4*)(tb_ + 16 * s_ + 8 * hh + 4); u32x4 bs_; \
            bs_.x = cvt_pk_bf16(bf_lo(bu_.x) * e0_[0], bf_hi(bu_.x) * e0_[1]); bs_.y = cvt_pk_bf16(bf_lo(bu_.y) * e0_[2], bf_hi(bu_.y) * e0_[3]); \
            bs_.z = cvt_pk_bf16(bf_lo(bu_.z) * e1_[0], bf_hi(bu_.z) * e1_[1]); bs_.w = cvt_pk_bf16(bf_lo(bu_.w) * e1_[2], bf_hi(bu_.w) * e1_[3]); \
            a_ = __builtin_amdgcn_mfma_f32_32x32x16_bf16(av_, __builtin_bit_cast(bf16x8, bs_), a_, 0, 0, 0); } \
        _Pragma("unroll") for (int g_ = 0; g_ < 4; ++g_) { u32x2 w_; w_.x = cvt_pk_bf16(-a_[4 * g_], -a_[4 * g_ + 1]); w_.y = cvt_pk_bf16(-a_[4 * g_ + 2], -a_[4 * g_ + 3]); \
            *(LAS u32x2*)(Ws + (32 * tbw + c) * 136 + 32 * kbw + 8 * g_ + 4 * hh) = w_; } } while (0)
    SC_GLOAD(0);
    SC_BAR();
    SC_LSTORE(0);
    SC_GLOAD(1);
    SC_BAR();
    SC_W(0);
    bf16x8 qf[8], af[4];
#pragma unroll
    for (int s = 0; s < 8; ++s) qf[s] = (bf16x8){0, 0, 0, 0, 0, 0, 0, 0};
#pragma unroll
    for (int s = 0; s < 4; ++s) af[s] = (bf16x8){0, 0, 0, 0, 0, 0, 0, 0};
    if (wave >= 4 && SC_TC(0) >= 4) { const bf16x8* qp = (const bf16x8*)(QN + ((size_t)bh * NTOK + 64 * SC_TC(0) + 32 * tb2 + c) * HD + 8 * hh);
#pragma unroll
        for (int s = 0; s < 8; ++s) qf[s] = qp[2 * s];
        const bf16x8* ap = (const bf16x8*)(AI + (((size_t)dir * NBH + bh) * NCH + SC_TC(0)) * 4096 + (32 * tb2 + c) * 64 + 8 * hh);
#pragma unroll
        for (int s = 0; s < 4; ++s) af[s] = ap[2 * s]; }
    SC_BAR();
    for (int step = 0; step < NCH; ++step) {
        const int p = step & 1, tc = SC_TC(step), tok0 = 64 * tc; const bool isx = tc >= 4;
        const LAS float* tab = (const LAS float*)(lds + G_TAB + p * 544);
        if (step + 1 < NCH) SC_LSTORE(p ^ 1);
        if (step + 2 < NCH) SC_GLOAD(step + 2);
        f32x16 oacc = {};
        if (wave < 4) {
            f32x16 a = {};
            a = mma_tile(a, (const LAS bf16_t*)(lds + G_TU + p * 9216) + 32 * tb2 * 72, 72, (const LAS bf16_t*)(lds + G_VT + p * 9216) + 32 * db2 * 72, 72, 4, lane);
            a = mma_tile(a, Ws + 32 * tb2 * 136, 136, STs + 32 * db2 * 136, 136, 8, lane);
#pragma unroll
            for (int g = 0; g < 4; ++g) { const f32x4 sc = *(const LAS f32x4*)(tab + 64 + 32 * tb2 + 8 * g + 4 * hh);
                u32x2 w, wg; w.x = cvt_pk_bf16(a[4 * g], a[4 * g + 1]); w.y = cvt_pk_bf16(a[4 * g + 2], a[4 * g + 3]);
                wg.x = cvt_pk_bf16(a[4 * g] * sc[0], a[4 * g + 1] * sc[1]); wg.y = cvt_pk_bf16(a[4 * g + 2] * sc[2], a[4 * g + 3] * sc[3]);
                *(LAS u32x2*)(VNs + (32 * db2 + c) * 72 + 32 * tb2 + 8 * g + 4 * hh) = w; *(LAS u32x2*)(VNGs + (32 * db2 + c) * 72 + 32 * tb2 + 8 * g + 4 * hh) = wg; }
        } else if (isx) {
            const LAS bf16_t* bp = STs + (32 * db2 + c) * 136 + 8 * hh;
#pragma unroll
            for (int s = 0; s < 8; ++s) oacc = __builtin_amdgcn_mfma_f32_32x32x16_bf16(qf[s], *(const LAS bf16x8*)(bp + 16 * s), oacc, 0, 0, 0);
#pragma unroll
            for (int g = 0; g < 4; ++g) { const f32x4 sc = *(const LAS f32x4*)(tab + 32 * tb2 + 8 * g + 4 * hh);
#pragma unroll
                for (int e = 0; e < 4; ++e) oacc[4 * g + e] *= 0.08838834764831845f * sc[e]; }
        }
        if (wave >= 4 && step + 1 < NCH && SC_TC(step + 1) >= 4) { const bf16x8* qp = (const bf16x8*)(QN + ((size_t)bh * NTOK + 64 * SC_TC(step + 1) + 32 * tb2 + c) * HD + 8 * hh);
#pragma unroll
            for (int s = 0; s < 8; ++s) qf[s] = qp[2 * s]; }
        SC_BAR();
        {
            const int kb = wave & 3, db = wave >> 2; const float egl = tab[128];
#pragma unroll
            for (int e = 0; e < 16; ++e) Sacc[e] *= egl;
            Sacc = mma_tile(Sacc, (const LAS bf16_t*)(lds + G_KT + p * 18432) + 32 * kb * 72, 72, VNGs + 32 * db * 72, 72, 4, lane);
#pragma unroll
            for (int g = 0; g < 4; ++g) { u32x2 w; w.x = cvt_pk_bf16(Sacc[4 * g], Sacc[4 * g + 1]); w.y = cvt_pk_bf16(Sacc[4 * g + 2], Sacc[4 * g + 3]);
                *(LAS u32x2*)(STs + (32 * db + c) * 136 + 32 * kb + 8 * g + 4 * hh) = w; }
        }
        if (step + 1 < NCH) SC_W(p ^ 1);
        if (wave >= 4 && isx) {
            const LAS bf16_t* bp = VNs + (32 * db2 + c) * 72 + 8 * hh;
#pragma unroll
            for (int s = 0; s < 4; ++s) oacc = __builtin_amdgcn_mfma_f32_32x32x16_bf16(af[s], *(const LAS bf16x8*)(bp + 16 * s), oacc, 0, 0, 0);
            bf16_t* op = Od + ((size_t)b * SEQ + (tok0 - CTXL) + 32 * tb2) * DM + h * HD + 64 * half + 32 * db2 + c;
#pragma unroll
            for (int e = 0; e < 16; ++e) { const int t = (e & 3) + 8 * (e >> 2) + 4 * hh; op[(size_t)t * DM] = f2bf(oacc[e]); }
        }
        if (wave >= 4 && step + 1 < NCH && SC_TC(step + 1) >= 4) { const bf16x8* ap = (const bf16x8*)(AI + (((size_t)dir * NBH + bh) * NCH + SC_TC(step + 1)) * 4096 + (32 * tb2 + c) * 64 + 8 * hh);
#pragma unroll
            for (int s = 0; s < 4; ++s) af[s] = ap[2 * s]; }
        SC_BAR();
    }
#undef SC_TC
#undef SC_BAR
#undef SC_GLOAD
#undef SC_LSTORE
#undef SC_W
}

#ifndef DBG_THR
#define DBG_THR 1000.f
#endif
__device__ __forceinline__ void finish_row(int row, const bf16_t* OF, const bf16_t* OB, const bf16_t* ZA, const float* hn, bf16_t* Y, int lane, unsigned* dbgh) {
    const f32x4 h0 = *(const f32x4*)(hn + 8 * (lane & 15)), h1 = *(const f32x4*)(hn + 8 * (lane & 15) + 4);
#pragma unroll
    for (int it = 0; it < 4; ++it) {
        const size_t off = (size_t)row * DM + it * 512 + lane * 8;
        const u32x4 a_ = *(const u32x4*)(OF + off), bq_ = *(const u32x4*)(OB + off), z = *(const u32x4*)(ZA + off);
        u32x4 a = a_, bq = bq_; if (ABLATE & 16) bq = (u32x4){0u, 0u, 0u, 0u}; if (ABLATE & 32) a = (u32x4){0u, 0u, 0u, 0u};
        float o[8] = {bf_lo(a.x) + bf_lo(bq.x), bf_hi(a.x) + bf_hi(bq.x), bf_lo(a.y) + bf_lo(bq.y), bf_hi(a.y) + bf_hi(bq.y), bf_lo(a.z) + bf_lo(bq.z), bf_hi(a.z) + bf_hi(bq.z), bf_lo(a.w) + bf_lo(bq.w), bf_hi(a.w) + bf_hi(bq.w)};
#if MK_DEBUG
        { float mb = 0.f, mf = 0.f; const float ofx[8] = {bf_lo(a.x), bf_hi(a.x), bf_lo(a.y), bf_hi(a.y), bf_lo(a.z), bf_hi(a.z), bf_lo(a.w), bf_hi(a.w)};
          const float obx[8] = {bf_lo(bq.x), bf_hi(bq.x), bf_lo(bq.y), bf_hi(bq.y), bf_lo(bq.z), bf_hi(bq.z), bf_lo(bq.w), bf_hi(bq.w)};
#pragma unroll
          for (int e = 0; e < 8; ++e) { mb = fmaxf(mb, fabsf(obx[e])); mf = fmaxf(mf, fabsf(ofx[e])); }
          const int bhq = (row / SEQ) * 16 + it * 4 + (lane >> 4);
          if (mb > DBG_THR) dbgh[bhq] = 1u; if (mf > DBG_THR) dbgh[64 + bhq] = 1u; }
#endif
        if (ABLATE & 128) { const float of_[8] = {bf_lo(a.x), bf_hi(a.x), bf_lo(a.y), bf_hi(a.y), bf_lo(a.z), bf_hi(a.z), bf_lo(a.w), bf_hi(a.w)};
            const float ob_[8] = {bf_lo(bq.x), bf_hi(bq.x), bf_lo(bq.y), bf_hi(bq.y), bf_lo(bq.z), bf_hi(bq.z), bf_lo(bq.w), bf_hi(bq.w)};
#pragma unroll
            for (int e = 0; e < 8; ++e) o[e] = of_[e] + ob_[e] * (1.f / 4096.f); }
        float ss = 0.f;
#pragma unroll
        for (int e = 0; e < 8; ++e) ss += o[e] * o[e];
        ss += __shfl_xor(ss, 1); ss += __shfl_xor(ss, 2); ss += __shfl_xor(ss, 4); ss += __shfl_xor(ss, 8);
        const float rs = rsqrtf(ss * (1.f / HD) + EPS);
        const float zf[8] = {bf_lo(z.x), bf_hi(z.x), bf_lo(z.y), bf_hi(z.y), bf_lo(z.z), bf_hi(z.z), bf_lo(z.w), bf_hi(z.w)};
        const float hv[8] = {h0[0], h0[1], h0[2], h0[3], h1[0], h1[1], h1[2], h1[3]};
        float y[8];
#pragma unroll
        for (int e = 0; e < 8; ++e) { y[e] = o[e] * rs * hv[e] * zf[e]; if (ABLATE & 1) y[e] = 0.f; }
        u32x4 w; w.x = cvt_pk_bf16(y[0], y[1]); w.y = cvt_pk_bf16(y[2], y[3]); w.z = cvt_pk_bf16(y[4], y[5]); w.w = cvt_pk_bf16(y[6], y[7]);
        *(u32x4*)(Y + (size_t)row * 4096 + it * 512 + lane * 8) = w;
    }
}

__device__ __forceinline__ void stats_row(int row, const bf16_t* P1, float* STATS, int lane) {
    const bf16_t* p = P1 + (size_t)row * N3 + 2048;
    float v[32]; float s = 0.f;
#pragma unroll
    for (int j = 0; j < 4; ++j) { const u32x4 a = *(const u32x4*)(p + j * 512 + lane * 8);
        v[8 * j] = bf_lo(a.x); v[8 * j + 1] = bf_hi(a.x); v[8 * j + 2] = bf_lo(a.y); v[8 * j + 3] = bf_hi(a.y); v[8 * j + 4] = bf_lo(a.z); v[8 * j + 5] = bf_hi(a.z); v[8 * j + 6] = bf_lo(a.w); v[8 * j + 7] = bf_hi(a.w); }
#pragma unroll
    for (int e = 0; e < 32; ++e) s += v[e];
    const float mu = wave_sum(s) * (1.f / DM); float q = 0.f;
#pragma unroll
    for (int e = 0; e < 32; ++e) { const float d = v[e] - mu; q += d * d; }
    const float rstd = rsqrtf(wave_sum(q) * (1.f / DM) + EPS);
    if (lane == 0) { STATS[2 * row] = mu; STATS[2 * row + 1] = rstd; }
}
template <int R> __device__ __forceinline__ void diff_task(const bf16_t* p, bf16_t* o) {
    unsigned v[64];
#pragma unroll
    for (int i = 0; i < 64; ++i) v[i] = *(const unsigned*)(p + (size_t)i * N3);
    float s0 = 0.f, s1 = 0.f;
#pragma unroll
    for (int i = 0; i < R; ++i) { s0 += bf_lo(v[i]); s1 += bf_hi(v[i]); }
#pragma unroll
    for (int i = 0; i < 64; ++i) {
        if (i + R < 64) { s0 += bf_lo(v[i + R]); s1 += bf_hi(v[i + R]); }
        if (i - R - 1 >= 0) { s0 -= bf_lo(v[i - R - 1 >= 0 ? i - R - 1 : 0]); s1 -= bf_hi(v[i - R - 1 >= 0 ? i - R - 1 : 0]); }
        const int hi = (i + R + 1 < 64) ? i + R + 1 : 64, lo = (i - R > 0) ? i - R : 0; const float inv = 1.0f / (float)(hi - lo);
        *(unsigned*)(o + (size_t)i * DM) = cvt_pk_bf16(s0 * inv - bf_lo(v[i]), s1 * inv - bf_hi(v[i]));
    }
}

constexpr int K_W = 0, K_V = 34816;
__device__ __forceinline__ void tmix_block(int blk, LAS unsigned char* lds, const float* ws, const float* bs, const float* lnw, const float* lnb, const float* STATS, const bf16_t* P1, bf16_t* Y2) {
    const int tid = threadIdx.x, wave = __builtin_amdgcn_readfirstlane(tid >> 6), lane = tid & 63;
    const int g = blk & 15, n = (blk >> 4) & 15;
    LAS bf16_t* Wsb = (LAS bf16_t*)(lds + K_W); LAS bf16_t* VnT = (LAS bf16_t*)(lds + K_V);
    for (int i = tid; i < 4096; i += 512) { const int p = i >> 5, q4 = (i & 31) * 4; const f32x4 w = *(const f32x4*)(ws + ((size_t)g * 128 + p) * 128 + q4);
        u32x2 o; o.x = cvt_pk_bf16(w.x, w.y); o.y = cvt_pk_bf16(w.z, w.w); *(LAS u32x2*)(Wsb + p * 136 + q4) = o; }
    const int pb = wave >> 1, c = lane & 31, hh = lane >> 5;
    const float bias = bs[g * 128 + 32 * pb + c];
    for (int b = 0; b < NB; ++b) {
        const int row0 = b * SEQ + 128 * n;
        for (int i = tid; i < 2048; i += 512) { const int q = i >> 4, c8 = (i & 15) * 8;
            const u32x4 a = *(const u32x4*)(P1 + (size_t)(row0 + q) * N3 + 2048 + 128 * g + c8);
            const float mu = STATS[2 * (row0 + q)], rstd = STATS[2 * (row0 + q) + 1];
            const f32x4 w0 = *(const f32x4*)(lnw + 128 * g + c8), w1 = *(const f32x4*)(lnw + 128 * g + c8 + 4), b0 = *(const f32x4*)(lnb + 128 * g + c8), b1 = *(const f32x4*)(lnb + 128 * g + c8 + 4);
            const float x[8] = {bf_lo(a.x), bf_hi(a.x), bf_lo(a.y), bf_hi(a.y), bf_lo(a.z), bf_hi(a.z), bf_lo(a.w), bf_hi(a.w)};
            const float wv[8] = {w0[0], w0[1], w0[2], w0[3], w1[0], w1[1], w1[2], w1[3]}, bv[8] = {b0[0], b0[1], b0[2], b0[3], b1[0], b1[1], b1[2], b1[3]};
#pragma unroll
            for (int e = 0; e < 8; ++e) VnT[(c8 + e) * 136 + q] = f2bf((x[e] - mu) * rstd * wv[e] + bv[e]); }
        __syncthreads();
        const size_t row = (size_t)(row0 + 32 * pb + c);
#pragma unroll
        for (int t = 0; t < 2; ++t) { const int cb = 2 * (wave & 1) + t;
            u32x2 gu[4], sz[4];
#pragma unroll
            for (int gq = 0; gq < 4; ++gq) { const int ch = 128 * g + 32 * cb + 8 * gq + 4 * hh; gu[gq] = *(const u32x2*)(P1 + row * N3 + ch); sz[gq] = *(const u32x2*)(P1 + row * N3 + 4096 + ch); }
            f32x16 a = {};
            a = mma_tile(a, VnT + 32 * cb * 136, 136, Wsb + 32 * pb * 136, 136, 8, lane);
#pragma unroll
            for (int gq = 0; gq < 4; ++gq) { const int ch = 128 * g + 32 * cb + 8 * gq + 4 * hh;
                const float y0 = bf_lo(gu[gq].x) * (a[4 * gq] + bias) * bf_lo(sz[gq].x), y1 = bf_hi(gu[gq].x) * (a[4 * gq + 1] + bias) * bf_hi(sz[gq].x);
                const float y2 = bf_lo(gu[gq].y) * (a[4 * gq + 2] + bias) * bf_lo(sz[gq].y), y3 = bf_hi(gu[gq].y) * (a[4 * gq + 3] + bias) * bf_hi(sz[gq].y);
                u32x2 w; w.x = cvt_pk_bf16(y0, y1); w.y = cvt_pk_bf16(y2, y3);
                *(u32x2*)(Y2 + row * 4096 + ch) = w; } }
        __syncthreads();
    }
}

__device__ __forceinline__ void final_row(float* xrow, const float* fw, int lane) {
    f32x4* xr = (f32x4*)xrow + lane;
    f32x4 v[8]; float s = 0.f;
#pragma unroll
    for (int j = 0; j < 8; ++j) { v[j] = xr[64 * j]; s += (v[j].x * v[j].x + v[j].y * v[j].y) + (v[j].z * v[j].z + v[j].w * v[j].w); }
    const float rstd = rsqrtf(wave_sum(s) * (1.f / DM) + EPS);
#pragma unroll
    for (int j = 0; j < 8; ++j) xr[64 * j] = v[j] * rstd * ((const f32x4*)fw)[lane + 64 * j];
}

__global__ void __launch_bounds__(512, 2) fwd_kernel(Args args) {
    extern __shared__ __attribute__((aligned(16))) unsigned char lds_raw[];
    LAS unsigned char* lds = (LAS unsigned char*)lds_raw;
    const int tid = threadIdx.x, lane = tid & 63, wave = __builtin_amdgcn_readfirstlane(tid >> 6);
    const int G = gridDim.x, bid = blockIdx.x;
    const int gw = bid * 8 + wave, NGW = G * 8;
    unsigned char* ws = args.ws;
    volatile LAS unsigned* MISC = (volatile LAS unsigned*)(lds + MISC_OFF);
    if (tid < 16) MISC[tid] = 0u;
    __syncthreads();
    if (args.never) cg::this_grid().sync();
    XcdBarrier bar; bar.bar = (unsigned*)(ws + WS_CTL) + CW_BAR; bar.x = 0; bar.st = MISC;
    const int lo = args.ph_lo, hi = args.ph_hi;
    if (hi - lo > 1) bar = xcd_barrier_post((unsigned*)(ws + WS_CTL) + CW_BAR, MISC);
#ifndef PH_MASK
#define PH_MASK 0x3fff
#endif
#define IN(k) ((((PH_MASK) >> (k)) & 1) && lo <= (k) && (k) < hi)
#if MK_STAMP
    unsigned long long* STAMPS = (unsigned long long*)((unsigned*)(ws + WS_CTL) + 3000);
#define STAMP(k) do { if (bid == 0 && tid == 0) STAMPS[k] = __builtin_amdgcn_s_memrealtime(); } while (0)
#else
#define STAMP(k) do { } while (0)
#endif
#define SEAM(k) do { if (IN(k) && IN((k) + 1)) xcd_barrier(bar); STAMP((k) + 1); } while (0)
    STAMP(0);
#define MOD ((float*)(ws + WS_MOD))
#if MK_DEBUG
    unsigned* DBG = (unsigned*)(ws + WS_CTL) + 2048; const int gt = bid * 512 + tid, ngt = G * 512;
#endif
#define WT1 ((bf16_t*)(ws + WS_WT1))
#define WT2 ((bf16_t*)(ws + WS_WT2))
#define WT3 ((bf16_t*)(ws + WS_WT3))
#define WT4 ((bf16_t*)(ws + WS_WT4))
#define WTP ((bf16_t*)(ws + WS_WTP))
#define H ((bf16_t*)(ws + WS_H))

    if (IN(0)) for (int rep_ = 0; rep_ < ((REPEAT_PH) == 0 ? (REPEAT_N) : 1); (++rep_, __syncthreads())) {
        if (bid < 192) { LAS float* tab = (LAS float*)lds; silu_table(args.in[I_C], args.in[I_CCTX], tab);
            for (int t = bid; t < 192; t += G) mod_task(args.in[I_ADAW], args.in[I_ADAB], MOD, 32 * t, tab, (LAS float*)(lds + 40960), wave, lane);
            __syncthreads(); }
        LAS float* scr = (LAS float*)(lds + wave * 16640);
        const SrcW1 s1; const SrcId sid;
        for (int it = gw; it < 8320 + 2048; it += NGW) {
            if (it < 8320) { const int cb = it >> 5, kb = it & 31; conv_item(args.in[I_EWIN], N1SRC, 2048, WT1, 64 * cb, 64 * kb, scr, lane, s1); }
            else { const int r = it - 8320, cb = r >> 6, kb = r & 63; conv_item(args.in[I_EWOUT], 2048, 4096, WT2, 64 * cb, 64 * kb, scr, lane, sid); }
        }
    }
    SEAM(0);
    if (IN(1)) for (int rep_ = 0; rep_ < ((REPEAT_PH) == 1 ? (REPEAT_N) : 1); (++rep_, __syncthreads())) {
#if MK_DEBUG
        dbg_f32(MOD, 5, 6144, 6144, DBG + 0, gt, ngt); dbg_bf16(WT1, 16640, 2048, 2048, DBG + 0, gt, ngt); dbg_bf16(WT2, 2048, 4096, 4096, DBG + 0, gt, ngt);
#endif
        for (int q = gw; q < MX / 4; q += NGW) hrows4(args.in[I_X] + (size_t)q * 4 * DM, args.in[I_NORMW], MOD + ((q * 4) / SEQ) * 6144, H + (size_t)q * 4 * DM, lane);
        for (int m = gw; m < MC; m += NGW) hrow(args.in[I_CTX] + (size_t)m * DM, args.in[I_NORMW], MOD + 4 * 6144, H + (size_t)(MX + m) * DM, lane);
    }
    SEAM(1);
    if (IN(2)) for (int rep_ = 0; rep_ < ((REPEAT_PH) == 2 ? (REPEAT_N) : 1); (++rep_, __syncthreads())) {
#if MK_DEBUG
        dbg_bf16(H, MT, 2048, 2048, DBG + 1, gt, ngt);
#endif
        Sched1 S{G, bid, (const char*)H, (const char*)WT1};
        Epi1 E{ws, args.in[I_ECONVB], args.in[I_ECONVQKV], lds};
        pg8::gemm_phase<Epi1, Sched1>(lds, 2048, 2048, 2048, S, E);
    }
    SEAM(2);
    if (IN(3)) for (int rep_ = 0; rep_ < ((REPEAT_PH) == 3 ? (REPEAT_N) : 1); (++rep_, __syncthreads())) {
#if MK_DEBUG
        dbg_bf16((const bf16_t*)(ws + WS_PQKV), MT, 6144, 6144, DBG + 2, gt, ngt); dbg_bf16((const bf16_t*)(ws + WS_ZA), MX, 2048, 2048, DBG + 2, gt, ngt);
        dbg_f32((const float*)(ws + WS_AB), MT, 64, 64, DBG + 2, gt, ngt); dbg_bf16((const bf16_t*)(ws + WS_Y) + 2048, MX, 2048, 4096, DBG + 2, gt, ngt);
#endif
    }
    STAMP(4);
    if (IN(4)) for (int rep_ = 0; rep_ < ((REPEAT_PH) == 4 ? (REPEAT_N) : 1); (++rep_, __syncthreads())) {
#if MK_DEBUG
        dbg_bf16((const bf16_t*)(ws + WS_QN), 64 * NTOK, 128, 128, DBG + 3, gt, ngt); dbg_bf16((const bf16_t*)(ws + WS_KN), 64 * NTOK, 128, 128, DBG + 3, gt, ngt);
        dbg_bf16((const bf16_t*)(ws + WS_KT), 64 * 128, NTOK, NTOK, DBG + 3, gt, ngt); dbg_bf16((const bf16_t*)(ws + WS_VT), 64 * 128, NTOK, NTOK, DBG + 3, gt, ngt);
        dbg_f32((const float*)(ws + WS_GG), 128, NTOK, NTOK, DBG + 3, gt, ngt); dbg_f32((const float*)(ws + WS_BETA), 128, NTOK, NTOK, DBG + 3, gt, ngt);
#endif
        { const int mb0 = (G == 256) ? 64 : 0;
          if (bid >= mb0 && bid < mb0 + 192) { LAS float* stab = (LAS float*)lds; silu_table(args.in[I_C], args.in[I_CCTX], stab);
              for (int t = bid - mb0; t < 192; t += G) mod_task(args.in[I_ADAW] + (size_t)2048 * 6144, args.in[I_ADAB] + 6144, MOD + 5 * 6144, 32 * t, stab, (LAS float*)(lds + 40960), wave, lane);
              __syncthreads(); } }
        LAS float* tab = (LAS float*)(lds + wave * 17920);
        const SrcId sid;
        auto copy_item = [&](int it) {
            if (it < 5120) { const int cb = it >> 5, kb = it & 31; conv_item(args.in[I_OWIN], N3, 2048, WT3, 64 * cb, 64 * kb, tab, lane, sid); }
            else if (it < 7168) { const int r = it - 5120, cb = r >> 6, kb = r & 63; conv_item(args.in[I_OWOUT], 2048, 4096, WT4, 64 * cb, 64 * kb, tab, lane, sid); }
            else { const int r = it - 7168, gq = r >> 6, cb = (r >> 3) & 7, kb = r & 7; conv_item(args.in[I_OPW] + (size_t)gq * 512 * 512, 512, 512, WTP + (size_t)gq * 512 * 512, 64 * cb, 64 * kb, tab, lane, sid); } };
        auto chunk = [&](int t) { chunk_task(t, (const bf16_t*)(ws + WS_QN), (const bf16_t*)(ws + WS_KN), (const float*)(ws + WS_AB), args.in[I_EALOG], args.in[I_EDTB], (float*)(ws + WS_GC), (bf16_t*)(ws + WS_TU), (bf16_t*)(ws + WS_AI), tab, lane); };
        constexpr int NCT = 2 * 64 * NCH, NCI = 5120 + 2048 + 256;
        const bool bal = (NGW == 2048);
        const int nslots = bal ? 8 : (NCT + NCI + NGW - 1) / NGW + 1;
        for (int i = 0; i < nslots; ++i) {
            int ct = -1, ci = -1;
            if (bal) {
                if (i == 0) ct = gw; else if (i == 6) ct = gw + 2048; else if (i == 7) { if (gw < 512) ct = gw + 4096; }
                else if (i <= 4) { if (gw >= 512) ci = (gw - 512) + 1536 * (i - 1); } else { if (gw < 1280) ci = 6144 + gw; }
            } else { const int L = gw + i * NGW; if (L < NCT) ct = L; else if (L < NCT + NCI) ci = L - NCT; }
            if (ct >= 0) chunk(ct);
            if (ci >= 0) copy_item(ci);
        }
    }
    SEAM(4);
    if (IN(5)) for (int rep_ = 0; rep_ < ((REPEAT_PH) == 5 ? (REPEAT_N) : 1); (++rep_, __syncthreads())) {
#if MK_DEBUG
        dbg_bf16((const bf16_t*)(ws + WS_TU), 2 * 64 * NCH, 4096, 4096, DBG + 4, gt, ngt);
        if (gt == 100) {
            const int dirq = 1, bhq = 0, tcq = 20, tok0q = 64 * tcq; const bf16_t* KNq = (const bf16_t*)(ws + WS_KN) + ((size_t)bhq * NTOK + tok0q) * HD;
            const float* gq = (const float*)(ws + WS_GG) + ((size_t)dirq * NBH + bhq) * NTOK + tok0q; const float* bq = (const float*)(ws + WS_BETA) + ((size_t)dirq * NBH + bhq) * NTOK + tok0q;
            const bf16_t* tq = (const bf16_t*)(ws + WS_TU) + (((size_t)dirq * NBH + bhq) * NCH + tcq) * 4096;
            float worst = 0.f;
            for (int a = 0; a < 64; a += 7) for (int b2 = 0; b2 < 64; b2 += 5) {
                float r = 0.f;
                for (int m = 0; m < 64; ++m) {
                    float im = (a == m) ? 1.f : 0.f;
                    if (m > a) { float kk = 0.f; for (int e = 0; e < HD; ++e) kk += bf2f(KNq[a * HD + e]) * bf2f(KNq[m * HD + e]); float gd = 0.f; for (int t = a; t < m; ++t) gd += gq[t]; im = bq[a] * kk * __expf(gd); }
                    const float T = bf2f(tq[m * 64 + b2]) / bq[b2];
                    r += im * T; }
                worst = fmaxf(worst, fabsf(r - ((a == b2) ? 1.f : 0.f))); }
            DBG[980] = __float_as_uint(worst); }
        if (gt < 64) { const int bhq = gt & 63; const bf16_t* tq = (const bf16_t*)(ws + WS_TU) + (((size_t)1 * NBH + bhq) * NCH + 20) * 4096; float so = 0.f;
            for (int i = 0; i < 64; ++i) for (int j = 0; j < 64; ++j) { const float v = fabsf(bf2f(tq[i * 64 + j])); if (i != j) so += v; }
            DBG[910 + bhq] = __float_as_uint(so); }
        dbg_max_bf16((const bf16_t*)(ws + WS_TU), (size_t)128 * NCH * 4096, DBG + 900, gt, ngt);
        dbg_max_bf16((const bf16_t*)(ws + WS_KN), (size_t)64 * NTOK * 128, DBG + 901, gt, ngt);
        dbg_max_bf16((const bf16_t*)(ws + WS_KT), (size_t)64 * NTOK * 128, DBG + 902, gt, ngt);
        dbg_max_bf16((const bf16_t*)(ws + WS_VT), (size_t)64 * NTOK * 128, DBG + 903, gt, ngt);
        dbg_max_bf16((const bf16_t*)(ws + WS_QN), (size_t)64 * NTOK * 128, DBG + 904, gt, ngt);
        for (int q = 0; q < 128; ++q) dbg_bf16((const bf16_t*)(ws + WS_AI) + ((size_t)q * NCH + 4) * 4096, 32, 4096, 4096, DBG + 4, gt, ngt);
        dbg_f32((const float*)(ws + WS_GC), 128, NTOK, NTOK, DBG + 4, gt, ngt); dbg_f32(MOD + 5 * 6144, 4, 6144, 6144, DBG + 4, gt, ngt);
        dbg_bf16(WT3, 10240, 2048, 2048, DBG + 4, gt, ngt); dbg_bf16(WT4, 2048, 4096, 4096, DBG + 4, gt, ngt); dbg_bf16(WTP, 2048, 512, 512, DBG + 4, gt, ngt);
#endif
        for (int ch0 = bid; ch0 < 256; ch0 += G) { const int ch = (G == 256) ? (2 * ((ch0 & 7) + 8 * (ch0 >> 4)) + ((ch0 >> 3) & 1)) : ch0;
            scan_chain(ch, lds, (const bf16_t*)(ws + WS_QN), (const bf16_t*)(ws + WS_KT), (const bf16_t*)(ws + WS_VT), (const bf16_t*)(ws + WS_TU), (const bf16_t*)(ws + WS_AI), (const float*)(ws + WS_GC), (bf16_t*)(ws + WS_OF), (bf16_t*)(ws + WS_OB)); __syncthreads(); }
    }
    SEAM(5);
    if (IN(6)) for (int rep_ = 0; rep_ < ((REPEAT_PH) == 6 ? (REPEAT_N) : 1); (++rep_, __syncthreads())) {
#if MK_DEBUG
        dbg_bf16((const bf16_t*)(ws + WS_OF), MX, 2048, 2048, DBG + 5, gt, ngt); dbg_bf16((const bf16_t*)(ws + WS_OB), MX, 2048, 2048, DBG + 5, gt, ngt);
        dbg_max_bf16((const bf16_t*)(ws + WS_OF), (size_t)MX * 2048, DBG + 905, gt, ngt); dbg_max_bf16((const bf16_t*)(ws + WS_OB), (size_t)MX * 2048, DBG + 906, gt, ngt);
#endif
        for (int m = gw; m < MX; m += NGW) finish_row(m, (const bf16_t*)(ws + WS_OF), (const bf16_t*)(ws + WS_OB), (const bf16_t*)(ws + WS_ZA), args.in[I_EHN], (bf16_t*)(ws + WS_Y), lane, (unsigned*)(ws + WS_CTL) + 3072);
    }
    SEAM(6);
    if (IN(7)) for (int rep_ = 0; rep_ < ((REPEAT_PH) == 7 ? (REPEAT_N) : 1); (++rep_, __syncthreads())) {
#if MK_DEBUG
        dbg_bf16((const bf16_t*)(ws + WS_Y), MX, 2048, 4096, DBG + 6, gt, ngt);
#endif
        pg8::StaticOrder S{32, 8, G, bid, (const char*)(ws + WS_Y), (const char*)WT2, (size_t)256 * 4096 * 2, (size_t)256 * 4096 * 2};
        EpiResid E{args.in[I_X], args.out, MOD + 4096};
        pg8::gemm_phase<EpiResid, pg8::StaticOrder>(lds, 4096, 4096, 4096, S, E);
    }
    SEAM(7);
    if (IN(8)) for (int rep_ = 0; rep_ < ((REPEAT_PH) == 8 ? (REPEAT_N) : 1); (++rep_, __syncthreads())) {
#if MK_DEBUG
        dbg_f32(args.out, MX, 2048, 2048, DBG + 7, gt, ngt);
#endif
        for (int q = gw; q < MX / 4; q += NGW) hrows4(args.out + (size_t)q * 4 * DM, args.in[I_NORMW] + DM, MOD + 5 * 6144 + ((q * 4) / SEQ) * 6144, H + (size_t)q * 4 * DM, lane);
    }
    SEAM(8);
    if (IN(9)) for (int rep_ = 0; rep_ < ((REPEAT_PH) == 9 ? (REPEAT_N) : 1); (++rep_, __syncthreads())) {
#if MK_DEBUG
        dbg_bf16(H, MX, 2048, 2048, DBG + 8, gt, ngt);
#endif
        pg8::StaticOrder S{32, 40, G, bid, (const char*)H, (const char*)WT3, (size_t)256 * 2048 * 2, (size_t)256 * 2048 * 2};
        Epi3 E{(bf16_t*)(ws + WS_P1)};
        pg8::gemm_phase<Epi3, pg8::StaticOrder>(lds, 2048, 2048, 2048, S, E);
    }
    SEAM(9);
    if (IN(10)) for (int rep_ = 0; rep_ < ((REPEAT_PH) == 10 ? (REPEAT_N) : 1); (++rep_, __syncthreads())) {
#if MK_DEBUG
        dbg_bf16((const bf16_t*)(ws + WS_P1), MX, N3, N3, DBG + 9, gt, ngt);
#endif
        for (int m = gw; m < MX; m += NGW) stats_row(m, (const bf16_t*)(ws + WS_P1), (float*)(ws + WS_STATS), lane);
        for (int t = gw; t < 128 * 16; t += NGW) { const int blk = t >> 4, cc = t & 15, grp = cc >> 2;
            const bf16_t* p = (const bf16_t*)(ws + WS_P1) + (size_t)(64 * blk) * N3 + 6144 + 128 * cc + 2 * lane; bf16_t* o = (bf16_t*)(ws + WS_DIFF) + (size_t)(64 * blk) * DM + 128 * cc + 2 * lane;
            if (grp == 0) diff_task<1>(p, o); else if (grp == 1) diff_task<2>(p, o); else if (grp == 2) diff_task<4>(p, o); else diff_task<8>(p, o); }
    }
    SEAM(10);
    if (IN(11)) for (int rep_ = 0; rep_ < ((REPEAT_PH) == 11 ? (REPEAT_N) : 1); (++rep_, __syncthreads())) {
#if MK_DEBUG
        dbg_f32((const float*)(ws + WS_STATS), 1, 2 * MX, 2 * MX, DBG + 10, gt, ngt); dbg_bf16((const bf16_t*)(ws + WS_DIFF), MX, 2048, 2048, DBG + 10, gt, ngt);
#endif
        SchedPool S{G, bid, (const char*)(ws + WS_DIFF), (const char*)WTP};
        EpiPool E{(const bf16_t*)(ws + WS_P1), (bf16_t*)(ws + WS_Y2), args.in[I_OPS]};
        pg8::gemm_phase<EpiPool, SchedPool>(lds, 512, 2048, 512, S, E);
        __syncthreads();
        for (int t = bid; t < 256; t += G) tmix_block(t, lds, args.in[I_OWS], args.in[I_OBS], args.in[I_OLNW], args.in[I_OLNB], (const float*)(ws + WS_STATS), (const bf16_t*)(ws + WS_P1), (bf16_t*)(ws + WS_Y2));
    }
    SEAM(11);
    if (IN(12)) {
#if MK_DEBUG
        dbg_bf16((const bf16_t*)(ws + WS_Y2), MX, 4096, 4096, DBG + 11, gt, ngt);
#endif
        pg8::StaticOrder S{32, 8, G, bid, (const char*)(ws + WS_Y2), (const char*)WT4, (size_t)256 * 4096 * 2, (size_t)256 * 4096 * 2};
        EpiResid E{args.out, args.out, MOD + 5 * 6144 + 4096};
        pg8::gemm_phase<EpiResid, pg8::StaticOrder>(lds, 4096, 4096, 4096, S, E);
    }
    SEAM(12);
    if (IN(13)) {
#if MK_DEBUG
        dbg_f32(args.out, MX, 2048, 2048, DBG + 12, gt, ngt);
        for (size_t i = gt; i < (size_t)MX * DM; i += ngt) { const float v = args.out[i]; if (badf(v)) args.out[i] = 0.f; }
        asm volatile("s_waitcnt vmcnt(0)" ::: "memory"); __syncthreads();
#endif
        for (int m = gw; m < MX; m += NGW) final_row(args.out + (size_t)m * DM, args.in[I_FNW], lane);
#if MK_DEBUG
        asm volatile("s_waitcnt vmcnt(0)" ::: "memory"); __syncthreads();
        if (bid == 0 && tid == 0) { int first = -1; unsigned mask = 0; for (int k = 12; k >= 0; --k) if (__hip_atomic_load(DBG + k, __ATOMIC_RELAXED, __HIP_MEMORY_SCOPE_AGENT)) { first = k; mask |= 1u << k; }
            if (first >= 0) args.out[0] = 1000.f * (float)(first + 1);
            { int cb = 0, cf = 0; for (int q = 0; q < 64; ++q) { cb += (int)__hip_atomic_load(DBG + 1024 + q, __ATOMIC_RELAXED, __HIP_MEMORY_SCOPE_AGENT); cf += (int)__hip_atomic_load(DBG + 1024 + 64 + q, __ATOMIC_RELAXED, __HIP_MEMORY_SCOPE_AGENT); }
              args.out[0] = 1000.f * (float)(DBG_SEL ? cf : cb) + 500.f;
              if (DBG_SEL == 30 || DBG_SEL == 31) { const int dsel = DBG_SEL - 30; int fb = -1; for (int q = 0; q < 64; ++q) if (__hip_atomic_load(DBG + 1024 + (dsel ? 0 : 64) + q, __ATOMIC_RELAXED, __HIP_MEMORY_SCOPE_AGENT)) { fb = q; break; }
                  float mg = 0.f; if (fb >= 0) { const float* gq = (const float*)(ws + WS_GG) + ((size_t)dsel * NBH + fb) * NTOK; for (int i = 256; i < NTOK; ++i) mg += gq[i]; mg = -mg / 2048.f; }
                  args.out[0] = 1.0e4f * mg + 1000.f * 1000.f * (float)(fb & 15); }
              else if (DBG_SEL == 200) { args.out[0] = 1.0e5f * __uint_as_float(__hip_atomic_load(DBG + 980, __ATOMIC_RELAXED, __HIP_MEMORY_SCOPE_AGENT)) + 1000.f; }
              else if (DBG_SEL >= 60 && DBG_SEL < 124) { args.out[0] = 1.0e3f * __uint_as_float(__hip_atomic_load(DBG + 910 + (DBG_SEL - 60), __ATOMIC_RELAXED, __HIP_MEMORY_SCOPE_AGENT)); }
              else if (DBG_SEL >= 40 && DBG_SEL < 60) { const int bhq = DBG_SEL - 40; const bf16_t* tq = (const bf16_t*)(ws + WS_TU) + (((size_t)1 * NBH + bhq) * NCH + 20) * 4096; float so = 0.f, sd = 0.f;
                  for (int i = 0; i < 64; ++i) for (int j = 0; j < 64; ++j) { const float v = fabsf(bf2f(tq[i * 64 + j])); if (i == j) sd += v; else so += v; }
                  args.out[0] = 1.0e4f * so + 1.0e8f; }
              else if (DBG_SEL >= 10) args.out[0] = 1.0e2f * __uint_as_float(__hip_atomic_load(DBG + 900 + (DBG_SEL - 10), __ATOMIC_RELAXED, __HIP_MEMORY_SCOPE_AGENT)); } }
#endif
    }
#if MK_STAMP
    if (IN(13)) {
        asm volatile("s_waitcnt vmcnt(0)" ::: "memory"); __syncthreads();
        if (bid == 0) {
            const unsigned long long t14 = __builtin_amdgcn_s_memrealtime();
            const float tA = (float)((SEL_A == 13 ? t14 : STAMPS[SEL_A + 1]) - STAMPS[SEL_A]) * 0.01f, tB = (float)((SEL_B == 13 ? t14 : STAMPS[SEL_B + 1]) - STAMPS[SEL_B]) * 0.01f;
            __syncthreads();
            for (int i = 1 + tid; i <= 1048576; i += 512) args.out[i] += tB * (1.f / 2000.f);
            if (tid == 0) args.out[0] += tA * (1.f / 100.f);
        }
    }
#endif
#if STOP_AFTER < 13
    if (lo == 14) {
        const size_t NO = (size_t)MX * DM; const size_t gtid = (size_t)bid * 512 + tid, ngtid = (size_t)G * 512;
        for (size_t i = gtid; i < NO; i += ngtid) {
            float acc = 0.f;
#define DG_BF(off, n) do { const bf16_t* q_ = (const bf16_t*)(ws + (off)); for (size_t j = i; j < (size_t)(n); j += NO) acc += bf2f(q_[j]); } while (0)
#define DG_F32(off, n) do { const float* q_ = (const float*)(ws + (off)); for (size_t j = i; j < (size_t)(n); j += NO) acc += q_[j]; } while (0)
#if STOP_AFTER == 0
            DG_BF(WS_WT1, (size_t)16640 * 2048); DG_BF(WS_WT2, (size_t)2048 * 4096); DG_F32(WS_MOD, 5 * 6144);
#elif STOP_AFTER == 1
            DG_BF(WS_H, (size_t)MT * 2048);
#elif STOP_AFTER == 2
            DG_BF(WS_PQKV, (size_t)MT * 6144); DG_BF(WS_ZA, (size_t)MX * 2048); DG_F32(WS_AB, (size_t)MT * 64);
            { const bf16_t* q_ = (const bf16_t*)(ws + WS_Y); const size_t r = i / 2048, c = i % 2048; acc += bf2f(q_[r * 4096 + 2048 + c]); }
#elif STOP_AFTER == 3
            DG_BF(WS_QN, (size_t)64 * NTOK * 128); DG_BF(WS_KN, (size_t)64 * NTOK * 128); DG_BF(WS_KT, (size_t)64 * NTOK * 128); DG_BF(WS_VT, (size_t)64 * NTOK * 128);
            DG_F32(WS_GG, (size_t)128 * NTOK); DG_F32(WS_BETA, (size_t)128 * NTOK);
#elif STOP_AFTER == 4
            DG_BF(WS_TU, (size_t)128 * NCH * 4096); DG_F32(WS_GC, (size_t)128 * NTOK); DG_F32(WS_MOD, 10 * 6144);
            DG_BF(WS_WT3, (size_t)10240 * 2048); DG_BF(WS_WT4, (size_t)2048 * 4096); DG_BF(WS_WTP, (size_t)2048 * 512);
            { const bf16_t* q_ = (const bf16_t*)(ws + WS_AI); for (size_t j = i; j < (size_t)128 * NCH * 4096; j += NO) { const size_t tcq = (j / 4096) % NCH; if (tcq >= 4) acc += bf2f(q_[j]); } }
#elif STOP_AFTER == 5
            DG_BF(WS_OF, (size_t)MX * 2048); DG_BF(WS_OB, (size_t)MX * 2048);
#elif STOP_AFTER == 6
            DG_BF(WS_Y, (size_t)MX * 4096);
#elif STOP_AFTER == 7
            acc = args.out[i];
#elif STOP_AFTER == 8
            DG_BF(WS_H, (size_t)MX * 2048);
#elif STOP_AFTER == 9
            DG_BF(WS_P1, (size_t)MX * N3);
#elif STOP_AFTER == 10
            DG_BF(WS_DIFF, (size_t)MX * 2048); DG_F32(WS_STATS, (size_t)MX * 2);
#elif STOP_AFTER == 11
            DG_BF(WS_Y2, (size_t)MX * 4096);
#else
            acc = args.out[i];
#endif
            if (badf(acc)) acc = 12345.f;
            args.out[i] = acc;
        }
    }
#endif
#undef IN
#undef SEAM
}

extern "C" void kernel_launch(void* const* d_in, const int* in_sizes, int n_in, void* d_out, int out_size, void* d_ws, size_t ws_size, hipStream_t stream) {
    static int grid = 0;
    if (grid == 0) {
        if (n_in != 23 || out_size != MX * DM || ws_size < WS_END) { fprintf(stderr, "kernel_launch: unexpected shapes (n_in %d, out %d, ws %zu < %zu)\n", n_in, out_size, ws_size, (size_t)WS_END); grid = -1; return; }
        int dev = 0, cus = 0, per_cu = 0;
        if (hipGetDevice(&dev) != hipSuccess || hipDeviceGetAttribute(&cus, hipDeviceAttributeMultiprocessorCount, dev) != hipSuccess) { grid = -1; return; }
        if (hipFuncSetAttribute((const void*)fwd_kernel, hipFuncAttributeMaxDynamicSharedMemorySize, LDS_BYTES) != hipSuccess) { fprintf(stderr, "kernel_launch: hipFuncSetAttribute failed\n"); grid = -1; return; }
        if (hipOccupancyMaxActiveBlocksPerMultiprocessor(&per_cu, (const void*)fwd_kernel, 512, LDS_BYTES) != hipSuccess || per_cu < 1) { fprintf(stderr, "kernel_launch: occupancy query says %d\n", per_cu); }
        (void)hipGetLastError();
        grid = cus;
    }
    if (grid < 0) return;
    if (hipMemsetAsync((char*)d_ws + WS_CTL, 0, CTL_BYTES, stream) != hipSuccess) { fprintf(stderr, "kernel_launch: memset failed\n"); return; }
    Args a{};
    for (int i = 0; i < 23; ++i) a.in[i] = (const float*)d_in[i];
    a.out = (float*)d_out; a.ws = (unsigned char*)d_ws; a.never = 0; a.pad = 0;
    const int nl = (STOP_AFTER < 13) ? STOP_AFTER + 2 : MK_N_LAUNCHES;
    for (int li = 0; li < nl; ++li) {
        a.ph_lo = (nl == 1) ? 0 : li; a.ph_hi = (nl == 1) ? NPHASE : li + 1;
        if (STOP_AFTER < 13 && li == nl - 1) { a.ph_lo = 14; a.ph_hi = 15; }
        void* kargs[] = {&a};
        hipError_t e = hipLaunchCooperativeKernel((const void*)fwd_kernel, dim3(grid), dim3(512), kargs, LDS_BYTES, stream);
        if (e != hipSuccess) { fprintf(stderr, "kernel_launch: launch %d failed: %s\n", li, hipGetErrorString(e)); break; }
    }
}
```

```cpp
#include <hip/hip_runtime.h>
#include <hip/hip_cooperative_groups.h>
#include <cstdio>
#include <cstdint>
namespace cg = cooperative_groups;

#ifndef MK_N_LAUNCHES
#define MK_N_LAUNCHES 1
#endif
#ifndef DBG_SEL
#define DBG_SEL 200
#endif
#ifndef MK_STAMP
#define MK_STAMP 0
#endif
#ifndef SEL_A
#define SEL_A 6
#endif
#ifndef SEL_B
#define SEL_B 5
#endif
#ifndef REPEAT_PH
#define REPEAT_PH 99
#endif
#ifndef REPEAT_N
#define REPEAT_N 2
#endif
#ifndef ABLATE
#define ABLATE 0
#endif
#ifndef STOP_AFTER
#define STOP_AFTER 13
#endif

#define LAS __attribute__((address_space(3)))
typedef unsigned short bf16_t;
typedef short bf16x8 __attribute__((ext_vector_type(8)));
typedef float f32x2 __attribute__((ext_vector_type(2)));
typedef float f32x4 __attribute__((ext_vector_type(4)));
typedef float f32x16 __attribute__((ext_vector_type(16)));
typedef unsigned u32x2 __attribute__((ext_vector_type(2)));
typedef unsigned u32x4 __attribute__((ext_vector_type(4)));

constexpr int DM = 2048, NB = 4, SEQ = 2048, CTXL = 256, MX = NB * SEQ, MC = NB * CTXL, MT = MX + MC;
constexpr int NTOK = CTXL + SEQ;
constexpr int NHD = 16, HD = 128, NBH = NB * NHD;
constexpr int N1SRC = 16448, N1P = 16640, N3 = 10240;
constexpr int NCH = NTOK / 64;
constexpr float EPS = 1e-6f;
constexpr int NPHASE = 14;

constexpr size_t MiB = 1u << 20;
constexpr size_t WS_CTL = 0, CTL_BYTES = 1 * MiB;
constexpr size_t WS_MOD = 1 * MiB;
constexpr size_t WS_GG = 2 * MiB, WS_BETA = 4 * MiB, WS_GC = 6 * MiB;
constexpr size_t WS_STATS = 7 * MiB + 512 * 1024;
constexpr size_t WS_WT2 = 8 * MiB;
constexpr size_t WS_WT1 = 24 * MiB;
constexpr size_t WS_WT3 = 24 * MiB, WS_WT4 = 64 * MiB, WS_WTP = 80 * MiB;
constexpr size_t WS_H = 89 * MiB;
constexpr size_t WS_OB = 89 * MiB;
constexpr size_t WS_PQKV = 125 * MiB;
constexpr size_t WS_TU = 125 * MiB, WS_AI = 161 * MiB, WS_OF = 197 * MiB;
constexpr size_t WS_ZA = 233 * MiB;
constexpr size_t WS_AB = 265 * MiB;
constexpr size_t WS_Y = 268 * MiB;
constexpr size_t WS_QN = 332 * MiB, WS_KN = 368 * MiB, WS_KT = 404 * MiB, WS_VT = 440 * MiB;
constexpr size_t WS_P1 = 125 * MiB;
constexpr size_t WS_DIFF = 285 * MiB;
constexpr size_t WS_Y2 = 396 * MiB;
constexpr size_t WS_END = 476 * MiB;
constexpr int CW_BAR = 4096;

constexpr int LDS_BYTES = 155648;
constexpr int MISC_OFF = LDS_BYTES - 256;

__device__ __forceinline__ float bf_lo(unsigned w) { return __uint_as_float(w << 16); }
__device__ __forceinline__ float bf_hi(unsigned w) { return __uint_as_float(w & 0xffff0000u); }
__device__ __forceinline__ float bf2f(bf16_t b) { return __uint_as_float(((unsigned)b) << 16); }
typedef __bf16 bf16v2 __attribute__((ext_vector_type(2)));
__device__ __forceinline__ unsigned cvt_pk_bf16(float lo, float hi) { const f32x2 v = {lo, hi}; const bf16v2 r = __builtin_convertvector(v, bf16v2); return __builtin_bit_cast(unsigned, r); }
__device__ __forceinline__ bf16_t f2bf(float f) { return (bf16_t)(cvt_pk_bf16(f, 0.f) & 0xffffu); }
__device__ __forceinline__ float sigmoid_f(float x) { return __builtin_amdgcn_rcpf(1.0f + __expf(-x)); }
__device__ __forceinline__ float silu_f(float x) { return x * sigmoid_f(x); }
__device__ __forceinline__ float gelu_f(float x) { const float u = 0.7978845608028654f * (x + 0.044715f * x * x * x); return x * sigmoid_f(2.0f * u); }
__device__ __forceinline__ float softplus_f(float x) { const float e = __expf(-fabsf(x)); const float l = e < 1e-3f ? e * (1.f - 0.5f * e) : __logf(1.f + e); return fmaxf(x, 0.f) + l; }
__device__ __forceinline__ float wave_sum(float v) {
#pragma unroll
    for (int o = 1; o < 64; o <<= 1) v += __shfl_xor(v, o);
    return v;
}
__device__ __forceinline__ float dpp_shr1(float x, float old) { return __builtin_bit_cast(float, __builtin_amdgcn_update_dpp(__builtin_bit_cast(int, old), __builtin_bit_cast(int, x), 0x111, 0xf, 0xf, false)); }
__device__ __forceinline__ float dpp_shl1(float x, float old) { return __builtin_bit_cast(float, __builtin_amdgcn_update_dpp(__builtin_bit_cast(int, old), __builtin_bit_cast(int, x), 0x101, 0xf, 0xf, false)); }
#ifndef MK_DEBUG
#define MK_DEBUG 0
#endif
__device__ __forceinline__ float dpp_ror1(float x) { return __builtin_bit_cast(float, __builtin_amdgcn_update_dpp(0, __builtin_bit_cast(int, x), 0x121, 0xf, 0xf, false)); }
__device__ __forceinline__ float dpp_ror15(float x) { return __builtin_bit_cast(float, __builtin_amdgcn_update_dpp(0, __builtin_bit_cast(int, x), 0x12f, 0xf, 0xf, false)); }
#define LDS_WAIT() asm volatile("s_waitcnt lgkmcnt(0)" ::: "memory")

#define XB_TMO      128
#define XB_XCNT(j)  (256  + 64 * (j))
#define XB_XSUB(j)  (1280 + 64 * (j))
#define XB_XGEN(j)  (2304 + 64 * (j))
#define XB_TOP      3328
#define XB_TOPGEN   3392
#define XCD_BAR_WORDS 3456
#define XB_SPIN_CAP (1u << 20)
__device__ __forceinline__ unsigned xb_ld(unsigned* p)              { return __hip_atomic_load(p, __ATOMIC_RELAXED, __HIP_MEMORY_SCOPE_AGENT); }
__device__ __forceinline__ unsigned xb_add(unsigned* p, unsigned v) { return __hip_atomic_fetch_add(p, v, __ATOMIC_RELAXED, __HIP_MEMORY_SCOPE_AGENT); }
__device__ __forceinline__ unsigned xb_xcc_id() { return (unsigned)__builtin_amdgcn_s_getreg((3 << 11) | 20) & 0xFu; }
#define XB_SPIN(cond, bar) do { unsigned _sp = 0; while (cond) { __builtin_amdgcn_s_sleep(1); \
    if ((++_sp & 255u) == 0u) { if (xb_ld(&(bar)[XB_TMO])) break; if (_sp > XB_SPIN_CAP) { atomicAdd(&(bar)[XB_TMO], 1u); break; } } } } while (0)
struct XcdBarrier { unsigned* bar; unsigned x; volatile LAS unsigned* st; };
__device__ __forceinline__ XcdBarrier xcd_barrier_post(unsigned* bar, volatile LAS unsigned* st) {
    XcdBarrier b; b.bar = bar; b.x = xb_xcc_id(); b.st = st;
    if (threadIdx.x == 0) (void)xb_add(&bar[XB_XCNT(b.x)], 1u);
    return b;
}
__device__ __forceinline__ void xcd_barrier_complete(unsigned* bar, unsigned x, unsigned& nloc, unsigned& nx) {
    const unsigned G = gridDim.x * gridDim.y * gridDim.z;
    unsigned sum, cnt, mine, sp = 0u;
    for (;;) {
        sum = 0u; cnt = 0u; mine = 0u;
#pragma unroll
        for (unsigned j = 0; j < 16; ++j) { const unsigned c = xb_ld(&bar[XB_XCNT(j)]); sum += c; cnt += (c > 0u) ? 1u : 0u; mine = (j == x) ? c : mine; }
        if (sum == G) break;
        __builtin_amdgcn_s_sleep(1);
        if ((++sp & 255u) == 0u) { if (xb_ld(&bar[XB_TMO])) break; if (sp > XB_SPIN_CAP) { atomicAdd(&bar[XB_TMO], 1u); break; } }
    }
    nloc = mine > 0u ? mine : 1u; nx = cnt > 0u ? cnt : 1u;
}
__device__ __forceinline__ void xcd_barrier(const XcdBarrier& b) {
    asm volatile("s_waitcnt vmcnt(0)" ::: "memory");
    __syncthreads();
    if (threadIdx.x == 0) {
        unsigned* bar = b.bar;
        __builtin_amdgcn_s_waitcnt(0);
        unsigned nloc = b.st[0], nx = b.st[1];
        if (nloc == 0u) { xcd_barrier_complete(bar, b.x, nloc, nx); b.st[0] = nloc; b.st[1] = nx; }
        const unsigned old = xb_add(&bar[XB_XSUB(b.x)], 1u);
        const unsigned gen = old / nloc;
        if (old + 1u == (gen + 1u) * nloc) {
            __builtin_amdgcn_fence(__ATOMIC_RELEASE, "agent");
            asm volatile("s_waitcnt vmcnt(0)" ::: "memory");
            const unsigned og = xb_add(&bar[XB_TOP], 1u);
            const unsigned tg = og / nx;
            if (og + 1u == (tg + 1u) * nx) xb_add(&bar[XB_TOPGEN], 1u);
            else XB_SPIN(xb_ld(&bar[XB_TOPGEN]) == tg, bar);
            __builtin_amdgcn_fence(__ATOMIC_ACQUIRE, "agent");
            xb_add(&bar[XB_XGEN(b.x)], 1u);
            asm volatile("s_waitcnt vmcnt(0)" ::: "memory");
        } else {
            XB_SPIN(xb_ld(&bar[XB_XGEN(b.x)]) == gen, bar);
            __builtin_amdgcn_fence(__ATOMIC_ACQUIRE, "agent");
            asm volatile("s_waitcnt vmcnt(0)" ::: "memory");
        }
    }
    __syncthreads();
}

namespace pg8 {
constexpr int BM = 256, BK = 64, HALF = 128, HTB = HALF * BK * 2, STAGE_BYTES = 8 * HTB, NXCD = 8, WGM = 8;
__host__ __device__ __forceinline__ int lds_byte(int r, int c) { const int st = (r >> 4) * 2 + (c >> 5), rr = r & 15, cc = c & 31, ob = rr * 64 + cc * 2; return st * 1024 + (ob ^ (((ob >> 9) & 1) << 5)); }
__host__ __device__ __forceinline__ void stage_rc(int b, int& R, int& C) { const int st = b / 1024, sb = b % 1024, swz = sb ^ (((sb >> 9) & 1) << 5); R = (st >> 1) * 16 + swz / 64; C = (st & 1) * 32 + (swz % 64) / 2; }
__host__ __device__ __forceinline__ int perm32(int rho) { const int n = rho >> 4, i = rho & 15; return 8 * (i >> 2) + 4 * n + (i & 3); }
struct Unit { int pm, pn, aux; const char* a; const char* b; };
__device__ __forceinline__ void tile_order(int L, int nM, int nN, int& pm, int& pn) {
    const int nwg = nM * nN; int wgid = L;
    { const int q = nwg / NXCD, r = nwg % NXCD, xcd = wgid % NXCD, off = wgid / NXCD; wgid = (xcd < r ? xcd * (q + 1) : r * (q + 1) + (xcd - r) * q) + off; }
    const int nig = WGM * nN, gid = wgid / nig, fm = gid * WGM, gsz = (nM - fm) < WGM ? (nM - fm) : WGM;
    pm = fm + ((wgid % nig) % gsz); pn = (wgid % nig) / gsz;
}
struct StaticOrder {
    int nM, nN, G, c; const char* A; const char* B; size_t ta, tb;
    __device__ __forceinline__ bool next(int i, Unit& u) const {
        const long L = (long)i * G + c; if (L >= (long)nM * nN) return false;
        tile_order((int)L, nM, nN, u.pm, u.pn); u.aux = 0; u.a = A + (size_t)u.pm * ta; u.b = B + (size_t)u.pn * tb; return true;
    }
};
#define PG8_LAS __attribute__((address_space(3)))
template <class Epi, class Sched>
__device__ __forceinline__ void gemm_phase(PG8_LAS unsigned char* lds, const int K, const int lda, const int ldb, const Sched& S, const Epi& E) {
    const int tid = threadIdx.x, wid = __builtin_amdgcn_readfirstlane(tid >> 6), lane = tid & 63, wr = wid >> 2, wc = wid & 3, fr = lane & 15, fq = lane >> 4;
    const int nt = K / BK;
    unsigned voffA[2], voffB[2];
#pragma unroll
    for (int i = 0; i < 2; ++i) { int R, C; stage_rc(tid * 16 + i * 8192, R, C); const int Rb = Epi::PERM ? ((R & ~31) + perm32(R & 31)) : R;
        voffA[i] = (unsigned)(R * lda + C) * 2u; voffB[i] = (unsigned)(Rb * ldb + C) * 2u; }
    const size_t kstep = (size_t)(BK * 2);
    const size_t hstepA = (size_t)HALF * lda * 2, hstepB = (size_t)HALF * ldb * 2;
    const unsigned ldsw = (unsigned)wid * 1024u;
    const int aoff = lds_byte(wr * 64 + fr, fq * 8), boff = lds_byte(wc * 32 + fr, fq * 8);
#define PG8_SA(b, h) (((b) * 2 + (h)) * HTB)
#define PG8_SB(b, h) ((4 + (b) * 2 + (h)) * HTB)
#define PG8_STAGE(bufoff, gbase, voff) do { _Pragma("unroll") for (int _i = 0; _i < 2; ++_i) \
        __builtin_amdgcn_global_load_lds((const unsigned*)((const char*)(gbase) + (voff)[_i]), (PG8_LAS unsigned*)(lds + (bufoff) + ldsw + _i * 8192), 16, 0, 0); } while (0)
#define PG8_LDA(dst, b, h) do { _Pragma("unroll") for (int m = 0; m < 4; ++m) _Pragma("unroll") for (int k = 0; k < 2; ++k) dst[m][k] = *(const PG8_LAS bf16x8*)(lds + PG8_SA(b, h) + aoff + m * 2048 + k * 1024); } while (0)
#define PG8_LDB(dst, b, h) do { _Pragma("unroll") for (int n = 0; n < 2; ++n) _Pragma("unroll") for (int k = 0; k < 2; ++k) dst[n][k] = *(const PG8_LAS bf16x8*)(lds + PG8_SB(b, h) + boff + n * 2048 + k * 1024); } while (0)
#define PG8_MMA(ai, bj, At, Bt) do { __builtin_amdgcn_s_setprio(1); _Pragma("unroll") for (int m = 0; m < 4; ++m) _Pragma("unroll") for (int n = 0; n < 2; ++n) _Pragma("unroll") for (int k = 0; k < 2; ++k) \
        acc[ai][bj][m][n] = __builtin_amdgcn_mfma_f32_16x16x32_bf16(Bt[n][k], At[m][k], acc[ai][bj][m][n], 0, 0, 0); __builtin_amdgcn_s_setprio(0); } while (0)
#define PG8_WAIT_V(n) asm volatile("s_waitcnt vmcnt(" #n ")" ::: "memory")
#define PG8_WAIT_L(n) asm volatile("s_waitcnt lgkmcnt(" #n ")" ::: "memory")
#define PG8_BAR __builtin_amdgcn_s_barrier()
#define PG8_SCHED __builtin_amdgcn_sched_barrier(0)
    Unit cur, nxt; int ui = 0;
    if (!S.next(0, cur)) return;
    f32x4 acc[2][2][4][2];
#pragma unroll
    for (int a = 0; a < 2; ++a)
#pragma unroll
        for (int b = 0; b < 2; ++b)
#pragma unroll
            for (int m = 0; m < 4; ++m)
#pragma unroll
                for (int n = 0; n < 2; ++n) acc[a][b][m][n] = (f32x4){0.f, 0.f, 0.f, 0.f};
    bf16x8 At[4][2], B0[2][2], B1[2][2];
    const char* cA = cur.a; const char* cB = cur.b;
    PG8_STAGE(PG8_SB(0, 0), cB, voffB); PG8_STAGE(PG8_SB(0, 1), cB + hstepB, voffB); PG8_STAGE(PG8_SA(0, 0), cA, voffA); PG8_STAGE(PG8_SA(0, 1), cA + hstepA, voffA);
    if (wr == 1) PG8_BAR;
    PG8_WAIT_V(2); PG8_BAR;
    PG8_STAGE(PG8_SB(1, 0), cB + kstep, voffB); PG8_STAGE(PG8_SA(1, 0), cA + kstep, voffA); PG8_STAGE(PG8_SB(1, 1), cB + hstepB + kstep, voffB);
    PG8_WAIT_V(6); PG8_BAR;
    for (;;) {
        const bool has_next = S.next(ui + 1, nxt);
        const char* nA = has_next ? nxt.a : cA; const char* nB = has_next ? nxt.b : cB;
        for (int t = 0; t < nt; t += 2) {
            const bool last = (t == nt - 2);
            const char* a1 = cA + (size_t)(t + 1) * kstep;
            const char* a2 = last ? nA : cA + (size_t)(t + 2) * kstep; const char* b2 = last ? nB : cB + (size_t)(t + 2) * kstep;
            const char* a3 = a2 + kstep; const char* b3 = b2 + kstep;
            PG8_LDB(B0, 0, 0); PG8_LDB(B1, 0, 1); PG8_SCHED; PG8_LDA(At, 0, 0); PG8_STAGE(PG8_SA(1, 1), a1 + hstepA, voffA);
            PG8_WAIT_V(8); PG8_WAIT_L(0); PG8_BAR; PG8_MMA(0, 0, At, B0); PG8_MMA(0, 1, At, B1); PG8_BAR; PG8_SCHED;
            PG8_LDA(At, 0, 1); PG8_STAGE(PG8_SB(0, 0), b2, voffB); PG8_STAGE(PG8_SB(0, 1), b2 + hstepB, voffB); PG8_STAGE(PG8_SA(0, 0), a2, voffA);
            PG8_WAIT_V(8); PG8_WAIT_L(0); PG8_BAR; PG8_MMA(1, 0, At, B0); PG8_MMA(1, 1, At, B1); PG8_BAR; PG8_SCHED;
            PG8_LDB(B0, 1, 0); PG8_LDB(B1, 1, 1); PG8_SCHED; PG8_LDA(At, 1, 0); PG8_STAGE(PG8_SA(0, 1), a2 + hstepA, voffA);
            PG8_WAIT_V(8); PG8_WAIT_L(0); PG8_BAR; PG8_MMA(0, 0, At, B0); PG8_MMA(0, 1, At, B1); PG8_BAR; PG8_SCHED;
            PG8_LDA(At, 1, 1); PG8_STAGE(PG8_SB(1, 0), b3, voffB); PG8_STAGE(PG8_SB(1, 1), b3 + hstepB, voffB); PG8_STAGE(PG8_SA(1, 0), a3, voffA);
            PG8_WAIT_V(8); PG8_WAIT_L(0); PG8_BAR; PG8_MMA(1, 0, At, B0); PG8_MMA(1, 1, At, B1); PG8_BAR; PG8_SCHED;
        }
        if (wr == 0) PG8_BAR;
        E(acc, cur, wr, wc, fr, fq);
        if (!has_next) break;
#pragma unroll
        for (int a = 0; a < 2; ++a)
#pragma unroll
            for (int b = 0; b < 2; ++b)
#pragma unroll
                for (int m = 0; m < 4; ++m)
#pragma unroll
                    for (int n = 0; n < 2; ++n) acc[a][b][m][n] = (f32x4){0.f, 0.f, 0.f, 0.f};
        cur = nxt; cA = nA; cB = nB; ++ui;
        if (wr == 1) PG8_BAR;
    }
    PG8_WAIT_V(0);
    PG8_BAR;
#undef PG8_SA
#undef PG8_SB
#undef PG8_STAGE
#undef PG8_LDA
#undef PG8_LDB
#undef PG8_MMA
#undef PG8_WAIT_V
#undef PG8_WAIT_L
#undef PG8_BAR
#undef PG8_SCHED
}
}

#if MK_DEBUG
__device__ __forceinline__ bool badf(float v) { return !(fabsf(v) < 1e30f); }
__device__ __forceinline__ void dbg_bf16(const bf16_t* p, int rows, int cols, size_t ld, unsigned* flag, int gt, int ngt) {
    const int cpr = cols / 8; bool bad = false;
    for (size_t i = gt; i < (size_t)rows * cpr; i += ngt) { const size_t r = i / cpr, c = (i % cpr) * 8; const u32x4 a = *(const u32x4*)(p + r * ld + c);
        bad |= badf(bf_lo(a.x)) | badf(bf_hi(a.x)) | badf(bf_lo(a.y)) | badf(bf_hi(a.y)) | badf(bf_lo(a.z)) | badf(bf_hi(a.z)) | badf(bf_lo(a.w)) | badf(bf_hi(a.w)); }
    if (bad) *flag = 1u;
}
__device__ __forceinline__ void dbg_max_bf16(const bf16_t* p, size_t n, unsigned* slot, int gt, int ngt) {
    float m = 0.f;
    for (size_t i = (size_t)gt * 8; i < n; i += (size_t)ngt * 8) { const u32x4 a = *(const u32x4*)(p + i);
        m = fmaxf(m, fmaxf(fmaxf(fmaxf(fabsf(bf_lo(a.x)), fabsf(bf_hi(a.x))), fmaxf(fabsf(bf_lo(a.y)), fabsf(bf_hi(a.y)))), fmaxf(fmaxf(fabsf(bf_lo(a.z)), fabsf(bf_hi(a.z))), fmaxf(fabsf(bf_lo(a.w)), fabsf(bf_hi(a.w)))))); }
    atomicMax(slot, __float_as_uint(m));
}
__device__ __forceinline__ void dbg_f32(const float* p, int rows, int cols, size_t ld, unsigned* flag, int gt, int ngt) {
    const int cpr = cols / 4; bool bad = false;
    for (size_t i = gt; i < (size_t)rows * cpr; i += ngt) { const size_t r = i / cpr, c = (i % cpr) * 4; const f32x4 a = *(const f32x4*)(p + r * ld + c);
        bad |= badf(a.x) | badf(a.y) | badf(a.z) | badf(a.w); }
    if (bad) *flag = 1u;
}
#endif
struct Args { const float* in[23]; float* out; unsigned char* ws; int ph_lo, ph_hi, never, pad; };
enum { I_X = 0, I_C, I_CTX, I_CCTX, I_ADAW, I_ADAB, I_NORMW, I_EWIN, I_ECONVQKV, I_EALOG, I_EDTB, I_EHN, I_ECONVB, I_EWOUT, I_OWIN, I_OLNW, I_OLNB, I_OWS, I_OBS, I_OPW, I_OPS, I_OWOUT, I_FNW };

template <class SrcFn>
__device__ __forceinline__ void conv_item(const float* W, int ldw, int K, bf16_t* WT, int c0, int k0, LAS float* scr, int lane, const SrcFn& src) {
    const int sc = src(c0 + lane);
    const float* wp = W + (size_t)k0 * ldw + (sc >= 0 ? sc : 0);
    float v[64];
#pragma unroll
    for (int i = 0; i < 64; ++i) v[i] = wp[(size_t)i * ldw];
#pragma unroll
    for (int i = 0; i < 64; ++i) scr[i * 65 + lane] = sc >= 0 ? v[i] : 0.f;
    LDS_WAIT(); asm volatile("" ::: "memory");
    const int kc = lane >> 3, cc = lane & 7;
#pragma unroll
    for (int j = 0; j < 8; ++j) { const int c = cc + 8 * j; const LAS float* sp = scr + (8 * kc) * 65 + c;
        u32x4 o; o.x = cvt_pk_bf16(sp[0 * 65], sp[1 * 65]); o.y = cvt_pk_bf16(sp[2 * 65], sp[3 * 65]); o.z = cvt_pk_bf16(sp[4 * 65], sp[5 * 65]); o.w = cvt_pk_bf16(sp[6 * 65], sp[7 * 65]);
        *(u32x4*)(WT + (size_t)(c0 + c) * K + k0 + 8 * kc) = o; }
    LDS_WAIT(); asm volatile("" ::: "memory");
}
struct SrcId { __device__ __forceinline__ int operator()(int c) const { return c; } };
struct SrcW1 { __device__ __forceinline__ int operator()(int c) const {
    if (c < 8192) return c;
    if (c < 16384) { const int cc = c - 8192, T = cc >> 8, cp = cc & 255, bj = cp >> 7, wc = (cp >> 5) & 3, fq = (cp >> 3) & 3, n = (cp >> 2) & 1, j = cp & 3;
        return 8256 + 2048 * (2 * bj + n) + 64 * T + 16 * wc + 4 * fq + j; }
    const int cp = c - 16384; return cp < 64 ? 8192 + cp : -1; } };

__device__ __forceinline__ void mod_task(const float* adaw, const float* adab, float* modl, int n0, const LAS float* tab, LAS float* red, int wave, int lane) {
    const int col = n0 + (lane & 31), kp = lane >> 5;
    float acc[5] = {0.f, 0.f, 0.f, 0.f, 0.f};
    const float* wp = adaw + (size_t)(256 * wave + kp) * 6144 + col;
#pragma unroll 32
    for (int kk = 0; kk < 128; ++kk) { const float wv = wp[(size_t)kk * 2 * 6144]; const int k = 256 * wave + 2 * kk + kp;
#pragma unroll
        for (int r = 0; r < 5; ++r) acc[r] += tab[r * 2048 + k] * wv; }
#pragma unroll
    for (int r = 0; r < 5; ++r) { acc[r] += __shfl_xor(acc[r], 32); if (lane < 32) red[(wave * 5 + r) * 32 + lane] = acc[r]; }
    __syncthreads();
    if (threadIdx.x < 160) { const int r = threadIdx.x >> 5, c = threadIdx.x & 31; float s = adab[n0 + c];
#pragma unroll
        for (int w = 0; w < 8; ++w) s += red[(w * 5 + r) * 32 + c];
        modl[r * 6144 + n0 + c] = s; }
    __syncthreads();
}
__device__ __forceinline__ void silu_table(const float* c, const float* cctx, LAS float* tab) {
    for (int i = threadIdx.x; i < 5 * 2048; i += 512) { const float v = i < 8192 ? c[i] : cctx[i - 8192]; tab[i] = silu_f(v); }
    __syncthreads();
}

__device__ __forceinline__ void hrow(const float* xrow, const float* nw, const float* modr, bf16_t* orow, int lane) {
    const f32x4* xr = (const f32x4*)xrow + lane;
    f32x4 v[8]; float s = 0.f;
#pragma unroll
    for (int j = 0; j < 8; ++j) { v[j] = xr[64 * j]; s += (v[j].x * v[j].x + v[j].y * v[j].y) + (v[j].z * v[j].z + v[j].w * v[j].w); }
    const float rstd = rsqrtf(wave_sum(s) * (1.f / DM) + EPS);
    u32x2* o8 = (u32x2*)orow + lane;
#pragma unroll
    for (int j = 0; j < 8; ++j) { const f32x4 w = ((const f32x4*)nw)[lane + 64 * j], sh = ((const f32x4*)modr)[lane + 64 * j], sc = ((const f32x4*)(modr + 2048))[lane + 64 * j];
        const f32x4 y = v[j] * rstd * w * (sc + 1.0f) + sh; u32x2 p; p.x = cvt_pk_bf16(y.x, y.y); p.y = cvt_pk_bf16(y.z, y.w); o8[64 * j] = p; }
}

__device__ __forceinline__ void hrows4(const float* x0, const float* nw, const float* modr, bf16_t* o0, int lane) {
    f32x4 g[8], sh[8];
#pragma unroll
    for (int j = 0; j < 8; ++j) { const f32x4 w = ((const f32x4*)nw)[lane + 64 * j], sc = ((const f32x4*)(modr + 2048))[lane + 64 * j]; g[j] = w * (sc + 1.0f); sh[j] = ((const f32x4*)modr)[lane + 64 * j]; }
    f32x4 v[8], nx[8];
#pragma unroll
    for (int j = 0; j < 8; ++j) v[j] = ((const f32x4*)x0)[lane + 64 * j];
#pragma unroll 1
    for (int k = 0; k < 4; ++k) {
        if (k < 3) {
#pragma unroll
            for (int j = 0; j < 8; ++j) nx[j] = ((const f32x4*)(x0 + (size_t)(k + 1) * DM))[lane + 64 * j]; }
        float s = 0.f;
#pragma unroll
        for (int j = 0; j < 8; ++j) s += (v[j].x * v[j].x + v[j].y * v[j].y) + (v[j].z * v[j].z + v[j].w * v[j].w);
        const float rstd = rsqrtf(wave_sum(s) * (1.f / DM) + EPS);
        u32x2* o8 = (u32x2*)(o0 + (size_t)k * DM) + lane;
#pragma unroll
        for (int j = 0; j < 8; ++j) { const f32x4 y = v[j] * rstd * g[j] + sh[j]; u32x2 p; p.x = cvt_pk_bf16(y.x, y.y); p.y = cvt_pk_bf16(y.z, y.w); o8[64 * j] = p; }
#pragma unroll
        for (int j = 0; j < 8; ++j) v[j] = nx[j];
    }
}

typedef f32x4 AccT[2][2][4][2];
struct Sched1 { int G, c; const char* A; const char* B;
    __device__ __forceinline__ bool next(int i, pg8::Unit& u) const {
        const int L = i * G + c; if (L >= 2148) return false;
        if (L < 2080) { int pv; pg8::tile_order(L, 32, 65, u.pm, pv);
            const int hc = (pv * 24) / 65, hn = ((pv + 1) * 24) / 65; u.pn = hn > hc ? hc : 24 + (pv - hc); }
        else { const int l = L - 2080; u.pm = 32 + (l & 3); const int t = l >> 2; u.pn = t < 16 ? 8 + t : 64; }
        u.aux = 0; u.a = A + (size_t)u.pm * (256 * 2048 * 2); u.b = B + (size_t)u.pn * (256 * 2048 * 2); return true; } };
struct Epi1 { static constexpr bool PERM = true;
    unsigned char* wsb; const float* convb; const float* convq; LAS unsigned char* lds;
#define E1_ZA ((bf16_t*)(wsb + WS_ZA))
#define E1_Y ((bf16_t*)(wsb + WS_Y))
#define E1_QN ((bf16_t*)(wsb + WS_QN))
#define E1_KN ((bf16_t*)(wsb + WS_KN))
#define E1_KT ((bf16_t*)(wsb + WS_KT))
#define E1_VT ((bf16_t*)(wsb + WS_VT))
#define E1_GG ((float*)(wsb + WS_GG))
#define E1_BETA ((float*)(wsb + WS_BETA))
    template <int M> __device__ __forceinline__ f32x4 conv4(const AccT& acc, int ai, int bj, int n, const f32x4& w0, const f32x4& w1, const f32x4& w2, const f32x4& hp, const f32x4& hn, int lane) const {
        f32x4 y;
#pragma unroll
        for (int j = 0; j < 4; ++j) {
            const float x = acc[ai][bj][M][n][j];
            const float bp = M > 0 ? dpp_ror1(acc[ai][bj][M > 0 ? M - 1 : 0][n][j]) : hp[j];
            const float bn = M < 3 ? dpp_ror15(acc[ai][bj][M < 3 ? M + 1 : 3][n][j]) : hn[j];
            const float up = dpp_shr1(x, bp), dn = dpp_shl1(x, bn);
            y[j] = silu_f(w0[j] * up + w1[j] * x + w2[j] * dn); }
        return y;
    }
    __device__ __forceinline__ void qkv(const bool CTX, const AccT& acc, const pg8::Unit& u, int wr, int wc, int fr, int fq) const {
        const int lane = 16 * fq + fr, tens = u.pn >> 3, hd0 = (u.pn & 7) * 2;
        LAS float* part = (LAS float*)(lds + 131072);
        LAS float* bnd = (LAS float*)(lds + 139264);
        LAS float* cwl = (LAS float*)(lds + 147456);
        { const int t_ = (int)threadIdx.x; const float* cq = convq + tens * 2048 + hd0 * 128;
          cwl[t_] = cq[(t_ >> 8) * 6144 + (t_ & 255)]; if (t_ < 256) cwl[512 + t_] = cq[2 * 6144 + t_]; }
        if (CTX) {
#pragma unroll
            for (int ai = 0; ai < 2; ++ai)
#pragma unroll
                for (int bj = 0; bj < 2; ++bj)
#pragma unroll
                    for (int n = 0; n < 2; ++n) { const int col = 128 * bj + 32 * wc + 8 * fq + 4 * n, g = 2 * ai + wr;
                        if (fr == 0) *(LAS f32x4*)(bnd + (g * 2 + 0) * 256 + col) = acc[ai][bj][0][n];
                        if (fr == 15) *(LAS f32x4*)(bnd + (g * 2 + 1) * 256 + col) = acc[ai][bj][3][n]; }
        }
        asm volatile("s_waitcnt lgkmcnt(0)" ::: "memory"); __builtin_amdgcn_s_barrier(); asm volatile("" ::: "memory");
        const int b = CTX ? (u.pm - 32) : (u.pm >> 3);
#pragma unroll
        for (int ai = 0; ai < 2; ++ai)
#pragma unroll
            for (int bj = 0; bj < 2; ++bj) {
                const int col = 128 * bj + 32 * wc + 8 * fq, g = 2 * ai + wr, bh = b * NHD + hd0 + bj;
                float ss[4] = {0.f, 0.f, 0.f, 0.f};
#pragma unroll
                for (int n = 0; n < 2; ++n) {
                    const f32x4 w0 = *(const LAS f32x4*)(cwl + col + 4 * n), w1 = *(const LAS f32x4*)(cwl + 256 + col + 4 * n), w2 = *(const LAS f32x4*)(cwl + 512 + col + 4 * n);
                    f32x4 hp = {0.f, 0.f, 0.f, 0.f}, hn = {0.f, 0.f, 0.f, 0.f};
                    if (CTX) { if (g > 0) hp = *(const LAS f32x4*)(bnd + ((g - 1) * 2 + 1) * 256 + col + 4 * n);
                               if (g < 3) hn = *(const LAS f32x4*)(bnd + ((g + 1) * 2 + 0) * 256 + col + 4 * n); }
                    const int ch = 32 * wc + 8 * fq + 4 * n;
#define E1_ROW(M) do { const f32x4 y = conv4<M>(acc, ai, bj, n, w0, w1, w2, hp, hn, lane); \
                        ss[M] += (y[0] * y[0] + y[1] * y[1]) + (y[2] * y[2] + y[3] * y[3]); \
                        const int r = 128 * ai + 64 * wr + 16 * (M) + fr; const int tok = CTX ? r : CTXL + ((u.pm & 7) * 256 + r); \
                        u32x2 w; w.x = cvt_pk_bf16(y[0], y[1]); w.y = cvt_pk_bf16(y[2], y[3]); \
                        if (tens == 0) *(u32x2*)(E1_QN + ((size_t)bh * NTOK + tok) * HD + ch) = w; \
                        if (tens == 1) *(u32x2*)(E1_KN + ((size_t)bh * NTOK + tok) * HD + ch) = w; \
                        if (tens >= 1) { bf16_t* T = (tens == 1 ? E1_KT : E1_VT) + ((size_t)bh * HD + ch) * NTOK + tok; \
                            T[0] = (bf16_t)(w.x & 0xffffu); T[NTOK] = (bf16_t)(w.x >> 16); T[2 * NTOK] = (bf16_t)(w.y & 0xffffu); T[3 * NTOK] = (bf16_t)(w.y >> 16); } \
                        } while (0)
                    E1_ROW(0); E1_ROW(1); E1_ROW(2); E1_ROW(3);
                    asm volatile("" ::: "memory"); __builtin_amdgcn_sched_barrier(0);
#undef E1_ROW
                }
                if (tens < 2) {
#pragma unroll
                    for (int m = 0; m < 4; ++m) { float t = ss[m]; t += __shfl_xor(t, 16); t += __shfl_xor(t, 32);
                        if (fq == 0) part[(128 * ai + 64 * wr + 16 * m + fr) * 8 + bj * 4 + wc] = t; } }
            }
        if (tens < 2) {
            asm volatile("s_waitcnt lgkmcnt(0)" ::: "memory"); __builtin_amdgcn_s_barrier(); asm volatile("" ::: "memory");
            const int t_ = (int)threadIdx.x, r = t_ & 255, bj = t_ >> 8;
            const f32x4 ps = *(const LAS f32x4*)(part + r * 8 + bj * 4);
            const int tok = CTX ? r : CTXL + ((u.pm & 7) * 256 + r);
            ((float*)(wsb + (tens == 0 ? WS_GG : WS_BETA)))[(size_t)(b * NHD + hd0 + bj) * NTOK + tok] = rsqrtf((ps[0] + ps[1]) + (ps[2] + ps[3]) + EPS);
        }
    }
    __device__ __forceinline__ void operator()(const AccT& acc, const pg8::Unit& u, int wr, int wc, int fr_in, int fq_in) const {
        int fr = fr_in, fq = fq_in; asm volatile("" : "+v"(fr), "+v"(fq));
        const int row0 = u.pm * 256 + wr * 64 + fr;
        if (u.pn < 24) { qkv(u.pm >= 32, acc, u, wr, wc, fr, fq); }
        else if (u.pn < 32) {
            const int col0 = (u.pn - 24) * 256 + wc * 32 + 8 * fq;
#pragma unroll
            for (int ai = 0; ai < 2; ++ai)
#pragma unroll
                for (int m = 0; m < 4; ++m) { bf16_t* rowp = E1_ZA + (size_t)(row0 + ai * 128 + m * 16) * 2048 + col0;
#pragma unroll
                    for (int bj = 0; bj < 2; ++bj) { f32x4 v0 = acc[ai][bj][m][0], v1 = acc[ai][bj][m][1];
#pragma unroll
                        for (int j = 0; j < 4; ++j) { v0[j] = silu_f(v0[j]); v1[j] = silu_f(v1[j]); }
                        u32x4 w; w.x = cvt_pk_bf16(v0[0], v0[1]); w.y = cvt_pk_bf16(v0[2], v0[3]); w.z = cvt_pk_bf16(v1[0], v1[1]); w.w = cvt_pk_bf16(v1[2], v1[3]);
                        *(u32x4*)(rowp + bj * 128) = w; } }
        } else if (u.pn < 64) {
            const int lane = 16 * fq + fr;
            const int ch0 = 64 * (u.pn - 32) + 16 * wc + 4 * fq;
            const f32x4 cw0 = *(const f32x4*)(convb + ch0), cw1 = *(const f32x4*)(convb + 2048 + ch0), cw2 = *(const f32x4*)(convb + 4096 + ch0);
#pragma unroll
            for (int ai = 0; ai < 2; ++ai) {
                f32x4 pr[4];
#pragma unroll
                for (int m = 0; m < 4; ++m) pr[m] = acc[ai][0][m][1] * acc[ai][1][m][0];
#pragma unroll
                for (int m = 0; m < 4; ++m) { f32x4 y;
#pragma unroll
                    for (int j = 0; j < 4; ++j) {
                        const float bp = m > 0 ? dpp_ror1(pr[m > 0 ? m - 1 : 0][j]) : 0.f;
                        const float bn = m < 3 ? dpp_ror15(pr[m < 3 ? m + 1 : 3][j]) : 0.f;
                        const float up = dpp_shr1(pr[m][j], bp), dn = dpp_shl1(pr[m][j], bn);
                        const float cv = cw0[j] * up + cw1[j] * pr[m][j] + cw2[j] * dn;
                        y[j] = acc[ai][0][m][0][j] * cv * silu_f(acc[ai][1][m][1][j]); }
                    u32x2 w; w.x = cvt_pk_bf16(y[0], y[1]); w.y = cvt_pk_bf16(y[2], y[3]);
                    *(u32x2*)(E1_Y + (size_t)(row0 + ai * 128 + m * 16) * 4096 + 2048 + ch0) = w; } }
        } else {
            if (wc < 2) {
#pragma unroll
                for (int ai = 0; ai < 2; ++ai)
#pragma unroll
                    for (int m = 0; m < 4; ++m)
#pragma unroll
                        for (int n = 0; n < 2; ++n) *(f32x4*)((float*)(wsb + WS_AB) + (size_t)(row0 + ai * 128 + m * 16) * 64 + 32 * wc + 8 * fq + 4 * n) = acc[ai][0][m][n]; }
        }
    } };
struct EpiResid { static constexpr bool PERM = false;
    const float* resid; float* out; const float* gate;
    __device__ __forceinline__ void operator()(const AccT& acc, const pg8::Unit& u, int wr, int wc, int fr, int fq) const {
        const int row0 = u.pm * 256 + wr * 64 + fr, col0 = u.pn * 256 + wc * 32 + 4 * fq; const float* g = gate + (size_t)(u.pm >> 3) * 6144;
        f32x4 gv[2][2];
#pragma unroll
        for (int bj = 0; bj < 2; ++bj)
#pragma unroll
            for (int n = 0; n < 2; ++n) gv[bj][n] = *(const f32x4*)(g + col0 + bj * 128 + n * 16);
#pragma unroll
        for (int ai = 0; ai < 2; ++ai)
#pragma unroll
            for (int m = 0; m < 4; ++m) { const size_t off = (size_t)(row0 + ai * 128 + m * 16) * DM + col0;
#pragma unroll
                for (int bj = 0; bj < 2; ++bj)
#pragma unroll
                    for (int n = 0; n < 2; ++n) { const f32x4 r = *(const f32x4*)(resid + off + bj * 128 + n * 16); *(f32x4*)(out + off + bj * 128 + n * 16) = r + gv[bj][n] * acc[ai][bj][m][n]; }
                asm volatile("" ::: "memory"); }
    } };
struct Epi3 { static constexpr bool PERM = true;
    bf16_t* P1;
    __device__ __forceinline__ void operator()(const AccT& acc, const pg8::Unit& u, int wr, int wc, int fr, int fq) const {
        const int row0 = u.pm * 256 + wr * 64 + fr, col0 = u.pn * 256 + wc * 32 + 8 * fq;
        const int act = u.pn < 16 ? 1 : ((u.pn >= 24 && u.pn < 32) ? 0 : 2);
#pragma unroll
        for (int ai = 0; ai < 2; ++ai)
#pragma unroll
            for (int m = 0; m < 4; ++m) { bf16_t* rowp = P1 + (size_t)(row0 + ai * 128 + m * 16) * N3 + col0;
#pragma unroll
                for (int bj = 0; bj < 2; ++bj) { f32x4 v0 = acc[ai][bj][m][0], v1 = acc[ai][bj][m][1];
                    if (act == 1) {
#pragma unroll
                        for (int j = 0; j < 4; ++j) { v0[j] = gelu_f(v0[j]); v1[j] = gelu_f(v1[j]); } }
                    else if (act == 2) {
#pragma unroll
                        for (int j = 0; j < 4; ++j) { v0[j] = silu_f(v0[j]); v1[j] = silu_f(v1[j]); } }
                    u32x4 w; w.x = cvt_pk_bf16(v0[0], v0[1]); w.y = cvt_pk_bf16(v0[2], v0[3]); w.z = cvt_pk_bf16(v1[0], v1[1]); w.w = cvt_pk_bf16(v1[2], v1[3]);
                    *(u32x4*)(rowp + bj * 128) = w; } }
    } };
struct SchedPool { int G, c; const char* A; const char* B;
    __device__ __forceinline__ bool next(int i, pg8::Unit& u) const {
        const int L = i * G + c; if (L >= 256) return false;
        u.aux = L >> 6; u.pn = (L >> 5) & 1; u.pm = L & 31;
        u.a = A + ((size_t)u.pm * 256 * 2048 + 512 * u.aux) * 2; u.b = B + ((size_t)u.aux * 512 * 512 + (size_t)u.pn * 256 * 512) * 2; return true; } };
struct EpiPool { static constexpr bool PERM = true;
    const bf16_t* P1; bf16_t* Y2; const float* pscale;
    __device__ __forceinline__ void operator()(const AccT& acc, const pg8::Unit& u, int wr, int wc, int fr, int fq) const {
        const int row0 = u.pm * 256 + wr * 64 + fr, colg = 512 * u.aux + 256 * u.pn + wc * 32 + 8 * fq;
        f32x4 ps[2][2];
#pragma unroll
        for (int bj = 0; bj < 2; ++bj)
#pragma unroll
            for (int n = 0; n < 2; ++n) ps[bj][n] = *(const f32x4*)(pscale + colg + bj * 128 + 4 * n);
#pragma unroll
        for (int ai = 0; ai < 2; ++ai)
#pragma unroll
            for (int m = 0; m < 4; ++m) { const size_t row = (size_t)(row0 + ai * 128 + m * 16);
#pragma unroll
                for (int bj = 0; bj < 2; ++bj) { const u32x4 z = *(const u32x4*)(P1 + row * N3 + 8192 + colg + bj * 128);
                    f32x4 v0 = acc[ai][bj][m][0] * ps[bj][0], v1 = acc[ai][bj][m][1] * ps[bj][1]; if (ABLATE & 8) { v0 = v0 * 0.f; v1 = v1 * 0.f; }
                    u32x4 w; w.x = cvt_pk_bf16(v0[0] * bf_lo(z.x), v0[1] * bf_hi(z.x)); w.y = cvt_pk_bf16(v0[2] * bf_lo(z.y), v0[3] * bf_hi(z.y));
                    w.z = cvt_pk_bf16(v1[0] * bf_lo(z.z), v1[1] * bf_hi(z.z)); w.w = cvt_pk_bf16(v1[2] * bf_lo(z.w), v1[3] * bf_hi(z.w));
                    *(u32x4*)(Y2 + row * 4096 + 2048 + colg + bj * 128) = w; } }
    } };

__device__ __forceinline__ void qkv_task(int task, const bf16_t* PQKV, const float* convw, bf16_t* QN, bf16_t* KN, bf16_t* KT, bf16_t* VT, int lane) {
    const int head = task & 15, tens = (task >> 4) % 3, blk = task / 48;
    int b, t0, prow0, tokb; bool isx;
    if (blk < 128) { isx = true; b = blk >> 5; t0 = (blk & 31) * 64; prow0 = b * SEQ + t0; tokb = CTXL + t0; }
    else { isx = false; const int cb = blk - 128; b = cb >> 2; t0 = (cb & 3) * 64; prow0 = MX + b * CTXL + t0; tokb = t0; }
    const int col = tens * 2048 + head * 128 + 2 * lane;
    const f32x2 w0 = *(const f32x2*)(convw + col), w1 = *(const f32x2*)(convw + 6144 + col), w2 = *(const f32x2*)(convw + 12288 + col);
    const bf16_t* p = PQKV + (size_t)prow0 * 6144 + col;
    const int bh = b * NHD + head;
    unsigned v[66];
    v[0] = 0u; v[65] = 0u;
    if (!isx && t0 > 0) v[0] = *(const unsigned*)(p - 6144);
    if (!isx && t0 < 192) v[65] = *(const unsigned*)(p + (size_t)64 * 6144);
#pragma unroll
    for (int i = 0; i < 64; ++i) v[i + 1] = *(const unsigned*)(p + (size_t)i * 6144);
    unsigned tr0[4], tr1[4];
    float hold0 = 0.f, hold1 = 0.f;
#pragma unroll
    for (int i = 0; i < 64; ++i) {
        const unsigned pv = v[i], cu = v[i + 1], nx = v[i + 2];
        float o0 = w0.x * bf_lo(pv) + w1.x * bf_lo(cu) + w2.x * bf_lo(nx);
        float o1 = w0.y * bf_hi(pv) + w1.y * bf_hi(cu) + w2.y * bf_hi(nx);
        o0 = silu_f(o0); o1 = silu_f(o1);
        if (tens < 2) { const float ss = wave_sum(o0 * o0 + o1 * o1); const float sc = rsqrtf(ss + EPS); o0 *= sc; o1 *= sc; }
        const int tok = tokb + i;
        if (tens == 0) *(unsigned*)(QN + ((size_t)bh * NTOK + tok) * HD + 2 * lane) = cvt_pk_bf16(o0, o1);
        if (tens == 1) *(unsigned*)(KN + ((size_t)bh * NTOK + tok) * HD + 2 * lane) = cvt_pk_bf16(o0, o1);
        if (tens >= 1) {
            if (i & 1) { tr0[(i >> 1) & 3] = cvt_pk_bf16(hold0, o0); tr1[(i >> 1) & 3] = cvt_pk_bf16(hold1, o1); } else { hold0 = o0; hold1 = o1; }
            if ((i & 7) == 7) { bf16_t* T = (tens == 1 ? KT : VT) + ((size_t)bh * HD + 2 * lane) * NTOK + tok - 7;
                *(u32x4*)T = (u32x4){tr0[0], tr0[1], tr0[2], tr0[3]}; *(u32x4*)(T + NTOK) = (u32x4){tr1[0], tr1[1], tr1[2], tr1[3]}; } }
    }
}
__device__ __forceinline__ void ab_task(int blk, const float* AB, const float* alog, const float* dtb, float* GG, float* BETA, int lane) {
    int b, prow0, tokb;
    if (blk < 128) { b = blk >> 5; const int t0 = (blk & 31) * 64; prow0 = b * SEQ + t0; tokb = CTXL + t0; }
    else { const int cb = blk - 128; b = cb >> 2; const int t0 = (cb & 3) * 64; prow0 = MX + b * CTXL + t0; tokb = t0; }
    const int kind = lane >> 4, h = lane & 15, d = kind & 1;
    const float A = __expf(alog[d * 16 + h]), db = dtb[d * 16 + h];
    float* dst = (kind < 2 ? GG : BETA) + ((size_t)d * NBH + b * NHD + h) * NTOK + tokb;
#pragma unroll 4
    for (int i = 0; i < 64; ++i) { const float v = AB[(size_t)(prow0 + i) * 64 + lane];
        dst[i] = kind < 2 ? -A * softplus_f(v + db) : sigmoid_f(v); }
}

template <int I> struct FS {
    static __device__ __forceinline__ void run(const LAS float* Ml, float (&Tc)[64], int lane) {
        float a = (lane == I) ? 1.f : 0.f;
#pragma unroll
        for (int jq = 0; jq < (I + 3) / 4; ++jq) { const f32x4 mv = *(const LAS f32x4*)(Ml + I * 68 + 4 * jq);
#pragma unroll
            for (int e = 0; e < 4; ++e) if (4 * jq + e < I) a = fmaf(-mv[e], Tc[4 * jq + e], a); }
        Tc[I] = a;
        __builtin_amdgcn_sched_barrier(0);
        if constexpr (I + 1 < 64) FS<I + 1>::run(Ml, Tc, lane);
    } };
__device__ __forceinline__ void chunk_task(int task, const bf16_t* QN, const bf16_t* KN, const float* AB, const float* alog, const float* dtb, float* GC, bf16_t* TU, bf16_t* AI, LAS float* tab, int lane, const float* RQ, const float* RK) {
    const int tc = task % NCH, bh = (task / NCH) & 63, dir = task / (NCH * 64);
    const int tok0 = 64 * tc;
    LAS float* Ml = tab + 128;
    const int mytok = tok0 + (dir ? 63 - lane : lane);
    const size_t gidx = ((size_t)dir * NBH + bh) * NTOK + mytok;
    const int hq = bh & 15, bq = bh >> 4;
    const float* abr = AB + (size_t)(mytok < CTXL ? MX + bq * CTXL + mytok : bq * SEQ + (mytok - CTXL)) * 64;
    const float gl = -__expf(alog[dir * 16 + hq]) * softplus_f(abr[dir * 16 + hq] + dtb[dir * 16 + hq]), bl = sigmoid_f(abr[32 + dir * 16 + hq]);
    float gc = gl;
#pragma unroll
    for (int o = 1; o < 64; o <<= 1) { const float t = __shfl_up(gc, o); if (lane >= o) gc += t; }
    GC[gidx] = gc;
    const float rkl = RK[(size_t)bh * NTOK + mytok], rql = (tc >= 4) ? RQ[(size_t)bh * NTOK + mytok] : 0.f;
    tab[lane] = gc; tab[64 + lane] = bl;
    LAS float* tab2 = tab + 128 + 64 * 68;
    tab2[lane] = rkl; tab2[64 + lane] = rql;
    LDS_WAIT(); asm volatile("" ::: "memory");
    const int r = lane & 31, hh = lane >> 5;
    bf16x8 ka[2][8];
#pragma unroll
    for (int ib = 0; ib < 2; ++ib) { const int tk = tok0 + (dir ? 63 - (32 * ib + r) : 32 * ib + r); const bf16x8* kp = (const bf16x8*)(KN + ((size_t)bh * NTOK + tk) * HD + 8 * hh);
#pragma unroll
        for (int s = 0; s < 8; ++s) ka[ib][s] = kp[2 * s]; }
    const bool isx = tc >= 4;
    bf16_t* aib = AI + (((size_t)dir * NBH + bh) * NCH + tc) * 4096;
    if (isx) {
#pragma unroll
        for (int ib = 0; ib < 2; ++ib) {
            bf16x8 qa[8]; { const int tk = tok0 + (dir ? 63 - (32 * ib + r) : 32 * ib + r); const bf16x8* qp = (const bf16x8*)(QN + ((size_t)bh * NTOK + tk) * HD + 8 * hh);
#pragma unroll
                for (int s = 0; s < 8; ++s) qa[s] = qp[2 * s]; }
#pragma unroll
            for (int jb = 0; jb < 2; ++jb) {
                f32x16 a = {};
                if (jb <= ib) {
#pragma unroll
                    for (int s = 0; s < 8; ++s) a = __builtin_amdgcn_mfma_f32_32x32x16_bf16(qa[s], ka[jb][s], a, 0, 0, 0); }
                const int jp = 32 * jb + r; const float gcj = tab[jp], rkj = tab2[jp];
                bf16_t vv[16];
#pragma unroll
                for (int g = 0; g < 4; ++g) { const f32x4 gci = *(const LAS f32x4*)(tab + 32 * ib + 8 * g + 4 * hh), rqi = *(const LAS f32x4*)(tab2 + 64 + 32 * ib + 8 * g + 4 * hh);
#pragma unroll
                    for (int e = 0; e < 4; ++e) { const int ip = 32 * ib + 8 * g + 4 * hh + e;
                        vv[4 * g + e] = f2bf((jp <= ip) ? 0.08838834764831845f * rqi[e] * rkj * a[4 * g + e] * __expf(gci[e] - gcj) : 0.f); } }
                if (dir == 0) { bf16_t* bp = aib + (32 * ib + 4 * hh) * 64 + jp;
#pragma unroll
                    for (int e = 0; e < 16; ++e) bp[((e & 3) + 8 * (e >> 2)) * 64] = vv[e]; }
                else { bf16_t* bp = aib + (63 - 32 * ib - 4 * hh) * 64 + (63 - jp);
#pragma unroll
                    for (int e = 0; e < 16; ++e) bp[-((e & 3) + 8 * (e >> 2)) * 64] = vv[e]; }
                asm volatile("" ::: "memory"); __builtin_amdgcn_sched_barrier(0); } }
    }
    f32x16 Mt[3];
#pragma unroll
    for (int t = 0; t < 3; ++t) { const int ib = t > 0, jb = t > 1; f32x16 a = {};
#pragma unroll
        for (int s = 0; s < 8; ++s) a = __builtin_amdgcn_mfma_f32_32x32x16_bf16(ka[ib][s], ka[jb][s], a, 0, 0, 0);
        Mt[t] = a; }
    LAS float* Mlb = Ml + 4 * hh * 68 + r;
#pragma unroll
    for (int t = 0; t < 3; ++t) { const int ib = t > 0, jb = t > 1; const int jp = 32 * jb + r; const float gcj = tab[jp], rkj = tab2[jp];
#pragma unroll
        for (int g = 0; g < 4; ++g) { const f32x4 gci = *(const LAS f32x4*)(tab + 32 * ib + 8 * g + 4 * hh), rki = *(const LAS f32x4*)(tab2 + 32 * ib + 8 * g + 4 * hh);
            f32x4 bi = *(const LAS f32x4*)(tab + 64 + 32 * ib + 8 * g + 4 * hh); bi = bi * rki * rkj;
#pragma unroll
            for (int e = 0; e < 4; ++e) { const int ip = 32 * ib + 8 * g + 4 * hh + e;
                Mt[t][4 * g + e] = (jp < ip) ? bi[e] * Mt[t][4 * g + e] * __expf(gci[e] - gcj) : 0.f;
                Mlb[(32 * ib + 8 * g + e) * 68 + 32 * jb] = Mt[t][4 * g + e]; } } }
    LDS_WAIT(); asm volatile("" ::: "memory");
    float Tc[64];
    FS<0>::run(Ml, Tc, lane);
    bf16_t* tub = TU + (((size_t)dir * NBH + bh) * NCH + tc) * 4096;
    if (dir == 0) { bf16_t* bp = tub + lane;
#pragma unroll
        for (int i = 0; i < 64; ++i) bp[i * 64] = f2bf(Tc[i] * bl); }
    else { bf16_t* bp = tub + 63 * 64 + (63 - lane);
#pragma unroll
        for (int i = 0; i < 64; ++i) bp[-i * 64] = f2bf(Tc[i] * bl); }
    LDS_WAIT(); asm volatile("" ::: "memory");
}

constexpr int G_KT = 0, G_VT = 36864, G_TU = 55296, G_W = 73728, G_ST = 91136, G_VN = 108544, G_VNG = 117760, G_TAB = 126976, TABB = 800;
template <int KSTEPS> __device__ __forceinline__ f32x16 mma_tile_t(f32x16 acc, const LAS bf16_t* A, int lda, const LAS bf16_t* B, int ldb, int lane) {
    const LAS bf16_t* ap = A + (lane & 31) * lda + 8 * (lane >> 5); const LAS bf16_t* bp = B + (lane & 31) * ldb + 8 * (lane >> 5);
    bf16x8 af_[KSTEPS], bf_[KSTEPS];
#pragma unroll
    for (int s = 0; s < KSTEPS; ++s) { af_[s] = *(const LAS bf16x8*)(ap + 16 * s); bf_[s] = *(const LAS bf16x8*)(bp + 16 * s); }
#pragma unroll
    for (int s = 0; s < KSTEPS; ++s) acc = __builtin_amdgcn_mfma_f32_32x32x16_bf16(af_[s], bf_[s], acc, 0, 0, 0);
    return acc;
}
__device__ __forceinline__ f32x16 mma_tile(f32x16 acc, const LAS bf16_t* A, int lda, const LAS bf16_t* B, int ldb, int ksteps, int lane) {
    return ksteps == 8 ? mma_tile_t<8>(acc, A, lda, B, ldb, lane) : mma_tile_t<4>(acc, A, lda, B, ldb, lane);
}
__device__ __forceinline__ void scan_chain(int chain, LAS unsigned char* lds, const bf16_t* QN, const bf16_t* KT, const bf16_t* VT, const bf16_t* TU, const bf16_t* AI, const float* GC, bf16_t* OF, bf16_t* OB, const float* RQ, const float* RK) {
#define SC_BAR() do { asm volatile("s_waitcnt lgkmcnt(0)" ::: "memory"); __builtin_amdgcn_s_barrier(); asm volatile("" ::: "memory"); } while (0)
    const int tid = threadIdx.x, wave = __builtin_amdgcn_readfirstlane(tid >> 6), lane = tid & 63;
    const int half = chain & 1, bh = (chain >> 1) & 63, dir = chain >> 7, b = bh >> 4, h = bh & 15;
    LAS bf16_t* Ws = (LAS bf16_t*)(lds + G_W); LAS bf16_t* STs = (LAS bf16_t*)(lds + G_ST); LAS bf16_t* VNs = (LAS bf16_t*)(lds + G_VN); LAS bf16_t* VNGs = (LAS bf16_t*)(lds + G_VNG);
    for (int i = tid; i < 17408 / 4; i += 512) ((LAS unsigned*)STs)[i] = 0u;
    f32x16 Sacc = {};
    bf16_t* Od = dir ? OB : OF;
    const int c = lane & 31, hh = lane >> 5;
    const int sr = tid >> 3, sc8 = (tid & 7) * 8;
    const int kbw = wave & 3, tbw = wave >> 2;
    const int tb2 = (wave >> 1) & 1, db2 = wave & 1;
    u32x4 rk0, rk1, rv, rt; float rg = 0.f, rgl = 0.f, rrk = 0.f, rrq = 0.f;
#define SC_TC(st) (dir == 0 ? (st) : ((st) < 4 ? 3 - (st) : 39 - (st)))
#define SC_GLOAD(st) do { const int tc_ = SC_TC(st), tok0_ = 64 * tc_; \
        rk0 = *(const u32x4*)(KT + ((size_t)bh * HD + sr) * NTOK + tok0_ + sc8); rk1 = *(const u32x4*)(KT + ((size_t)bh * HD + 64 + sr) * NTOK + tok0_ + sc8); \
        rv = *(const u32x4*)(VT + ((size_t)bh * HD + 64 * half + sr) * NTOK + tok0_ + sc8); rt = *(const u32x4*)(TU + (((size_t)dir * NBH + bh) * NCH + tc_) * 4096 + sr * 64 + sc8); \
        if (tid < 64) { const float* gp_ = GC + ((size_t)dir * NBH + bh) * NTOK + tok0_; rg = gp_[tid]; rgl = gp_[dir ? 0 : 63]; rrk = RK[(size_t)bh * NTOK + tok0_ + tid]; rrq = RQ[(size_t)bh * NTOK + tok0_ + tid]; } } while (0)
#define SC_LSTORE(p) do { LAS bf16_t* kt_ = (LAS bf16_t*)(lds + G_KT + (p) * 18432); \
        *(LAS u32x4*)(kt_ + sr * 72 + sc8) = rk0; *(LAS u32x4*)(kt_ + (64 + sr) * 72 + sc8) = rk1; \
        *(LAS u32x4*)((LAS bf16_t*)(lds + G_VT + (p) * 9216) + sr * 72 + sc8) = rv; *(LAS u32x4*)((LAS bf16_t*)(lds + G_TU + (p) * 9216) + sr * 72 + sc8) = rt; \
        if (tid < 64) { LAS float* tb_ = (LAS float*)(lds + G_TAB + (p) * TABB); const float eg_ = __expf(rg); tb_[tid] = eg_ * rrk; tb_[64 + tid] = __expf(rgl - rg) * rrk; tb_[136 + tid] = 0.08838834764831845f * eg_ * rrq; if (tid == 0) tb_[128] = __expf(rgl); } } while (0)
#define SC_W(p) do { const LAS bf16_t* ap_ = (const LAS bf16_t*)(lds + G_KT + (p) * 18432) + (32 * kbw + c) * 72 + 8 * hh; const LAS bf16_t* bp_ = (const LAS bf16_t*)(lds + G_TU + (p) * 9216) + (32 * tbw + c) * 72 + 8 * hh; \
        const LAS float* tb_ = (const LAS float*)(lds + G_TAB + (p) * TABB); f32x16 a_ = {}; \
        _Pragma("unroll") for (int s_ = 0; s_ < 4; ++s_) { const bf16x8 av_ = *(const LAS bf16x8*)(ap_ + 16 * s_); const u32x4 bu_ = *(const LAS u32x4*)(bp_ + 16 * s_); \
            const f32x4 e0_ = *(const LAS f32x4*)(tb_ + 16 * s_ + 8 * hh), e1_ = *(const LAS f32x4*)(tb_ + 16 * s_ + 8 * hh + 4); u32x4 bs_; \
            bs_.x = cvt_pk_bf16(bf_lo(bu_.x) * e0_[0], bf_hi(bu_.x) * e0_[1]); bs_.y = cvt_pk_bf16(bf_lo(bu_.y) * e0_[2], bf_hi(bu_.y) * e0_[3]); \
            bs_.z = cvt_pk_bf16(bf_lo(bu_.z) * e1_[0], bf_hi(bu_.z) * e1_[1]); bs_.w = cvt_pk_bf16(bf_lo(bu_.w) * e1_[2], bf_hi(bu_.w) * e1_[3]); \
            a_ = __builtin_amdgcn_mfma_f32_32x32x16_bf16(av_, __builtin_bit_cast(bf16x8, bs_), a_, 0, 0, 0); } \
        _Pragma("unroll") for (int g_ = 0; g_ < 4; ++g_) { u32x2 w_; w_.x = cvt_pk_bf16(-a_[4 * g_], -a_[4 * g_ + 1]); w_.y = cvt_pk_bf16(-a_[4 * g_ + 2], -a_[4 * g_ + 3]); \
            *(LAS u32x2*)(Ws + (32 * tbw + c) * 136 + 32 * kbw + 8 * g_ + 4 * hh) = w_; } } while (0)
    SC_GLOAD(0);
    SC_BAR();
    SC_LSTORE(0);
    SC_GLOAD(1);
    SC_BAR();
    SC_W(0);
    bf16x8 qf[8], af[4];
#pragma unroll
    for (int s = 0; s < 8; ++s) qf[s] = (bf16x8){0, 0, 0, 0, 0, 0, 0, 0};
#pragma unroll
    for (int s = 0; s < 4; ++s) af[s] = (bf16x8){0, 0, 0, 0, 0, 0, 0, 0};
    if (wave >= 4 && SC_TC(0) >= 4) { const bf16x8* qp = (const bf16x8*)(QN + ((size_t)bh * NTOK + 64 * SC_TC(0) + 32 * tb2 + c) * HD + 8 * hh);
#pragma unroll
        for (int s = 0; s < 8; ++s) qf[s] = qp[2 * s];
        const bf16x8* ap = (const bf16x8*)(AI + (((size_t)dir * NBH + bh) * NCH + SC_TC(0)) * 4096 + (32 * tb2 + c) * 64 + 8 * hh);
#pragma unroll
        for (int s = 0; s < 4; ++s) af[s] = ap[2 * s]; }
    SC_BAR();
    for (int step = 0; step < NCH; ++step) {
        const int p = step & 1, tc = SC_TC(step), tok0 = 64 * tc; const bool isx = tc >= 4;
        const LAS float* tab = (const LAS float*)(lds + G_TAB + p * TABB);
        if (step + 1 < NCH) SC_LSTORE(p ^ 1);
        if (step + 2 < NCH) SC_GLOAD(step + 2);
        f32x16 oacc = {};
        if (wave < 4) {
            f32x16 a = {};
            a = mma_tile(a, (const LAS bf16_t*)(lds + G_TU + p * 9216) + 32 * tb2 * 72, 72, (const LAS bf16_t*)(lds + G_VT + p * 9216) + 32 * db2 * 72, 72, 4, lane);
            a = mma_tile(a, Ws + 32 * tb2 * 136, 136, STs + 32 * db2 * 136, 136, 8, lane);
#pragma unroll
            for (int g = 0; g < 4; ++g) { const f32x4 sc = *(const LAS f32x4*)(tab + 64 + 32 * tb2 + 8 * g + 4 * hh);
                u32x2 w, wg; w.x = cvt_pk_bf16(a[4 * g], a[4 * g + 1]); w.y = cvt_pk_bf16(a[4 * g + 2], a[4 * g + 3]);
                wg.x = cvt_pk_bf16(a[4 * g] * sc[0], a[4 * g + 1] * sc[1]); wg.y = cvt_pk_bf16(a[4 * g + 2] * sc[2], a[4 * g + 3] * sc[3]);
                *(LAS u32x2*)(VNs + (32 * db2 + c) * 72 + 32 * tb2 + 8 * g + 4 * hh) = w; *(LAS u32x2*)(VNGs + (32 * db2 + c) * 72 + 32 * tb2 + 8 * g + 4 * hh) = wg; }
        } else if (isx) {
            const LAS bf16_t* bp = STs + (32 * db2 + c) * 136 + 8 * hh;
#pragma unroll
            for (int s = 0; s < 8; ++s) oacc = __builtin_amdgcn_mfma_f32_32x32x16_bf16(qf[s], *(const LAS bf16x8*)(bp + 16 * s), oacc, 0, 0, 0);
#pragma unroll
            for (int g = 0; g < 4; ++g) { const f32x4 sc = *(const LAS f32x4*)(tab + 136 + 32 * tb2 + 8 * g + 4 * hh);
#pragma unroll
                for (int e = 0; e < 4; ++e) oacc[4 * g + e] *= sc[e]; }
        }
        if (wave >= 4 && step + 1 < NCH && SC_TC(step + 1) >= 4) { const bf16x8* qp = (const bf16x8*)(QN + ((size_t)bh * NTOK + 64 * SC_TC(step + 1) + 32 * tb2 + c) * HD + 8 * hh);
#pragma unroll
            for (int s = 0; s < 8; ++s) qf[s] = qp[2 * s]; }
        SC_BAR();
        {
            const int kb = wave & 3, db = wave >> 2; const float egl = tab[128];
#pragma unroll
            for (int e = 0; e < 16; ++e) Sacc[e] *= egl;
            Sacc = mma_tile(Sacc, (const LAS bf16_t*)(lds + G_KT + p * 18432) + 32 * kb * 72, 72, VNGs + 32 * db * 72, 72, 4, lane);
#pragma unroll
            for (int g = 0; g < 4; ++g) { u32x2 w; w.x = cvt_pk_bf16(Sacc[4 * g], Sacc[4 * g + 1]); w.y = cvt_pk_bf16(Sacc[4 * g + 2], Sacc[4 * g + 3]);
                *(LAS u32x2*)(STs + (32 * db + c) * 136 + 32 * kb + 8 * g + 4 * hh) = w; }
        }
        if (step + 1 < NCH) SC_W(p ^ 1);
        if (wave >= 4 && isx) {
            const LAS bf16_t* bp = VNs + (32 * db2 + c) * 72 + 8 * hh;
#pragma unroll
            for (int s = 0; s < 4; ++s) oacc = __builtin_amdgcn_mfma_f32_32x32x16_bf16(af[s], *(const LAS bf16x8*)(bp + 16 * s), oacc, 0, 0, 0);
            bf16_t* op = Od + ((size_t)b * SEQ + (tok0 - CTXL) + 32 * tb2) * DM + h * HD + 64 * half + 32 * db2 + c;
#pragma unroll
            for (int e = 0; e < 16; ++e) { const int t = (e & 3) + 8 * (e >> 2) + 4 * hh; op[(size_t)t * DM] = f2bf(oacc[e]); }
        }
        if (wave >= 4 && step + 1 < NCH && SC_TC(step + 1) >= 4) { const bf16x8* ap = (const bf16x8*)(AI + (((size_t)dir * NBH + bh) * NCH + SC_TC(step + 1)) * 4096 + (32 * tb2 + c) * 64 + 8 * hh);
#pragma unroll
            for (int s = 0; s < 4; ++s) af[s] = ap[2 * s]; }
        SC_BAR();
    }
#undef SC_TC
#undef SC_BAR
#undef SC_GLOAD
#undef SC_LSTORE
#undef SC_W
}

#ifndef DBG_THR
#define DBG_THR 1000.f
#endif
__device__ __forceinline__ void finish_row(int row, const bf16_t* OF, const bf16_t* OB, const bf16_t* ZA, const float* hn, bf16_t* Y, int lane, unsigned* dbgh) {
    const f32x4 h0 = *(const f32x4*)(hn + 8 * (lane & 15)), h1 = *(const f32x4*)(hn + 8 * (lane & 15) + 4);
#pragma unroll
    for (int it = 0; it < 4; ++it) {
        const size_t off = (size_t)row * DM + it * 512 + lane * 8;
        const u32x4 a_ = *(const u32x4*)(OF + off), bq_ = *(const u32x4*)(OB + off), z = *(const u32x4*)(ZA + off);
        u32x4 a = a_, bq = bq_; if (ABLATE & 16) bq = (u32x4){0u, 0u, 0u, 0u}; if (ABLATE & 32) a = (u32x4){0u, 0u, 0u, 0u};
        float o[8] = {bf_lo(a.x) + bf_lo(bq.x), bf_hi(a.x) + bf_hi(bq.x), bf_lo(a.y) + bf_lo(bq.y), bf_hi(a.y) + bf_hi(bq.y), bf_lo(a.z) + bf_lo(bq.z), bf_hi(a.z) + bf_hi(bq.z), bf_lo(a.w) + bf_lo(bq.w), bf_hi(a.w) + bf_hi(bq.w)};
#if MK_DEBUG
        { float mb = 0.f, mf = 0.f; const float ofx[8] = {bf_lo(a.x), bf_hi(a.x), bf_lo(a.y), bf_hi(a.y), bf_lo(a.z), bf_hi(a.z), bf_lo(a.w), bf_hi(a.w)};
          const float obx[8] = {bf_lo(bq.x), bf_hi(bq.x), bf_lo(bq.y), bf_hi(bq.y), bf_lo(bq.z), bf_hi(bq.z), bf_lo(bq.w), bf_hi(bq.w)};
#pragma unroll
          for (int e = 0; e < 8; ++e) { mb = fmaxf(mb, fabsf(obx[e])); mf = fmaxf(mf, fabsf(ofx[e])); }
          const int bhq = (row / SEQ) * 16 + it * 4 + (lane >> 4);
          if (mb > DBG_THR) dbgh[bhq] = 1u; if (mf > DBG_THR) dbgh[64 + bhq] = 1u; }
#endif
        if (ABLATE & 128) { const float of_[8] = {bf_lo(a.x), bf_hi(a.x), bf_lo(a.y), bf_hi(a.y), bf_lo(a.z), bf_hi(a.z), bf_lo(a.w), bf_hi(a.w)};
            const float ob_[8] = {bf_lo(bq.x), bf_hi(bq.x), bf_lo(bq.y), bf_hi(bq.y), bf_lo(bq.z), bf_hi(bq.z), bf_lo(bq.w), bf_hi(bq.w)};
#pragma unroll
            for (int e = 0; e < 8; ++e) o[e] = of_[e] + ob_[e] * (1.f / 4096.f); }
        float ss = 0.f;
#pragma unroll
        for (int e = 0; e < 8; ++e) ss += o[e] * o[e];
        ss += __shfl_xor(ss, 1); ss += __shfl_xor(ss, 2); ss += __shfl_xor(ss, 4); ss += __shfl_xor(ss, 8);
        const float rs = rsqrtf(ss * (1.f / HD) + EPS);
        const float zf[8] = {bf_lo(z.x), bf_hi(z.x), bf_lo(z.y), bf_hi(z.y), bf_lo(z.z), bf_hi(z.z), bf_lo(z.w), bf_hi(z.w)};
        const float hv[8] = {h0[0], h0[1], h0[2], h0[3], h1[0], h1[1], h1[2], h1[3]};
        float y[8];
#pragma unroll
        for (int e = 0; e < 8; ++e) { y[e] = o[e] * rs * hv[e] * zf[e]; if (ABLATE & 1) y[e] = 0.f; }
        u32x4 w; w.x = cvt_pk_bf16(y[0], y[1]); w.y = cvt_pk_bf16(y[2], y[3]); w.z = cvt_pk_bf16(y[4], y[5]); w.w = cvt_pk_bf16(y[6], y[7]);
        *(u32x4*)(Y + (size_t)row * 4096 + it * 512 + lane * 8) = w;
    }
}

__device__ __forceinline__ void stats_row(int row, const bf16_t* P1, float* STATS, int lane) {
    const bf16_t* p = P1 + (size_t)row * N3 + 2048;
    float v[32]; float s = 0.f;
#pragma unroll
    for (int j = 0; j < 4; ++j) { const u32x4 a = *(const u32x4*)(p + j * 512 + lane * 8);
        v[8 * j] = bf_lo(a.x); v[8 * j + 1] = bf_hi(a.x); v[8 * j + 2] = bf_lo(a.y); v[8 * j + 3] = bf_hi(a.y); v[8 * j + 4] = bf_lo(a.z); v[8 * j + 5] = bf_hi(a.z); v[8 * j + 6] = bf_lo(a.w); v[8 * j + 7] = bf_hi(a.w); }
#pragma unroll
    for (int e = 0; e < 32; ++e) s += v[e];
    const float mu = wave_sum(s) * (1.f / DM); float q = 0.f;
#pragma unroll
    for (int e = 0; e < 32; ++e) { const float d = v[e] - mu; q += d * d; }
    const float rstd = rsqrtf(wave_sum(q) * (1.f / DM) + EPS);
    if (lane == 0) { STATS[2 * row] = mu; STATS[2 * row + 1] = rstd; }
}
template <int R> __device__ __forceinline__ void diff_task(const bf16_t* p, bf16_t* o) {
    unsigned v[64];
#pragma unroll
    for (int i = 0; i < 64; ++i) v[i] = *(const unsigned*)(p + (size_t)i * N3);
    float s0 = 0.f, s1 = 0.f;
#pragma unroll
    for (int i = 0; i < R; ++i) { s0 += bf_lo(v[i]); s1 += bf_hi(v[i]); }
#pragma unroll
    for (int i = 0; i < 64; ++i) {
        if (i + R < 64) { s0 += bf_lo(v[i + R]); s1 += bf_hi(v[i + R]); }
        if (i - R - 1 >= 0) { s0 -= bf_lo(v[i - R - 1 >= 0 ? i - R - 1 : 0]); s1 -= bf_hi(v[i - R - 1 >= 0 ? i - R - 1 : 0]); }
        const int hi = (i + R + 1 < 64) ? i + R + 1 : 64, lo = (i - R > 0) ? i - R : 0; const float inv = 1.0f / (float)(hi - lo);
        *(unsigned*)(o + (size_t)i * DM) = cvt_pk_bf16(s0 * inv - bf_lo(v[i]), s1 * inv - bf_hi(v[i]));
    }
}

constexpr int K_W = 0, K_V = 34816;
__device__ __forceinline__ void tmix_block(int blk, LAS unsigned char* lds, const float* ws, const float* bs, const float* lnw, const float* lnb, const float* STATS, const bf16_t* P1, bf16_t* Y2) {
    const int tid = threadIdx.x, wave = __builtin_amdgcn_readfirstlane(tid >> 6), lane = tid & 63;
    const int g = blk & 15, n = (blk >> 4) & 15;
    LAS bf16_t* Wsb = (LAS bf16_t*)(lds + K_W); LAS bf16_t* VnT = (LAS bf16_t*)(lds + K_V);
    for (int i = tid; i < 4096; i += 512) { const int p = i >> 5, q4 = (i & 31) * 4; const f32x4 w = *(const f32x4*)(ws + ((size_t)g * 128 + p) * 128 + q4);
        u32x2 o; o.x = cvt_pk_bf16(w.x, w.y); o.y = cvt_pk_bf16(w.z, w.w); *(LAS u32x2*)(Wsb + p * 136 + q4) = o; }
    const int pb = wave >> 1, c = lane & 31, hh = lane >> 5;
    const float bias = bs[g * 128 + 32 * pb + c];
    for (int b = 0; b < NB; ++b) {
        const int row0 = b * SEQ + 128 * n;
        for (int i = tid; i < 2048; i += 512) { const int q = i >> 4, c8 = (i & 15) * 8;
            const u32x4 a = *(const u32x4*)(P1 + (size_t)(row0 + q) * N3 + 2048 + 128 * g + c8);
            const float mu = STATS[2 * (row0 + q)], rstd = STATS[2 * (row0 + q) + 1];
            const f32x4 w0 = *(const f32x4*)(lnw + 128 * g + c8), w1 = *(const f32x4*)(lnw + 128 * g + c8 + 4), b0 = *(const f32x4*)(lnb + 128 * g + c8), b1 = *(const f32x4*)(lnb + 128 * g + c8 + 4);
            const float x[8] = {bf_lo(a.x), bf_hi(a.x), bf_lo(a.y), bf_hi(a.y), bf_lo(a.z), bf_hi(a.z), bf_lo(a.w), bf_hi(a.w)};
            const float wv[8] = {w0[0], w0[1], w0[2], w0[3], w1[0], w1[1], w1[2], w1[3]}, bv[8] = {b0[0], b0[1], b0[2], b0[3], b1[0], b1[1], b1[2], b1[3]};
#pragma unroll
            for (int e = 0; e < 8; ++e) VnT[(c8 + e) * 136 + q] = f2bf((x[e] - mu) * rstd * wv[e] + bv[e]); }
        __syncthreads();
        const size_t row = (size_t)(row0 + 32 * pb + c);
#pragma unroll
        for (int t = 0; t < 2; ++t) { const int cb = 2 * (wave & 1) + t;
            u32x2 gu[4], sz[4];
#pragma unroll
            for (int gq = 0; gq < 4; ++gq) { const int ch = 128 * g + 32 * cb + 8 * gq + 4 * hh; gu[gq] = *(const u32x2*)(P1 + row * N3 + ch); sz[gq] = *(const u32x2*)(P1 + row * N3 + 4096 + ch); }
            f32x16 a = {};
            a = mma_tile(a, VnT + 32 * cb * 136, 136, Wsb + 32 * pb * 136, 136, 8, lane);
#pragma unroll
            for (int gq = 0; gq < 4; ++gq) { const int ch = 128 * g + 32 * cb + 8 * gq + 4 * hh;
                const float y0 = bf_lo(gu[gq].x) * (a[4 * gq] + bias) * bf_lo(sz[gq].x), y1 = bf_hi(gu[gq].x) * (a[4 * gq + 1] + bias) * bf_hi(sz[gq].x);
                const float y2 = bf_lo(gu[gq].y) * (a[4 * gq + 2] + bias) * bf_lo(sz[gq].y), y3 = bf_hi(gu[gq].y) * (a[4 * gq + 3] + bias) * bf_hi(sz[gq].y);
                u32x2 w; w.x = cvt_pk_bf16(y0, y1); w.y = cvt_pk_bf16(y2, y3);
                *(u32x2*)(Y2 + row * 4096 + ch) = w; } }
        __syncthreads();
    }
}

__device__ __forceinline__ void final_row(float* xrow, const float* fw, int lane) {
    f32x4* xr = (f32x4*)xrow + lane;
    f32x4 v[8]; float s = 0.f;
#pragma unroll
    for (int j = 0; j < 8; ++j) { v[j] = xr[64 * j]; s += (v[j].x * v[j].x + v[j].y * v[j].y) + (v[j].z * v[j].z + v[j].w * v[j].w); }
    const float rstd = rsqrtf(wave_sum(s) * (1.f / DM) + EPS);
#pragma unroll
    for (int j = 0; j < 8; ++j) xr[64 * j] = v[j] * rstd * ((const f32x4*)fw)[lane + 64 * j];
}

__global__ void __launch_bounds__(512, 2) fwd_kernel(Args args) {
    extern __shared__ __attribute__((aligned(16))) unsigned char lds_raw[];
    LAS unsigned char* lds = (LAS unsigned char*)lds_raw;
    const int tid = threadIdx.x, lane = tid & 63, wave = __builtin_amdgcn_readfirstlane(tid >> 6);
    const int G = gridDim.x, bid = blockIdx.x;
    const int gw = bid * 8 + wave, NGW = G * 8;
    unsigned char* ws = args.ws;
    volatile LAS unsigned* MISC = (volatile LAS unsigned*)(lds + MISC_OFF);
    if (tid < 16) MISC[tid] = 0u;
    __syncthreads();
    if (args.never) cg::this_grid().sync();
    XcdBarrier bar; bar.bar = (unsigned*)(ws + WS_CTL) + CW_BAR; bar.x = 0; bar.st = MISC;
    const int lo = args.ph_lo, hi = args.ph_hi;
    if (hi - lo > 1) bar = xcd_barrier_post((unsigned*)(ws + WS_CTL) + CW_BAR, MISC);
#ifndef PH_MASK
#define PH_MASK 0x3fff
#endif
#define IN(k) ((((PH_MASK) >> (k)) & 1) && lo <= (k) && (k) < hi)
#if MK_STAMP
    unsigned long long* STAMPS = (unsigned long long*)((unsigned*)(ws + WS_CTL) + 3000);
#define STAMP(k) do { if (bid == 0 && tid == 0) STAMPS[k] = __builtin_amdgcn_s_memrealtime(); } while (0)
#else
#define STAMP(k) do { } while (0)
#endif
#define SEAM(k) do { if (IN(k) && IN((k) + 1)) xcd_barrier(bar); STAMP((k) + 1); } while (0)
    STAMP(0);
#define MOD ((float*)(ws + WS_MOD))
#if MK_DEBUG
    unsigned* DBG = (unsigned*)(ws + WS_CTL) + 2048; const int gt = bid * 512 + tid, ngt = G * 512;
#endif
#define WT1 ((bf16_t*)(ws + WS_WT1))
#define WT2 ((bf16_t*)(ws + WS_WT2))
#define WT3 ((bf16_t*)(ws + WS_WT3))
#define WT4 ((bf16_t*)(ws + WS_WT4))
#define WTP ((bf16_t*)(ws + WS_WTP))
#define H ((bf16_t*)(ws + WS_H))

    if (IN(0)) for (int rep_ = 0; rep_ < ((REPEAT_PH) == 0 ? (REPEAT_N) : 1); (++rep_, __syncthreads())) {
        if (bid < 192) { LAS float* tab = (LAS float*)lds; silu_table(args.in[I_C], args.in[I_CCTX], tab);
            for (int t = bid; t < 192; t += G) mod_task(args.in[I_ADAW], args.in[I_ADAB], MOD, 32 * t, tab, (LAS float*)(lds + 40960), wave, lane);
            __syncthreads(); }
        LAS float* scr = (LAS float*)(lds + wave * 16640);
        const SrcW1 s1; const SrcId sid;
        for (int it = gw; it < 8320 + (G == 256 ? 0 : 2048); it += NGW) {
            if (it < 8320) { const int cb = it >> 5, kb = it & 31; conv_item(args.in[I_EWIN], N1SRC, 2048, WT1, 64 * cb, 64 * kb, scr, lane, s1); }
            else { const int r = it - 8320, cb = r >> 6, kb = r & 63; conv_item(args.in[I_EWOUT], 2048, 4096, WT2, 64 * cb, 64 * kb, scr, lane, sid); }
        }
    }
    SEAM(0);
    if (IN(1)) for (int rep_ = 0; rep_ < ((REPEAT_PH) == 1 ? (REPEAT_N) : 1); (++rep_, __syncthreads())) {
#if MK_DEBUG
        dbg_f32(MOD, 5, 6144, 6144, DBG + 0, gt, ngt); dbg_bf16(WT1, 16640, 2048, 2048, DBG + 0, gt, ngt); dbg_bf16(WT2, 2048, 4096, 4096, DBG + 0, gt, ngt);
#endif
        for (int q = gw; q < MX / 4; q += NGW) hrows4(args.in[I_X] + (size_t)q * 4 * DM, args.in[I_NORMW], MOD + ((q * 4) / SEQ) * 6144, H + (size_t)q * 4 * DM, lane);
        for (int m = gw; m < MC; m += NGW) hrow(args.in[I_CTX] + (size_t)m * DM, args.in[I_NORMW], MOD + 4 * 6144, H + (size_t)(MX + m) * DM, lane);
    }
    SEAM(1);
    if (IN(2)) for (int rep_ = 0; rep_ < ((REPEAT_PH) == 2 ? (REPEAT_N) : 1); (++rep_, __syncthreads())) {
#if MK_DEBUG
        dbg_bf16(H, MT, 2048, 2048, DBG + 1, gt, ngt);
#endif
        Sched1 S{G, bid, (const char*)H, (const char*)WT1};
        Epi1 E{ws, args.in[I_ECONVB], args.in[I_ECONVQKV], lds};
        pg8::gemm_phase<Epi1, Sched1>(lds, 2048, 2048, 2048, S, E);
        if (G == 256 && bid >= 100) {
            __syncthreads();
            LAS float* stab = (LAS float*)lds; silu_table(args.in[I_C], args.in[I_CCTX], stab);
            for (int t = bid - 100; t < 192; t += 156) mod_task(args.in[I_ADAW] + (size_t)2048 * 6144, args.in[I_ADAB] + 6144, MOD + 5 * 6144, 32 * t, stab, (LAS float*)(lds + 40960), wave, lane);
            __syncthreads();
            LAS float* scr = (LAS float*)(lds + wave * 16640); const SrcId sid;
            for (int r = (bid - 100) * 8 + wave; r < 2048; r += 156 * 8) { const int cb = r >> 6, kb = r & 63; conv_item(args.in[I_EWOUT], 2048, 4096, WT2, 64 * cb, 64 * kb, scr, lane, sid); }
        }
    }
    SEAM(2);
    if (IN(3)) for (int rep_ = 0; rep_ < ((REPEAT_PH) == 3 ? (REPEAT_N) : 1); (++rep_, __syncthreads())) {
#if MK_DEBUG
        dbg_bf16((const bf16_t*)(ws + WS_PQKV), MT, 6144, 6144, DBG + 2, gt, ngt); dbg_bf16((const bf16_t*)(ws + WS_ZA), MX, 2048, 2048, DBG + 2, gt, ngt);
        dbg_f32((const float*)(ws + WS_AB), MT, 64, 64, DBG + 2, gt, ngt); dbg_bf16((const bf16_t*)(ws + WS_Y) + 2048, MX, 2048, 4096, DBG + 2, gt, ngt);
#endif
    }
    STAMP(4);
    if (IN(4)) for (int rep_ = 0; rep_ < ((REPEAT_PH) == 4 ? (REPEAT_N) : 1); (++rep_, __syncthreads())) {
#if MK_DEBUG
        dbg_bf16((const bf16_t*)(ws + WS_QN), 64 * NTOK, 128, 128, DBG + 3, gt, ngt); dbg_bf16((const bf16_t*)(ws + WS_KN), 64 * NTOK, 128, 128, DBG + 3, gt, ngt);
        dbg_bf16((const bf16_t*)(ws + WS_KT), 64 * 128, NTOK, NTOK, DBG + 3, gt, ngt); dbg_bf16((const bf16_t*)(ws + WS_VT), 64 * 128, NTOK, NTOK, DBG + 3, gt, ngt);
        dbg_f32((const float*)(ws + WS_GG), 128, NTOK, NTOK, DBG + 3, gt, ngt); dbg_f32((const float*)(ws + WS_BETA), 128, NTOK, NTOK, DBG + 3, gt, ngt);
#endif
        if (G != 256 && bid < 192) { LAS float* stab = (LAS float*)lds; silu_table(args.in[I_C], args.in[I_CCTX], stab);
            for (int t = bid; t < 192; t += G) mod_task(args.in[I_ADAW] + (size_t)2048 * 6144, args.in[I_ADAB] + 6144, MOD + 5 * 6144, 32 * t, stab, (LAS float*)(lds + 40960), wave, lane);
            __syncthreads(); }
        LAS float* tab = (LAS float*)(lds + wave * 18432);
        const SrcId sid;
        auto copy_item = [&](int it) {
            if (it < 5120) { const int cb = it >> 5, kb = it & 31; conv_item(args.in[I_OWIN], N3, 2048, WT3, 64 * cb, 64 * kb, tab, lane, sid); }
            else if (it < 7168) { const int r = it - 5120, cb = r >> 6, kb = r & 63; conv_item(args.in[I_OWOUT], 2048, 4096, WT4, 64 * cb, 64 * kb, tab, lane, sid); }
            else { const int r = it - 7168, gq = r >> 6, cb = (r >> 3) & 7, kb = r & 7; conv_item(args.in[I_OPW] + (size_t)gq * 512 * 512, 512, 512, WTP + (size_t)gq * 512 * 512, 64 * cb, 64 * kb, tab, lane, sid); } };
        auto chunk = [&](int t) { chunk_task(t, (const bf16_t*)(ws + WS_QN), (const bf16_t*)(ws + WS_KN), (const float*)(ws + WS_AB), args.in[I_EALOG], args.in[I_EDTB], (float*)(ws + WS_GC), (bf16_t*)(ws + WS_TU), (bf16_t*)(ws + WS_AI), tab, lane, (const float*)(ws + WS_GG), (const float*)(ws + WS_BETA)); };
        constexpr int NCT = 2 * 64 * NCH, NCI = 5120 + 2048 + 256;
        const bool bal = (NGW == 2048);
        const int nslots = bal ? 8 : (NCT + NCI + NGW - 1) / NGW + 1;
        for (int i = 0; i < nslots; ++i) {
            int ct = -1, ci = -1;
            if (bal) {
                if (i == 0) ct = gw; else if (i == 6) ct = gw + 2048; else if (i == 7) { if (gw < 512) ct = gw + 4096; }
                else if (i <= 4) { if (gw >= 512) ci = (gw - 512) + 1536 * (i - 1); } else { if (gw < 1280) ci = 6144 + gw; }
            } else { const int L = gw + i * NGW; if (L < NCT) ct = L; else if (L < NCT + NCI) ci = L - NCT; }
            if (ct >= 0) chunk(ct);
            if (ci >= 0) copy_item(ci);
        }
    }
    SEAM(4);
    if (IN(5)) for (int rep_ = 0; rep_ < ((REPEAT_PH) == 5 ? (REPEAT_N) : 1); (++rep_, __syncthreads())) {
#if MK_DEBUG
        dbg_bf16((const bf16_t*)(ws + WS_TU), 2 * 64 * NCH, 4096, 4096, DBG + 4, gt, ngt);
        if (gt == 100) {
            const int dirq = 1, bhq = 0, tcq = 20, tok0q = 64 * tcq; const bf16_t* KNq = (const bf16_t*)(ws + WS_KN) + ((size_t)bhq * NTOK + tok0q) * HD;
            const float* gq = (const float*)(ws + WS_GG) + ((size_t)dirq * NBH + bhq) * NTOK + tok0q; const float* bq = (const float*)(ws + WS_BETA) + ((size_t)dirq * NBH + bhq) * NTOK + tok0q;
            const bf16_t* tq = (const bf16_t*)(ws + WS_TU) + (((size_t)dirq * NBH + bhq) * NCH + tcq) * 4096;
            float worst = 0.f;
            for (int a = 0; a < 64; a += 7) for (int b2 = 0; b2 < 64; b2 += 5) {
                float r = 0.f;
                for (int m = 0; m < 64; ++m) {
                    float im = (a == m) ? 1.f : 0.f;
                    if (m > a) { float kk = 0.f; for (int e = 0; e < HD; ++e) kk += bf2f(KNq[a * HD + e]) * bf2f(KNq[m * HD + e]); float gd = 0.f; for (int t = a; t < m; ++t) gd += gq[t]; im = bq[a] * kk * __expf(gd); }
                    const float T = bf2f(tq[m * 64 + b2]) / bq[b2];
                    r += im * T; }
                worst = fmaxf(worst, fabsf(r - ((a == b2) ? 1.f : 0.f))); }
            DBG[980] = __float_as_uint(worst); }
        if (gt < 64) { const int bhq = gt & 63; const bf16_t* tq = (const bf16_t*)(ws + WS_TU) + (((size_t)1 * NBH + bhq) * NCH + 20) * 4096; float so = 0.f;
            for (int i = 0; i < 64; ++i) for (int j = 0; j < 64; ++j) { const float v = fabsf(bf2f(tq[i * 64 + j])); if (i != j) so += v; }
            DBG[910 + bhq] = __float_as_uint(so); }
        dbg_max_bf16((const bf16_t*)(ws + WS_TU), (size_t)128 * NCH * 4096, DBG + 900, gt, ngt);
        dbg_max_bf16((const bf16_t*)(ws + WS_KN), (size_t)64 * NTOK * 128, DBG + 901, gt, ngt);
        dbg_max_bf16((const bf16_t*)(ws + WS_KT), (size_t)64 * NTOK * 128, DBG + 902, gt, ngt);
        dbg_max_bf16((const bf16_t*)(ws + WS_VT), (size_t)64 * NTOK * 128, DBG + 903, gt, ngt);
        dbg_max_bf16((const bf16_t*)(ws + WS_QN), (size_t)64 * NTOK * 128, DBG + 904, gt, ngt);
        for (int q = 0; q < 128; ++q) dbg_bf16((const bf16_t*)(ws + WS_AI) + ((size_t)q * NCH + 4) * 4096, 32, 4096, 4096, DBG + 4, gt, ngt);
        dbg_f32((const float*)(ws + WS_GC), 128, NTOK, NTOK, DBG + 4, gt, ngt); dbg_f32(MOD + 5 * 6144, 4, 6144, 6144, DBG + 4, gt, ngt);
        dbg_bf16(WT3, 10240, 2048, 2048, DBG + 4, gt, ngt); dbg_bf16(WT4, 2048, 4096, 4096, DBG + 4, gt, ngt); dbg_bf16(WTP, 2048, 512, 512, DBG + 4, gt, ngt);
#endif
        for (int ch0 = bid; ch0 < 256; ch0 += G) { const int ch = (G == 256) ? (2 * ((ch0 & 7) + 8 * (ch0 >> 4)) + ((ch0 >> 3) & 1)) : ch0;
            scan_chain(ch, lds, (const bf16_t*)(ws + WS_QN), (const bf16_t*)(ws + WS_KT), (const bf16_t*)(ws + WS_VT), (const bf16_t*)(ws + WS_TU), (const bf16_t*)(ws + WS_AI), (const float*)(ws + WS_GC), (bf16_t*)(ws + WS_OF), (bf16_t*)(ws + WS_OB), (const float*)(ws + WS_GG), (const float*)(ws + WS_BETA)); __syncthreads(); }
    }
    SEAM(5);
    if (IN(6)) for (int rep_ = 0; rep_ < ((REPEAT_PH) == 6 ? (REPEAT_N) : 1); (++rep_, __syncthreads())) {
#if MK_DEBUG
        dbg_bf16((const bf16_t*)(ws + WS_OF), MX, 2048, 2048, DBG + 5, gt, ngt); dbg_bf16((const bf16_t*)(ws + WS_OB), MX, 2048, 2048, DBG + 5, gt, ngt);
        dbg_max_bf16((const bf16_t*)(ws + WS_OF), (size_t)MX * 2048, DBG + 905, gt, ngt); dbg_max_bf16((const bf16_t*)(ws + WS_OB), (size_t)MX * 2048, DBG + 906, gt, ngt);
#endif
        for (int m = gw; m < MX; m += NGW) finish_row(m, (const bf16_t*)(ws + WS_OF), (const bf16_t*)(ws + WS_OB), (const bf16_t*)(ws + WS_ZA), args.in[I_EHN], (bf16_t*)(ws + WS_Y), lane, (unsigned*)(ws + WS_CTL) + 3072);
    }
    SEAM(6);
    if (IN(7)) for (int rep_ = 0; rep_ < ((REPEAT_PH) == 7 ? (REPEAT_N) : 1); (++rep_, __syncthreads())) {
#if MK_DEBUG
        dbg_bf16((const bf16_t*)(ws + WS_Y), MX, 2048, 4096, DBG + 6, gt, ngt);
#endif
        pg8::StaticOrder S{32, 8, G, bid, (const char*)(ws + WS_Y), (const char*)WT2, (size_t)256 * 4096 * 2, (size_t)256 * 4096 * 2};
        EpiResid E{args.in[I_X], args.out, MOD + 4096};
        pg8::gemm_phase<EpiResid, pg8::StaticOrder>(lds, 4096, 4096, 4096, S, E);
    }
    SEAM(7);
    if (IN(8)) for (int rep_ = 0; rep_ < ((REPEAT_PH) == 8 ? (REPEAT_N) : 1); (++rep_, __syncthreads())) {
#if MK_DEBUG
        dbg_f32(args.out, MX, 2048, 2048, DBG + 7, gt, ngt);
#endif
        for (int q = gw; q < MX / 4; q += NGW) hrows4(args.out + (size_t)q * 4 * DM, args.in[I_NORMW] + DM, MOD + 5 * 6144 + ((q * 4) / SEQ) * 6144, H + (size_t)q * 4 * DM, lane);
    }
    SEAM(8);
    if (IN(9)) for (int rep_ = 0; rep_ < ((REPEAT_PH) == 9 ? (REPEAT_N) : 1); (++rep_, __syncthreads())) {
#if MK_DEBUG
        dbg_bf16(H, MX, 2048, 2048, DBG + 8, gt, ngt);
#endif
        pg8::StaticOrder S{32, 40, G, bid, (const char*)H, (const char*)WT3, (size_t)256 * 2048 * 2, (size_t)256 * 2048 * 2};
        Epi3 E{(bf16_t*)(ws + WS_P1)};
        pg8::gemm_phase<Epi3, pg8::StaticOrder>(lds, 2048, 2048, 2048, S, E);
    }
    SEAM(9);
    if (IN(10)) for (int rep_ = 0; rep_ < ((REPEAT_PH) == 10 ? (REPEAT_N) : 1); (++rep_, __syncthreads())) {
#if MK_DEBUG
        dbg_bf16((const bf16_t*)(ws + WS_P1), MX, N3, N3, DBG + 9, gt, ngt);
#endif
        for (int m = gw; m < MX; m += NGW) stats_row(m, (const bf16_t*)(ws + WS_P1), (float*)(ws + WS_STATS), lane);
        for (int t = gw; t < 128 * 16; t += NGW) { const int blk = t >> 4, cc = t & 15, grp = cc >> 2;
            const bf16_t* p = (const bf16_t*)(ws + WS_P1) + (size_t)(64 * blk) * N3 + 6144 + 128 * cc + 2 * lane; bf16_t* o = (bf16_t*)(ws + WS_DIFF) + (size_t)(64 * blk) * DM + 128 * cc + 2 * lane;
            if (grp == 0) diff_task<1>(p, o); else if (grp == 1) diff_task<2>(p, o); else if (grp == 2) diff_task<4>(p, o); else diff_task<8>(p, o); }
    }
    SEAM(10);
    if (IN(11)) for (int rep_ = 0; rep_ < ((REPEAT_PH) == 11 ? (REPEAT_N) : 1); (++rep_, __syncthreads())) {
#if MK_DEBUG
        dbg_f32((const float*)(ws + WS_STATS), 1, 2 * MX, 2 * MX, DBG + 10, gt, ngt); dbg_bf16((const bf16_t*)(ws + WS_DIFF), MX, 2048, 2048, DBG + 10, gt, ngt);
#endif
        SchedPool S{G, bid, (const char*)(ws + WS_DIFF), (const char*)WTP};
        EpiPool E{(const bf16_t*)(ws + WS_P1), (bf16_t*)(ws + WS_Y2), args.in[I_OPS]};
        pg8::gemm_phase<EpiPool, SchedPool>(lds, 512, 2048, 512, S, E);
        __syncthreads();
        for (int t = bid; t < 256; t += G) tmix_block(t, lds, args.in[I_OWS], args.in[I_OBS], args.in[I_OLNW], args.in[I_OLNB], (const float*)(ws + WS_STATS), (const bf16_t*)(ws + WS_P1), (bf16_t*)(ws + WS_Y2));
    }
    SEAM(11);
    if (IN(12)) {
#if MK_DEBUG
        dbg_bf16((const bf16_t*)(ws + WS_Y2), MX, 4096, 4096, DBG + 11, gt, ngt);
#endif
        pg8::StaticOrder S{32, 8, G, bid, (const char*)(ws + WS_Y2), (const char*)WT4, (size_t)256 * 4096 * 2, (size_t)256 * 4096 * 2};
        EpiResid E{args.out, args.out, MOD + 5 * 6144 + 4096};
        pg8::gemm_phase<EpiResid, pg8::StaticOrder>(lds, 4096, 4096, 4096, S, E);
    }
    SEAM(12);
    if (IN(13)) {
#if MK_DEBUG
        dbg_f32(args.out, MX, 2048, 2048, DBG + 12, gt, ngt);
        for (size_t i = gt; i < (size_t)MX * DM; i += ngt) { const float v = args.out[i]; if (badf(v)) args.out[i] = 0.f; }
        asm volatile("s_waitcnt vmcnt(0)" ::: "memory"); __syncthreads();
#endif
        for (int m = gw; m < MX; m += NGW) final_row(args.out + (size_t)m * DM, args.in[I_FNW], lane);
#if MK_DEBUG
        asm volatile("s_waitcnt vmcnt(0)" ::: "memory"); __syncthreads();
        if (bid == 0 && tid == 0) { int first = -1; unsigned mask = 0; for (int k = 12; k >= 0; --k) if (__hip_atomic_load(DBG + k, __ATOMIC_RELAXED, __HIP_MEMORY_SCOPE_AGENT)) { first = k; mask |= 1u << k; }
            if (first >= 0) args.out[0] = 1000.f * (float)(first + 1);
            { int cb = 0, cf = 0; for (int q = 0; q < 64; ++q) { cb += (int)__hip_atomic_load(DBG + 1024 + q, __ATOMIC_RELAXED, __HIP_MEMORY_SCOPE_AGENT); cf += (int)__hip_atomic_load(DBG + 1024 + 64 + q, __ATOMIC_RELAXED, __HIP_MEMORY_SCOPE_AGENT); }
              args.out[0] = 1000.f * (float)(DBG_SEL ? cf : cb) + 500.f;
              if (DBG_SEL == 30 || DBG_SEL == 31) { const int dsel = DBG_SEL - 30; int fb = -1; for (int q = 0; q < 64; ++q) if (__hip_atomic_load(DBG + 1024 + (dsel ? 0 : 64) + q, __ATOMIC_RELAXED, __HIP_MEMORY_SCOPE_AGENT)) { fb = q; break; }
                  float mg = 0.f; if (fb >= 0) { const float* gq = (const float*)(ws + WS_GG) + ((size_t)dsel * NBH + fb) * NTOK; for (int i = 256; i < NTOK; ++i) mg += gq[i]; mg = -mg / 2048.f; }
                  args.out[0] = 1.0e4f * mg + 1000.f * 1000.f * (float)(fb & 15); }
              else if (DBG_SEL == 200) { args.out[0] = 1.0e5f * __uint_as_float(__hip_atomic_load(DBG + 980, __ATOMIC_RELAXED, __HIP_MEMORY_SCOPE_AGENT)) + 1000.f; }
              else if (DBG_SEL >= 60 && DBG_SEL < 124) { args.out[0] = 1.0e3f * __uint_as_float(__hip_atomic_load(DBG + 910 + (DBG_SEL - 60), __ATOMIC_RELAXED, __HIP_MEMORY_SCOPE_AGENT)); }
              else if (DBG_SEL >= 40 && DBG_SEL < 60) { const int bhq = DBG_SEL - 40; const bf16_t* tq = (const bf16_t*)(ws + WS_TU) + (((size_t)1 * NBH + bhq) * NCH + 20) * 4096; float so = 0.f, sd = 0.f;
                  for (int i = 0; i < 64; ++i) for (int j = 0; j < 64; ++j) { const float v = fabsf(bf2f(tq[i * 64 + j])); if (i == j) sd += v; else so += v; }
                  args.out[0] = 1.0e4f * so + 1.0e8f; }
              else if (DBG_SEL >= 10) args.out[0] = 1.0e2f * __uint_as_float(__hip_atomic_load(DBG + 900 + (DBG_SEL - 10), __ATOMIC_RELAXED, __HIP_MEMORY_SCOPE_AGENT)); } }
#endif
    }
#if MK_STAMP
    if (IN(13)) {
        asm volatile("s_waitcnt vmcnt(0)" ::: "memory"); __syncthreads();
        if (bid == 0) {
            const unsigned long long t14 = __builtin_amdgcn_s_memrealtime();
            const float tA = (float)((SEL_A == 13 ? t14 : STAMPS[SEL_A + 1]) - STAMPS[SEL_A]) * 0.01f, tB = (float)((SEL_B == 13 ? t14 : STAMPS[SEL_B + 1]) - STAMPS[SEL_B]) * 0.01f;
            __syncthreads();
            for (int i = 1 + tid; i <= 1048576; i += 512) args.out[i] += tB * (1.f / 2000.f);
            if (tid == 0) args.out[0] += tA * (1.f / 100.f);
        }
    }
#endif
#if STOP_AFTER < 13
    if (lo == 14) {
        const size_t NO = (size_t)MX * DM; const size_t gtid = (size_t)bid * 512 + tid, ngtid = (size_t)G * 512;
        for (size_t i = gtid; i < NO; i += ngtid) {
            float acc = 0.f;
#define DG_BF(off, n) do { const bf16_t* q_ = (const bf16_t*)(ws + (off)); for (size_t j = i; j < (size_t)(n); j += NO) acc += bf2f(q_[j]); } while (0)
#define DG_F32(off, n) do { const float* q_ = (const float*)(ws + (off)); for (size_t j = i; j < (size_t)(n); j += NO) acc += q_[j]; } while (0)
#if STOP_AFTER == 0
            DG_BF(WS_WT1, (size_t)16640 * 2048); DG_BF(WS_WT2, (size_t)2048 * 4096); DG_F32(WS_MOD, 5 * 6144);
#elif STOP_AFTER == 1
            DG_BF(WS_H, (size_t)MT * 2048);
#elif STOP_AFTER == 2
            DG_BF(WS_PQKV, (size_t)MT * 6144); DG_BF(WS_ZA, (size_t)MX * 2048); DG_F32(WS_AB, (size_t)MT * 64);
            { const bf16_t* q_ = (const bf16_t*)(ws + WS_Y); const size_t r = i / 2048, c = i % 2048; acc += bf2f(q_[r * 4096 + 2048 + c]); }
#elif STOP_AFTER == 3
            DG_BF(WS_QN, (size_t)64 * NTOK * 128); DG_BF(WS_KN, (size_t)64 * NTOK * 128); DG_BF(WS_KT, (size_t)64 * NTOK * 128); DG_BF(WS_VT, (size_t)64 * NTOK * 128);
            DG_F32(WS_GG, (size_t)128 * NTOK); DG_F32(WS_BETA, (size_t)128 * NTOK);
#elif STOP_AFTER == 4
            DG_BF(WS_TU, (size_t)128 * NCH * 4096); DG_F32(WS_GC, (size_t)128 * NTOK); DG_F32(WS_MOD, 10 * 6144);
            DG_BF(WS_WT3, (size_t)10240 * 2048); DG_BF(WS_WT4, (size_t)2048 * 4096); DG_BF(WS_WTP, (size_t)2048 * 512);
            { const bf16_t* q_ = (const bf16_t*)(ws + WS_AI); for (size_t j = i; j < (size_t)128 * NCH * 4096; j += NO) { const size_t tcq = (j / 4096) % NCH; if (tcq >= 4) acc += bf2f(q_[j]); } }
#elif STOP_AFTER == 5
            DG_BF(WS_OF, (size_t)MX * 2048); DG_BF(WS_OB, (size_t)MX * 2048);
#elif STOP_AFTER == 6
            DG_BF(WS_Y, (size_t)MX * 4096);
#elif STOP_AFTER == 7
            acc = args.out[i];
#elif STOP_AFTER == 8
            DG_BF(WS_H, (size_t)MX * 2048);
#elif STOP_AFTER == 9
            DG_BF(WS_P1, (size_t)MX * N3);
#elif STOP_AFTER == 10
            DG_BF(WS_DIFF, (size_t)MX * 2048); DG_F32(WS_STATS, (size_t)MX * 2);
#elif STOP_AFTER == 11
            DG_BF(WS_Y2, (size_t)MX * 4096);
#else
            acc = args.out[i];
#endif
            if (badf(acc)) acc = 12345.f;
            args.out[i] = acc;
        }
    }
#endif
#undef IN
#undef SEAM
}

extern "C" void kernel_launch(void* const* d_in, const int* in_sizes, int n_in, void* d_out, int out_size, void* d_ws, size_t ws_size, hipStream_t stream) {
    static int grid = 0;
    if (grid == 0) {
        if (n_in != 23 || out_size != MX * DM || ws_size < WS_END) { fprintf(stderr, "kernel_launch: unexpected shapes (n_in %d, out %d, ws %zu < %zu)\n", n_in, out_size, ws_size, (size_t)WS_END); grid = -1; return; }
        int dev = 0, cus = 0, per_cu = 0;
        if (hipGetDevice(&dev) != hipSuccess || hipDeviceGetAttribute(&cus, hipDeviceAttributeMultiprocessorCount, dev) != hipSuccess) { grid = -1; return; }
        if (hipFuncSetAttribute((const void*)fwd_kernel, hipFuncAttributeMaxDynamicSharedMemorySize, LDS_BYTES) != hipSuccess) { fprintf(stderr, "kernel_launch: hipFuncSetAttribute failed\n"); grid = -1; return; }
        if (hipOccupancyMaxActiveBlocksPerMultiprocessor(&per_cu, (const void*)fwd_kernel, 512, LDS_BYTES) != hipSuccess || per_cu < 1) { fprintf(stderr, "kernel_launch: occupancy query says %d\n", per_cu); }
        (void)hipGetLastError();
        grid = cus;
    }
    if (grid < 0) return;
    if (hipMemsetAsync((char*)d_ws + WS_CTL, 0, CTL_BYTES, stream) != hipSuccess) { fprintf(stderr, "kernel_launch: memset failed\n"); return; }
    Args a{};
    for (int i = 0; i < 23; ++i) a.in[i] = (const float*)d_in[i];
    a.out = (float*)d_out; a.ws = (unsigned char*)d_ws; a.never = 0; a.pad = 0;
    const int nl = (STOP_AFTER < 13) ? STOP_AFTER + 2 : MK_N_LAUNCHES;
    for (int li = 0; li < nl; ++li) {
        a.ph_lo = (nl == 1) ? 0 : li; a.ph_hi = (nl == 1) ? NPHASE : li + 1;
        if (STOP_AFTER < 13 && li == nl - 1) { a.ph_lo = 14; a.ph_hi = 15; }
        void* kargs[] = {&a};
        hipError_t e = hipLaunchCooperativeKernel((const void*)fwd_kernel, dim3(grid), dim3(512), kargs, LDS_BYTES, stream);
        if (e != hipSuccess) { fprintf(stderr, "kernel_launch: launch %d failed: %s\n", li, hipGetErrorString(e)); break; }
    }
}
```
